# Optimizing an MI355X kernel written in HIP

```python
import math
import jax, jax.numpy as jnp
from jax import lax
import numpy as np

D_MODEL = 1024
BATCH = 2
SEQ = 8192
DEPTH = 1

EPS = 1e-6
A_GROUPS = 8
A_GROUP_DIM = D_MODEL // A_GROUPS
A_WIDTH = A_GROUPS * A_GROUP_DIM
CHUNK = 128
B_HEADS = 8
B_HEAD_DIM = D_MODEL // 16
B_V_DIM = 2 * B_HEAD_DIM
QK_WIDTH = B_HEADS * 2 * B_HEAD_DIM
B_WIDTH = B_HEADS * B_V_DIM
Q_BLOCK = 128
IN_COLS = 2 * A_WIDTH + 2 * QK_WIDTH + B_WIDTH
N_GROUPS = 4
EXPERTS_PER_GROUP = 8
N_EXPERTS = N_GROUPS * EXPERTS_PER_GROUP
TOP_K = 2
D_EXPERT = D_MODEL // 4
MOE_BLOCK = 128

kernel_name = "hybrid_gmlp_diffattn_hiermoe"


def rmsnorm(x, g):
    xf = x.astype(jnp.float32)
    r = lax.rsqrt(jnp.mean(xf * xf, axis=-1, keepdims=True) + EPS)
    return (xf * r).astype(x.dtype) * g


def chunked_spatial_gating(u, v, g_v, w_s, b_s):
    bsz, s, _ = u.shape
    nc = s // CHUNK
    v = rmsnorm(v.reshape(bsz, s, A_GROUPS, A_GROUP_DIM), g_v)
    v = v.reshape(bsz, nc, CHUNK, A_GROUPS, A_GROUP_DIM)
    causal = jnp.tril(jnp.ones((CHUNK, CHUNK), dtype=bool))
    ws = jnp.where(causal[None], w_s, 0.0)
    z = jnp.einsum('gts,bcsgd->bctgd', ws, v) + b_s.T[None, None, :, :, None]
    return u * z.reshape(bsz, s, A_WIDTH)


def diff_attention(q, k, v, lam, slopes):
    bsz, nh, _, s, hd = q.shape
    nb = s // Q_BLOCK
    key_pos = jnp.arange(s)
    scale = hd ** -0.5

    def block(i):
        start = i * Q_BLOCK
        qb = lax.dynamic_slice_in_dim(q, start, Q_BLOCK, axis=3)
        sc = jnp.einsum('bhcqd,bhckd->bhcqk', qb, k,
                        preferred_element_type=jnp.float32) * scale
        q_pos = start + jnp.arange(Q_BLOCK)
        dist = (q_pos[:, None] - key_pos[None, :]).astype(jnp.float32)
        alibi = -slopes[:, None, None] * jnp.abs(dist)[None]
        sc = jnp.where((dist >= 0)[None, None, None], sc + alibi[None, :, None], -jnp.inf)
        p = jax.nn.softmax(sc, axis=-1)
        a = p[:, :, 0] - lam * p[:, :, 1]
        return jnp.einsum('bhqk,bhkd->bhqd', a.astype(v.dtype), v)

    out = lax.map(block, jnp.arange(nb))
    return out.transpose(1, 2, 0, 3, 4).reshape(bsz, nh, s, v.shape[-1])


def hierarchical_moe(h, w_rg, b_rg, w_re, b_re, w1, w3, w2):
    bsz, s, d = h.shape
    t = h.reshape(-1, d)
    n_tok = t.shape[0]
    g_prob = jax.nn.softmax((t @ w_rg + b_rg).astype(jnp.float32), axis=-1)
    g_gate, g_idx = lax.top_k(g_prob, 1)
    e_logits = (t @ w_re + b_re).astype(jnp.float32).reshape(n_tok, N_GROUPS, EXPERTS_PER_GROUP)
    e_logits = jnp.take_along_axis(e_logits, g_idx[:, :, None], axis=1)[:, 0]
    e_w, e_idx = lax.top_k(jax.nn.softmax(e_logits, axis=-1), TOP_K)
    e_w = e_w / jnp.sum(e_w, axis=-1, keepdims=True)
    weight = g_gate * e_w
    expert_id = g_idx * EXPERTS_PER_GROUP + e_idx
    combine = jnp.sum(jax.nn.one_hot(expert_id, N_EXPERTS, dtype=jnp.float32)
                      * weight[..., None], axis=1)

    def expert_block(args):
        tk, c = args
        hid = jax.nn.silu(jnp.einsum('td,edf->tef', tk, w1)) * jnp.einsum('td,edf->tef', tk, w3)
        hid = hid * c[:, :, None].astype(hid.dtype)
        return jnp.einsum('tef,efd->td', hid, w2)

    y = lax.map(expert_block, (t.reshape(-1, MOE_BLOCK, d),
                               combine.reshape(-1, MOE_BLOCK, N_EXPERTS)))
    return y.reshape(bsz, s, d)


def setup_inputs(seed: int = 0) -> dict:
    key = jax.random.key(seed)
    ks = jax.random.split(key, 32)
    f32 = jnp.float32
    L, D = DEPTH, D_MODEL

    def nrm(k, shape, scale):
        return jax.random.normal(k, shape, f32) * scale

    def gain(k, shape):
        return 1.0 + 0.02 * jax.random.normal(k, shape, f32)

    return {
        "x": jax.random.normal(ks[0], (BATCH, SEQ, D), f32),
        "norm1_g": gain(ks[1], (L, D)),
        "w_in": nrm(ks[2], (L, D, IN_COLS), D ** -0.5),
        "v_norm_g": gain(ks[3], (L, A_GROUPS, A_GROUP_DIM)),
        "w_s": nrm(ks[4], (L, A_GROUPS, CHUNK, CHUNK), CHUNK ** -0.5),
        "b_s": 1.0 + 0.02 * jax.random.normal(ks[5], (L, A_GROUPS, CHUNK), f32),
        "q_norm_g": gain(ks[6], (L, B_HEAD_DIM)),
        "k_norm_g": gain(ks[7], (L, B_HEAD_DIM)),
        "lambda_q1": nrm(ks[8], (L, B_HEAD_DIM), 0.1),
        "lambda_k1": nrm(ks[9], (L, B_HEAD_DIM), 0.1),
        "lambda_q2": nrm(ks[10], (L, B_HEAD_DIM), 0.1),
        "lambda_k2": nrm(ks[11], (L, B_HEAD_DIM), 0.1),
        "sub_norm_g": gain(ks[12], (L, B_V_DIM)),
        "w_up_a": nrm(ks[13], (L, A_WIDTH, D), A_WIDTH ** -0.5),
        "w_up_b": nrm(ks[14], (L, B_WIDTH, D), B_WIDTH ** -0.5),
        "w_gate": nrm(ks[15], (L, D, 2 * D), D ** -0.5),
        "b_gate": nrm(ks[16], (L, 2 * D), 0.02),
        "w_out": nrm(ks[17], (L, D, D), D ** -0.5),
        "norm2_g": gain(ks[18], (L, D)),
        "w_rg": nrm(ks[19], (L, D, N_GROUPS), D ** -0.5),
        "b_rg": nrm(ks[20], (L, N_GROUPS), 0.01),
        "w_re": nrm(ks[21], (L, D, N_EXPERTS), D ** -0.5),
        "b_re": nrm(ks[22], (L, N_EXPERTS), 0.01),
        "w1": nrm(ks[23], (L, N_EXPERTS, D, D_EXPERT), D ** -0.5),
        "w3": nrm(ks[24], (L, N_EXPERTS, D, D_EXPERT), D ** -0.5),
        "w2": nrm(ks[25], (L, N_EXPERTS, D_EXPERT, D), D_EXPERT ** -0.5),
    }


def reference(x, norm1_g, w_in, v_norm_g, w_s, b_s, q_norm_g, k_norm_g,
              lambda_q1, lambda_k1, lambda_q2, lambda_k2, sub_norm_g,
              w_up_a, w_up_b, w_gate, b_gate, w_out, norm2_g,
              w_rg, b_rg, w_re, b_re, w1, w3, w2):
    bsz, s, d = x.shape
    slopes = jnp.exp2(-8.0 * (jnp.arange(B_HEADS) + 1) / B_HEADS)
    splits = [A_WIDTH, 2 * A_WIDTH, 2 * A_WIDTH + QK_WIDTH, 2 * A_WIDTH + 2 * QK_WIDTH]
    for l in range(DEPTH):
        lam_init = 0.8 - 0.6 * math.exp(-0.3 * l)
        h = rmsnorm(x, norm1_g[l])
        proj = h @ w_in[l]
        u, v_a, q, k, v_b = jnp.split(proj, splits, axis=-1)

        y_a = chunked_spatial_gating(u, v_a, v_norm_g[l], w_s[l], b_s[l])

        q = rmsnorm(q.reshape(bsz, s, B_HEADS, 2, B_HEAD_DIM), q_norm_g[l]).transpose(0, 2, 3, 1, 4)
        k = rmsnorm(k.reshape(bsz, s, B_HEADS, 2, B_HEAD_DIM), k_norm_g[l]).transpose(0, 2, 3, 1, 4)
        vb = v_b.reshape(bsz, s, B_HEADS, B_V_DIM).transpose(0, 2, 1, 3)
        lam = (jnp.exp(jnp.sum(lambda_q1[l].astype(jnp.float32) * lambda_k1[l].astype(jnp.float32)))
               - jnp.exp(jnp.sum(lambda_q2[l].astype(jnp.float32) * lambda_k2[l].astype(jnp.float32)))
               + lam_init)
        o = diff_attention(q, k, vb, lam, slopes)
        o = rmsnorm(o, sub_norm_g[l]) * (1.0 - lam_init)
        y_b = o.transpose(0, 2, 1, 3).reshape(bsz, s, B_WIDTH)

        gates = jax.nn.sigmoid(h @ w_gate[l] + b_gate[l])
        g_a, g_b = jnp.split(gates, 2, axis=-1)
        merged = g_a * (y_a @ w_up_a[l]) + g_b * (y_b @ w_up_b[l])
        x = x + merged @ w_out[l]

        h2 = rmsnorm(x, norm2_g[l])
        x = x + hierarchical_moe(h2, w_rg[l], b_rg[l], w_re[l], b_re[l], w1[l], w3[l], w2[l])
    return x
```

```cpp
#include <hip/hip_runtime.h>
#include <hip/hip_cooperative_groups.h>
#include <cstdio>
#include <cstdint>
namespace cg = cooperative_groups;

#ifndef MK_ONE_LAUNCH
#define MK_ONE_LAUNCH 0
#endif

#define LAS __attribute__((address_space(3)))
typedef unsigned short bf16_t;
typedef short bf16x8 __attribute__((ext_vector_type(8)));
typedef short s16x4 __attribute__((ext_vector_type(4)));
typedef float f32x4 __attribute__((ext_vector_type(4)));
typedef float f32x16 __attribute__((ext_vector_type(16)));
typedef float f32x2 __attribute__((ext_vector_type(2)));
typedef unsigned u32x4 __attribute__((ext_vector_type(4)));
typedef unsigned u32x2 __attribute__((ext_vector_type(2)));
typedef __bf16 bf16x2_t __attribute__((ext_vector_type(2)));

constexpr int NB = 2, SEQ = 8192, DM = 1024, M = NB * SEQ;
constexpr int NH = 8;
constexpr int N1 = 7168;
constexpr int NE = 32, DE = 256;
constexpr float EPS = 1e-6f;
constexpr float LOG2E = 1.4426950408889634f;
constexpr float C2 = 0.125f * LOG2E;
constexpr float LAM_INIT = 0.2f;
constexpr int NWAVES = 8, NTHREADS = 512;
constexpr int NPHASE = 10;

constexpr size_t MiB = 1u << 20;
constexpr size_t WS_CTL = 0;
constexpr size_t CTL_ZERO_BYTES = 4096;
constexpr size_t WS_W1T = 1 * MiB;
constexpr size_t WS_WUPT = 15 * MiB;
constexpr size_t WS_WOUTT = 19 * MiB;
constexpr size_t WS_WST = 21 * MiB;
constexpr size_t WS_ROUTE = 22 * MiB;
constexpr size_t WS_XN = 32 * MiB;
constexpr size_t WS_U = 64 * MiB;
constexpr size_t WS_VA = 96 * MiB;
constexpr size_t WS_Q = 128 * MiB;
constexpr size_t WS_K = 160 * MiB;
constexpr size_t WS_VB = 192 * MiB;
constexpr size_t WS_W13T = 160 * MiB;
constexpr size_t WS_W2T = 192 * MiB;
constexpr size_t WS_HID = 208 * MiB;
constexpr size_t WS_HPERM = 64 * MiB;
constexpr size_t WS_YBUF = 64 * MiB;
constexpr size_t WS_END = 256 * MiB;
constexpr size_t RT_TOKE = 0, RT_TOKW = 256 * 1024, RT_TOKPOS = 512 * 1024, RT_ROWW = 768 * 1024;
constexpr int CW_CNT = 0, CW_FILL = 64;

#define LDS_WAIT() asm volatile("s_waitcnt lgkmcnt(0)" ::: "memory")
#define SBAR() __builtin_amdgcn_sched_barrier(0)
__device__ __forceinline__ unsigned cvtpk(float lo, float hi) { f32x2 v = {lo, hi}; bf16x2_t b = __builtin_convertvector(v, bf16x2_t); return __builtin_bit_cast(unsigned, b); }
__device__ __forceinline__ float bf2f(short b) { return __uint_as_float(((unsigned)(unsigned short)b) << 16); }
__device__ __forceinline__ float wave_sum(float v) {
#pragma unroll
    for (int o = 1; o < 64; o <<= 1) v += __shfl_xor(v, o);
    return v;
}
__device__ __forceinline__ void st4(bf16_t* p, f32x4 v) { u32x2 w; w.x = cvtpk(v[0], v[1]); w.y = cvtpk(v[2], v[3]); *(u32x2*)p = w; }
__device__ __forceinline__ f32x4 ld4(const bf16_t* p) { const u32x2 w = *(const u32x2*)p; f32x4 r; r[0] = __uint_as_float(w.x << 16); r[1] = __uint_as_float(w.x & 0xffff0000u); r[2] = __uint_as_float(w.y << 16); r[3] = __uint_as_float(w.y & 0xffff0000u); return r; }

struct Args { const float* in[26]; float* out; unsigned char* ws; int ph_lo, ph_hi; };

struct Frame {
    LAS unsigned char* lds; char* ldsg;
    int tid, lane, wid, blk, G, gw, NGW;
    const Args* a; float* out; unsigned char* ws; unsigned* ctl;
};
enum { I_X = 0, I_N1G, I_WIN, I_VNG, I_WS, I_BS, I_QNG, I_KNG, I_LQ1, I_LK1, I_LQ2, I_LK2, I_SUBG, I_WUPA, I_WUPB, I_WGATE, I_BGATE, I_WOUT, I_N2G, I_WRG, I_BRG, I_WRE, I_BRE, I_W1, I_W3, I_W2 };

__device__ __forceinline__ void wave_gemm(f32x4 (&acc)[2][4], const bf16_t* ap0, const bf16_t* ap1, const bf16_t* bp0, const bf16_t* bp1, const bf16_t* bp2, const bf16_t* bp3, int K) {
#pragma unroll 2
    for (int k0 = 0; k0 < K; k0 += 32) {
        const bf16x8 a0 = *(const bf16x8*)(ap0 + k0), a1 = *(const bf16x8*)(ap1 + k0);
        const bf16x8 b0 = *(const bf16x8*)(bp0 + k0), b1 = *(const bf16x8*)(bp1 + k0), b2 = *(const bf16x8*)(bp2 + k0), b3 = *(const bf16x8*)(bp3 + k0);
        acc[0][0] = __builtin_amdgcn_mfma_f32_16x16x32_bf16(b0, a0, acc[0][0], 0, 0, 0);
        acc[0][1] = __builtin_amdgcn_mfma_f32_16x16x32_bf16(b1, a0, acc[0][1], 0, 0, 0);
        acc[0][2] = __builtin_amdgcn_mfma_f32_16x16x32_bf16(b2, a0, acc[0][2], 0, 0, 0);
        acc[0][3] = __builtin_amdgcn_mfma_f32_16x16x32_bf16(b3, a0, acc[0][3], 0, 0, 0);
        acc[1][0] = __builtin_amdgcn_mfma_f32_16x16x32_bf16(b0, a1, acc[1][0], 0, 0, 0);
        acc[1][1] = __builtin_amdgcn_mfma_f32_16x16x32_bf16(b1, a1, acc[1][1], 0, 0, 0);
        acc[1][2] = __builtin_amdgcn_mfma_f32_16x16x32_bf16(b2, a1, acc[1][2], 0, 0, 0);
        acc[1][3] = __builtin_amdgcn_mfma_f32_16x16x32_bf16(b3, a1, acc[1][3], 0, 0, 0);
    }
}
__device__ __forceinline__ void acc_zero(f32x4 (&acc)[2][4]) {
#pragma unroll
    for (int m = 0; m < 2; ++m)
#pragma unroll
        for (int n = 0; n < 4; ++n) acc[m][n] = (f32x4){0.f, 0.f, 0.f, 0.f};
}

template <class RM>
__device__ __forceinline__ void transpose_item(const float* W, int N, bf16_t* WT, int ldt, int koff, RM rm, LAS float* scr, int item, int lane) {
    const int nblk = N / 32, kb = item / nblk, nb = item % nblk, k0 = 64 * kb, n0 = 32 * nb;
#pragma unroll 8
    for (int i = 0; i < 32; ++i) { const int kk = 2 * i + (lane >> 5); scr[kk * 33 + (lane & 31)] = W[(size_t)(k0 + kk) * N + n0 + (lane & 31)]; }
    LDS_WAIT(); asm volatile("" ::: "memory");
    const int c = lane & 7;
#pragma unroll
    for (int j = 0; j < 4; ++j) { const int n = (lane >> 3) + 8 * j; const LAS float* s = scr + (8 * c) * 33 + n;
        u32x4 o; o.x = cvtpk(s[0 * 33], s[1 * 33]); o.y = cvtpk(s[2 * 33], s[3 * 33]); o.z = cvtpk(s[4 * 33], s[5 * 33]); o.w = cvtpk(s[6 * 33], s[7 * 33]);
        *(u32x4*)(WT + (size_t)rm(n0 + n) * ldt + koff + k0 + 8 * c) = o; }
    LDS_WAIT(); asm volatile("" ::: "memory");
}
struct RmAdd { int off; __device__ __forceinline__ int operator()(int n) const { return off + n; } };
struct RmW13 { int off; __device__ __forceinline__ int operator()(int n) const { return off + (n >> 7) * 256 + (n & 127); } };

__device__ __forceinline__ void p0_prologue(Frame& F) {
    LAS float* scr = (LAS float*)(F.lds + F.wid * 16384);
    bf16_t* W1T = (bf16_t*)(F.ws + WS_W1T); bf16_t* WUPT = (bf16_t*)(F.ws + WS_WUPT); bf16_t* WOUTT = (bf16_t*)(F.ws + WS_WOUTT);
    constexpr int I_A = 16 * 160, I_B = 16 * 64, I_C = 16 * 32;
    constexpr int NITEMS = I_A + I_B + 3 * I_C;
    for (int it = F.gw; it < NITEMS; it += F.NGW) {
        int r = it;
        if (r < I_A) { transpose_item(F.a->in[I_WIN], 5120, W1T, 1024, 0, RmAdd{0}, scr, r, F.lane); continue; } r -= I_A;
        if (r < I_B) { transpose_item(F.a->in[I_WGATE], 2048, W1T, 1024, 0, RmAdd{5120}, scr, r, F.lane); continue; } r -= I_B;
        if (r < I_C) { transpose_item(F.a->in[I_WUPA], 1024, WUPT, 2048, 0, RmAdd{0}, scr, r, F.lane); continue; } r -= I_C;
        if (r < I_C) { transpose_item(F.a->in[I_WUPB], 1024, WUPT, 2048, 1024, RmAdd{0}, scr, r, F.lane); continue; } r -= I_C;
        transpose_item(F.a->in[I_WOUT], 1024, WOUTT, 1024, 0, RmAdd{0}, scr, r, F.lane);
    }
    { bf16_t* WST = (bf16_t*)(F.ws + WS_WST); const float* ws_ = F.a->in[I_WS];
      for (int i = F.blk * NTHREADS + F.tid; i < 8 * 128 * 128 / 2; i += F.G * NTHREADS) { const int e = 2 * i, s = e & 127, t = (e >> 7) & 127;
          const float a = (s <= t) ? ws_[e] : 0.f, b = (s + 1 <= t) ? ws_[e + 1] : 0.f; *(unsigned*)(WST + e) = cvtpk(a, b); } }
    { bf16_t* XN = (bf16_t*)(F.ws + WS_XN); const float* x = F.a->in[I_X]; const f32x4* g4 = (const f32x4*)F.a->in[I_N1G] + F.lane;
      for (int m = F.gw; m < M; m += F.NGW) { const f32x4* xr = (const f32x4*)(x + (size_t)m * DM) + F.lane;
          f32x4 v[4]; float s = 0.f;
#pragma unroll
          for (int j = 0; j < 4; ++j) { v[j] = xr[64 * j]; s += (v[j][0] * v[j][0] + v[j][1] * v[j][1]) + (v[j][2] * v[j][2] + v[j][3] * v[j][3]); }
          const float r = rsqrtf(wave_sum(s) * (1.f / DM) + EPS);
#pragma unroll
          for (int j = 0; j < 4; ++j) { const f32x4 g = g4[64 * j]; st4(XN + (size_t)m * DM + 4 * F.lane + 256 * j, (v[j] * r) * g); } } }
}

__device__ __forceinline__ void p1_proj(Frame& F) {
    const bf16_t* XN = (const bf16_t*)(F.ws + WS_XN); const bf16_t* W1T = (const bf16_t*)(F.ws + WS_W1T);
    bf16_t* U = (bf16_t*)(F.ws + WS_U); bf16_t* VA = (bf16_t*)(F.ws + WS_VA); bf16_t* Q = (bf16_t*)(F.ws + WS_Q); bf16_t* Kb = (bf16_t*)(F.ws + WS_K); bf16_t* VB = (bf16_t*)(F.ws + WS_VB);
    bf16_t* GATE = (bf16_t*)F.out;
    const int fr = F.lane & 15, fq = F.lane >> 4, wm = F.wid >> 1, wn = F.wid & 1;
    constexpr int TN = N1 / 128;
    for (int L = F.blk; L < (M / 128) * TN; L += F.G) {
        const int tm = L / TN, tn = L % TN, row0 = tm * 128 + 32 * wm, col0 = tn * 128 + 64 * wn;
        const bf16_t* ap = XN + (size_t)(row0 + fr) * DM + 8 * fq; const bf16_t* bp = W1T + (size_t)(col0 + fr) * DM + 8 * fq;
        f32x4 acc[2][4]; acc_zero(acc);
        wave_gemm(acc, ap, ap + 16 * DM, bp, bp + 16 * DM, bp + 32 * DM, bp + 48 * DM, DM);
        const int seg = col0 >> 10;
        if (seg <= 1 || seg == 4) { bf16_t* dst = (seg == 0 ? U : seg == 1 ? VA : VB) + (col0 & 1023) + 4 * fq;
#pragma unroll
            for (int m = 0; m < 2; ++m)
#pragma unroll
                for (int n = 0; n < 4; ++n) st4(dst + (size_t)(row0 + 16 * m + fr) * DM + 16 * n, acc[m][n]);
        } else if (seg == 2 || seg == 3) {
            const float* g = F.a->in[seg == 2 ? I_QNG : I_KNG]; bf16_t* dst = (seg == 2 ? Q : Kb) + (col0 & 1023) + 4 * fq; const float sc = seg == 2 ? C2 : 1.f;
            f32x4 gv[4];
#pragma unroll
            for (int n = 0; n < 4; ++n) gv[n] = *(const f32x4*)(g + 16 * n + 4 * fq);
#pragma unroll
            for (int m = 0; m < 2; ++m) { float ss = 0.f;
#pragma unroll
                for (int n = 0; n < 4; ++n) { const f32x4 a = acc[m][n]; ss += (a[0] * a[0] + a[1] * a[1]) + (a[2] * a[2] + a[3] * a[3]); }
                ss += __shfl_xor(ss, 16); ss += __shfl_xor(ss, 32);
                const float r = rsqrtf(ss * (1.f / 64.f) + EPS);
#pragma unroll
                for (int n = 0; n < 4; ++n) st4(dst + (size_t)(row0 + 16 * m + fr) * DM + 16 * n, ((acc[m][n] * r) * gv[n]) * sc); }
        } else { const int c = col0 - 5120 + 4 * fq; const float* bg = F.a->in[I_BGATE] + c;
#pragma unroll
            for (int n = 0; n < 4; ++n) { const f32x4 b = *(const f32x4*)(bg + 16 * n);
#pragma unroll
                for (int m = 0; m < 2; ++m) { f32x4 v = acc[m][n] + b;
#pragma unroll
                    for (int j = 0; j < 4; ++j) v[j] = 1.f / (1.f + __expf(-v[j]));
                    st4(GATE + (size_t)(row0 + 16 * m + fr) * 2048 + c + 16 * n, v); } }
        }
    }
}

__device__ __forceinline__ void p2_mixer_a(Frame& F) {
    const bf16_t* VA = (const bf16_t*)(F.ws + WS_VA); bf16_t* U = (bf16_t*)(F.ws + WS_U); const bf16_t* WST = (const bf16_t*)(F.ws + WS_WST);
    const float* gv = F.a->in[I_VNG]; const float* bs = F.a->in[I_BS];
    bf16_t* vT = (bf16_t*)F.ldsg;
    const int fr = F.lane & 15, fq = F.lane >> 4, wm = F.wid >> 1, wn = F.wid & 1;
    for (int L = F.blk; L < 1024; L += F.G) {
        const int c = L >> 3, g = L & 7;
        { const int s = F.tid >> 2, ds = (F.tid & 3) * 32; const bf16_t* src = VA + (size_t)(c * 128 + s) * DM + g * 128 + ds;
          bf16x8 v[4]; float ss = 0.f;
#pragma unroll
          for (int i = 0; i < 4; ++i) { v[i] = *(const bf16x8*)(src + 8 * i);
#pragma unroll
              for (int j = 0; j < 8; ++j) { const float x = bf2f(v[i][j]); ss += x * x; } }
          ss += __shfl_xor(ss, 1); ss += __shfl_xor(ss, 2);
          const float r = rsqrtf(ss * (1.f / 128.f) + EPS);
#pragma unroll
          for (int i = 0; i < 4; ++i)
#pragma unroll
              for (int j = 0; j < 8; ++j) { const int d = ds + 8 * i + j; const float x = (bf2f(v[i][j]) * r) * gv[g * 128 + d]; vT[d * 136 + s] = (bf16_t)(cvtpk(x, 0.f) & 0xffffu); } }
        __syncthreads();
        const bf16_t* ap = WST + g * 16384 + (32 * wm + fr) * 128 + 8 * fq; const bf16_t* bp = vT + (64 * wn + fr) * 136 + 8 * fq;
        f32x4 acc[2][4]; acc_zero(acc);
        wave_gemm(acc, ap, ap + 16 * 128, bp, bp + 16 * 136, bp + 32 * 136, bp + 48 * 136, 32 * (wm + 1));
#pragma unroll
        for (int m = 0; m < 2; ++m) { const int t = 32 * wm + 16 * m + fr; const float b = bs[g * 128 + t]; bf16_t* up = U + (size_t)(c * 128 + t) * DM + g * 128 + 64 * wn + 4 * fq;
#pragma unroll
            for (int n = 0; n < 4; ++n) { const f32x4 u = ld4(up + 16 * n); st4(up + 16 * n, u * (acc[m][n] + b)); } }
        __syncthreads();
    }
}

namespace att {
constexpr int QBLK = 32, KVBLK = 64, QB = 128, PITCH = 1024;
constexpr int SHM_V = KVBLK * 128 * 2, SHM_K = 2 * KVBLK * 64 * 2;
constexpr int LDS_WSF = 2 * SHM_V + 2 * SHM_K, LDS_XCH = LDS_WSF + NWAVES * 64 * 4, LDS_BYTES = LDS_XCH + 4 * 16 * 4 * 64 * 4;
constexpr float THR2 = 8.f * LOG2E;
#define KSWZ64(row, colB) ((row) * 128 + ((colB) ^ ((((row) >> 1) & 7) << 4)))
__device__ __forceinline__ int v_st(int k, int c) { const int kk = (k & ~0xC) | ((k & 4) << 1) | ((k & 8) >> 1); return ((kk >> 3) * 4 + (c >> 5)) * 512 + ((kk & 7) * 32 + (c & 31)) * 2; }
__device__ __forceinline__ int v_rd_base(int lane) { return ((lane & 3) << 3) | (((lane >> 2) & 3) << 6) | (((lane >> 4) & 1) << 5) | (((lane >> 5) & 1) << 8); }
constexpr int v_rd_off(int d0, int ks, int half) { return d0 * 512 + ks * 4096 + half * 2048; }
__device__ __forceinline__ int crow(int r, int hi) { return (r & 3) + 8 * (r >> 2) + 4 * hi; }

__device__ __forceinline__ void mask_tile(f32x16& p0, f32x16& p1, int dq) {
    const float NEG = -__builtin_inff();
#pragma unroll
    for (int r = 0; r < 16; ++r) { const int c = (r & 3) + 8 * (r >> 2);
        if (dq - c < 0) p0[r] = NEG;
        if (dq - c - 32 < 0) p1[r] = NEG; }
}
__device__ __forceinline__ void partialSM(f32x16& p0, f32x16& p1, float& m_reg, float& mn, float& alpha) {
    float pmax = p0[0];
#pragma unroll
    for (int r = 1; r < 16; ++r) pmax = fmaxf(pmax, p0[r]);
#pragma unroll
    for (int r = 0; r < 16; ++r) pmax = fmaxf(pmax, p1[r]);
    { auto rr = __builtin_amdgcn_permlane32_swap(__float_as_uint(pmax), __float_as_uint(pmax), false, false);
      pmax = fmaxf(__uint_as_float(rr[0]), __uint_as_float(rr[1])); }
    if (__builtin_expect(__all((pmax - m_reg) <= THR2), 1)) { mn = m_reg; alpha = 1.f; }
    else { mn = fmaxf(m_reg, pmax); alpha = __builtin_amdgcn_exp2f(m_reg - mn); m_reg = mn; }
#pragma unroll
    for (int r = 0; r < 16; ++r) p0[r] = p0[r] - mn;
#pragma unroll
    for (int r = 0; r < 16; ++r) p1[r] = p1[r] - mn;
#pragma unroll
    for (int r = 0; r < 16; ++r) p0[r] = __builtin_amdgcn_exp2f(p0[r]);
}
__device__ __forceinline__ void finishSM(f32x16& p0, f32x16& p1, float alpha, float& l_reg, bf16x8& pa0, bf16x8& pa1, bf16x8& pa2, bf16x8& pa3) {
#pragma unroll
    for (int r = 0; r < 16; ++r) p1[r] = __builtin_amdgcn_exp2f(p1[r]);
    float ps = 0;
#pragma unroll
    for (int r = 0; r < 16; ++r) ps += p0[r];
#pragma unroll
    for (int r = 0; r < 16; ++r) ps += p1[r];
    { auto rr = __builtin_amdgcn_permlane32_swap(__float_as_uint(ps), __float_as_uint(ps), false, false);
      ps = __uint_as_float(rr[0]) + __uint_as_float(rr[1]); }
    l_reg = l_reg * alpha + ps;
#define PK4(P, B_, OUT) do { unsigned a0 = cvtpk(P[B_+0], P[B_+1]), a1 = cvtpk(P[B_+2], P[B_+3]);                          \
        unsigned b0 = cvtpk(P[B_+4], P[B_+5]), b1 = cvtpk(P[B_+6], P[B_+7]);                                             \
        auto r0 = __builtin_amdgcn_permlane32_swap(a0, b0, false, false); auto r1 = __builtin_amdgcn_permlane32_swap(a1, b1, false, false); \
        u32x4 w = {r0[0], r1[0], r0[1], r1[1]}; OUT = __builtin_bit_cast(bf16x8, w); } while (0)
    PK4(p0, 0, pa0); PK4(p0, 8, pa1); PK4(p1, 0, pa2); PK4(p1, 8, pa3);
#undef PK4
}
template <int KB>
__device__ __forceinline__ void qkt(f32x16& p0, f32x16& p1, const char* Kmap_lds, int r32, int hi, const bf16x8* qr, bf16x8 kx0, bf16x8 kx1, bf16x8 qx) {
    p0 = __builtin_amdgcn_mfma_f32_32x32x16_bf16(kx0, qx, f32x16{}, 0, 0, 0); p1 = __builtin_amdgcn_mfma_f32_32x32x16_bf16(kx1, qx, f32x16{}, 0, 0, 0);
#pragma unroll
    for (int d0 = 0; d0 < 4; ++d0) { const char* a = Kmap_lds + KB * SHM_K + KSWZ64(r32, (d0 * 16 + hi * 8) * 2);
        const bf16x8 b0 = *reinterpret_cast<const bf16x8*>(a);
        const bf16x8 b1 = *reinterpret_cast<const bf16x8*>(a + 32 * 128);
        p0 = __builtin_amdgcn_mfma_f32_32x32x16_bf16(b0, qr[d0], p0, 0, 0, 0);
        p1 = __builtin_amdgcn_mfma_f32_32x32x16_bf16(b1, qr[d0], p1, 0, 0, 0); }
}
template <int VB>
__device__ __forceinline__ void pv_tile(f32x16* o, int vb0, bf16x8 pa0, bf16x8 pa1, bf16x8 pa2, bf16x8 pa3) {
#define TRRD(dst, off) asm volatile("ds_read_b64_tr_b16 %0, %1 offset:%2" : "=&v"(dst) : "v"(vb0), "i"(off) : "memory")
#define PV_D0(d0) do { s16x4 l0, l1, l2, l3, h0, h1, h2, h3; constexpr int b_ = VB * SHM_V + v_rd_off(d0, 0, 0); \
        TRRD(l0, b_); TRRD(h0, b_ + 2048); TRRD(l1, b_ + 4096); TRRD(h1, b_ + 6144); TRRD(l2, b_ + 8192); TRRD(h2, b_ + 10240); TRRD(l3, b_ + 12288); TRRD(h3, b_ + 14336); \
        asm volatile("s_waitcnt lgkmcnt(0)" ::: "memory"); SBAR();   \
        o[d0] = __builtin_amdgcn_mfma_f32_32x32x16_bf16(pa0, (bf16x8){l0[0], l0[1], l0[2], l0[3], h0[0], h0[1], h0[2], h0[3]}, o[d0], 0, 0, 0);   \
        o[d0] = __builtin_amdgcn_mfma_f32_32x32x16_bf16(pa1, (bf16x8){l1[0], l1[1], l1[2], l1[3], h1[0], h1[1], h1[2], h1[3]}, o[d0], 0, 0, 0);   \
        o[d0] = __builtin_amdgcn_mfma_f32_32x32x16_bf16(pa2, (bf16x8){l2[0], l2[1], l2[2], l2[3], h2[0], h2[1], h2[2], h2[3]}, o[d0], 0, 0, 0);   \
        o[d0] = __builtin_amdgcn_mfma_f32_32x32x16_bf16(pa3, (bf16x8){l3[0], l3[1], l3[2], l3[3], h3[0], h3[1], h3[2], h3[3]}, o[d0], 0, 0, 0); } while (0)
    PV_D0(0); PV_D0(1); PV_D0(2); PV_D0(3);
#undef PV_D0
#undef TRRD
}

__device__ __forceinline__ bf16x8 qx_of(unsigned sdw, float tb) {
    const unsigned h_ = cvtpk(tb, 0.f) & 0xffffu; const float lo_ = tb - __uint_as_float(h_ << 16);
    return __builtin_bit_cast(bf16x8, (u32x4){sdw, h_ | (cvtpk(lo_, 0.f) << 16), 0u, 0u});
}
struct BlockRef { int base; int P0; int jlo; float slope2; };
#define BR_Q(br) ((const bf16_t*)(wsb + WS_Q) + (br).base)
#define BR_K(br) ((const bf16_t*)(wsb + WS_K) + (br).base)
#define BR_V(br) ((const bf16_t*)(wsb + WS_VB) + (br).base)
#define BR_O(br) ((bf16_t*)(wsb + WS_Q) + (br).base)
struct Seam { bf16x8 qr[4]; bf16x8 st_v0, st_v1, st_k0, st_k1; };
#define VMW() asm volatile("s_waitcnt vmcnt(0)" ::: "memory")
#define VMWN(n) asm volatile("s_waitcnt vmcnt(%0)" :: "i"(n) : "memory")
#define BLD(soff) __builtin_bit_cast(bf16x8, __builtin_amdgcn_raw_buffer_load_b128(rsrc, voff, (int)(soff), 0))
#define SLOAD_H(br, k0) do { const unsigned so_ = (unsigned)((br).base + (k0) * PITCH) * 2u;                                  \
                         S.st_v0 = BLD((unsigned)WS_VB + so_); S.st_v1 = BLD((unsigned)WS_VB + so_ + 32u * PITCH * 2u);              \
                         S.st_k0 = BLD((unsigned)WS_K + so_); S.st_k1 = BLD((unsigned)WS_K + so_ + 32u * PITCH * 2u); } while (0)
#define SWRITE_HK(bf) do { *(bf16x8*)(K_lds + (bf) * SHM_K + kws) = S.st_k0; *(bf16x8*)(K_lds + (bf) * SHM_K + kws + 32 * 128) = S.st_k1; } while (0)
#define SWRITE_HV(bf) do { *(bf16x8*)(V_lds + (bf) * SHM_V + vst0) = S.st_v0; *(bf16x8*)(V_lds + (bf) * SHM_V + vst1) = S.st_v1; } while (0)
#define SWRITE_H(bf) do { SWRITE_HV(bf); SWRITE_HK(bf); } while (0)
__device__ __forceinline__ void attn_prime(const unsigned char* wsb, const BlockRef& cur, char* lds, Seam& S) {
    const int tid = threadIdx.x, wid = __builtin_amdgcn_readfirstlane(tid >> 6), lane = tid & 63, r32 = lane & 31, hi = lane >> 5;
    const int map = wid >> 2, rw = wid & 3;
    const int sr = tid >> 4, sc = (tid & 15) * 8, kws = (sc >> 6) * 8192 + KSWZ64(sr, (sc & 63) * 2); char* K_lds = lds + 2 * SHM_V;
    const int voff = (sr * PITCH + sc) * 2; const __amdgpu_buffer_rsrc_t rsrc = __builtin_amdgcn_make_buffer_rsrc((void*)wsb, 0, 0x10000000, 0x00020000);
    const int kb0 = cur.jlo * KVBLK;
#pragma unroll
    for (int d0 = 0; d0 < 4; ++d0) S.qr[d0] = *(const bf16x8*)(BR_Q(cur) + (size_t)(cur.P0 + rw * QBLK + r32) * PITCH + map * 64 + d0 * 16 + hi * 8);
    SLOAD_H(cur, kb0); VMW(); SWRITE_HK(0);
    __syncthreads();
}
__device__ __forceinline__ void attn_block(unsigned char* wsb, const BlockRef& cur, const BlockRef& nxt, char* lds, Seam& S, float lam, const float* subg) {
    const int tid = threadIdx.x, wid = __builtin_amdgcn_readfirstlane(tid >> 6), lane = tid & 63, r32 = lane & 31, hi = lane >> 5;
    const int map = wid >> 2, rw = wid & 3;
    const int j_lo = cur.jlo, j_hi = cur.P0 / KVBLK + 2, NT = j_hi - j_lo;
    const int kbn = nxt.jlo * KVBLK;
    const int qlo = cur.P0 + rw * QBLK, qm = qlo + r32 - 4 * hi;
    const float slope2 = cur.slope2; const int qpos = qlo + r32;
    unsigned sdw; { const unsigned h_ = cvtpk(slope2, 0.f) & 0xffffu; const float lo_ = slope2 - __uint_as_float(h_ << 16); sdw = h_ | (cvtpk(lo_, 0.f) << 16); }
    bf16x8 kx0, kx1; { const unsigned c0 = cvtpk((float)r32, (float)r32), c1 = cvtpk((float)(r32 + 32), (float)(r32 + 32)), one = hi ? 0u : 0x3f803f80u;
        kx0 = __builtin_bit_cast(bf16x8, (u32x4){hi ? 0u : c0, one, 0u, 0u}); kx1 = __builtin_bit_cast(bf16x8, (u32x4){hi ? 0u : c1, one, 0u, 0u}); }
    char* V_lds = lds; char* K_lds = lds + 2 * SHM_V; const char* Kmap = K_lds + map * 8192;
    float* ws = (float*)(lds + LDS_WSF) + wid * 64; float* li_l = ws, * al_l = ws + 32;
    float m_reg = -1e30f, l_reg = 0; f32x16 o[4] = {};
    const int sr = tid >> 4, sc = (tid & 15) * 8, vst0 = v_st(sr, sc), vst1 = v_st(32 + sr, sc), kws = (sc >> 6) * 8192 + KSWZ64(sr, (sc & 63) * 2);
    const int vb0 = (int)(uintptr_t)V_lds + v_rd_base(lane);
    const int voff = (sr * PITCH + sc) * 2; const __amdgpu_buffer_rsrc_t rsrc = __builtin_amdgcn_make_buffer_rsrc((void*)wsb, 0, 0x10000000, 0x00020000);
#define RESC(a) do { if (__any((a) < 1.f)) { if (hi == 0) al_l[r32] = (a); asm volatile("s_waitcnt lgkmcnt(0)" ::: "memory");              \
                     _Pragma("unroll") for (int d_ = 0; d_ < 4; ++d_) _Pragma("unroll") for (int r = 0; r < 16; ++r) o[d_][r] *= al_l[crow(r, hi)]; } } while (0)
#define KBASE(t) ((j_lo + (t)) * KVBLK)
#define MASKT(P0_, P1_, t) do { const int kb_ = KBASE(t); if (kb_ + KVBLK - 1 > qlo) mask_tile(P0_, P1_, qm - kb_); } while (0)
#define QX(t) qx_of(sdw, slope2 * (float)(KBASE(t) - qpos))
#define SEAM_K0() do { VMWN(4); SWRITE_HK(0); SBAR(); } while (0)
    f32x16 pA0, pA1, pB0, pB1; float mnA, mnB, alA, alB; bf16x8 pa0, pa1, pa2, pa3;
    SWRITE_HV(0); SBAR();
    if (NT > 1) { SLOAD_H(cur, KBASE(1)); }
    SBAR(); qkt<0>(pA0, pA1, Kmap, r32, hi, S.qr, kx0, kx1, QX(0));
    MASKT(pA0, pA1, 0); partialSM(pA0, pA1, m_reg, mnA, alA);
    if (NT > 1) { VMW(); SWRITE_H(1); }
    __syncthreads();
#define HALF_STEP(PX0, PX1, mnX, alX, PY0, PY1, alY, t, KB, VB, SB) do {                                                      \
        SBAR(); qkt<KB>(PX0, PX1, Kmap, r32, hi, S.qr, kx0, kx1, QX(t));                                                           \
        finishSM(PY0, PY1, alY, l_reg, pa0, pa1, pa2, pa3); SBAR();                                                           \
        if ((t) + 1 < NT) { SLOAD_H(cur, KBASE((t) + 1)); SBAR(); }                                               \
        pv_tile<VB>(o, vb0, pa0, pa1, pa2, pa3); MASKT(PX0, PX1, (t)); partialSM(PX0, PX1, m_reg, mnX, alX);                                        \
        __syncthreads();                                                                                                      \
        if ((t) + 1 < NT) { VMW(); SWRITE_H(SB); }                                                                          \
        RESC(alX); __syncthreads(); } while (0)
    for (int t = 1; t + 1 < NT; t += 2) {
        HALF_STEP(pB0, pB1, mnB, alB, pA0, pA1, alA, t, 1, 0, 0);
        HALF_STEP(pA0, pA1, mnA, alA, pB0, pB1, alB, t + 1, 0, 1, 1);
    }
    const bool even = (NT & 1) == 0;
    if (even) { SBAR(); qkt<1>(pB0, pB1, Kmap, r32, hi, S.qr, kx0, kx1, QX(NT - 1)); SBAR(); }
    { const int nmap = map, nrw = rw;
      SLOAD_H(nxt, kbn); SBAR();
#pragma unroll
      for (int d0 = 0; d0 < 4; ++d0) S.qr[d0] = *(const bf16x8*)(BR_Q(nxt) + (size_t)(nxt.P0 + nrw * QBLK + r32) * PITCH + nmap * 64 + d0 * 16 + hi * 8); }
    SBAR();
    finishSM(pA0, pA1, alA, l_reg, pa0, pa1, pa2, pa3); SBAR();
    pv_tile<0>(o, vb0, pa0, pa1, pa2, pa3);
    if (even) { MASKT(pB0, pB1, NT - 1); partialSM(pB0, pB1, m_reg, mnB, alB); __syncthreads(); RESC(alB);
        finishSM(pB0, pB1, alB, l_reg, pa0, pa1, pa2, pa3); SBAR(); pv_tile<1>(o, vb0, pa0, pa1, pa2, pa3); }
    SBAR(); SEAM_K0();
    if (hi == 0) li_l[r32] = l_reg; asm volatile("s_waitcnt lgkmcnt(0)" ::: "memory");
    float rli[16];
#pragma unroll
    for (int r = 0; r < 16; ++r) rli[r] = __builtin_amdgcn_rcpf(li_l[crow(r, hi)]);
    float* xch = (float*)(lds + LDS_XCH) + (size_t)rw * (16 * 4 * 64) + lane;
    if (map == 1) {
#pragma unroll
        for (int r = 0; r < 16; ++r)
#pragma unroll
            for (int d0 = 0; d0 < 4; ++d0) xch[(r * 4 + d0) * 64] = o[d0][r] * rli[r];
    }
    __syncthreads();
    if (map == 0) {
        float gsub[4];
#pragma unroll
        for (int d0 = 0; d0 < 4; ++d0) gsub[d0] = subg[d0 * 32 + r32] * (1.f - LAM_INIT);
        int obase = (cur.P0 + rw * QBLK + 4 * hi) * PITCH + r32; asm volatile("" : "+v"(obase));
        bf16_t* Ow = BR_O(cur) + obase;
#pragma unroll
        for (int r = 0; r < 16; ++r) { float d[4]; float ss = 0.f;
#pragma unroll
            for (int d0 = 0; d0 < 4; ++d0) { d[d0] = o[d0][r] * rli[r] - lam * xch[(r * 4 + d0) * 64]; ss += d[d0] * d[d0]; }
            ss += __shfl_xor(ss, 1); ss += __shfl_xor(ss, 2); ss += __shfl_xor(ss, 4); ss += __shfl_xor(ss, 8); ss += __shfl_xor(ss, 16);
            const float rs = rsqrtf(ss * (1.f / 128.f) + EPS); const int orow = (r & 3) + 8 * (r >> 2);
#pragma unroll
            for (int d0 = 0; d0 < 4; ++d0) { const float v = (d[d0] * rs) * gsub[d0]; const float vn = __shfl_xor(v, 1);
                if ((r32 & 1) == 0) *(unsigned*)(Ow + orow * PITCH + d0 * 32) = cvtpk(v, vn); } }
    }
    __syncthreads();
#undef RESC
#undef KBASE
#undef MASKT
#undef QX
#undef SEAM_K0
#undef HALF_STEP
}
#undef BLD
#undef BR_Q
#undef BR_K
#undef BR_V
#undef BR_O
#undef VMW
#undef VMWN
#undef SLOAD_H
#undef SWRITE_HK
#undef SWRITE_HV
#undef SWRITE_H
}

__device__ __forceinline__ att::BlockRef attn_ref(Frame& F, int L) {
    const int qb = 63 - (L >> 4), bh = L & 15, b = bh >> 3, h = bh & 7;
    att::BlockRef r; r.base = b * SEQ * 1024 + h * 128;
    r.P0 = qb * 128; r.jlo = 0; r.slope2 = exp2f(-(float)(h + 1)) * LOG2E;
    return r;
}
__device__ __forceinline__ int attn_unit_of(int i, int blk, int G) { return i * G + ((i & 1) ? (G - 1 - blk) : blk); }
__device__ __forceinline__ void p2_attention(Frame& F) {
    float s1 = 0.f, s2 = 0.f;
    for (int i = 0; i < 64; ++i) { s1 += F.a->in[I_LQ1][i] * F.a->in[I_LK1][i]; s2 += F.a->in[I_LQ2][i] * F.a->in[I_LK2][i]; }
    const float lam = expf(s1) - expf(s2) + LAM_INIT;
    constexpr int NUNITS = 1024;
    int i = 0; int L = attn_unit_of(0, F.blk, F.G); if (L >= NUNITS) return;
    att::BlockRef cur = attn_ref(F, L); att::Seam S;
    __syncthreads();
    att::attn_prime(F.ws, cur, F.ldsg, S);
    for (;;) {
        const int Ln = attn_unit_of(i + 1, F.blk, F.G); const bool last = Ln >= NUNITS;
        const att::BlockRef nxt = last ? cur : attn_ref(F, Ln);
        att::attn_block(F.ws, cur, nxt, F.ldsg, S, lam, F.a->in[I_SUBG]);
        if (last) break;
        cur = nxt; ++i;
    }
}

__device__ __forceinline__ void p3_merged(Frame& F) {
    const bf16_t* YA = (const bf16_t*)(F.ws + WS_U); const bf16_t* YB = (const bf16_t*)(F.ws + WS_Q); const bf16_t* WUPT = (const bf16_t*)(F.ws + WS_WUPT);
    const bf16_t* GATE = (const bf16_t*)F.out; bf16_t* MG = (bf16_t*)(F.ws + WS_XN);
    const int fr = F.lane & 15, fq = F.lane >> 4, wm = F.wid >> 1, wn = F.wid & 1;
    for (int L = F.blk; L < 1024; L += F.G) {
        const int tm = L >> 3, tn = L & 7, row0 = tm * 128 + 32 * wm, col0 = tn * 128 + 64 * wn;
        const bf16_t* apa = YA + (size_t)(row0 + fr) * DM + 8 * fq; const bf16_t* apb = YB + (size_t)(row0 + fr) * DM + 8 * fq; const bf16_t* bp = WUPT + (size_t)(col0 + fr) * 2048 + 8 * fq;
        f32x4 accA[2][4], accB[2][4]; acc_zero(accA); acc_zero(accB);
        wave_gemm(accA, apa, apa + 16 * DM, bp, bp + 16 * 2048, bp + 32 * 2048, bp + 48 * 2048, DM);
        wave_gemm(accB, apb, apb + 16 * DM, bp + 1024, bp + 1024 + 16 * 2048, bp + 1024 + 32 * 2048, bp + 1024 + 48 * 2048, DM);
#pragma unroll
        for (int m = 0; m < 2; ++m)
#pragma unroll
            for (int n = 0; n < 4; ++n) { const size_t row = row0 + 16 * m + fr; const int col = col0 + 16 * n + 4 * fq;
                const f32x4 ga = ld4(GATE + row * 2048 + col), gb = ld4(GATE + row * 2048 + 1024 + col);
                st4(MG + row * DM + col, ga * accA[m][n] + gb * accB[m][n]); }
    }
}
__device__ __forceinline__ void p4_out(Frame& F) {
    const bf16_t* MG = (const bf16_t*)(F.ws + WS_XN); const bf16_t* WOUTT = (const bf16_t*)(F.ws + WS_WOUTT); const float* x = F.a->in[I_X];
    const int fr = F.lane & 15, fq = F.lane >> 4, wm = F.wid >> 1, wn = F.wid & 1;
    for (int L = F.blk; L < 1024; L += F.G) {
        const int tm = L >> 3, tn = L & 7, row0 = tm * 128 + 32 * wm, col0 = tn * 128 + 64 * wn;
        const bf16_t* ap = MG + (size_t)(row0 + fr) * DM + 8 * fq; const bf16_t* bp = WOUTT + (size_t)(col0 + fr) * DM + 8 * fq;
        f32x4 acc[2][4]; acc_zero(acc);
        wave_gemm(acc, ap, ap + 16 * DM, bp, bp + 16 * DM, bp + 32 * DM, bp + 48 * DM, DM);
#pragma unroll
        for (int m = 0; m < 2; ++m)
#pragma unroll
            for (int n = 0; n < 4; ++n) { const size_t off = (size_t)(row0 + 16 * m + fr) * DM + col0 + 16 * n + 4 * fq;
                *(f32x4*)(F.out + off) = *(const f32x4*)(x + off) + acc[m][n]; }
    }
}
__device__ __forceinline__ void h2_row(Frame& F, int t, f32x4 (&h)[4]) {
    const f32x4* xr = (const f32x4*)(F.out + (size_t)t * DM) + F.lane; const f32x4* g4 = (const f32x4*)F.a->in[I_N2G] + F.lane;
    float s = 0.f;
#pragma unroll
    for (int j = 0; j < 4; ++j) { h[j] = xr[64 * j]; s += (h[j][0] * h[j][0] + h[j][1] * h[j][1]) + (h[j][2] * h[j][2] + h[j][3] * h[j][3]); }
    const float r = rsqrtf(wave_sum(s) * (1.f / DM) + EPS);
#pragma unroll
    for (int j = 0; j < 4; ++j) h[j] = (h[j] * r) * g4[64 * j];
}
__device__ __forceinline__ void p5_router(Frame& F) {
    const float* wrg = F.a->in[I_WRG]; const float* wre = F.a->in[I_WRE]; const float* brg = F.a->in[I_BRG]; const float* bre = F.a->in[I_BRE];
    int* toke = (int*)(F.ws + WS_ROUTE + RT_TOKE); float* tokw = (float*)(F.ws + WS_ROUTE + RT_TOKW);
    for (int t = F.gw; t < M; t += F.NGW) {
        f32x4 h[4]; h2_row(F, t, h);
        f32x4 gl = {0.f, 0.f, 0.f, 0.f};
#pragma unroll
        for (int j = 0; j < 4; ++j)
#pragma unroll
            for (int e = 0; e < 4; ++e) { const int k = 256 * j + 4 * F.lane + e; gl += *(const f32x4*)(wrg + (size_t)k * 4) * h[j][e]; }
#pragma unroll
        for (int i = 0; i < 4; ++i) gl[i] = wave_sum(gl[i]) + brg[i];
        int g = 0; float gm = gl[0];
#pragma unroll
        for (int i = 1; i < 4; ++i) if (gl[i] > gm) { gm = gl[i]; g = i; }
        float gs = 0.f;
#pragma unroll
        for (int i = 0; i < 4; ++i) gs += expf(gl[i] - gm);
        const float ggate = 1.f / gs;
        f32x4 ea = {0.f, 0.f, 0.f, 0.f}, eb = {0.f, 0.f, 0.f, 0.f};
#pragma unroll
        for (int j = 0; j < 4; ++j)
#pragma unroll
            for (int e = 0; e < 4; ++e) { const int k = 256 * j + 4 * F.lane + e; const float* wp = wre + (size_t)k * 32 + g * 8;
                ea += *(const f32x4*)wp * h[j][e]; eb += *(const f32x4*)(wp + 4) * h[j][e]; }
        float el[8];
#pragma unroll
        for (int i = 0; i < 4; ++i) { el[i] = wave_sum(ea[i]) + bre[g * 8 + i]; el[4 + i] = wave_sum(eb[i]) + bre[g * 8 + 4 + i]; }
        int i1 = 0; float v1 = el[0];
#pragma unroll
        for (int i = 1; i < 8; ++i) if (el[i] > v1) { v1 = el[i]; i1 = i; }
        int i2 = -1; float v2 = -__builtin_inff();
#pragma unroll
        for (int i = 0; i < 8; ++i) if (i != i1 && el[i] > v2) { v2 = el[i]; i2 = i; }
        const float a = expf(v2 - v1), w1 = 1.f / (1.f + a), w2 = a / (1.f + a);
        if (F.lane == 0) { const int e1 = g * 8 + i1, e2 = g * 8 + i2;
            toke[2 * t] = e1; toke[2 * t + 1] = e2; tokw[2 * t] = ggate * w1; tokw[2 * t + 1] = ggate * w2;
            atomicAdd(F.ctl + CW_CNT + e1, 1u); atomicAdd(F.ctl + CW_CNT + e2, 1u); }
    }
}
__device__ __forceinline__ void moe_offsets(Frame& F, LAS int* offs) {
    __syncthreads();
    if (F.tid == 0) { int o = 0; for (int e = 0; e < NE; ++e) { offs[e] = o; const int c = (int)__hip_atomic_load(F.ctl + CW_CNT + e, __ATOMIC_RELAXED, __HIP_MEMORY_SCOPE_AGENT); o += (c + 255) & ~255; } offs[NE] = o; }
    __syncthreads();
}
__device__ __forceinline__ int expert_of_row(LAS int* offs, int row) { int e = 0;
#pragma unroll 1
    for (int i = 1; i < NE; ++i) if (row >= offs[i]) e = i;
    return e; }
__device__ __forceinline__ void p6_permute(Frame& F) {
    LAS int* offs = (LAS int*)(F.lds + 140 * 1024);
    moe_offsets(F, offs);
    const int* toke = (const int*)(F.ws + WS_ROUTE + RT_TOKE); const float* tokw = (const float*)(F.ws + WS_ROUTE + RT_TOKW);
    int* tokpos = (int*)(F.ws + WS_ROUTE + RT_TOKPOS); float* roww = (float*)(F.ws + WS_ROUTE + RT_ROWW);
    bf16_t* HP = (bf16_t*)(F.ws + WS_HPERM);
    for (int t = F.gw; t < M; t += F.NGW) {
        f32x4 h[4]; h2_row(F, t, h);
#pragma unroll
        for (int k = 0; k < 2; ++k) { const int e = toke[2 * t + k]; int pos = 0;
            if (F.lane == 0) { pos = offs[e] + (int)atomicAdd(F.ctl + CW_FILL + e, 1u); tokpos[2 * t + k] = pos; roww[pos] = tokw[2 * t + k]; }
            pos = __shfl(pos, 0);
#pragma unroll
            for (int j = 0; j < 4; ++j) st4(HP + (size_t)pos * DM + 4 * F.lane + 256 * j, h[j]); }
    }
    for (int idx = F.gw; idx < NE * 256; idx += F.NGW) { const int e = idx >> 8, i = idx & 255; const int c = (int)__hip_atomic_load(F.ctl + CW_CNT + e, __ATOMIC_RELAXED, __HIP_MEMORY_SCOPE_AGENT);
        const int row = offs[e] + c + i;
        if (row < offs[e + 1]) { if (F.lane == 0) roww[row] = 0.f;
#pragma unroll
            for (int j = 0; j < 4; ++j) *(u32x2*)(HP + (size_t)row * DM + 4 * F.lane + 256 * j) = (u32x2){0u, 0u}; } }
    LAS float* scr = (LAS float*)(F.lds + F.wid * 16384);
    bf16_t* W13T = (bf16_t*)(F.ws + WS_W13T); bf16_t* W2T = (bf16_t*)(F.ws + WS_W2T);
    for (int it = F.gw; it < NE * 384; it += F.NGW) { const int e = it / 384, r = it % 384;
        if (r < 128) transpose_item(F.a->in[I_W1] + (size_t)e * 1024 * 256, 256, W13T, 1024, 0, RmW13{e * 512}, scr, r, F.lane);
        else if (r < 256) transpose_item(F.a->in[I_W3] + (size_t)e * 1024 * 256, 256, W13T, 1024, 0, RmW13{e * 512 + 128}, scr, r - 128, F.lane);
        else transpose_item(F.a->in[I_W2] + (size_t)e * 256 * 1024, 1024, W2T, 256, 0, RmAdd{e * 1024}, scr, r - 256, F.lane); }
}
__device__ __forceinline__ void p7_moe1(Frame& F) {
    LAS int* offs = (LAS int*)(F.lds + 140 * 1024);
    moe_offsets(F, offs);
    const bf16_t* HP = (const bf16_t*)(F.ws + WS_HPERM); const bf16_t* W13T = (const bf16_t*)(F.ws + WS_W13T); bf16_t* HID = (bf16_t*)(F.ws + WS_HID);
    const float* roww = (const float*)(F.ws + WS_ROUTE + RT_ROWW);
    const int fr = F.lane & 15, fq = F.lane >> 4, wm = F.wid >> 1, wn = F.wid & 1;
    const int nunits = (offs[NE] / 128) * 4;
    for (int L = F.blk; L < nunits; L += F.G) {
        const int tm = L >> 2, ct = L & 3, row0 = tm * 128 + 32 * wm, hc = ct * 64 + 32 * wn;
        const int e = expert_of_row(offs, tm * 128);
        const bf16_t* ap = HP + (size_t)(row0 + fr) * DM + 8 * fq;
        const bf16_t* bp = W13T + ((size_t)e * 512 + (hc >> 7) * 256 + (hc & 127) + fr) * DM + 8 * fq;
        f32x4 acc[2][4]; acc_zero(acc);
        wave_gemm(acc, ap, ap + 16 * DM, bp, bp + 16 * DM, bp + 128 * DM, bp + 144 * DM, DM);
#pragma unroll
        for (int m = 0; m < 2; ++m) { const int row = row0 + 16 * m + fr; const float w = roww[row];
#pragma unroll
            for (int n = 0; n < 2; ++n) { const f32x4 a1 = acc[m][n], a3 = acc[m][n + 2]; f32x4 hv;
#pragma unroll
                for (int j = 0; j < 4; ++j) hv[j] = ((a1[j] / (1.f + __expf(-a1[j]))) * a3[j]) * w;
                st4(HID + (size_t)row * DE + hc + 16 * n + 4 * fq, hv); } }
    }
}
__device__ __forceinline__ void p8_moe2(Frame& F) {
    LAS int* offs = (LAS int*)(F.lds + 140 * 1024);
    moe_offsets(F, offs);
    const bf16_t* HID = (const bf16_t*)(F.ws + WS_HID); const bf16_t* W2T = (const bf16_t*)(F.ws + WS_W2T); bf16_t* YB = (bf16_t*)(F.ws + WS_YBUF);
    const int fr = F.lane & 15, fq = F.lane >> 4, wm = F.wid >> 1, wn = F.wid & 1;
    const int nunits = (offs[NE] / 128) * 8;
    for (int L = F.blk; L < nunits; L += F.G) {
        const int tm = L >> 3, tn = L & 7, row0 = tm * 128 + 32 * wm, col0 = tn * 128 + 64 * wn;
        const int e = expert_of_row(offs, tm * 128);
        const bf16_t* ap = HID + (size_t)(row0 + fr) * DE + 8 * fq; const bf16_t* bp = W2T + ((size_t)e * 1024 + col0 + fr) * DE + 8 * fq;
        f32x4 acc[2][4]; acc_zero(acc);
        wave_gemm(acc, ap, ap + 16 * DE, bp, bp + 16 * DE, bp + 32 * DE, bp + 48 * DE, DE);
#pragma unroll
        for (int m = 0; m < 2; ++m)
#pragma unroll
            for (int n = 0; n < 4; ++n) st4(YB + (size_t)(row0 + 16 * m + fr) * DM + col0 + 16 * n + 4 * fq, acc[m][n]);
    }
}
__device__ __forceinline__ void p9_combine(Frame& F) {
    const bf16_t* YB = (const bf16_t*)(F.ws + WS_YBUF); const int* tokpos = (const int*)(F.ws + WS_ROUTE + RT_TOKPOS);
    for (int t = F.gw; t < M; t += F.NGW) { const int p0 = tokpos[2 * t], p1 = tokpos[2 * t + 1];
        f32x4* xr = (f32x4*)(F.out + (size_t)t * DM) + F.lane;
#pragma unroll
        for (int j = 0; j < 4; ++j) { const f32x4 a = ld4(YB + (size_t)p0 * DM + 4 * F.lane + 256 * j), b = ld4(YB + (size_t)p1 * DM + 4 * F.lane + 256 * j);
            xr[64 * j] = xr[64 * j] + (a + b); } }
}

constexpr int LDS_BYTES = 147456;
__global__ void __launch_bounds__(NTHREADS, 2) fwd_kernel(Args args) {
    extern __shared__ __attribute__((aligned(16))) unsigned char lds[];
    Frame F;
    F.lds = (LAS unsigned char*)lds; F.ldsg = (char*)lds;
    F.tid = threadIdx.x; F.lane = F.tid & 63; F.wid = __builtin_amdgcn_readfirstlane(F.tid >> 6);
    F.blk = blockIdx.x; F.G = gridDim.x; F.gw = F.blk * NWAVES + F.wid; F.NGW = F.G * NWAVES;
    F.a = &args;
    F.out = args.out; F.ws = args.ws; F.ctl = (unsigned*)(args.ws + WS_CTL);
    const int lo = args.ph_lo, hi = args.ph_hi;
#if MK_ONE_LAUNCH
    cg::grid_group grid = cg::this_grid();
#define SEAM(k) do { if (lo <= (k) && (k) + 1 < hi) { grid.sync(); } } while (0)
#else
#define SEAM(k) do { } while (0)
#endif
#define IN(k) (lo <= (k) && (k) < hi)
    if (IN(0)) { p0_prologue(F); } SEAM(0);
    if (IN(1)) { p1_proj(F); } SEAM(1);
    if (IN(2)) { p2_mixer_a(F); p2_attention(F); } SEAM(2);
    if (IN(3)) { p3_merged(F); } SEAM(3);
    if (IN(4)) { p4_out(F); } SEAM(4);
    if (IN(5)) { p5_router(F); } SEAM(5);
    if (IN(6)) { p6_permute(F); } SEAM(6);
    if (IN(7)) { p7_moe1(F); } SEAM(7);
    if (IN(8)) { p8_moe2(F); } SEAM(8);
    if (IN(9)) { p9_combine(F); }
#undef IN
#undef SEAM
}

extern "C" void kernel_launch(void* const* d_in, const int* in_sizes, int n_in, void* d_out, int out_size, void* d_ws, size_t ws_size, hipStream_t stream) {
    static int grid = 0;
    if (grid == 0) {
        if (n_in != 26 || out_size != M * DM || ws_size < WS_END) { fprintf(stderr, "kernel_launch: unexpected shapes (n_in %d out %d ws %zu)\n", n_in, out_size, ws_size); grid = -1; return; }
        int dev = 0, cus = 0, per_cu = 0;
        (void)hipGetDevice(&dev); (void)hipDeviceGetAttribute(&cus, hipDeviceAttributeMultiprocessorCount, dev);
        if (hipFuncSetAttribute((const void*)fwd_kernel, hipFuncAttributeMaxDynamicSharedMemorySize, LDS_BYTES) != hipSuccess) { fprintf(stderr, "kernel_launch: hipFuncSetAttribute failed\n"); grid = -1; return; }
        if (hipOccupancyMaxActiveBlocksPerMultiprocessor(&per_cu, (const void*)fwd_kernel, NTHREADS, LDS_BYTES) != hipSuccess || per_cu < 1) { fprintf(stderr, "kernel_launch: occupancy query says %d\n", per_cu); per_cu = 1; }
        (void)hipGetLastError();
        grid = cus;
    }
    if (grid < 0) return;
    (void)hipMemsetAsync((char*)d_ws + WS_CTL, 0, CTL_ZERO_BYTES, stream);
    Args a{};
    for (int i = 0; i < 26; ++i) a.in[i] = (const float*)d_in[i];
    a.out = (float*)d_out; a.ws = (unsigned char*)d_ws;
#if MK_ONE_LAUNCH
    a.ph_lo = 0; a.ph_hi = NPHASE;
    void* kargs[] = {&a};
    hipError_t e = hipLaunchCooperativeKernel((const void*)fwd_kernel, dim3(grid), dim3(NTHREADS), kargs, LDS_BYTES, stream);
    if (e != hipSuccess) fprintf(stderr, "cooperative launch failed: %s (grid %d)\n", hipGetErrorString(e), grid);
#else
    for (int p = 0; p < NPHASE; ++p) { a.ph_lo = p; a.ph_hi = p + 1; hipLaunchKernelGGL(fwd_kernel, dim3(grid), dim3(NTHREADS), LDS_BYTES, stream, a); }
#endif
}
```

```cpp
#include <hip/hip_runtime.h>
#include <hip/hip_cooperative_groups.h>
#include <cstdio>
#include <cstdint>
namespace cg = cooperative_groups;

#ifndef MK_ONE_LAUNCH
#define MK_ONE_LAUNCH 1
#endif

#define LAS __attribute__((address_space(3)))
typedef unsigned short bf16_t;
typedef short bf16x8 __attribute__((ext_vector_type(8)));
typedef short s16x4 __attribute__((ext_vector_type(4)));
typedef float f32x4 __attribute__((ext_vector_type(4)));
typedef float f32x16 __attribute__((ext_vector_type(16)));
typedef float f32x2 __attribute__((ext_vector_type(2)));
typedef unsigned u32x4 __attribute__((ext_vector_type(4)));
typedef unsigned u32x2 __attribute__((ext_vector_type(2)));
typedef __bf16 bf16x2_t __attribute__((ext_vector_type(2)));

constexpr int NB = 2, SEQ = 8192, DM = 1024, M = NB * SEQ;
constexpr int NH = 8;
constexpr int N1 = 7168;
constexpr int NE = 32, DE = 256;
constexpr float EPS = 1e-6f;
constexpr float LOG2E = 1.4426950408889634f;
constexpr float C2 = 0.125f * LOG2E;
constexpr float LAM_INIT = 0.2f;
constexpr int NWAVES = 8, NTHREADS = 512;
constexpr int NPHASE = 10;
constexpr int ECAP = 16384, ECAP_LOG = 14;

constexpr size_t MiB = 1u << 20;
constexpr size_t WS_CTL = 0;
constexpr size_t CTL_ZERO_BYTES = 65536;
constexpr size_t WS_W1T = 1 * MiB;
constexpr size_t WS_WUPT = 15 * MiB;
constexpr size_t WS_WOUTT = 19 * MiB;
constexpr size_t WS_WST = 21 * MiB;
constexpr size_t WS_ROUTE = 22 * MiB;
constexpr size_t WS_XN = 32 * MiB;
constexpr size_t WS_U = 64 * MiB;
constexpr size_t WS_VA = 96 * MiB;
constexpr size_t WS_Q = 128 * MiB;
constexpr size_t WS_K = 160 * MiB;
constexpr size_t WS_VB = 192 * MiB;
constexpr size_t WS_W13T = 160 * MiB;
constexpr size_t WS_W2T = 192 * MiB;
constexpr size_t WS_HID = 208 * MiB;
constexpr size_t WS_H2 = 32 * MiB;
constexpr size_t WS_YBUF = 64 * MiB;
constexpr size_t WS_YA = 224 * MiB;
constexpr size_t WS_T = 64 * MiB;
constexpr size_t WS_END = 256 * MiB;
constexpr size_t RT_TOKE = 0, RT_TOKW = 256 * 1024, RT_TOKPOS = 512 * 1024, RT_WRT = 1024 * 1024, RT_ALIST = 1536 * 1024, RT_ROWTOK = 2048 * 1024, RT_ROWW = 4096 * 1024;
constexpr int CW_CNT = 8192, CW_CNT_STRIDE = 64, CW_AQ = 512, CW_BAR = 1024;

#define LDS_WAIT() asm volatile("s_waitcnt lgkmcnt(0)" ::: "memory")
#define SBAR() __builtin_amdgcn_sched_barrier(0)
__device__ __forceinline__ unsigned cvtpk(float lo, float hi) { f32x2 v = {lo, hi}; bf16x2_t b = __builtin_convertvector(v, bf16x2_t); return __builtin_bit_cast(unsigned, b); }
__device__ __forceinline__ float bf2f(short b) { return __uint_as_float(((unsigned)(unsigned short)b) << 16); }
__device__ __forceinline__ float wave_sum(float v) {
#pragma unroll
    for (int o = 1; o < 64; o <<= 1) v += __shfl_xor(v, o);
    return v;
}
__device__ __forceinline__ void st4(bf16_t* p, f32x4 v) { u32x2 w; w.x = cvtpk(v[0], v[1]); w.y = cvtpk(v[2], v[3]); *(u32x2*)p = w; }
__device__ __forceinline__ f32x4 ld4(const bf16_t* p) { const u32x2 w = *(const u32x2*)p; f32x4 r; r[0] = __uint_as_float(w.x << 16); r[1] = __uint_as_float(w.x & 0xffff0000u); r[2] = __uint_as_float(w.y << 16); r[3] = __uint_as_float(w.y & 0xffff0000u); return r; }

struct Args { const float* in[26]; float* out; unsigned char* ws; int ph_lo, ph_hi; };

struct Frame {
    LAS unsigned char* lds; char* ldsg;
    int tid, lane, wid, blk, G, gw, NGW;
    const Args* a; float* out; unsigned char* ws; unsigned* ctl;
};
enum { I_X = 0, I_N1G, I_WIN, I_VNG, I_WS, I_BS, I_QNG, I_KNG, I_LQ1, I_LK1, I_LQ2, I_LK2, I_SUBG, I_WUPA, I_WUPB, I_WGATE, I_BGATE, I_WOUT, I_N2G, I_WRG, I_BRG, I_WRE, I_BRE, I_W1, I_W3, I_W2 };

__device__ __forceinline__ void wave_gemm(f32x4 (&acc)[2][4], const bf16_t* ap0, const bf16_t* ap1, const bf16_t* bp0, const bf16_t* bp1, const bf16_t* bp2, const bf16_t* bp3, int K) {
#pragma unroll 2
    for (int k0 = 0; k0 < K; k0 += 32) {
        const bf16x8 a0 = *(const bf16x8*)(ap0 + k0), a1 = *(const bf16x8*)(ap1 + k0);
        const bf16x8 b0 = *(const bf16x8*)(bp0 + k0), b1 = *(const bf16x8*)(bp1 + k0), b2 = *(const bf16x8*)(bp2 + k0), b3 = *(const bf16x8*)(bp3 + k0);
        acc[0][0] = __builtin_amdgcn_mfma_f32_16x16x32_bf16(b0, a0, acc[0][0], 0, 0, 0);
        acc[0][1] = __builtin_amdgcn_mfma_f32_16x16x32_bf16(b1, a0, acc[0][1], 0, 0, 0);
        acc[0][2] = __builtin_amdgcn_mfma_f32_16x16x32_bf16(b2, a0, acc[0][2], 0, 0, 0);
        acc[0][3] = __builtin_amdgcn_mfma_f32_16x16x32_bf16(b3, a0, acc[0][3], 0, 0, 0);
        acc[1][0] = __builtin_amdgcn_mfma_f32_16x16x32_bf16(b0, a1, acc[1][0], 0, 0, 0);
        acc[1][1] = __builtin_amdgcn_mfma_f32_16x16x32_bf16(b1, a1, acc[1][1], 0, 0, 0);
        acc[1][2] = __builtin_amdgcn_mfma_f32_16x16x32_bf16(b2, a1, acc[1][2], 0, 0, 0);
        acc[1][3] = __builtin_amdgcn_mfma_f32_16x16x32_bf16(b3, a1, acc[1][3], 0, 0, 0);
    }
}
__device__ __forceinline__ void acc_zero(f32x4 (&acc)[2][4]) {
#pragma unroll
    for (int m = 0; m < 2; ++m)
#pragma unroll
        for (int n = 0; n < 4; ++n) acc[m][n] = (f32x4){0.f, 0.f, 0.f, 0.f};
}

namespace pg8 {
#define PG8_LAS __attribute__((address_space(3)))
constexpr int BM = 256, BK = 64, HALF = 128, HTB = HALF * BK * 2  , STAGE_BYTES = 8 * HTB, NXCD = 8, WGM = 8;

__host__ __device__ __forceinline__ int lds_byte(int r, int c) { const int st = (r >> 4) * 2 + (c >> 5), rr = r & 15, cc = c & 31, ob = rr * 64 + cc * 2; return st * 1024 + (ob ^ (((ob >> 9) & 1) << 5)); }
__host__ __device__ __forceinline__ void stage_rc(int b, int& R, int& C) { const int st = b / 1024, sb = b % 1024, swz = sb ^ (((sb >> 9) & 1) << 5); R = (st >> 1) * 16 + swz / 64; C = (st & 1) * 32 + (swz % 64) / 2; }
__host__ __device__ __forceinline__ int perm32(int rho) { const int n = rho >> 4, i = rho & 15; return 8 * (i >> 2) + 4 * n + (i & 3); }

struct Unit { int pm, pn, pb, rbase, nvalid; };
struct Gemm { const bf16_t* A; const bf16_t* Bt; int K; const int* rowtok; };

struct StaticOrder {
    int nM, nN, nwg, G, c;
    __host__ __device__ void init(int M, int N, int G_, int c_) { nM = M / BM; nN = N / BM; nwg = nM * nN; G = G_; c = c_; }
    __host__ __device__ bool next(int i, Unit& u) const {
        const long L = (long)i * G + c; if (L >= nwg) return false;
        int wgid = (int)L; { const int q = nwg / NXCD, r = nwg % NXCD, xcd = wgid % NXCD, off = wgid / NXCD; wgid = (xcd < r ? xcd * (q + 1) : r * (q + 1) + (xcd - r) * q) + off; }
        const int nig = WGM * nN, gid = wgid / nig, fm = gid * WGM, gsz = (nM - fm) < WGM ? (nM - fm) : WGM;
        u.pm = fm + ((wgid % nig) % gsz); u.pn = (wgid % nig) / gsz; u.pb = u.pn; u.rbase = 0; u.nvalid = 0; return true;
    }
    __device__ __forceinline__ void a_ready(const Unit&) const {}
    __device__ __forceinline__ void done(const Unit&) const {}
};
template <class Epi, class Sched, bool ALIGN_EPI = false, bool SP2 = false, bool BP64 = false, bool GATHER = false>
__device__ __forceinline__ void gemm_phase(PG8_LAS unsigned char* lds, const Gemm g, const Sched& S, const Epi& E) {
    const int tid = threadIdx.x, wid = __builtin_amdgcn_readfirstlane(tid >> 6), lane = tid & 63, wr = wid >> 2, wc = wid & 3, fr = lane & 15, fq = lane >> 4;
    const int K = g.K, nt = K / BK;
    unsigned voffA[2], voffB[2];
#pragma unroll
    for (int i = 0; i < 2; ++i) { int R, C; stage_rc(tid * 16 + i * 8192, R, C); const int Rp = Epi::PERM ? ((R & ~31) + perm32(R & 31)) : R; const int Rb = BP64 ? (64 * (Rp >> 5) + (Rp & 31)) : Rp;
        voffA[i] = (unsigned)(R * K + C) * 2u; voffB[i] = (unsigned)(Rb * K + C) * 2u; }
    const size_t kstep = (size_t)(BK * 2);
    const size_t hstep = (size_t)HALF * K * 2;
    const size_t tstep = 2 * hstep;
    const size_t bhs = BP64 ? (size_t)32 * K * 2 : hstep;
    const unsigned ldsw = (unsigned)wid * 1024u;
    const int aoff = lds_byte(wr * 64 + fr, fq * 8), boff = lds_byte(wc * 32 + fr, fq * 8);
#define PG8_SA(b, h) (((b) * 2 + (h)) * HTB)
#define PG8_SB(b, h) ((4 + (b) * 2 + (h)) * HTB)
#define PG8_STAGE(bufoff, gbase, voff) do { _Pragma("unroll") for (int _i = 0; _i < 2; ++_i) \
        __builtin_amdgcn_global_load_lds((const unsigned*)((const char*)(gbase) + (voff)[_i]), (PG8_LAS unsigned*)(lds + (bufoff) + ldsw + _i * 8192), 16, 0, 0); } while (0)
#define PG8_LDA(dst, b, h) do { _Pragma("unroll") for (int m = 0; m < 4; ++m) _Pragma("unroll") for (int k = 0; k < 2; ++k) dst[m][k] = *(const PG8_LAS bf16x8*)(lds + PG8_SA(b, h) + aoff + m * 2048 + k * 1024); } while (0)
#define PG8_LDB(dst, b, h) do { _Pragma("unroll") for (int n = 0; n < 2; ++n) _Pragma("unroll") for (int k = 0; k < 2; ++k) dst[n][k] = *(const PG8_LAS bf16x8*)(lds + PG8_SB(b, h) + boff + n * 2048 + k * 1024); } while (0)
#define PG8_MMA(ai, bj, At, Bt) do { __builtin_amdgcn_s_setprio(1); _Pragma("unroll") for (int m = 0; m < 4; ++m) _Pragma("unroll") for (int n = 0; n < 2; ++n) _Pragma("unroll") for (int k = 0; k < 2; ++k) \
        acc[ai][bj][m][n] = __builtin_amdgcn_mfma_f32_16x16x32_bf16(Bt[n][k], At[m][k], acc[ai][bj][m][n], 0, 0, 0); __builtin_amdgcn_s_setprio(0); } while (0)
#define PG8_WAIT_V(n) asm volatile("s_waitcnt vmcnt(" #n ")" ::: "memory")
#define PG8_WAIT_L(n) asm volatile("s_waitcnt lgkmcnt(" #n ")" ::: "memory")
#define PG8_BAR __builtin_amdgcn_s_barrier()
#define PG8_SCHED __builtin_amdgcn_sched_barrier(0)
    Unit cur, nxt; int ui = 0;
    if (!S.next(0, cur)) return;
    static_assert(!GATHER || SP2, "GATHER is written for the SP2 loop");
    unsigned vA0[2] = {0u, 0u}, vA1[2] = {0u, 0u}, nvA0[2] = {0u, 0u}, nvA1[2] = {0u, 0u};
#define PG8_GLOAD(u_, d0_, d1_) do { _Pragma("unroll") for (int _i = 0; _i < 2; ++_i) { int R_, C_; stage_rc(tid * 16 + _i * 8192, R_, C_); \
        const int t0_ = R_ < (u_).nvalid ? g.rowtok[(u_).rbase + R_] : 0, t1_ = HALF + R_ < (u_).nvalid ? g.rowtok[(u_).rbase + HALF + R_] : 0; d0_[_i] = (unsigned)(t0_ * K + C_) * 2u; d1_[_i] = (unsigned)(t1_ * K + C_) * 2u; } } while (0)
#define PG8_STAGE_A(bufoff, ptr, half, vcur0, vcur1) do { if constexpr (GATHER) { PG8_STAGE(bufoff, ptr, (half) ? vcur1 : vcur0); } else { PG8_STAGE(bufoff, (ptr) + ((half) ? hstep : (size_t)0), voffA); } } while (0)
    if constexpr (GATHER) PG8_GLOAD(cur, vA0, vA1);
    f32x4 acc[2][2][4][2];
#pragma unroll
    for (int a = 0; a < 2; ++a)
#pragma unroll
        for (int b = 0; b < 2; ++b)
#pragma unroll
            for (int m = 0; m < 4; ++m)
#pragma unroll
                for (int n = 0; n < 2; ++n) acc[a][b][m][n] = (f32x4){0.f, 0.f, 0.f, 0.f};
    bf16x8 At[4][2], B0[2][2], B1[2][2];
    const char* cA = (const char*)g.A + (GATHER ? (size_t)0 : (size_t)cur.pm * tstep); const char* cB = (const char*)g.Bt + (size_t)cur.pb * tstep;
    S.a_ready(cur);
    if constexpr (SP2) {
        PG8_STAGE(PG8_SB(0, 0), cB, voffB); PG8_STAGE(PG8_SB(0, 1), cB + bhs, voffB); PG8_STAGE_A(PG8_SA(0, 0), cA, 0, vA0, vA1); PG8_STAGE_A(PG8_SA(0, 1), cA, 1, vA0, vA1);
        if (wr == 1) PG8_BAR;
        PG8_WAIT_V(2); PG8_BAR;
        PG8_STAGE(PG8_SB(1, 0), cB + kstep, voffB); PG8_STAGE_A(PG8_SA(1, 0), cA + kstep, 0, vA0, vA1); PG8_STAGE(PG8_SB(1, 1), cB + bhs + kstep, voffB);
        PG8_WAIT_V(6); PG8_BAR;
    } else {
        PG8_STAGE(PG8_SB(0, 0), cB, voffB); PG8_STAGE(PG8_SA(0, 0), cA, voffA); PG8_STAGE(PG8_SB(0, 1), cB + bhs, voffB); PG8_STAGE(PG8_SA(0, 1), cA + hstep, voffA);
        if (wr == 1) PG8_BAR;
        PG8_WAIT_V(4); PG8_BAR;
        PG8_STAGE(PG8_SB(1, 0), cB + kstep, voffB); PG8_STAGE(PG8_SA(1, 0), cA + kstep, voffA); PG8_STAGE(PG8_SB(1, 1), cB + bhs + kstep, voffB);
        PG8_WAIT_V(6); PG8_BAR;
    }
    for (;;) {
        const bool has_next = S.next(ui + 1, nxt);
        const char* nA = (has_next && !GATHER) ? (const char*)g.A + (size_t)nxt.pm * tstep : cA; const char* nB = has_next ? (const char*)g.Bt + (size_t)nxt.pb * tstep : cB;
        if constexpr (GATHER) { if (has_next) { PG8_GLOAD(nxt, nvA0, nvA1); } else { nvA0[0] = vA0[0]; nvA0[1] = vA0[1]; nvA1[0] = vA1[0]; nvA1[1] = vA1[1]; } }
        for (int t = 0; t < nt; t += 2) {
            const bool last = (t == nt - 2);
            const char* a1 = cA + (size_t)(t + 1) * kstep;
            const char* a2 = last ? nA : cA + (size_t)(t + 2) * kstep; const char* b2 = last ? nB : cB + (size_t)(t + 2) * kstep;
            const char* a3 = a2 + kstep; const char* b3 = b2 + kstep;
            if (last && has_next) S.a_ready(nxt);
            unsigned xA0[2], xA1[2];
            if constexpr (GATHER) { xA0[0] = last ? nvA0[0] : vA0[0]; xA0[1] = last ? nvA0[1] : vA0[1]; xA1[0] = last ? nvA1[0] : vA1[0]; xA1[1] = last ? nvA1[1] : vA1[1]; }
            if constexpr (SP2) {
            PG8_LDB(B0, 0, 0); PG8_LDB(B1, 0, 1); PG8_SCHED; PG8_LDA(At, 0, 0); PG8_STAGE_A(PG8_SA(1, 1), a1, 1, vA0, vA1);
            PG8_WAIT_V(8); PG8_WAIT_L(0); PG8_BAR; PG8_MMA(0, 0, At, B0); PG8_MMA(0, 1, At, B1); PG8_BAR; PG8_SCHED;
            PG8_LDA(At, 0, 1); PG8_STAGE(PG8_SB(0, 0), b2, voffB); PG8_STAGE(PG8_SB(0, 1), b2 + bhs, voffB); PG8_STAGE_A(PG8_SA(0, 0), a2, 0, xA0, xA1);
            PG8_WAIT_V(8); PG8_WAIT_L(0); PG8_BAR; PG8_MMA(1, 0, At, B0); PG8_MMA(1, 1, At, B1); PG8_BAR; PG8_SCHED;
            PG8_LDB(B0, 1, 0); PG8_LDB(B1, 1, 1); PG8_SCHED; PG8_LDA(At, 1, 0); PG8_STAGE_A(PG8_SA(0, 1), a2, 1, xA0, xA1);
            PG8_WAIT_V(8); PG8_WAIT_L(0); PG8_BAR; PG8_MMA(0, 0, At, B0); PG8_MMA(0, 1, At, B1); PG8_BAR; PG8_SCHED;
            PG8_LDA(At, 1, 1); PG8_STAGE(PG8_SB(1, 0), b3, voffB); PG8_STAGE(PG8_SB(1, 1), b3 + bhs, voffB); PG8_STAGE_A(PG8_SA(1, 0), a3, 0, xA0, xA1);
            PG8_WAIT_V(8); PG8_WAIT_L(0); PG8_BAR; PG8_MMA(1, 0, At, B0); PG8_MMA(1, 1, At, B1); PG8_BAR; PG8_SCHED;
            } else {
            PG8_LDB(B0, 0, 0); PG8_SCHED; PG8_LDA(At, 0, 0); PG8_STAGE(PG8_SA(1, 1), a1 + hstep, voffA);
            PG8_WAIT_L(8); PG8_BAR; PG8_WAIT_L(0); PG8_MMA(0, 0, At, B0); PG8_BAR; PG8_SCHED;
            PG8_LDB(B1, 0, 1); PG8_STAGE(PG8_SB(0, 0), b2, voffB);
            PG8_BAR; PG8_WAIT_L(0); PG8_MMA(0, 1, At, B1); PG8_BAR;
            PG8_LDA(At, 0, 1); PG8_STAGE(PG8_SA(0, 0), a2, voffA);
            PG8_BAR; PG8_WAIT_L(0); PG8_MMA(1, 0, At, B0); PG8_BAR; PG8_SCHED;
            PG8_STAGE(PG8_SB(0, 1), b2 + bhs, voffB);
            PG8_WAIT_V(6); PG8_BAR; PG8_MMA(1, 1, At, B1); PG8_BAR;
            PG8_LDB(B0, 1, 0); PG8_SCHED; PG8_LDA(At, 1, 0); PG8_STAGE(PG8_SA(0, 1), a2 + hstep, voffA);
            PG8_WAIT_L(8); PG8_BAR; PG8_WAIT_L(0); PG8_MMA(0, 0, At, B0); PG8_BAR; PG8_SCHED;
            PG8_LDB(B1, 1, 1); PG8_STAGE(PG8_SB(1, 0), b3, voffB);
            PG8_BAR; PG8_WAIT_L(0); PG8_MMA(0, 1, At, B1); PG8_BAR;
            PG8_LDA(At, 1, 1); PG8_STAGE(PG8_SA(1, 0), a3, voffA);
            PG8_BAR; PG8_WAIT_L(0); PG8_MMA(1, 0, At, B0); PG8_BAR; PG8_SCHED;
            PG8_STAGE(PG8_SB(1, 1), b3 + bhs, voffB);
            PG8_WAIT_V(6); PG8_BAR; PG8_MMA(1, 1, At, B1); PG8_BAR;
            }
        }
        if constexpr (ALIGN_EPI) { if (wr == 0) PG8_BAR; }
        if constexpr (!Epi::AFTER_DRAIN) { E(acc, cur, wr, wc, fr, fq); S.done(cur); }
        if (!has_next) break;
#pragma unroll
        for (int a = 0; a < 2; ++a)
#pragma unroll
            for (int b = 0; b < 2; ++b)
#pragma unroll
                for (int m = 0; m < 4; ++m)
#pragma unroll
                    for (int n = 0; n < 2; ++n) acc[a][b][m][n] = (f32x4){0.f, 0.f, 0.f, 0.f};
        cur = nxt; cA = nA; cB = nB; ++ui;
        if constexpr (GATHER) { vA0[0] = nvA0[0]; vA0[1] = nvA0[1]; vA1[0] = nvA1[0]; vA1[1] = nvA1[1]; }
        if constexpr (ALIGN_EPI) { if (wr == 1) PG8_BAR; }
    }
    PG8_WAIT_V(0);
    if constexpr (!ALIGN_EPI) { if (wr == 0) PG8_BAR; }
    PG8_BAR;
    if constexpr (Epi::AFTER_DRAIN) { E.fused(acc, cur, wr, wc, fr, fq, lds, wid, lane); S.done(cur); }
#undef PG8_GLOAD
#undef PG8_STAGE_A
#undef PG8_SA
#undef PG8_SB
#undef PG8_STAGE
#undef PG8_LDA
#undef PG8_LDB
#undef PG8_MMA
#undef PG8_WAIT_V
#undef PG8_WAIT_L
#undef PG8_BAR
#undef PG8_SCHED
}
}

#define PG8_SP2 true
#define PG8_ALIGN true
__device__ __forceinline__ void st8(bf16_t* p, f32x4 a, f32x4 b) { u32x4 w; w.x = cvtpk(a[0], a[1]); w.y = cvtpk(a[2], a[3]); w.z = cvtpk(b[0], b[1]); w.w = cvtpk(b[2], b[3]); *(u32x4*)p = w; }
__device__ __forceinline__ void ld8(const bf16_t* p, f32x4& a, f32x4& b) { const u32x4 w = *(const u32x4*)p;
    a[0] = __uint_as_float(w.x << 16); a[1] = __uint_as_float(w.x & 0xffff0000u); a[2] = __uint_as_float(w.y << 16); a[3] = __uint_as_float(w.y & 0xffff0000u);
    b[0] = __uint_as_float(w.z << 16); b[1] = __uint_as_float(w.z & 0xffff0000u); b[2] = __uint_as_float(w.w << 16); b[3] = __uint_as_float(w.w & 0xffff0000u); }
struct EpiProj {
    static constexpr bool PERM = true, AFTER_DRAIN = false;
    unsigned char* ws; bf16_t* GATE; const float *qg, *kg, *bgate;
    __device__ __forceinline__ void operator()(const f32x4 (&acc)[2][2][4][2], const pg8::Unit& u, int wr, int wc, int fr, int fq) const {
        asm volatile("" : "+v"(fr), "+v"(fq));
        const int seg = u.pn >> 2;
        const int row0 = u.pm * 256 + wr * 64 + fr;
        const int cw = (u.pn & 3) * 256 + wc * 64 + 8 * fq;
        if (seg <= 1 || seg == 4) { bf16_t* dst = (bf16_t*)(ws + WS_U + (size_t)seg * (32 * MiB)) + cw;
#pragma unroll
            for (int ai = 0; ai < 2; ++ai)
#pragma unroll
                for (int m = 0; m < 4; ++m) { bf16_t* rp = dst + (size_t)(row0 + ai * 128 + m * 16) * DM;
#pragma unroll
                    for (int bj = 0; bj < 2; ++bj) st8(rp + 32 * bj, acc[ai][bj][m][0], acc[ai][bj][m][1]); }
        } else if (seg == 2 || seg == 3) { const float* g = (seg == 2 ? qg : kg) + 8 * fq; bf16_t* dst = (bf16_t*)(ws + WS_U + (size_t)seg * (32 * MiB)) + cw; const float sc = seg == 2 ? C2 : 1.f;
            f32x4 gv[2][2];
#pragma unroll
            for (int bj = 0; bj < 2; ++bj)
#pragma unroll
                for (int n = 0; n < 2; ++n) gv[bj][n] = *(const f32x4*)(g + 32 * bj + 4 * n) * sc;
#pragma unroll
            for (int ai = 0; ai < 2; ++ai)
#pragma unroll
                for (int m = 0; m < 4; ++m) { float ss = 0.f;
#pragma unroll
                    for (int bj = 0; bj < 2; ++bj)
#pragma unroll
                        for (int n = 0; n < 2; ++n) { const f32x4 a = acc[ai][bj][m][n]; ss += (a[0] * a[0] + a[1] * a[1]) + (a[2] * a[2] + a[3] * a[3]); }
                    ss += __shfl_xor(ss, 16); ss += __shfl_xor(ss, 32);
                    const float r = rsqrtf(ss * (1.f / 64.f) + EPS); bf16_t* rp = dst + (size_t)(row0 + ai * 128 + m * 16) * DM;
#pragma unroll
                    for (int bj = 0; bj < 2; ++bj) st8(rp + 32 * bj, (acc[ai][bj][m][0] * r) * gv[bj][0], (acc[ai][bj][m][1] * r) * gv[bj][1]); }
        } else { const int c = (u.pn - 20) * 256 + wc * 64 + 8 * fq; const float* bg = bgate + c;
#pragma unroll
            for (int bj = 0; bj < 2; ++bj) { const f32x4 b0 = *(const f32x4*)(bg + 32 * bj), b1 = *(const f32x4*)(bg + 32 * bj + 4);
#pragma unroll
                for (int ai = 0; ai < 2; ++ai)
#pragma unroll
                    for (int m = 0; m < 4; ++m) { f32x4 v0 = acc[ai][bj][m][0] + b0, v1 = acc[ai][bj][m][1] + b1;
#pragma unroll
                        for (int j = 0; j < 4; ++j) { v0[j] = __builtin_amdgcn_rcpf(1.f + __builtin_amdgcn_exp2f(-LOG2E * v0[j])); v1[j] = __builtin_amdgcn_rcpf(1.f + __builtin_amdgcn_exp2f(-LOG2E * v1[j])); }
                        st8(GATE + (size_t)(row0 + ai * 128 + m * 16) * 2048 + c + 32 * bj, v0, v1); } }
        }
    }
};

#define EPI_LOOP(...) _Pragma("unroll") for (int ai = 0; ai < 2; ++ai) _Pragma("unroll") for (int m = 0; m < 4; ++m) { const size_t row = (size_t)(u.pm * 256 + wr * 64 + fr + ai * 128 + m * 16); \
        _Pragma("unroll") for (int bj = 0; bj < 2; ++bj) { const int col = u.pn * 256 + bj * 128 + wc * 32 + 8 * fq; const f32x4 a0 = acc[ai][bj][m][0], a1 = acc[ai][bj][m][1]; __VA_ARGS__ } if (m & 1) asm volatile("" ::: "memory"); }
struct EpiGateT {
    static constexpr bool PERM = true, AFTER_DRAIN = false;
    const bf16_t* GATE; bf16_t* T;
    __device__ __forceinline__ void operator()(const f32x4 (&acc)[2][2][4][2], const pg8::Unit& u, int wr, int wc, int fr, int fq) const {
        asm volatile("" : "+v"(fr), "+v"(fq));
        EPI_LOOP( f32x4 g0, g1; ld8(GATE + row * 2048 + col, g0, g1); st8(T + row * DM + col, g0 * a0, g1 * a1); )
    }
};
struct EpiMerged {
    static constexpr bool PERM = true, AFTER_DRAIN = false;
    const bf16_t* GATE; const bf16_t* T; bf16_t* MG;
    __device__ __forceinline__ void operator()(const f32x4 (&acc)[2][2][4][2], const pg8::Unit& u, int wr, int wc, int fr, int fq) const {
        asm volatile("" : "+v"(fr), "+v"(fq));
        EPI_LOOP( f32x4 g0, g1, t0, t1; ld8(GATE + row * 2048 + 1024 + col, g0, g1); ld8(T + row * DM + col, t0, t1); st8(MG + row * DM + col, t0 + g0 * a0, t1 + g1 * a1); )
    }
};
struct EpiOut {
    static constexpr bool PERM = true, AFTER_DRAIN = false;
    const float* x; float* out;
    __device__ __forceinline__ void operator()(const f32x4 (&acc)[2][2][4][2], const pg8::Unit& u, int wr, int wc, int fr, int fq) const {
        asm volatile("" : "+v"(fr), "+v"(fq));
        EPI_LOOP( const float* xp = x + row * DM + col; float* op = out + row * DM + col; const f32x4 x0 = *(const f32x4*)xp, x1 = *(const f32x4*)(xp + 4); *(f32x4*)op = x0 + a0; *(f32x4*)(op + 4) = x1 + a1; )
    }
};
struct EpiY {
    static constexpr bool PERM = true, AFTER_DRAIN = false;
    bf16_t* Y;
    __device__ __forceinline__ void operator()(const f32x4 (&acc)[2][2][4][2], const pg8::Unit& u, int wr, int wc, int fr, int fq) const {
        asm volatile("" : "+v"(fr), "+v"(fq));
        EPI_LOOP( st8(Y + row * DM + col, a0, a1); )
    }
};
struct EpiSwiglu {
    static constexpr bool PERM = true, AFTER_DRAIN = false;
    const float* roww; bf16_t* HID;
    __device__ __forceinline__ void operator()(const f32x4 (&acc)[2][2][4][2], const pg8::Unit& u, int wr, int wc, int fr, int fq) const {
        asm volatile("" : "+v"(fr), "+v"(fq));
#pragma unroll
        for (int ai = 0; ai < 2; ++ai)
#pragma unroll
            for (int m = 0; m < 4; ++m) { const int rl = wr * 64 + fr + ai * 128 + m * 16; const size_t row = (size_t)(u.pm * 256 + rl); const float w = rl < u.nvalid ? roww[u.rbase + rl] : 0.f;
                f32x4 hv[2];
#pragma unroll
                for (int n = 0; n < 2; ++n) { const f32x4 a1 = acc[ai][0][m][n], a3 = acc[ai][1][m][n];
#pragma unroll
                    for (int j = 0; j < 4; ++j) hv[n][j] = ((a1[j] * __builtin_amdgcn_rcpf(1.f + __builtin_amdgcn_exp2f(-LOG2E * a1[j]))) * a3[j]) * w; }
                st8(HID + row * DE + u.pn * 128 + wc * 32 + 8 * fq, hv[0], hv[1]); }
    }
};
__device__ __forceinline__ int expert_of_row(LAS int* offs, int row);
struct MoeOrder {
    LAS int* offs; int npn, G, c, lo, hi;
    __device__ __forceinline__ bool next(int i, pg8::Unit& u) const { const int L = lo + i * G + c; if (L >= hi || c < 0) return false;
        const int tile = L / npn, pn = L - tile * npn, e = expert_of_row(offs, tile * 256), lr0 = tile * 256 - offs[e], nv = offs[40 + e] - lr0;
        u.pm = tile; u.pn = pn; u.pb = e * npn + pn; u.rbase = e * ECAP + lr0; u.nvalid = nv < 256 ? nv : 256; return true; }
    __device__ __forceinline__ void a_ready(const pg8::Unit&) const {}
    __device__ __forceinline__ void done(const pg8::Unit&) const {}
};

__device__ __forceinline__ float attn_dmin_unit(const float* qg, const float* kg) {
    const int ln = threadIdx.x & 63; float a = fabsf(qg[ln]), b = fabsf(kg[ln]);
#pragma unroll
    for (int o = 1; o < 64; o <<= 1) { a = fmaxf(a, __shfl_xor(a, o)); b = fmaxf(b, __shfl_xor(b, o)); }
    return 2.02f * (8.f * a * b) + 106.f;
}
__device__ __forceinline__ int attn_jlo(float dmin1, int h, int qb) {
    const float dmin = dmin1 * exp2f((float)(h + 1)); const float lowk = (float)(qb * 128) - dmin;
    return lowk > 0.f ? ((int)lowk) >> 6 : 0;
}
__device__ __forceinline__ void tr_load(const float* W, int N, int item, int lane, float (&v)[32]) {
    const int nblk = N / 32, kb = item / nblk, nb = item % nblk, k0 = 64 * kb, n0 = 32 * nb;
    const float* wp = W + (size_t)(k0 + (lane >> 5)) * N + n0 + (lane & 31);
#pragma unroll
    for (int i = 0; i < 32; ++i) v[i] = wp[(size_t)(2 * i) * N];
}
template <class RM>
__device__ __forceinline__ void tr_store(const float (&v)[32], int N, bf16_t* WT, int ldt, int koff, RM rm, LAS float* scr, int item, int lane) {
    const int nblk = N / 32, kb = item / nblk, nb = item % nblk, k0 = 64 * kb, n0 = 32 * nb;
    { LAS float* sp = scr + (lane >> 5) * 33 + (lane & 31);
#pragma unroll
      for (int i = 0; i < 32; ++i) sp[2 * i * 33] = v[i]; }
    LDS_WAIT(); asm volatile("" ::: "memory");
    const int c = lane & 7;
#pragma unroll
    for (int j = 0; j < 4; ++j) { const int n = (lane >> 3) + 8 * j; const LAS float* s = scr + (8 * c) * 33 + n;
        u32x4 o; o.x = cvtpk(s[0 * 33], s[1 * 33]); o.y = cvtpk(s[2 * 33], s[3 * 33]); o.z = cvtpk(s[4 * 33], s[5 * 33]); o.w = cvtpk(s[6 * 33], s[7 * 33]);
        *(u32x4*)(WT + (size_t)rm(n0 + n) * ldt + koff + k0 + 8 * c) = o; }
    LDS_WAIT(); asm volatile("" ::: "memory");
}
template <class RM>
__device__ __forceinline__ void transpose_item(const float* W, int N, bf16_t* WT, int ldt, int koff, RM rm, LAS float* scr, int item, int lane) {
    float v[32]; tr_load(W, N, item, lane, v); tr_store(v, N, WT, ldt, koff, rm, scr, item, lane);
}
struct RmAdd { int off; __device__ __forceinline__ int operator()(int n) const { return off + n; } };
struct RmW13 { int off; __device__ __forceinline__ int operator()(int n) const { return off + (n >> 7) * 256 + (n & 127); } };

__device__ __forceinline__ void p0_prologue(Frame& F) {
    LAS float* scr = (LAS float*)(F.lds + F.wid * 16384);
    bf16_t* W1T = (bf16_t*)(F.ws + WS_W1T); bf16_t* WUPT = (bf16_t*)(F.ws + WS_WUPT); bf16_t* WOUTT = (bf16_t*)(F.ws + WS_WOUTT);
    constexpr int I_A = 16 * 160, I_B = 16 * 64, I_C = 16 * 32;
    constexpr int NITEMS = I_A + I_B + 3 * I_C;
    for (int it = F.gw; it < NITEMS; it += F.NGW) {
        int r = it;
        if (r < I_A) { transpose_item(F.a->in[I_WIN], 5120, W1T, 1024, 0, RmAdd{0}, scr, r, F.lane); continue; } r -= I_A;
        if (r < I_B) { transpose_item(F.a->in[I_WGATE], 2048, W1T, 1024, 0, RmAdd{5120}, scr, r, F.lane); continue; } r -= I_B;
        if (r < I_C) { transpose_item(F.a->in[I_WUPA], 1024, WUPT, 1024, 0, RmAdd{0}, scr, r, F.lane); continue; } r -= I_C;
        if (r < I_C) { transpose_item(F.a->in[I_WUPB], 1024, WUPT, 1024, 0, RmAdd{1024}, scr, r, F.lane); continue; } r -= I_C;
        transpose_item(F.a->in[I_WOUT], 1024, WOUTT, 1024, 0, RmAdd{0}, scr, r, F.lane);
    }
    { bf16_t* WST = (bf16_t*)(F.ws + WS_WST); const float* ws_ = F.a->in[I_WS];
      for (int i = F.blk * NTHREADS + F.tid; i < 8 * 128 * 128 / 2; i += F.G * NTHREADS) { const int e = 2 * i, s = e & 127, t = (e >> 7) & 127;
          const float a = (s <= t) ? ws_[e] : 0.f, b = (s + 1 <= t) ? ws_[e + 1] : 0.f; *(unsigned*)(WST + e) = cvtpk(a, b); } }
    { float* WRT = (float*)(F.ws + WS_ROUTE + RT_WRT); const float* g2 = F.a->in[I_N2G]; const float* wrg = F.a->in[I_WRG]; const float* wre = F.a->in[I_WRE];
      for (int i = F.blk * NTHREADS + F.tid; i < 48 * 1024; i += F.G * NTHREADS) { const int j = i >> 10, k = i & 1023;
          const float w = j < 4 ? wrg[k * 4 + j] : (j < 36 ? wre[k * 32 + (j - 4)] : 0.f); WRT[i] = g2[k] * w; } }
    if (F.blk == 0) { LAS int* hist = (LAS int*)(F.lds + 136 * 1024); LAS int* gt = hist + 160;
        for (int i = F.tid; i < 320; i += NTHREADS) hist[i] = 0;
        __syncthreads();
        const float dmin1 = attn_dmin_unit(F.a->in[I_QNG], F.a->in[I_KNG]);
        int w[2], jl[2];
#pragma unroll
        for (int q = 0; q < 2; ++q) { const int u = F.tid + q * NTHREADS, qb = u >> 4; jl[q] = attn_jlo(dmin1, u & 7, qb); w[q] = 2 * qb + 2 - jl[q]; atomicAdd((int*)(hist + w[q]), 1); }
        __syncthreads();
        if (F.tid < 64) { int h0 = 0, h1 = 0, h2 = 0; const int i0 = 3 * F.tid;
            if (i0 < 160) h0 = hist[i0]; if (i0 + 1 < 160) h1 = hist[i0 + 1]; if (i0 + 2 < 160) h2 = hist[i0 + 2];
            const int tot = h0 + h1 + h2; int suf = tot;
#pragma unroll
            for (int o = 1; o < 64; o <<= 1) { const int vv = __shfl_down(suf, o); if (F.tid + o < 64) suf += vv; }
            const int above = suf - tot;
            if (i0 + 2 < 160) gt[i0 + 2] = above; if (i0 + 1 < 160) gt[i0 + 1] = above + h2; if (i0 < 160) gt[i0] = above + h2 + h1; }
        __syncthreads();
#pragma unroll
        for (int q = 0; q < 2; ++q) { const int u = F.tid + q * NTHREADS; const int rank = atomicAdd((int*)(gt + w[q]), 1);
            ((int*)(F.ws + WS_ROUTE + RT_ALIST))[rank] = u | (jl[q] << 16); }
        __syncthreads(); }
    { bf16_t* XN = (bf16_t*)(F.ws + WS_XN); const float* x = F.a->in[I_X]; const f32x4* g4 = (const f32x4*)F.a->in[I_N1G] + F.lane;
      for (int m0 = F.gw * 4; m0 < M; m0 += F.NGW * 4) { f32x4 v[4][4];
#pragma unroll
          for (int q = 0; q < 4; ++q) { const f32x4* xr = (const f32x4*)(x + (size_t)(m0 + q) * DM) + F.lane;
#pragma unroll
              for (int j = 0; j < 4; ++j) v[q][j] = xr[64 * j]; }
#pragma unroll
          for (int q = 0; q < 4; ++q) { float s = 0.f;
#pragma unroll
              for (int j = 0; j < 4; ++j) s += (v[q][j][0] * v[q][j][0] + v[q][j][1] * v[q][j][1]) + (v[q][j][2] * v[q][j][2] + v[q][j][3] * v[q][j][3]);
              const float r = rsqrtf(wave_sum(s) * (1.f / DM) + EPS);
#pragma unroll
              for (int j = 0; j < 4; ++j) { const f32x4 g = g4[64 * j]; st4(XN + (size_t)(m0 + q) * DM + 4 * F.lane + 256 * j, (v[q][j] * r) * g); } } } }
}

__device__ __forceinline__ void p1_proj(Frame& F) {
    pg8::Gemm g{(const bf16_t*)(F.ws + WS_XN), (const bf16_t*)(F.ws + WS_W1T), DM, nullptr};
    pg8::StaticOrder S; S.init(M, N1, F.G, F.blk);
    static_assert(WS_VA == WS_U + 32 * MiB && WS_Q == WS_U + 64 * MiB && WS_K == WS_U + 96 * MiB && WS_VB == WS_U + 128 * MiB, "EpiProj layout");
    EpiProj E{F.ws, (bf16_t*)F.out, F.a->in[I_QNG], F.a->in[I_KNG], F.a->in[I_BGATE]};
    pg8::gemm_phase<EpiProj, pg8::StaticOrder, PG8_ALIGN, PG8_SP2, true>(F.lds, g, S, E);
}

__device__ __forceinline__ void p2_mixer_a(Frame& F) {
    const bf16_t* VA = (const bf16_t*)(F.ws + WS_VA); const bf16_t* U = (const bf16_t*)(F.ws + WS_U); bf16_t* YA = (bf16_t*)(F.ws + WS_YA); const bf16_t* WST = (const bf16_t*)(F.ws + WS_WST);
    const float* gv = F.a->in[I_VNG]; const float* bs = F.a->in[I_BS];
    bf16_t* vT = (bf16_t*)F.ldsg;
    const int fr = F.lane & 15, fq = F.lane >> 4, wm = F.wid >> 1, wn = F.wid & 1;
    for (int L = F.blk; L < 1024; L += F.G) {
        const int c = L >> 3, g = L & 7;
        { const int s = F.tid >> 2, ds = (F.tid & 3) * 32; const bf16_t* src = VA + (size_t)(c * 128 + s) * DM + g * 128 + ds;
          bf16x8 v[4]; float ss = 0.f;
#pragma unroll
          for (int i = 0; i < 4; ++i) { v[i] = *(const bf16x8*)(src + 8 * i);
#pragma unroll
              for (int j = 0; j < 8; ++j) { const float x = bf2f(v[i][j]); ss += x * x; } }
          ss += __shfl_xor(ss, 1); ss += __shfl_xor(ss, 2);
          const float r = rsqrtf(ss * (1.f / 128.f) + EPS);
#pragma unroll
          for (int i = 0; i < 4; ++i)
#pragma unroll
              for (int j = 0; j < 8; ++j) { const int d = ds + 8 * i + j; const float x = (bf2f(v[i][j]) * r) * gv[g * 128 + d]; vT[d * 136 + s] = (bf16_t)(cvtpk(x, 0.f) & 0xffffu); } }
        __syncthreads();
        const bf16_t* ap = WST + g * 16384 + (32 * wm + fr) * 128 + 8 * fq; const bf16_t* bp = vT + (64 * wn + fr) * 136 + 8 * fq;
        f32x4 acc[2][4]; acc_zero(acc);
        wave_gemm(acc, ap, ap + 16 * 128, bp, bp + 16 * 136, bp + 32 * 136, bp + 48 * 136, 32 * (wm + 1));
#pragma unroll
        for (int m = 0; m < 2; ++m) { const int t = 32 * wm + 16 * m + fr; const float b = bs[g * 128 + t]; const size_t uo = (size_t)(c * 128 + t) * DM + g * 128 + 64 * wn + 4 * fq; const bf16_t* up = U + uo; bf16_t* yp = YA + uo;
#pragma unroll
            for (int n = 0; n < 4; ++n) { const f32x4 u = ld4(up + 16 * n); st4(yp + 16 * n, u * (acc[m][n] + b)); } }
        __syncthreads();
    }
}

namespace att {
constexpr int QBLK = 32, KVBLK = 64, QB = 128, PITCH = 1024;
constexpr int SHM_V = KVBLK * 128 * 2, SHM_K = 2 * KVBLK * 64 * 2;
constexpr int LDS_WSF = 2 * SHM_V + 2 * SHM_K, LDS_XCH = LDS_WSF + NWAVES * 64 * 4, LDS_BYTES = LDS_XCH + 4 * 16 * 4 * 64 * 4;
constexpr float THR2 = 8.f * LOG2E;
#define KSWZ64(row, colB) ((row) * 128 + ((colB) ^ ((((row) >> 1) & 7) << 4)))
__device__ __forceinline__ int v_st(int k, int c) { const int kk = (k & ~0xC) | ((k & 4) << 1) | ((k & 8) >> 1); return ((kk >> 3) * 4 + (c >> 5)) * 512 + ((kk & 7) * 32 + (c & 31)) * 2; }
__device__ __forceinline__ int v_rd_base(int lane) { return ((lane & 3) << 3) | (((lane >> 2) & 3) << 6) | (((lane >> 4) & 1) << 5) | (((lane >> 5) & 1) << 8); }
constexpr int v_rd_off(int d0, int ks, int half) { return d0 * 512 + ks * 4096 + half * 2048; }
__device__ __forceinline__ int crow(int r, int hi) { return (r & 3) + 8 * (r >> 2) + 4 * hi; }

__device__ __forceinline__ void mask_tile(f32x16& p0, f32x16& p1, int dq) {
    const float NEG = -__builtin_inff();
#pragma unroll
    for (int r = 0; r < 16; ++r) { const int c = (r & 3) + 8 * (r >> 2);
        if (dq - c < 0) p0[r] = NEG;
        if (dq - c - 32 < 0) p1[r] = NEG; }
}
__device__ __forceinline__ void partialSM(f32x16& p0, f32x16& p1, float& m_reg, float& alpha) {
    float pmax = __builtin_fmaxf(__builtin_fmaxf(p0[0], p0[1]), p0[2]);
#pragma unroll
    for (int r = 3; r < 15; r += 2) pmax = __builtin_fmaxf(__builtin_fmaxf(pmax, p0[r]), p0[r + 1]);
    pmax = __builtin_fmaxf(__builtin_fmaxf(pmax, p0[15]), p1[0]);
#pragma unroll
    for (int r = 1; r < 15; r += 2) pmax = __builtin_fmaxf(__builtin_fmaxf(pmax, p1[r]), p1[r + 1]);
    pmax = __builtin_fmaxf(pmax, p1[15]);
    { auto rr = __builtin_amdgcn_permlane32_swap(__float_as_uint(pmax), __float_as_uint(pmax), false, false);
      pmax = fmaxf(__uint_as_float(rr[0]), __uint_as_float(rr[1])); }
    alpha = 1.f;
    if (__builtin_expect(!__all(pmax <= THR2), 0)) { asm volatile("" ::: "memory");
        const float d = fmaxf(pmax, 0.f); m_reg += d; alpha = __builtin_amdgcn_exp2f(-d);
#pragma unroll
        for (int r = 0; r < 16; ++r) { p0[r] -= d; p1[r] -= d; } }
#pragma unroll
    for (int r = 0; r < 16; ++r) p0[r] = __builtin_amdgcn_exp2f(p0[r]);
}
__device__ __forceinline__ void finishSM(f32x16& p0, f32x16& p1, float alpha, float& l_reg, bf16x8& pa0, bf16x8& pa1, bf16x8& pa2, bf16x8& pa3) {
#pragma unroll
    for (int r = 0; r < 16; ++r) p1[r] = __builtin_amdgcn_exp2f(p1[r]);
    float ps = 0;
#pragma unroll
    for (int r = 0; r < 16; ++r) ps += p0[r];
#pragma unroll
    for (int r = 0; r < 16; ++r) ps += p1[r];
    { auto rr = __builtin_amdgcn_permlane32_swap(__float_as_uint(ps), __float_as_uint(ps), false, false);
      ps = __uint_as_float(rr[0]) + __uint_as_float(rr[1]); }
    l_reg = l_reg * alpha + ps;
#define PK4(P, B_, OUT) do { unsigned a0 = cvtpk(P[B_+0], P[B_+1]), a1 = cvtpk(P[B_+2], P[B_+3]);                          \
        unsigned b0 = cvtpk(P[B_+4], P[B_+5]), b1 = cvtpk(P[B_+6], P[B_+7]);                                             \
        auto r0 = __builtin_amdgcn_permlane32_swap(a0, b0, false, false); auto r1 = __builtin_amdgcn_permlane32_swap(a1, b1, false, false); \
        u32x4 w = {r0[0], r1[0], r0[1], r1[1]}; OUT = __builtin_bit_cast(bf16x8, w); } while (0)
    PK4(p0, 0, pa0); PK4(p0, 8, pa1); PK4(p1, 0, pa2); PK4(p1, 8, pa3);
#undef PK4
}
template <int KB>
__device__ __forceinline__ void qkt(f32x16& p0, f32x16& p1, const char* Kmap_lds, int r32, int hi, const bf16x8* qr, bf16x8 kx0, bf16x8 kx1, bf16x8 qx) {
    p0 = __builtin_amdgcn_mfma_f32_32x32x16_bf16(kx0, qx, f32x16{}, 0, 0, 0); p1 = __builtin_amdgcn_mfma_f32_32x32x16_bf16(kx1, qx, f32x16{}, 0, 0, 0);
#pragma unroll
    for (int d0 = 0; d0 < 4; ++d0) { const char* a = Kmap_lds + KB * SHM_K + KSWZ64(r32, (d0 * 16 + hi * 8) * 2);
        const bf16x8 b0 = *reinterpret_cast<const bf16x8*>(a);
        const bf16x8 b1 = *reinterpret_cast<const bf16x8*>(a + 32 * 128);
        p0 = __builtin_amdgcn_mfma_f32_32x32x16_bf16(b0, qr[d0], p0, 0, 0, 0);
        p1 = __builtin_amdgcn_mfma_f32_32x32x16_bf16(b1, qr[d0], p1, 0, 0, 0); }
}
template <int VB>
__device__ __forceinline__ void pv_tile(f32x16* o, int vb0, bf16x8 pa0, bf16x8 pa1, bf16x8 pa2, bf16x8 pa3) {
#define TRRD(dst, off) asm volatile("ds_read_b64_tr_b16 %0, %1 offset:%2" : "=&v"(dst) : "v"(vb0), "i"(off) : "memory")
#define PV_D0(d0) do { s16x4 l0, l1, l2, l3, h0, h1, h2, h3; constexpr int b_ = VB * SHM_V + v_rd_off(d0, 0, 0); \
        TRRD(l0, b_); TRRD(h0, b_ + 2048); TRRD(l1, b_ + 4096); TRRD(h1, b_ + 6144); TRRD(l2, b_ + 8192); TRRD(h2, b_ + 10240); TRRD(l3, b_ + 12288); TRRD(h3, b_ + 14336); \
        asm volatile("s_waitcnt lgkmcnt(0)" ::: "memory"); SBAR();   \
        o[d0] = __builtin_amdgcn_mfma_f32_32x32x16_bf16(pa0, (bf16x8){l0[0], l0[1], l0[2], l0[3], h0[0], h0[1], h0[2], h0[3]}, o[d0], 0, 0, 0);   \
        o[d0] = __builtin_amdgcn_mfma_f32_32x32x16_bf16(pa1, (bf16x8){l1[0], l1[1], l1[2], l1[3], h1[0], h1[1], h1[2], h1[3]}, o[d0], 0, 0, 0);   \
        o[d0] = __builtin_amdgcn_mfma_f32_32x32x16_bf16(pa2, (bf16x8){l2[0], l2[1], l2[2], l2[3], h2[0], h2[1], h2[2], h2[3]}, o[d0], 0, 0, 0);   \
        o[d0] = __builtin_amdgcn_mfma_f32_32x32x16_bf16(pa3, (bf16x8){l3[0], l3[1], l3[2], l3[3], h3[0], h3[1], h3[2], h3[3]}, o[d0], 0, 0, 0); } while (0)
    PV_D0(0); PV_D0(1); PV_D0(2); PV_D0(3);
#undef PV_D0
#undef TRRD
}

__device__ __forceinline__ bf16x8 qx_of(unsigned sdw, float x) {
    const unsigned h_ = cvtpk(x, 0.f) & 0xffffu; const float r1 = x - __uint_as_float(h_ << 16);
    const unsigned m_ = cvtpk(r1, 0.f) & 0xffffu; const float r2 = r1 - __uint_as_float(m_ << 16);
    return __builtin_bit_cast(bf16x8, (u32x4){sdw, h_ | (m_ << 16), cvtpk(r2, 0.f) & 0xffffu, 0u});
}
struct BlockRef { int base; int P0; int jlo; float slope2; };
#define BR_Q(br) ((const bf16_t*)(wsb + WS_Q) + (br).base)
#define BR_K(br) ((const bf16_t*)(wsb + WS_K) + (br).base)
#define BR_V(br) ((const bf16_t*)(wsb + WS_VB) + (br).base)
#define BR_O(br) ((bf16_t*)(wsb + WS_XN) + (br).base)
struct Seam { bf16x8 qr[4]; bf16x8 st_v0, st_v1, st_k0, st_k1; };
#define VMW() asm volatile("s_waitcnt vmcnt(0)" ::: "memory")
#define VMWN(n) asm volatile("s_waitcnt vmcnt(%0)" :: "i"(n) : "memory")
#define BLD(soff) __builtin_bit_cast(bf16x8, __builtin_amdgcn_raw_buffer_load_b128(rsrc, voff, (int)(soff), 0))
#define SLOAD_H(br, k0) do { const unsigned so_ = (unsigned)((br).base + (k0) * PITCH) * 2u;                                  \
                         S.st_v0 = BLD((unsigned)WS_VB + so_); S.st_v1 = BLD((unsigned)WS_VB + so_ + 32u * PITCH * 2u);              \
                         S.st_k0 = BLD((unsigned)WS_K + so_); S.st_k1 = BLD((unsigned)WS_K + so_ + 32u * PITCH * 2u); } while (0)
#define SWRITE_HK(bf) do { *(bf16x8*)(K_lds + (bf) * SHM_K + kws) = S.st_k0; *(bf16x8*)(K_lds + (bf) * SHM_K + kws + 32 * 128) = S.st_k1; } while (0)
#define SWRITE_HV(bf) do { *(bf16x8*)(V_lds + (bf) * SHM_V + vst0) = S.st_v0; *(bf16x8*)(V_lds + (bf) * SHM_V + vst1) = S.st_v1; } while (0)
#define SWRITE_H(bf) do { SWRITE_HV(bf); SWRITE_HK(bf); } while (0)
__device__ __forceinline__ void attn_prime(const unsigned char* wsb, const BlockRef& cur, char* lds, Seam& S) {
    const int tid = threadIdx.x, wid = __builtin_amdgcn_readfirstlane(tid >> 6), lane = tid & 63, r32 = lane & 31, hi = lane >> 5;
    const int map = wid >> 2, rw = wid & 3;
    const int sr = tid >> 4, sc = (tid & 15) * 8, kws = (sc >> 6) * 8192 + KSWZ64(sr, (sc & 63) * 2); char* K_lds = lds + 2 * SHM_V;
    const int voff = (sr * PITCH + sc) * 2; const __amdgpu_buffer_rsrc_t rsrc = __builtin_amdgcn_make_buffer_rsrc((void*)wsb, 0, 0x10000000, 0x00020000);
    const int kb0 = cur.jlo * KVBLK;
#pragma unroll
    for (int d0 = 0; d0 < 4; ++d0) S.qr[d0] = *(const bf16x8*)(BR_Q(cur) + (size_t)(cur.P0 + rw * QBLK + r32) * PITCH + map * 64 + d0 * 16 + hi * 8);
    SLOAD_H(cur, kb0); VMW(); SWRITE_HK(0);
    __syncthreads();
}
__device__ __forceinline__ void attn_block(unsigned char* wsb, const BlockRef& cur, const BlockRef& nxt, char* lds, Seam& S, float lam, const float* subg) {
    const int tid = threadIdx.x, wid = __builtin_amdgcn_readfirstlane(tid >> 6), lane = tid & 63, r32 = lane & 31, hi = lane >> 5;
    const int map = wid >> 2, rw = wid & 3;
    const int j_lo = cur.jlo, j_hi = cur.P0 / KVBLK + 2, NT = j_hi - j_lo;
    const int kbn = nxt.jlo * KVBLK;
    const int qlo = cur.P0 + rw * QBLK, qm = qlo + r32 - 4 * hi;
    const float slope2 = cur.slope2; const int qpos = qlo + r32;
    unsigned sdw; { const unsigned h_ = cvtpk(slope2, 0.f) & 0xffffu; const float lo_ = slope2 - __uint_as_float(h_ << 16); sdw = h_ | (cvtpk(lo_, 0.f) << 16); }
    bf16x8 kx0, kx1; { const unsigned c0 = cvtpk((float)r32, (float)r32), c1 = cvtpk((float)(r32 + 32), (float)(r32 + 32)), one = hi ? 0u : 0x3f803f80u;
        kx0 = __builtin_bit_cast(bf16x8, (u32x4){hi ? 0u : c0, one, one & 0xffffu, 0u}); kx1 = __builtin_bit_cast(bf16x8, (u32x4){hi ? 0u : c1, one, one & 0xffffu, 0u}); }
    char* V_lds = lds; char* K_lds = lds + 2 * SHM_V; const char* Kmap = K_lds + map * 8192;
    float* ws = (float*)(lds + LDS_WSF) + wid * 64; float* li_l = ws, * al_l = ws + 32;
    float m_reg = 0.f, l_reg = 0; f32x16 o[4] = {};
    const int sr = tid >> 4, sc = (tid & 15) * 8, vst0 = v_st(sr, sc), vst1 = v_st(32 + sr, sc), kws = (sc >> 6) * 8192 + KSWZ64(sr, (sc & 63) * 2);
    const int vb0 = (int)(uintptr_t)V_lds + v_rd_base(lane);
    const int voff = (sr * PITCH + sc) * 2; const __amdgpu_buffer_rsrc_t rsrc = __builtin_amdgcn_make_buffer_rsrc((void*)wsb, 0, 0x10000000, 0x00020000);
#define RESC(a) do { if (__any((a) < 1.f)) { if (hi == 0) al_l[r32] = (a); asm volatile("s_waitcnt lgkmcnt(0)" ::: "memory");              \
                     _Pragma("unroll") for (int d_ = 0; d_ < 4; ++d_) _Pragma("unroll") for (int r = 0; r < 16; ++r) o[d_][r] *= al_l[crow(r, hi)]; } } while (0)
#define KBASE(t) ((j_lo + (t)) * KVBLK)
#define MASKT(P0_, P1_, t) do { const int kb_ = KBASE(t); if (kb_ + KVBLK - 1 > qlo) { asm volatile("" ::: "memory"); mask_tile(P0_, P1_, qm - kb_); } } while (0)
#define QX(t) qx_of(sdw, slope2 * (float)(KBASE(t) - qpos) - m_reg)
#define SEAM_K0() do { VMWN(4); SWRITE_HK(0); SBAR(); } while (0)
    f32x16 pA0, pA1, pB0, pB1; float alA, alB; bf16x8 pa0, pa1, pa2, pa3;
    SWRITE_HV(0); SBAR();
    if (NT > 1) { SLOAD_H(cur, KBASE(1)); }
    SBAR(); qkt<0>(pA0, pA1, Kmap, r32, hi, S.qr, kx0, kx1, QX(0));
    MASKT(pA0, pA1, 0); partialSM(pA0, pA1, m_reg, alA);
    if (NT > 1) { VMW(); SWRITE_H(1); }
    __syncthreads();
#define HALF_STEP(PX0, PX1, alX, PY0, PY1, alY, t, KB, VB, SB) do {                                                      \
        SBAR(); qkt<KB>(PX0, PX1, Kmap, r32, hi, S.qr, kx0, kx1, QX(t));                                                           \
        finishSM(PY0, PY1, alY, l_reg, pa0, pa1, pa2, pa3); SBAR();                                                           \
        if ((t) + 1 < NT) { SLOAD_H(cur, KBASE((t) + 1)); SBAR(); }                                               \
        pv_tile<VB>(o, vb0, pa0, pa1, pa2, pa3); MASKT(PX0, PX1, (t)); partialSM(PX0, PX1, m_reg, alX);                                        \
        __syncthreads();                                                                                                      \
        if ((t) + 1 < NT) { VMW(); SWRITE_H(SB); }                                                                          \
        RESC(alX); __syncthreads(); } while (0)
    for (int t = 1; t + 1 < NT; t += 2) {
        HALF_STEP(pB0, pB1, alB, pA0, pA1, alA, t, 1, 0, 0);
        HALF_STEP(pA0, pA1, alA, pB0, pB1, alB, t + 1, 0, 1, 1);
    }
    const bool even = (NT & 1) == 0;
    if (even) { SBAR(); qkt<1>(pB0, pB1, Kmap, r32, hi, S.qr, kx0, kx1, QX(NT - 1)); SBAR(); }
    { const int nmap = map, nrw = rw;
      SLOAD_H(nxt, kbn); SBAR();
#pragma unroll
      for (int d0 = 0; d0 < 4; ++d0) S.qr[d0] = *(const bf16x8*)(BR_Q(nxt) + (size_t)(nxt.P0 + nrw * QBLK + r32) * PITCH + nmap * 64 + d0 * 16 + hi * 8); }
    SBAR();
    finishSM(pA0, pA1, alA, l_reg, pa0, pa1, pa2, pa3); SBAR();
    pv_tile<0>(o, vb0, pa0, pa1, pa2, pa3);
    if (even) { MASKT(pB0, pB1, NT - 1); partialSM(pB0, pB1, m_reg, alB); __syncthreads(); RESC(alB);
        finishSM(pB0, pB1, alB, l_reg, pa0, pa1, pa2, pa3); SBAR(); pv_tile<1>(o, vb0, pa0, pa1, pa2, pa3); }
    SBAR(); SEAM_K0();
    if (hi == 0) li_l[r32] = l_reg; asm volatile("s_waitcnt lgkmcnt(0)" ::: "memory");
    float rli[16];
#pragma unroll
    for (int r = 0; r < 16; ++r) rli[r] = __builtin_amdgcn_rcpf(li_l[crow(r, hi)]);
    float* xch = (float*)(lds + LDS_XCH) + (size_t)rw * (16 * 4 * 64) + lane;
    if (map == 1) {
#pragma unroll
        for (int r = 0; r < 16; ++r)
#pragma unroll
            for (int d0 = 0; d0 < 4; ++d0) xch[(r * 4 + d0) * 64] = o[d0][r] * rli[r];
    }
    __syncthreads();
    if (map == 0) {
        float gsub[4];
#pragma unroll
        for (int d0 = 0; d0 < 4; ++d0) gsub[d0] = subg[d0 * 32 + r32] * (1.f - LAM_INIT);
        int obase = (cur.P0 + rw * QBLK + 4 * hi) * PITCH + r32; asm volatile("" : "+v"(obase));
        bf16_t* Ow = BR_O(cur) + obase;
#pragma unroll
        for (int r = 0; r < 16; ++r) { float d[4]; float ss = 0.f;
#pragma unroll
            for (int d0 = 0; d0 < 4; ++d0) { d[d0] = o[d0][r] * rli[r] - lam * xch[(r * 4 + d0) * 64]; ss += d[d0] * d[d0]; }
            ss += __shfl_xor(ss, 1); ss += __shfl_xor(ss, 2); ss += __shfl_xor(ss, 4); ss += __shfl_xor(ss, 8); ss += __shfl_xor(ss, 16);
            const float rs = rsqrtf(ss * (1.f / 128.f) + EPS); const int orow = (r & 3) + 8 * (r >> 2);
#pragma unroll
            for (int d0 = 0; d0 < 4; ++d0) { const float v = (d[d0] * rs) * gsub[d0]; const float vn = __shfl_xor(v, 1);
                if ((r32 & 1) == 0) *(unsigned*)(Ow + orow * PITCH + d0 * 32) = cvtpk(v, vn); } }
    }
    __syncthreads();
#undef RESC
#undef KBASE
#undef MASKT
#undef QX
#undef SEAM_K0
#undef HALF_STEP
}
#undef BLD
#undef BR_Q
#undef BR_K
#undef BR_V
#undef BR_O
#undef VMW
#undef VMWN
#undef SLOAD_H
#undef SWRITE_HK
#undef SWRITE_HV
#undef SWRITE_H
}


__device__ __forceinline__ att::BlockRef attn_ref(Frame& F, int L) {
    const int ent = ((const int*)(F.ws + WS_ROUTE + RT_ALIST))[L]; const int u = ent & 0xffff, qb = u >> 4, bh = u & 15, b = bh >> 3, h = bh & 7;
    att::BlockRef r; r.base = b * SEQ * 1024 + h * 128;
    r.P0 = qb * 128; r.jlo = ent >> 16; r.slope2 = exp2f(-(float)(h + 1)) * LOG2E;
    return r;
}
__device__ __forceinline__ void p2_attention(Frame& F) {
    const float s1 = wave_sum(F.a->in[I_LQ1][F.lane] * F.a->in[I_LK1][F.lane]), s2 = wave_sum(F.a->in[I_LQ2][F.lane] * F.a->in[I_LK2][F.lane]);
    const float lam = expf(s1) - expf(s2) + LAM_INIT;
    constexpr int NUNITS = 1024;
    volatile LAS int* qs = (volatile LAS int*)(F.lds + 143 * 1024);
    __syncthreads();
    const int v = (F.G % 8 == 0) ? (F.blk % 8) * (F.G / 8) + F.blk / 8 : F.blk;
    int L = v, Ln = 2 * F.G - 1 - v;
    if (L >= NUNITS) return;
    att::BlockRef cur = attn_ref(F, L); att::Seam S;
    att::attn_prime(F.ws, cur, F.ldsg, S);
    for (;;) {
        const bool last = Ln >= NUNITS;
        int nn = 0; if (F.tid == 0 && !last) nn = 2 * F.G + (int)atomicAdd(F.ctl + CW_AQ, 1u);
        const att::BlockRef nxt = last ? cur : attn_ref(F, Ln);
        att::attn_block(F.ws, cur, nxt, F.ldsg, S, lam, F.a->in[I_SUBG]);
        if (last) break;
        if (F.tid == 0) qs[0] = nn;
        __syncthreads();
        cur = nxt; Ln = qs[0];
        __syncthreads();
    }
}

__device__ __forceinline__ void p3_merged(Frame& F) {
    pg8::StaticOrder S; S.init(M, DM, F.G, F.blk);
    { pg8::Gemm g{(const bf16_t*)(F.ws + WS_YA), (const bf16_t*)(F.ws + WS_WUPT), DM, nullptr}; EpiGateT E{(const bf16_t*)F.out, (bf16_t*)(F.ws + WS_T)};
      pg8::gemm_phase<EpiGateT, pg8::StaticOrder, PG8_ALIGN, PG8_SP2, false>(F.lds, g, S, E); }
    { pg8::Gemm g{(const bf16_t*)(F.ws + WS_XN), (const bf16_t*)(F.ws + WS_WUPT) + 1024 * 1024, DM, nullptr}; EpiMerged E{(const bf16_t*)F.out, (const bf16_t*)(F.ws + WS_T), (bf16_t*)(F.ws + WS_Q)};
      pg8::gemm_phase<EpiMerged, pg8::StaticOrder, PG8_ALIGN, PG8_SP2, false>(F.lds, g, S, E); }
}
__device__ __forceinline__ void p4_out(Frame& F) {
    pg8::StaticOrder S; S.init(M, DM, F.G, F.blk);
    pg8::Gemm g{(const bf16_t*)(F.ws + WS_Q), (const bf16_t*)(F.ws + WS_WOUTT), DM, nullptr}; EpiOut E{F.a->in[I_X], F.out};
    pg8::gemm_phase<EpiOut, pg8::StaticOrder, PG8_ALIGN, PG8_SP2, false>(F.lds, g, S, E);
}
__device__ __forceinline__ void h2_row(Frame& F, int t, f32x4 (&h)[4]) {
    const f32x4* xr = (const f32x4*)(F.out + (size_t)t * DM) + F.lane; const f32x4* g4 = (const f32x4*)F.a->in[I_N2G] + F.lane;
    float s = 0.f;
#pragma unroll
    for (int j = 0; j < 4; ++j) { h[j] = xr[64 * j]; s += (h[j][0] * h[j][0] + h[j][1] * h[j][1]) + (h[j][2] * h[j][2] + h[j][3] * h[j][3]); }
    const float r = rsqrtf(wave_sum(s) * (1.f / DM) + EPS);
#pragma unroll
    for (int j = 0; j < 4; ++j) h[j] = (h[j] * r) * g4[64 * j];
}
__device__ __forceinline__ void p5_router(Frame& F) {
    const float* WRT = (const float*)(F.ws + WS_ROUTE + RT_WRT); const float* brg = F.a->in[I_BRG]; const float* bre = F.a->in[I_BRE];
    int* tokpos = (int*)(F.ws + WS_ROUTE + RT_TOKPOS); float* roww = (float*)(F.ws + WS_ROUTE + RT_ROWW); int* rowtok = (int*)(F.ws + WS_ROUTE + RT_ROWTOK);
    LAS float* lg = (LAS float*)(F.lds + 128 * 1024 + (F.wid & 3) * 3072);
    const int i16 = F.lane & 15, kq = F.lane >> 4;
    if (F.wid < 4)
    for (int task = F.blk * 4 + F.wid; task < M / 16; task += F.G * 4) { const int t0 = task * 16;
        const float* xp = F.out + (size_t)(t0 + i16) * DM + 4 * kq; const float* wp = WRT + (size_t)i16 * DM + 4 * kq;
        f32x4 acc0 = {0.f, 0.f, 0.f, 0.f}, acc1 = acc0, acc2 = acc0; float ss = 0.f;
#pragma unroll 4
        for (int s = 0; s < 64; ++s) { const f32x4 xa = *(const f32x4*)(xp + 16 * s);
            const f32x4 w0 = *(const f32x4*)(wp + 16 * s), w1 = *(const f32x4*)(wp + 16 * DM + 16 * s), w2 = *(const f32x4*)(wp + 32 * DM + 16 * s);
            ss += (xa[0] * xa[0] + xa[1] * xa[1]) + (xa[2] * xa[2] + xa[3] * xa[3]);
#pragma unroll
            for (int e = 0; e < 4; ++e) { acc0 = __builtin_amdgcn_mfma_f32_16x16x4f32(xa[e], w0[e], acc0, 0, 0, 0); acc1 = __builtin_amdgcn_mfma_f32_16x16x4f32(xa[e], w1[e], acc1, 0, 0, 0);
                acc2 = __builtin_amdgcn_mfma_f32_16x16x4f32(xa[e], w2[e], acc2, 0, 0, 0); } }
        ss += __shfl_xor(ss, 16); ss += __shfl_xor(ss, 32);
        const float rr = rsqrtf(ss * (1.f / DM) + EPS);
#pragma unroll
        for (int reg = 0; reg < 4; ++reg) { LAS float* p = lg + (4 * kq + reg) * 48 + i16; p[0] = acc0[reg]; p[16] = acc1[reg]; p[32] = acc2[reg]; }
        LDS_WAIT(); asm volatile("" ::: "memory");
        if (F.lane < 16) { const LAS float* p = lg + F.lane * 48;
            float gl[4];
#pragma unroll
            for (int i = 0; i < 4; ++i) gl[i] = p[i] * rr + brg[i];
            int g = 0; float gm = gl[0];
#pragma unroll
            for (int i = 1; i < 4; ++i) if (gl[i] > gm) { gm = gl[i]; g = i; }
            float gs = 0.f;
#pragma unroll
            for (int i = 0; i < 4; ++i) gs += expf(gl[i] - gm);
            const float ggate = 1.f / gs;
            float el[8];
#pragma unroll
            for (int i = 0; i < 8; ++i) el[i] = p[4 + g * 8 + i] * rr + bre[g * 8 + i];
            int i1 = 0; float v1 = el[0];
#pragma unroll
            for (int i = 1; i < 8; ++i) if (el[i] > v1) { v1 = el[i]; i1 = i; }
            int i2 = -1; float v2 = -__builtin_inff();
#pragma unroll
            for (int i = 0; i < 8; ++i) if (i != i1 && el[i] > v2) { v2 = el[i]; i2 = i; }
            const float a = expf(v2 - v1), w1 = 1.f / (1.f + a), w2 = a / (1.f + a);
            const int t = t0 + F.lane, e1 = g * 8 + i1, e2 = g * 8 + i2;
            const int r1 = (int)atomicAdd(F.ctl + CW_CNT + e1 * CW_CNT_STRIDE, 1u), r2 = (int)atomicAdd(F.ctl + CW_CNT + e2 * CW_CNT_STRIDE, 1u);
            rowtok[e1 * ECAP + r1] = t; roww[e1 * ECAP + r1] = ggate * w1; rowtok[e2 * ECAP + r2] = t; roww[e2 * ECAP + r2] = ggate * w2;
            tokpos[2 * t] = (e1 << ECAP_LOG) | r1; tokpos[2 * t + 1] = (e2 << ECAP_LOG) | r2; }
        LDS_WAIT(); asm volatile("" ::: "memory");
    }
    if (F.wid < 4) { bf16_t* H2 = (bf16_t*)(F.ws + WS_H2);
      for (int t0 = (F.blk * 4 + F.wid) * 2; t0 < M; t0 += F.G * 4 * 2) { f32x4 h0[4], h1[4]; h2_row(F, t0, h0); h2_row(F, t0 + 1, h1);
#pragma unroll
          for (int j = 0; j < 4; ++j) { st4(H2 + (size_t)t0 * DM + 4 * F.lane + 256 * j, h0[j]); st4(H2 + (size_t)(t0 + 1) * DM + 4 * F.lane + 256 * j, h1[j]); } } }
    if (F.wid >= 4) {
      LAS float* scr = (LAS float*)(F.lds + (F.wid - 4) * 32768);
      bf16_t* W13T = (bf16_t*)(F.ws + WS_W13T); bf16_t* W2T = (bf16_t*)(F.ws + WS_W2T);
#define XW_SRC(it_) (((it_) % 384) < 128 ? F.a->in[I_W1] + (size_t)((it_) / 384) * 1024 * 256 : ((it_) % 384) < 256 ? F.a->in[I_W3] + (size_t)((it_) / 384) * 1024 * 256 : F.a->in[I_W2] + (size_t)((it_) / 384) * 256 * 1024)
#define XW_STORE(v_, it_, scr_) do { const int e_ = (it_) / 384, r_ = (it_) % 384; \
          if (r_ < 128) tr_store(v_, 256, W13T, 1024, 0, RmW13{e_ * 512}, scr_, r_, F.lane); \
          else if (r_ < 256) tr_store(v_, 256, W13T, 1024, 0, RmW13{e_ * 512 + 128}, scr_, r_ - 128, F.lane); \
          else tr_store(v_, 1024, W2T, 256, 0, RmAdd{e_ * 1024}, scr_, r_ - 256, F.lane); } while (0)
      const int stride = F.G * 4;
      for (int it = F.blk * 4 + (F.wid - 4); it < NE * 384; it += 2 * stride) { const int it2 = it + stride; const bool two = it2 < NE * 384;
          float va[32], vb[32];
          { const int r = it % 384; tr_load(XW_SRC(it), r < 256 ? 256 : 1024, r < 128 ? r : r < 256 ? r - 128 : r - 256, F.lane, va); }
          if (two) { const int r = it2 % 384; tr_load(XW_SRC(it2), r < 256 ? 256 : 1024, r < 128 ? r : r < 256 ? r - 128 : r - 256, F.lane, vb); }
          XW_STORE(va, it, scr);
          if (two) XW_STORE(vb, it2, scr + 64 * 33); }
#undef XW_SRC
#undef XW_STORE
    }
}
__device__ __forceinline__ void moe_offsets(Frame& F, LAS int* offs) {
    __syncthreads();
    if (F.tid < 64) { const int c = F.tid < NE ? (int)__hip_atomic_load(F.ctl + CW_CNT + F.tid * CW_CNT_STRIDE, __ATOMIC_RELAXED, __HIP_MEMORY_SCOPE_AGENT) : 0; const int p = (c + 255) & ~255; int incl = p;
#pragma unroll
        for (int o = 1; o < 32; o <<= 1) { const int v = __shfl_up(incl, o); if ((F.tid & 63) >= o) incl += v; }
        if (F.tid < NE) { offs[F.tid] = incl - p; offs[40 + F.tid] = c; } if (F.tid == NE - 1) offs[NE] = incl; }
    __syncthreads();
}
__device__ __forceinline__ int expert_of_row(LAS int* offs, int row) { int e = 0;
#pragma unroll 1
    for (int i = 1; i < NE; ++i) if (row >= offs[i]) e = i;
    return e; }
__device__ __forceinline__ void moe_gemm1(Frame& F, LAS int* offs, int G, int c, int lo, int hi) {
    MoeOrder S{offs, 2, G, c, lo, hi};
    pg8::Gemm g{(const bf16_t*)(F.ws + WS_H2), (const bf16_t*)(F.ws + WS_W13T), DM, (const int*)(F.ws + WS_ROUTE + RT_ROWTOK)}; EpiSwiglu E{(const float*)(F.ws + WS_ROUTE + RT_ROWW), (bf16_t*)(F.ws + WS_HID)};
    pg8::gemm_phase<EpiSwiglu, MoeOrder, PG8_ALIGN, PG8_SP2, false, true>(F.lds, g, S, E);
}
__device__ __forceinline__ void moe_gemm2(Frame& F, LAS int* offs, int G, int c, int lo, int hi) {
    MoeOrder S{offs, 4, G, c, lo, hi};
    int kde = DE; asm volatile("" : "+s"(kde));
    pg8::Gemm g{(const bf16_t*)(F.ws + WS_HID), (const bf16_t*)(F.ws + WS_W2T), kde, nullptr}; EpiY E{(bf16_t*)(F.ws + WS_YBUF)};
    pg8::gemm_phase<EpiY, MoeOrder, PG8_ALIGN, PG8_SP2, false>(F.lds, g, S, E);
}
__device__ __forceinline__ void p7_moe_a(Frame& F) {
    LAS int* offs = (LAS int*)(F.lds + 140 * 1024); moe_offsets(F, offs);
    const int n1 = (offs[NE] / 256) * 2;
    moe_gemm1(F, offs, F.G, F.blk, 0, n1 < F.G ? n1 : F.G);
}
__device__ __forceinline__ void p7_moe_b(Frame& F) {
    LAS int* offs = (LAS int*)(F.lds + 140 * 1024); moe_offsets(F, offs);
    const int T = offs[NE] / 256, n1 = T * 2; int nrem = n1 - F.G; if (nrem < 0) nrem = 0; if (nrem > F.G / 2) nrem = F.G / 2;
    const int t2 = (T < F.G / 2 ? T : F.G / 2) * 4;
    if (F.blk < nrem) moe_gemm1(F, offs, nrem, F.blk, F.G, n1);
    else moe_gemm2(F, offs, F.G - nrem, F.blk - nrem, 0, t2);
}
__device__ __forceinline__ void p8_moe_c(Frame& F) {
    LAS int* offs = (LAS int*)(F.lds + 140 * 1024); moe_offsets(F, offs);
    const int T = offs[NE] / 256;
    moe_gemm2(F, offs, F.G, F.blk, (T < F.G / 2 ? T : F.G / 2) * 4, T * 4);
}
__device__ __forceinline__ void p9_combine(Frame& F) {
    LAS int* offs = (LAS int*)(F.lds + 140 * 1024);
    moe_offsets(F, offs);
    const bf16_t* YB = (const bf16_t*)(F.ws + WS_YBUF); const int* tokpos = (const int*)(F.ws + WS_ROUTE + RT_TOKPOS);
    for (int t0 = F.gw * 4; t0 < M; t0 += F.NGW * 4) { int p[4][2];
#pragma unroll
        for (int q = 0; q < 4; ++q) { const int a0 = tokpos[2 * (t0 + q)], a1 = tokpos[2 * (t0 + q) + 1]; p[q][0] = offs[a0 >> ECAP_LOG] + (a0 & (ECAP - 1)); p[q][1] = offs[a1 >> ECAP_LOG] + (a1 & (ECAP - 1)); }
        f32x4 xv[4][4];
#pragma unroll
        for (int q = 0; q < 4; ++q)
#pragma unroll
            for (int j = 0; j < 4; ++j) xv[q][j] = ((const f32x4*)(F.out + (size_t)(t0 + q) * DM) + F.lane)[64 * j];
#pragma unroll
        for (int q = 0; q < 4; ++q) {
            f32x4 a[4], b[4];
#pragma unroll
            for (int j = 0; j < 4; ++j) { a[j] = ld4(YB + (size_t)p[q][0] * DM + 4 * F.lane + 256 * j); b[j] = ld4(YB + (size_t)p[q][1] * DM + 4 * F.lane + 256 * j); }
#pragma unroll
            for (int j = 0; j < 4; ++j) ((f32x4*)(F.out + (size_t)(t0 + q) * DM) + F.lane)[64 * j] = xv[q][j] + (a[j] + b[j]); } }
}

#define XB_TMO      128
#define XB_XCNT(j)  (256  + 64 * (j))
#define XB_XSUB(j)  (1280 + 64 * (j))
#define XB_XGEN(j)  (2304 + 64 * (j))
#define XB_TOP      3328
#define XB_TOPGEN   3392
#define XCD_BAR_WORDS 3456
#define XB_SPIN_CAP (1u << 22)

__device__ __forceinline__ unsigned xb_ld(unsigned* p)              { return __hip_atomic_load(p, __ATOMIC_RELAXED, __HIP_MEMORY_SCOPE_AGENT); }
__device__ __forceinline__ unsigned xb_add(unsigned* p, unsigned v) { return __hip_atomic_fetch_add(p, v, __ATOMIC_RELAXED, __HIP_MEMORY_SCOPE_AGENT); }
__device__ __forceinline__ unsigned xb_xcc_id() { return (unsigned)__builtin_amdgcn_s_getreg((3 << 11) | 20) & 0xFu; }
#define XB_SPIN(cond, bar) do { unsigned _sp = 0; while (cond) { __builtin_amdgcn_s_sleep(1); \
    if ((++_sp & 255u) == 0u) { if (xb_ld(&(bar)[XB_TMO])) break; if (_sp > XB_SPIN_CAP) { atomicAdd(&(bar)[XB_TMO], 1u); break; } } } } while (0)

struct XcdBarrier {
    unsigned* bar; unsigned x;
    volatile LAS unsigned* st;
};

__device__ __forceinline__ XcdBarrier xcd_barrier_post(unsigned* bar, volatile LAS unsigned* st) {
    XcdBarrier b; b.bar = bar; b.x = xb_xcc_id(); b.st = st;
    if (threadIdx.x == 0) (void)xb_add(&bar[XB_XCNT(b.x)], 1u);
    return b;
}
__device__ __forceinline__ void xcd_barrier_complete(unsigned* bar, unsigned x, unsigned& nloc, unsigned& nx) {
    const unsigned G = gridDim.x * gridDim.y * gridDim.z;
    unsigned sum, cnt, mine, sp = 0u;
    for (;;) {
        sum = 0u; cnt = 0u; mine = 0u;
#pragma unroll
        for (unsigned j = 0; j < 16; ++j) { const unsigned c = xb_ld(&bar[XB_XCNT(j)]); sum += c; cnt += (c > 0u) ? 1u : 0u; mine = (j == x) ? c : mine; }
        if (sum == G) break;
        __builtin_amdgcn_s_sleep(1);
        if ((++sp & 255u) == 0u) { if (xb_ld(&bar[XB_TMO])) break; if (sp > XB_SPIN_CAP) { atomicAdd(&bar[XB_TMO], 1u); break; } }
    }
    nloc = mine > 0u ? mine : 1u; nx = cnt > 0u ? cnt : 1u;
}

__device__ __forceinline__ void xcd_barrier(const XcdBarrier& b) {
    asm volatile("s_waitcnt vmcnt(0)" ::: "memory");
    __syncthreads();
    if (threadIdx.x == 0) {
        unsigned* bar = b.bar;
        __builtin_amdgcn_s_waitcnt(0);
        unsigned nloc = b.st[0], nx = b.st[1];
        if (nloc == 0u) { xcd_barrier_complete(bar, b.x, nloc, nx); b.st[0] = nloc; b.st[1] = nx; }
        const unsigned old = xb_add(&bar[XB_XSUB(b.x)], 1u);
        const unsigned gen = old / nloc;
        if (old + 1u == (gen + 1u) * nloc) {
            __builtin_amdgcn_fence(__ATOMIC_RELEASE, "agent");
            asm volatile("s_waitcnt vmcnt(0)" ::: "memory");
            const unsigned og = xb_add(&bar[XB_TOP], 1u);
            const unsigned tg = og / nx;
            if (og + 1u == (tg + 1u) * nx) xb_add(&bar[XB_TOPGEN], 1u);
            else XB_SPIN(xb_ld(&bar[XB_TOPGEN]) == tg, bar);
            __builtin_amdgcn_fence(__ATOMIC_ACQUIRE, "agent");
            xb_add(&bar[XB_XGEN(b.x)], 1u);
            asm volatile("s_waitcnt vmcnt(0)" ::: "memory");
        } else {
            XB_SPIN(xb_ld(&bar[XB_XGEN(b.x)]) == gen, bar);
            __builtin_amdgcn_fence(__ATOMIC_ACQUIRE, "agent");
            asm volatile("s_waitcnt vmcnt(0)" ::: "memory");
        }
    }
    __syncthreads();
}
constexpr int LDS_BYTES = 147456;
__global__ void __launch_bounds__(NTHREADS, 2) fwd_kernel(Args args) {
    extern __shared__ __attribute__((aligned(16))) unsigned char lds[];
    Frame F;
    F.lds = (LAS unsigned char*)lds; F.ldsg = (char*)lds;
    F.tid = threadIdx.x; F.lane = F.tid & 63; F.wid = __builtin_amdgcn_readfirstlane(F.tid >> 6);
    F.blk = blockIdx.x; F.G = gridDim.x; F.gw = F.blk * NWAVES + F.wid; F.NGW = F.G * NWAVES;
    F.a = &args;
    F.out = args.out; F.ws = args.ws; F.ctl = (unsigned*)(args.ws + WS_CTL);
    const int lo = args.ph_lo, hi = args.ph_hi;
#if MK_ONE_LAUNCH
    cg::grid_group grid = cg::this_grid();
    volatile LAS unsigned* bst = (volatile LAS unsigned*)(F.lds + 144 * 1024 - 16);
    if (F.tid < 2) bst[F.tid] = 0u;
    __syncthreads();
    const XcdBarrier bar = xcd_barrier_post(F.ctl + CW_BAR, bst);
#define SEAM(k) do { if (lo <= (k) && (k) + 1 < hi) { xcd_barrier(bar); } asm volatile("" : "+v"(F.tid), "+v"(F.lane)); } while (0)
    if (hi > NPHASE) grid.sync();
#else
#define SEAM(k) do { } while (0)
#endif
#define IN(k) (lo <= (k) && (k) < hi)
    if (IN(0)) { p0_prologue(F); } SEAM(0);
    if (IN(1)) { p1_proj(F); } SEAM(1);
    if (IN(2)) { p2_mixer_a(F); p2_attention(F); } SEAM(2);
    if (IN(3)) { p3_merged(F); } SEAM(3);
    if (IN(4)) { p4_out(F); } SEAM(4);
    if (IN(5)) { p5_router(F); } SEAM(5);
    if (IN(6)) { p7_moe_a(F); } SEAM(6);
    if (IN(7)) { p7_moe_b(F); } SEAM(7);
    if (IN(8)) { p8_moe_c(F); } SEAM(8);
    if (IN(9)) { p9_combine(F); }
#undef IN
#undef SEAM
}

extern "C" void kernel_launch(void* const* d_in, const int* in_sizes, int n_in, void* d_out, int out_size, void* d_ws, size_t ws_size, hipStream_t stream) {
    static int grid = 0;
    if (grid == 0) {
        if (n_in != 26 || out_size != M * DM || ws_size < WS_END) { fprintf(stderr, "kernel_launch: unexpected shapes (n_in %d out %d ws %zu)\n", n_in, out_size, ws_size); grid = -1; return; }
        int dev = 0, cus = 0, per_cu = 0;
        (void)hipGetDevice(&dev); (void)hipDeviceGetAttribute(&cus, hipDeviceAttributeMultiprocessorCount, dev);
        if (hipFuncSetAttribute((const void*)fwd_kernel, hipFuncAttributeMaxDynamicSharedMemorySize, LDS_BYTES) != hipSuccess) { fprintf(stderr, "kernel_launch: hipFuncSetAttribute failed\n"); grid = -1; return; }
        if (hipOccupancyMaxActiveBlocksPerMultiprocessor(&per_cu, (const void*)fwd_kernel, NTHREADS, LDS_BYTES) != hipSuccess || per_cu < 1) { fprintf(stderr, "kernel_launch: occupancy query says %d\n", per_cu); per_cu = 1; }
        (void)hipGetLastError();
        grid = cus;
    }
    if (grid < 0) return;
    (void)hipMemsetAsync((char*)d_ws + WS_CTL, 0, CTL_ZERO_BYTES, stream);
    Args a{};
    for (int i = 0; i < 26; ++i) a.in[i] = (const float*)d_in[i];
    a.out = (float*)d_out; a.ws = (unsigned char*)d_ws;
#if MK_ONE_LAUNCH
    a.ph_lo = 0; a.ph_hi = NPHASE;
    void* kargs[] = {&a};
    hipError_t e = hipLaunchCooperativeKernel((const void*)fwd_kernel, dim3(grid), dim3(NTHREADS), kargs, LDS_BYTES, stream);
    if (e != hipSuccess) fprintf(stderr, "cooperative launch failed: %s (grid %d)\n", hipGetErrorString(e), grid);
#else
    for (int p = 0; p < NPHASE; ++p) { a.ph_lo = p; a.ph_hi = p + 1; hipLaunchKernelGGL(fwd_kernel, dim3(grid), dim3(NTHREADS), LDS_BYTES, stream, a); }
#endif
}
```

```cpp
#include <hip/hip_runtime.h>
#include <hip/hip_cooperative_groups.h>
#include <cstdio>
#include <cstdint>
namespace cg = cooperative_groups;

#ifndef MK_ONE_LAUNCH
#define MK_ONE_LAUNCH 1
#endif

#define LAS __attribute__((address_space(3)))
typedef unsigned short bf16_t;
typedef short bf16x8 __attribute__((ext_vector_type(8)));
typedef short s16x4 __attribute__((ext_vector_type(4)));
typedef float f32x4 __attribute__((ext_vector_type(4)));
typedef float f32x16 __attribute__((ext_vector_type(16)));
typedef float f32x2 __attribute__((ext_vector_type(2)));
typedef unsigned u32x4 __attribute__((ext_vector_type(4)));
typedef unsigned u32x2 __attribute__((ext_vector_type(2)));
typedef __bf16 bf16x2_t __attribute__((ext_vector_type(2)));

constexpr int NB = 2, SEQ = 8192, DM = 1024, M = NB * SEQ;
constexpr int NH = 8;
constexpr int N1 = 7168;
constexpr int NE = 32, DE = 256;
constexpr float EPS = 1e-6f;
constexpr float LOG2E = 1.4426950408889634f;
constexpr float C2 = 0.125f * LOG2E;
constexpr float LAM_INIT = 0.2f;
constexpr int NWAVES = 8, NTHREADS = 512;
constexpr int NPHASE = 10;
constexpr int ECAP = 16384, ECAP_LOG = 14;

constexpr size_t MiB = 1u << 20;
constexpr size_t WS_CTL = 0;
constexpr size_t CTL_ZERO_BYTES = 65536;
constexpr size_t WS_W1T = 1 * MiB;
constexpr size_t WS_WUPT = 15 * MiB;
constexpr size_t WS_WOUTT = 19 * MiB;
constexpr size_t WS_WST = 21 * MiB;
constexpr size_t WS_ROUTE = 22 * MiB;
constexpr size_t WS_XN = 32 * MiB;
constexpr size_t WS_U = 64 * MiB;
constexpr size_t WS_VA = 96 * MiB;
constexpr size_t WS_Q = 128 * MiB;
constexpr size_t WS_K = 160 * MiB;
constexpr size_t WS_VB = 192 * MiB;
constexpr size_t WS_W13T = 160 * MiB;
constexpr size_t WS_W2T = 192 * MiB;
constexpr size_t WS_HID = 208 * MiB;
constexpr size_t WS_H2 = 32 * MiB;
constexpr size_t WS_YBUF = 64 * MiB;
constexpr size_t WS_YA = 224 * MiB;
constexpr size_t WS_T = 64 * MiB;
constexpr size_t WS_END = 256 * MiB;
constexpr size_t RT_TOKE = 0, RT_TOKW = 256 * 1024, RT_TOKPOS = 512 * 1024, RT_WRT = 1024 * 1024, RT_ALIST = 1536 * 1024, RT_ROWTOK = 2048 * 1024, RT_ROWW = 4096 * 1024;
constexpr int CW_CNT = 8192, CW_CNT_STRIDE = 64, CW_AQ = 512, CW_BAR = 1024;

#define LDS_WAIT() asm volatile("s_waitcnt lgkmcnt(0)" ::: "memory")
#define SBAR() __builtin_amdgcn_sched_barrier(0)
__device__ __forceinline__ unsigned cvtpk(float lo, float hi) { f32x2 v = {lo, hi}; bf16x2_t b = __builtin_convertvector(v, bf16x2_t); return __builtin_bit_cast(unsigned, b); }
__device__ __forceinline__ float bf2f(short b) { return __uint_as_float(((unsigned)(unsigned short)b) << 16); }
__device__ __forceinline__ float wave_sum(float v) {
#pragma unroll
    for (int o = 1; o < 64; o <<= 1) v += __shfl_xor(v, o);
    return v;
}
__device__ __forceinline__ void st4(bf16_t* p, f32x4 v) { u32x2 w; w.x = cvtpk(v[0], v[1]); w.y = cvtpk(v[2], v[3]); *(u32x2*)p = w; }
__device__ __forceinline__ f32x4 ld4(const bf16_t* p) { const u32x2 w = *(const u32x2*)p; f32x4 r; r[0] = __uint_as_float(w.x << 16); r[1] = __uint_as_float(w.x & 0xffff0000u); r[2] = __uint_as_float(w.y << 16); r[3] = __uint_as_float(w.y & 0xffff0000u); return r; }

struct Args { const float* in[26]; float* out; unsigned char* ws; int ph_lo, ph_hi; };

struct Frame {
    LAS unsigned char* lds; char* ldsg;
    int tid, lane, wid, blk, G, gw, NGW;
    const Args* a; float* out; unsigned char* ws; unsigned* ctl;
};
enum { I_X = 0, I_N1G, I_WIN, I_VNG, I_WS, I_BS, I_QNG, I_KNG, I_LQ1, I_LK1, I_LQ2, I_LK2, I_SUBG, I_WUPA, I_WUPB, I_WGATE, I_BGATE, I_WOUT, I_N2G, I_WRG, I_BRG, I_WRE, I_BRE, I_W1, I_W3, I_W2 };

__device__ __forceinline__ void wave_gemm(f32x4 (&acc)[2][4], const bf16_t* ap0, const bf16_t* ap1, const bf16_t* bp0, const bf16_t* bp1, const bf16_t* bp2, const bf16_t* bp3, int K) {
#pragma unroll 2
    for (int k0 = 0; k0 < K; k0 += 32) {
        const bf16x8 a0 = *(const bf16x8*)(ap0 + k0), a1 = *(const bf16x8*)(ap1 + k0);
        const bf16x8 b0 = *(const bf16x8*)(bp0 + k0), b1 = *(const bf16x8*)(bp1 + k0), b2 = *(const bf16x8*)(bp2 + k0), b3 = *(const bf16x8*)(bp3 + k0);
        acc[0][0] = __builtin_amdgcn_mfma_f32_16x16x32_bf16(b0, a0, acc[0][0], 0, 0, 0);
        acc[0][1] = __builtin_amdgcn_mfma_f32_16x16x32_bf16(b1, a0, acc[0][1], 0, 0, 0);
        acc[0][2] = __builtin_amdgcn_mfma_f32_16x16x32_bf16(b2, a0, acc[0][2], 0, 0, 0);
        acc[0][3] = __builtin_amdgcn_mfma_f32_16x16x32_bf16(b3, a0, acc[0][3], 0, 0, 0);
        acc[1][0] = __builtin_amdgcn_mfma_f32_16x16x32_bf16(b0, a1, acc[1][0], 0, 0, 0);
        acc[1][1] = __builtin_amdgcn_mfma_f32_16x16x32_bf16(b1, a1, acc[1][1], 0, 0, 0);
        acc[1][2] = __builtin_amdgcn_mfma_f32_16x16x32_bf16(b2, a1, acc[1][2], 0, 0, 0);
        acc[1][3] = __builtin_amdgcn_mfma_f32_16x16x32_bf16(b3, a1, acc[1][3], 0, 0, 0);
    }
}
__device__ __forceinline__ void acc_zero(f32x4 (&acc)[2][4]) {
#pragma unroll
    for (int m = 0; m < 2; ++m)
#pragma unroll
        for (int n = 0; n < 4; ++n) acc[m][n] = (f32x4){0.f, 0.f, 0.f, 0.f};
}

namespace pg8 {
#define PG8_LAS __attribute__((address_space(3)))
constexpr int BM = 256, BK = 64, HALF = 128, HTB = HALF * BK * 2  , STAGE_BYTES = 8 * HTB, NXCD = 8, WGM = 8;

__host__ __device__ __forceinline__ int lds_byte(int r, int c) { const int st = (r >> 4) * 2 + (c >> 5), rr = r & 15, cc = c & 31, ob = rr * 64 + cc * 2; return st * 1024 + (ob ^ (((ob >> 9) & 1) << 5)); }
__host__ __device__ __forceinline__ void stage_rc(int b, int& R, int& C) { const int st = b / 1024, sb = b % 1024, swz = sb ^ (((sb >> 9) & 1) << 5); R = (st >> 1) * 16 + swz / 64; C = (st & 1) * 32 + (swz % 64) / 2; }
__host__ __device__ __forceinline__ int perm32(int rho) { const int n = rho >> 4, i = rho & 15; return 8 * (i >> 2) + 4 * n + (i & 3); }

struct Unit { int pm, pn, pb, rbase, nvalid; };
struct Gemm { const bf16_t* A; const bf16_t* Bt; int K; const int* rowtok; };

struct StaticOrder {
    int nM, nN, nwg, G, c;
    __host__ __device__ void init(int M, int N, int G_, int c_) { nM = M / BM; nN = N / BM; nwg = nM * nN; G = G_; c = c_; }
    __host__ __device__ bool next(int i, Unit& u) const {
        const long L = (long)i * G + c; if (L >= nwg) return false;
        int wgid = (int)L; { const int q = nwg / NXCD, r = nwg % NXCD, xcd = wgid % NXCD, off = wgid / NXCD; wgid = (xcd < r ? xcd * (q + 1) : r * (q + 1) + (xcd - r) * q) + off; }
        const int nig = WGM * nN, gid = wgid / nig, fm = gid * WGM, gsz = (nM - fm) < WGM ? (nM - fm) : WGM;
        u.pm = fm + ((wgid % nig) % gsz); u.pn = (wgid % nig) / gsz; u.pb = u.pn; u.rbase = 0; u.nvalid = 0; return true;
    }
    __device__ __forceinline__ void a_ready(const Unit&) const {}
    __device__ __forceinline__ void done(const Unit&) const {}
};
template <class Epi, class Sched, bool ALIGN_EPI = false, bool SP2 = false, bool BP64 = false, bool GATHER = false>
__device__ __forceinline__ void gemm_phase(PG8_LAS unsigned char* lds, const Gemm g, const Sched& S, const Epi& E) {
    const int tid = threadIdx.x, wid = __builtin_amdgcn_readfirstlane(tid >> 6), lane = tid & 63, wr = wid >> 2, wc = wid & 3, fr = lane & 15, fq = lane >> 4;
    const int K = g.K, nt = K / BK;
    unsigned voffA[2], voffB[2];
#pragma unroll
    for (int i = 0; i < 2; ++i) { int R, C; stage_rc(tid * 16 + i * 8192, R, C); const int Rp = Epi::PERM ? ((R & ~31) + perm32(R & 31)) : R; const int Rb = BP64 ? (64 * (Rp >> 5) + (Rp & 31)) : Rp;
        voffA[i] = (unsigned)(R * K + C) * 2u; voffB[i] = (unsigned)(Rb * K + C) * 2u; }
    const size_t kstep = (size_t)(BK * 2);
    const size_t hstep = (size_t)HALF * K * 2;
    const size_t tstep = 2 * hstep;
    const size_t bhs = BP64 ? (size_t)32 * K * 2 : hstep;
    const unsigned ldsw = (unsigned)wid * 1024u;
    const int aoff = lds_byte(wr * 64 + fr, fq * 8), boff = lds_byte(wc * 32 + fr, fq * 8);
#define PG8_SA(b, h) (((b) * 2 + (h)) * HTB)
#define PG8_SB(b, h) ((4 + (b) * 2 + (h)) * HTB)
#define PG8_STAGE(bufoff, gbase, voff) do { _Pragma("unroll") for (int _i = 0; _i < 2; ++_i) \
        __builtin_amdgcn_global_load_lds((const unsigned*)((const char*)(gbase) + (voff)[_i]), (PG8_LAS unsigned*)(lds + (bufoff) + ldsw + _i * 8192), 16, 0, 0); } while (0)
#define PG8_LDA(dst, b, h) do { _Pragma("unroll") for (int m = 0; m < 4; ++m) _Pragma("unroll") for (int k = 0; k < 2; ++k) dst[m][k] = *(const PG8_LAS bf16x8*)(lds + PG8_SA(b, h) + aoff + m * 2048 + k * 1024); } while (0)
#define PG8_LDB(dst, b, h) do { _Pragma("unroll") for (int n = 0; n < 2; ++n) _Pragma("unroll") for (int k = 0; k < 2; ++k) dst[n][k] = *(const PG8_LAS bf16x8*)(lds + PG8_SB(b, h) + boff + n * 2048 + k * 1024); } while (0)
#define PG8_MMA(ai, bj, At, Bt) do { __builtin_amdgcn_s_setprio(1); _Pragma("unroll") for (int m = 0; m < 4; ++m) _Pragma("unroll") for (int n = 0; n < 2; ++n) _Pragma("unroll") for (int k = 0; k < 2; ++k) \
        acc[ai][bj][m][n] = __builtin_amdgcn_mfma_f32_16x16x32_bf16(Bt[n][k], At[m][k], acc[ai][bj][m][n], 0, 0, 0); __builtin_amdgcn_s_setprio(0); } while (0)
#define PG8_WAIT_V(n) asm volatile("s_waitcnt vmcnt(" #n ")" ::: "memory")
#define PG8_WAIT_L(n) asm volatile("s_waitcnt lgkmcnt(" #n ")" ::: "memory")
#define PG8_BAR __builtin_amdgcn_s_barrier()
#define PG8_SCHED __builtin_amdgcn_sched_barrier(0)
    Unit cur, nxt; int ui = 0;
    if (!S.next(0, cur)) return;
    static_assert(!GATHER || SP2, "GATHER is written for the SP2 loop");
    unsigned vA0[2] = {0u, 0u}, vA1[2] = {0u, 0u}, nvA0[2] = {0u, 0u}, nvA1[2] = {0u, 0u};
#define PG8_GLOAD(u_, d0_, d1_) do { _Pragma("unroll") for (int _i = 0; _i < 2; ++_i) { int R_, C_; stage_rc(tid * 16 + _i * 8192, R_, C_); \
        const int t0_ = R_ < (u_).nvalid ? g.rowtok[(u_).rbase + R_] : 0, t1_ = HALF + R_ < (u_).nvalid ? g.rowtok[(u_).rbase + HALF + R_] : 0; d0_[_i] = (unsigned)(t0_ * K + C_) * 2u; d1_[_i] = (unsigned)(t1_ * K + C_) * 2u; } } while (0)
#define PG8_STAGE_A(bufoff, ptr, half, vcur0, vcur1) do { if constexpr (GATHER) { PG8_STAGE(bufoff, ptr, (half) ? vcur1 : vcur0); } else { PG8_STAGE(bufoff, (ptr) + ((half) ? hstep : (size_t)0), voffA); } } while (0)
    if constexpr (GATHER) PG8_GLOAD(cur, vA0, vA1);
    f32x4 acc[2][2][4][2];
#pragma unroll
    for (int a = 0; a < 2; ++a)
#pragma unroll
        for (int b = 0; b < 2; ++b)
#pragma unroll
            for (int m = 0; m < 4; ++m)
#pragma unroll
                for (int n = 0; n < 2; ++n) acc[a][b][m][n] = (f32x4){0.f, 0.f, 0.f, 0.f};
    bf16x8 At[4][2], B0[2][2], B1[2][2];
    const char* cA = (const char*)g.A + (GATHER ? (size_t)0 : (size_t)cur.pm * tstep); const char* cB = (const char*)g.Bt + (size_t)cur.pb * tstep;
    S.a_ready(cur);
    if constexpr (SP2) {
        PG8_STAGE(PG8_SB(0, 0), cB, voffB); PG8_STAGE(PG8_SB(0, 1), cB + bhs, voffB); PG8_STAGE_A(PG8_SA(0, 0), cA, 0, vA0, vA1); PG8_STAGE_A(PG8_SA(0, 1), cA, 1, vA0, vA1);
        if (wr == 1) PG8_BAR;
        PG8_WAIT_V(2); PG8_BAR;
        PG8_STAGE(PG8_SB(1, 0), cB + kstep, voffB); PG8_STAGE_A(PG8_SA(1, 0), cA + kstep, 0, vA0, vA1); PG8_STAGE(PG8_SB(1, 1), cB + bhs + kstep, voffB);
        PG8_WAIT_V(6); PG8_BAR;
    } else {
        PG8_STAGE(PG8_SB(0, 0), cB, voffB); PG8_STAGE(PG8_SA(0, 0), cA, voffA); PG8_STAGE(PG8_SB(0, 1), cB + bhs, voffB); PG8_STAGE(PG8_SA(0, 1), cA + hstep, voffA);
        if (wr == 1) PG8_BAR;
        PG8_WAIT_V(4); PG8_BAR;
        PG8_STAGE(PG8_SB(1, 0), cB + kstep, voffB); PG8_STAGE(PG8_SA(1, 0), cA + kstep, voffA); PG8_STAGE(PG8_SB(1, 1), cB + bhs + kstep, voffB);
        PG8_WAIT_V(6); PG8_BAR;
    }
    for (;;) {
        const bool has_next = S.next(ui + 1, nxt);
        const char* nA = (has_next && !GATHER) ? (const char*)g.A + (size_t)nxt.pm * tstep : cA; const char* nB = has_next ? (const char*)g.Bt + (size_t)nxt.pb * tstep : cB;
        if constexpr (GATHER) { if (has_next) { PG8_GLOAD(nxt, nvA0, nvA1); } else { nvA0[0] = vA0[0]; nvA0[1] = vA0[1]; nvA1[0] = vA1[0]; nvA1[1] = vA1[1]; } }
        for (int t = 0; t < nt; t += 2) {
            const bool last = (t == nt - 2);
            const char* a1 = cA + (size_t)(t + 1) * kstep;
            const char* a2 = last ? nA : cA + (size_t)(t + 2) * kstep; const char* b2 = last ? nB : cB + (size_t)(t + 2) * kstep;
            const char* a3 = a2 + kstep; const char* b3 = b2 + kstep;
            if (last && has_next) S.a_ready(nxt);
            unsigned xA0[2], xA1[2];
            if constexpr (GATHER) { xA0[0] = last ? nvA0[0] : vA0[0]; xA0[1] = last ? nvA0[1] : vA0[1]; xA1[0] = last ? nvA1[0] : vA1[0]; xA1[1] = last ? nvA1[1] : vA1[1]; }
            if constexpr (SP2) {
            PG8_LDB(B0, 0, 0); PG8_LDB(B1, 0, 1); PG8_SCHED; PG8_LDA(At, 0, 0); PG8_STAGE_A(PG8_SA(1, 1), a1, 1, vA0, vA1);
            PG8_WAIT_V(8); PG8_WAIT_L(0); PG8_BAR; PG8_MMA(0, 0, At, B0); PG8_MMA(0, 1, At, B1); PG8_BAR; PG8_SCHED;
            PG8_LDA(At, 0, 1); PG8_STAGE(PG8_SB(0, 0), b2, voffB); PG8_STAGE(PG8_SB(0, 1), b2 + bhs, voffB); PG8_STAGE_A(PG8_SA(0, 0), a2, 0, xA0, xA1);
            PG8_WAIT_V(8); PG8_WAIT_L(0); PG8_BAR; PG8_MMA(1, 0, At, B0); PG8_MMA(1, 1, At, B1); PG8_BAR; PG8_SCHED;
            PG8_LDB(B0, 1, 0); PG8_LDB(B1, 1, 1); PG8_SCHED; PG8_LDA(At, 1, 0); PG8_STAGE_A(PG8_SA(0, 1), a2, 1, xA0, xA1);
            PG8_WAIT_V(8); PG8_WAIT_L(0); PG8_BAR; PG8_MMA(0, 0, At, B0); PG8_MMA(0, 1, At, B1); PG8_BAR; PG8_SCHED;
            PG8_LDA(At, 1, 1); PG8_STAGE(PG8_SB(1, 0), b3, voffB); PG8_STAGE(PG8_SB(1, 1), b3 + bhs, voffB); PG8_STAGE_A(PG8_SA(1, 0), a3, 0, xA0, xA1);
            PG8_WAIT_V(8); PG8_WAIT_L(0); PG8_BAR; PG8_MMA(1, 0, At, B0); PG8_MMA(1, 1, At, B1); PG8_BAR; PG8_SCHED;
            } else {
            PG8_LDB(B0, 0, 0); PG8_SCHED; PG8_LDA(At, 0, 0); PG8_STAGE(PG8_SA(1, 1), a1 + hstep, voffA);
            PG8_WAIT_L(8); PG8_BAR; PG8_WAIT_L(0); PG8_MMA(0, 0, At, B0); PG8_BAR; PG8_SCHED;
            PG8_LDB(B1, 0, 1); PG8_STAGE(PG8_SB(0, 0), b2, voffB);
            PG8_BAR; PG8_WAIT_L(0); PG8_MMA(0, 1, At, B1); PG8_BAR;
            PG8_LDA(At, 0, 1); PG8_STAGE(PG8_SA(0, 0), a2, voffA);
            PG8_BAR; PG8_WAIT_L(0); PG8_MMA(1, 0, At, B0); PG8_BAR; PG8_SCHED;
            PG8_STAGE(PG8_SB(0, 1), b2 + bhs, voffB);
            PG8_WAIT_V(6); PG8_BAR; PG8_MMA(1, 1, At, B1); PG8_BAR;
            PG8_LDB(B0, 1, 0); PG8_SCHED; PG8_LDA(At, 1, 0); PG8_STAGE(PG8_SA(0, 1), a2 + hstep, voffA);
            PG8_WAIT_L(8); PG8_BAR; PG8_WAIT_L(0); PG8_MMA(0, 0, At, B0); PG8_BAR; PG8_SCHED;
            PG8_LDB(B1, 1, 1); PG8_STAGE(PG8_SB(1, 0), b3, voffB);
            PG8_BAR; PG8_WAIT_L(0); PG8_MMA(0, 1, At, B1); PG8_BAR;
            PG8_LDA(At, 1, 1); PG8_STAGE(PG8_SA(1, 0), a3, voffA);
            PG8_BAR; PG8_WAIT_L(0); PG8_MMA(1, 0, At, B0); PG8_BAR; PG8_SCHED;
            PG8_STAGE(PG8_SB(1, 1), b3 + bhs, voffB);
            PG8_WAIT_V(6); PG8_BAR; PG8_MMA(1, 1, At, B1); PG8_BAR;
            }
        }
        if constexpr (ALIGN_EPI) { if (wr == 0) PG8_BAR; }
        if constexpr (!Epi::AFTER_DRAIN) { E(acc, cur, wr, wc, fr, fq); S.done(cur); }
        if (!has_next) break;
#pragma unroll
        for (int a = 0; a < 2; ++a)
#pragma unroll
            for (int b = 0; b < 2; ++b)
#pragma unroll
                for (int m = 0; m < 4; ++m)
#pragma unroll
                    for (int n = 0; n < 2; ++n) acc[a][b][m][n] = (f32x4){0.f, 0.f, 0.f, 0.f};
        cur = nxt; cA = nA; cB = nB; ++ui;
        if constexpr (GATHER) { vA0[0] = nvA0[0]; vA0[1] = nvA0[1]; vA1[0] = nvA1[0]; vA1[1] = nvA1[1]; }
        if constexpr (ALIGN_EPI) { if (wr == 1) PG8_BAR; }
    }
    PG8_WAIT_V(0);
    if constexpr (!ALIGN_EPI) { if (wr == 0) PG8_BAR; }
    PG8_BAR;
    if constexpr (Epi::AFTER_DRAIN) { E.fused(acc, cur, wr, wc, fr, fq, lds, wid, lane); S.done(cur); }
#undef PG8_GLOAD
#undef PG8_STAGE_A
#undef PG8_SA
#undef PG8_SB
#undef PG8_STAGE
#undef PG8_LDA
#undef PG8_LDB
#undef PG8_MMA
#undef PG8_WAIT_V
#undef PG8_WAIT_L
#undef PG8_BAR
#undef PG8_SCHED
}
}

#define PG8_SP2 true
#define PG8_ALIGN true
__device__ __forceinline__ void st8(bf16_t* p, f32x4 a, f32x4 b) { u32x4 w; w.x = cvtpk(a[0], a[1]); w.y = cvtpk(a[2], a[3]); w.z = cvtpk(b[0], b[1]); w.w = cvtpk(b[2], b[3]); *(u32x4*)p = w; }
__device__ __forceinline__ void ld8(const bf16_t* p, f32x4& a, f32x4& b) { const u32x4 w = *(const u32x4*)p;
    a[0] = __uint_as_float(w.x << 16); a[1] = __uint_as_float(w.x & 0xffff0000u); a[2] = __uint_as_float(w.y << 16); a[3] = __uint_as_float(w.y & 0xffff0000u);
    b[0] = __uint_as_float(w.z << 16); b[1] = __uint_as_float(w.z & 0xffff0000u); b[2] = __uint_as_float(w.w << 16); b[3] = __uint_as_float(w.w & 0xffff0000u); }
struct EpiProj {
    static constexpr bool PERM = true, AFTER_DRAIN = false;
    unsigned char* ws; bf16_t* GATE; const float *qg, *kg, *bgate;
    __device__ __forceinline__ void operator()(const f32x4 (&acc)[2][2][4][2], const pg8::Unit& u, int wr, int wc, int fr, int fq) const {
        asm volatile("" : "+v"(fr), "+v"(fq));
        const int seg = u.pn >> 2;
        const int row0 = u.pm * 256 + wr * 64 + fr;
        const int cw = (u.pn & 3) * 256 + wc * 64 + 8 * fq;
        if (seg <= 1 || seg == 4) { bf16_t* dst = (bf16_t*)(ws + WS_U + (size_t)seg * (32 * MiB)) + cw;
#pragma unroll
            for (int ai = 0; ai < 2; ++ai)
#pragma unroll
                for (int m = 0; m < 4; ++m) { bf16_t* rp = dst + (size_t)(row0 + ai * 128 + m * 16) * DM;
#pragma unroll
                    for (int bj = 0; bj < 2; ++bj) st8(rp + 32 * bj, acc[ai][bj][m][0], acc[ai][bj][m][1]); }
        } else if (seg == 2 || seg == 3) { const float* g = (seg == 2 ? qg : kg) + 8 * fq; bf16_t* dst = (bf16_t*)(ws + WS_U + (size_t)seg * (32 * MiB)) + cw; const float sc = seg == 2 ? C2 : 1.f;
            f32x4 gv[2][2];
#pragma unroll
            for (int bj = 0; bj < 2; ++bj)
#pragma unroll
                for (int n = 0; n < 2; ++n) gv[bj][n] = *(const f32x4*)(g + 32 * bj + 4 * n) * sc;
#pragma unroll
            for (int ai = 0; ai < 2; ++ai)
#pragma unroll
                for (int m = 0; m < 4; ++m) { float ss = 0.f;
#pragma unroll
                    for (int bj = 0; bj < 2; ++bj)
#pragma unroll
                        for (int n = 0; n < 2; ++n) { const f32x4 a = acc[ai][bj][m][n]; ss += (a[0] * a[0] + a[1] * a[1]) + (a[2] * a[2] + a[3] * a[3]); }
                    ss += __shfl_xor(ss, 16); ss += __shfl_xor(ss, 32);
                    const float r = rsqrtf(ss * (1.f / 64.f) + EPS); bf16_t* rp = dst + (size_t)(row0 + ai * 128 + m * 16) * DM;
#pragma unroll
                    for (int bj = 0; bj < 2; ++bj) st8(rp + 32 * bj, (acc[ai][bj][m][0] * r) * gv[bj][0], (acc[ai][bj][m][1] * r) * gv[bj][1]); }
        } else { const int c = (u.pn - 20) * 256 + wc * 64 + 8 * fq; const float* bg = bgate + c;
#pragma unroll
            for (int bj = 0; bj < 2; ++bj) { const f32x4 b0 = *(const f32x4*)(bg + 32 * bj), b1 = *(const f32x4*)(bg + 32 * bj + 4);
#pragma unroll
                for (int ai = 0; ai < 2; ++ai)
#pragma unroll
                    for (int m = 0; m < 4; ++m) { f32x4 v0 = acc[ai][bj][m][0] + b0, v1 = acc[ai][bj][m][1] + b1;
#pragma unroll
                        for (int j = 0; j < 4; ++j) { v0[j] = __builtin_amdgcn_rcpf(1.f + __builtin_amdgcn_exp2f(-LOG2E * v0[j])); v1[j] = __builtin_amdgcn_rcpf(1.f + __builtin_amdgcn_exp2f(-LOG2E * v1[j])); }
                        st8(GATE + (size_t)(row0 + ai * 128 + m * 16) * 2048 + c + 32 * bj, v0, v1); } }
        }
    }
};

#define EPI_LOOP(...) _Pragma("unroll") for (int ai = 0; ai < 2; ++ai) _Pragma("unroll") for (int m = 0; m < 4; ++m) { const size_t row = (size_t)(u.pm * 256 + wr * 64 + fr + ai * 128 + m * 16); \
        _Pragma("unroll") for (int bj = 0; bj < 2; ++bj) { const int col = u.pn * 256 + bj * 128 + wc * 32 + 8 * fq; const f32x4 a0 = acc[ai][bj][m][0], a1 = acc[ai][bj][m][1]; __VA_ARGS__ } if (m & 1) asm volatile("" ::: "memory"); }
struct EpiGateT {
    static constexpr bool PERM = true, AFTER_DRAIN = false;
    const bf16_t* GATE; bf16_t* T;
    __device__ __forceinline__ void operator()(const f32x4 (&acc)[2][2][4][2], const pg8::Unit& u, int wr, int wc, int fr, int fq) const {
        asm volatile("" : "+v"(fr), "+v"(fq));
        EPI_LOOP( f32x4 g0, g1; ld8(GATE + row * 2048 + col, g0, g1); st8(T + row * DM + col, g0 * a0, g1 * a1); )
    }
};
struct EpiMerged {
    static constexpr bool PERM = true, AFTER_DRAIN = false;
    const bf16_t* GATE; const bf16_t* T; bf16_t* MG;
    __device__ __forceinline__ void operator()(const f32x4 (&acc)[2][2][4][2], const pg8::Unit& u, int wr, int wc, int fr, int fq) const {
        asm volatile("" : "+v"(fr), "+v"(fq));
        EPI_LOOP( f32x4 g0, g1, t0, t1; ld8(GATE + row * 2048 + 1024 + col, g0, g1); ld8(T + row * DM + col, t0, t1); st8(MG + row * DM + col, t0 + g0 * a0, t1 + g1 * a1); )
    }
};
struct EpiOut {
    static constexpr bool PERM = true, AFTER_DRAIN = false;
    const float* x; float* out;
    __device__ __forceinline__ void operator()(const f32x4 (&acc)[2][2][4][2], const pg8::Unit& u, int wr, int wc, int fr, int fq) const {
        asm volatile("" : "+v"(fr), "+v"(fq));
        EPI_LOOP( const float* xp = x + row * DM + col; float* op = out + row * DM + col; const f32x4 x0 = *(const f32x4*)xp, x1 = *(const f32x4*)(xp + 4); *(f32x4*)op = x0 + a0; *(f32x4*)(op + 4) = x1 + a1; )
    }
};
struct EpiY {
    static constexpr bool PERM = true, AFTER_DRAIN = false;
    bf16_t* Y;
    __device__ __forceinline__ void operator()(const f32x4 (&acc)[2][2][4][2], const pg8::Unit& u, int wr, int wc, int fr, int fq) const {
        asm volatile("" : "+v"(fr), "+v"(fq));
        EPI_LOOP( st8(Y + row * DM + col, a0, a1); )
    }
};
struct EpiSwiglu {
    static constexpr bool PERM = true, AFTER_DRAIN = false;
    const float* roww; bf16_t* HID;
    __device__ __forceinline__ void operator()(const f32x4 (&acc)[2][2][4][2], const pg8::Unit& u, int wr, int wc, int fr, int fq) const {
        asm volatile("" : "+v"(fr), "+v"(fq));
#pragma unroll
        for (int ai = 0; ai < 2; ++ai)
#pragma unroll
            for (int m = 0; m < 4; ++m) { const int rl = wr * 64 + fr + ai * 128 + m * 16; const size_t row = (size_t)(u.pm * 256 + rl); const float w = rl < u.nvalid ? roww[u.rbase + rl] : 0.f;
                f32x4 hv[2];
#pragma unroll
                for (int n = 0; n < 2; ++n) { const f32x4 a1 = acc[ai][0][m][n], a3 = acc[ai][1][m][n];
#pragma unroll
                    for (int j = 0; j < 4; ++j) hv[n][j] = ((a1[j] * __builtin_amdgcn_rcpf(1.f + __builtin_amdgcn_exp2f(-LOG2E * a1[j]))) * a3[j]) * w; }
                st8(HID + row * DE + u.pn * 128 + wc * 32 + 8 * fq, hv[0], hv[1]); }
    }
};
__device__ __forceinline__ int expert_of_row(LAS int* offs, int row);
struct MoeOrder {
    LAS int* offs; int npn, G, c, lo, hi;
    __device__ __forceinline__ bool next(int i, pg8::Unit& u) const { const int L = lo + i * G + c; if (L >= hi || c < 0) return false;
        const int tile = L / npn, pn = L - tile * npn, e = expert_of_row(offs, tile * 256), lr0 = tile * 256 - offs[e], nv = offs[40 + e] - lr0;
        u.pm = tile; u.pn = pn; u.pb = e * npn + pn; u.rbase = e * ECAP + lr0; u.nvalid = nv < 256 ? nv : 256; return true; }
    __device__ __forceinline__ void a_ready(const pg8::Unit&) const {}
    __device__ __forceinline__ void done(const pg8::Unit&) const {}
};

__device__ __forceinline__ float attn_dmin_unit(const float* qg, const float* kg) {
    const int ln = threadIdx.x & 63; float a = fabsf(qg[ln]), b = fabsf(kg[ln]);
#pragma unroll
    for (int o = 1; o < 64; o <<= 1) { a = fmaxf(a, __shfl_xor(a, o)); b = fmaxf(b, __shfl_xor(b, o)); }
    return 2.02f * (8.f * a * b) + 106.f;
}
__device__ __forceinline__ int attn_jlo(float dmin1, int h, int qb) {
    const float dmin = dmin1 * exp2f((float)(h + 1)); const float lowk = (float)(qb * 128) - dmin;
    return lowk > 0.f ? ((int)lowk) >> 6 : 0;
}
__device__ __forceinline__ void tr_load(const float* W, int N, int item, int lane, float (&v)[32]) {
    const int nblk = N / 32, kb = item / nblk, nb = item % nblk, k0 = 64 * kb, n0 = 32 * nb;
    const float* wp = W + (size_t)(k0 + (lane >> 5)) * N + n0 + (lane & 31);
#pragma unroll
    for (int i = 0; i < 32; ++i) v[i] = wp[(size_t)(2 * i) * N];
}
template <class RM>
__device__ __forceinline__ void tr_store(const float (&v)[32], int N, bf16_t* WT, int ldt, int koff, RM rm, LAS float* scr, int item, int lane) {
    const int nblk = N / 32, kb = item / nblk, nb = item % nblk, k0 = 64 * kb, n0 = 32 * nb;
    { LAS float* sp = scr + (lane >> 5) * 33 + (lane & 31);
#pragma unroll
      for (int i = 0; i < 32; ++i) sp[2 * i * 33] = v[i]; }
    LDS_WAIT(); asm volatile("" ::: "memory");
    const int c = lane & 7;
#pragma unroll
    for (int j = 0; j < 4; ++j) { const int n = (lane >> 3) + 8 * j; const LAS float* s = scr + (8 * c) * 33 + n;
        u32x4 o; o.x = cvtpk(s[0 * 33], s[1 * 33]); o.y = cvtpk(s[2 * 33], s[3 * 33]); o.z = cvtpk(s[4 * 33], s[5 * 33]); o.w = cvtpk(s[6 * 33], s[7 * 33]);
        *(u32x4*)(WT + (size_t)rm(n0 + n) * ldt + koff + k0 + 8 * c) = o; }
    LDS_WAIT(); asm volatile("" ::: "memory");
}
template <class RM>
__device__ __forceinline__ void transpose_item(const float* W, int N, bf16_t* WT, int ldt, int koff, RM rm, LAS float* scr, int item, int lane) {
    float v[32]; tr_load(W, N, item, lane, v); tr_store(v, N, WT, ldt, koff, rm, scr, item, lane);
}
template <class RM>
__device__ __forceinline__ void transpose_block_item(const float* W, int N, int k0, int n0, bf16_t* WT, int ldt, int koff, RM rm, LAS unsigned char* lds, int tid) {
    const int w = tid >> 6, lane = tid & 63;
    f32x4 v[8];
#pragma unroll
    for (int r = 0; r < 8; ++r) v[r] = *(const f32x4*)(W + (size_t)(k0 + 8 * w + r) * N + n0 + 4 * lane);
#pragma unroll
    for (int c = 0; c < 4; ++c) { u32x4 o; o.x = cvtpk(v[0][c], v[1][c]); o.y = cvtpk(v[2][c], v[3][c]); o.z = cvtpk(v[4][c], v[5][c]); o.w = cvtpk(v[6][c], v[7][c]);
        *(LAS u32x4*)(lds + (4 * lane + c) * 144 + 16 * w) = o; }
    __syncthreads();
#pragma unroll
    for (int i = 0; i < 4; ++i) { const int q = tid + 512 * i, row = q >> 3, ch = q & 7;
        *(u32x4*)(WT + (size_t)rm(n0 + row) * ldt + koff + k0 + 8 * ch) = *(const LAS u32x4*)(lds + row * 144 + 16 * ch); }
    __syncthreads();
}
struct RmAdd { int off; __device__ __forceinline__ int operator()(int n) const { return off + n; } };
struct RmW13 { int off; __device__ __forceinline__ int operator()(int n) const { return off + (n >> 7) * 256 + (n & 127); } };

__device__ __forceinline__ void p0_prologue(Frame& F) {
    bf16_t* W1T = (bf16_t*)(F.ws + WS_W1T); bf16_t* WUPT = (bf16_t*)(F.ws + WS_WUPT); bf16_t* WOUTT = (bf16_t*)(F.ws + WS_WOUTT);
    { constexpr int I_A = 16 * 20, I_B = 16 * 8, I_C = 16 * 4; constexpr int NITEMS = I_A + I_B + 3 * I_C;
      for (int it = F.blk; it < NITEMS; it += F.G) { int r = it;
          if (r < I_A) { transpose_block_item(F.a->in[I_WIN], 5120, 64 * (r / 20), 256 * (r % 20), W1T, 1024, 0, RmAdd{0}, F.lds, F.tid); continue; } r -= I_A;
          if (r < I_B) { transpose_block_item(F.a->in[I_WGATE], 2048, 64 * (r / 8), 256 * (r % 8), W1T, 1024, 0, RmAdd{5120}, F.lds, F.tid); continue; } r -= I_B;
          if (r < I_C) { transpose_block_item(F.a->in[I_WUPA], 1024, 64 * (r / 4), 256 * (r % 4), WUPT, 1024, 0, RmAdd{0}, F.lds, F.tid); continue; } r -= I_C;
          if (r < I_C) { transpose_block_item(F.a->in[I_WUPB], 1024, 64 * (r / 4), 256 * (r % 4), WUPT, 1024, 0, RmAdd{1024}, F.lds, F.tid); continue; } r -= I_C;
          transpose_block_item(F.a->in[I_WOUT], 1024, 64 * (r / 4), 256 * (r % 4), WOUTT, 1024, 0, RmAdd{0}, F.lds, F.tid); } }
    { bf16_t* WST = (bf16_t*)(F.ws + WS_WST); const float* ws_ = F.a->in[I_WS];
      for (int i = F.blk * NTHREADS + F.tid; i < 8 * 128 * 128 / 2; i += F.G * NTHREADS) { const int e = 2 * i, s = e & 127, t = (e >> 7) & 127;
          const float a = (s <= t) ? ws_[e] : 0.f, b = (s + 1 <= t) ? ws_[e + 1] : 0.f; *(unsigned*)(WST + e) = cvtpk(a, b); } }
    { float* WRT = (float*)(F.ws + WS_ROUTE + RT_WRT); const float* g2 = F.a->in[I_N2G]; const float* wrg = F.a->in[I_WRG]; const float* wre = F.a->in[I_WRE];
      for (int i = F.blk * NTHREADS + F.tid; i < 48 * 1024; i += F.G * NTHREADS) { const int j = i >> 10, k = i & 1023;
          const float w = j < 4 ? wrg[k * 4 + j] : (j < 36 ? wre[k * 32 + (j - 4)] : 0.f); WRT[i] = g2[k] * w; } }
    if (F.blk == 0) { LAS int* hist = (LAS int*)(F.lds + 136 * 1024); LAS int* gt = hist + 160;
        for (int i = F.tid; i < 320; i += NTHREADS) hist[i] = 0;
        __syncthreads();
        const float dmin1 = attn_dmin_unit(F.a->in[I_QNG], F.a->in[I_KNG]);
        int w[2], jl[2];
#pragma unroll
        for (int q = 0; q < 2; ++q) { const int u = F.tid + q * NTHREADS, qb = u >> 4; jl[q] = attn_jlo(dmin1, u & 7, qb); w[q] = 2 * qb + 2 - jl[q]; atomicAdd((int*)(hist + w[q]), 1); }
        __syncthreads();
        if (F.tid < 64) { int h0 = 0, h1 = 0, h2 = 0; const int i0 = 3 * F.tid;
            if (i0 < 160) h0 = hist[i0]; if (i0 + 1 < 160) h1 = hist[i0 + 1]; if (i0 + 2 < 160) h2 = hist[i0 + 2];
            const int tot = h0 + h1 + h2; int suf = tot;
#pragma unroll
            for (int o = 1; o < 64; o <<= 1) { const int vv = __shfl_down(suf, o); if (F.tid + o < 64) suf += vv; }
            const int above = suf - tot;
            if (i0 + 2 < 160) gt[i0 + 2] = above; if (i0 + 1 < 160) gt[i0 + 1] = above + h2; if (i0 < 160) gt[i0] = above + h2 + h1; }
        __syncthreads();
#pragma unroll
        for (int q = 0; q < 2; ++q) { const int u = F.tid + q * NTHREADS; const int rank = atomicAdd((int*)(gt + w[q]), 1);
            ((int*)(F.ws + WS_ROUTE + RT_ALIST))[rank] = u | (jl[q] << 16); }
        __syncthreads(); }
    { bf16_t* XN = (bf16_t*)(F.ws + WS_XN); const float* x = F.a->in[I_X]; const f32x4* g4 = (const f32x4*)F.a->in[I_N1G] + F.lane;
      for (int m0 = F.gw * 4; m0 < M; m0 += F.NGW * 4) { f32x4 v[4][4];
#pragma unroll
          for (int q = 0; q < 4; ++q) { const f32x4* xr = (const f32x4*)(x + (size_t)(m0 + q) * DM) + F.lane;
#pragma unroll
              for (int j = 0; j < 4; ++j) v[q][j] = xr[64 * j]; }
#pragma unroll
          for (int q = 0; q < 4; ++q) { float s = 0.f;
#pragma unroll
              for (int j = 0; j < 4; ++j) s += (v[q][j][0] * v[q][j][0] + v[q][j][1] * v[q][j][1]) + (v[q][j][2] * v[q][j][2] + v[q][j][3] * v[q][j][3]);
              const float r = rsqrtf(wave_sum(s) * (1.f / DM) + EPS);
#pragma unroll
              for (int j = 0; j < 4; ++j) { const f32x4 g = g4[64 * j]; st4(XN + (size_t)(m0 + q) * DM + 4 * F.lane + 256 * j, (v[q][j] * r) * g); } } } }
}

__device__ __forceinline__ void p1_proj(Frame& F) {
    pg8::Gemm g{(const bf16_t*)(F.ws + WS_XN), (const bf16_t*)(F.ws + WS_W1T), DM, nullptr};
    pg8::StaticOrder S; S.init(M, N1, F.G, F.blk);
    static_assert(WS_VA == WS_U + 32 * MiB && WS_Q == WS_U + 64 * MiB && WS_K == WS_U + 96 * MiB && WS_VB == WS_U + 128 * MiB, "EpiProj layout");
    EpiProj E{F.ws, (bf16_t*)F.out, F.a->in[I_QNG], F.a->in[I_KNG], F.a->in[I_BGATE]};
    pg8::gemm_phase<EpiProj, pg8::StaticOrder, PG8_ALIGN, PG8_SP2, true>(F.lds, g, S, E);
}

__device__ __forceinline__ void p2_mixer_a(Frame& F) {
    const bf16_t* VA = (const bf16_t*)(F.ws + WS_VA); const bf16_t* U = (const bf16_t*)(F.ws + WS_U); bf16_t* YA = (bf16_t*)(F.ws + WS_YA); const bf16_t* WST = (const bf16_t*)(F.ws + WS_WST);
    const float* gv = F.a->in[I_VNG]; const float* bs = F.a->in[I_BS];
    bf16_t* vT = (bf16_t*)F.ldsg;
    bf16_t* wS = (bf16_t*)(F.ldsg + 128 * 136 * 2);
    const int fr = F.lane & 15, fq = F.lane >> 4, wm = F.wid >> 1, wn = F.wid & 1;
    const int s_ = F.tid >> 2, ds = (F.tid & 3) * 32;
    int gstaged = -1;
    bf16x8 v[4];
    if (F.blk < 1024) { const int c = F.blk >> 3, g = F.blk & 7; const bf16_t* src = VA + (size_t)(c * 128 + s_) * DM + g * 128 + ds;
#pragma unroll
        for (int i = 0; i < 4; ++i) v[i] = *(const bf16x8*)(src + 8 * i); }
    for (int L = F.blk; L < 1024; L += F.G) {
        const int c = L >> 3, g = L & 7;
        if (g != gstaged) { __syncthreads();
#pragma unroll
            for (int i = 0; i < 4; ++i) { const int q = F.tid + 512 * i, t = q >> 4, ch = q & 15; *(bf16x8*)(wS + t * 136 + 8 * ch) = *(const bf16x8*)(WST + g * 16384 + t * 128 + 8 * ch); }
            gstaged = g; }
        { float ss = 0.f;
#pragma unroll
          for (int i = 0; i < 4; ++i)
#pragma unroll
              for (int j = 0; j < 8; ++j) { const float x = bf2f(v[i][j]); ss += x * x; }
          ss += __shfl_xor(ss, 1); ss += __shfl_xor(ss, 2);
          const float r = rsqrtf(ss * (1.f / 128.f) + EPS);
#pragma unroll
          for (int i = 0; i < 4; ++i)
#pragma unroll
              for (int j = 0; j < 8; ++j) { const int d = ds + 8 * i + j; const float x = (bf2f(v[i][j]) * r) * gv[g * 128 + d]; vT[d * 136 + s_] = (bf16_t)(cvtpk(x, 0.f) & 0xffffu); } }
        __syncthreads();
        const int Ln = L + F.G;
        if (Ln < 1024) { const bf16_t* src = VA + (size_t)((Ln >> 3) * 128 + s_) * DM + (Ln & 7) * 128 + ds;
#pragma unroll
            for (int i = 0; i < 4; ++i) v[i] = *(const bf16x8*)(src + 8 * i); }
        f32x4 uu[2][4]; float bb[2];
#pragma unroll
        for (int m = 0; m < 2; ++m) { const int t = 32 * wm + 16 * m + fr; bb[m] = bs[g * 128 + t]; const bf16_t* up = U + (size_t)(c * 128 + t) * DM + g * 128 + 64 * wn + 4 * fq;
#pragma unroll
            for (int n = 0; n < 4; ++n) uu[m][n] = ld4(up + 16 * n); }
        const bf16_t* ap = wS + (32 * wm + fr) * 136 + 8 * fq; const bf16_t* bp = vT + (64 * wn + fr) * 136 + 8 * fq;
        f32x4 acc[2][4]; acc_zero(acc);
        wave_gemm(acc, ap, ap + 16 * 136, bp, bp + 16 * 136, bp + 32 * 136, bp + 48 * 136, 32 * (wm + 1));
#pragma unroll
        for (int m = 0; m < 2; ++m) { const int t = 32 * wm + 16 * m + fr; bf16_t* yp = YA + (size_t)(c * 128 + t) * DM + g * 128 + 64 * wn + 4 * fq;
#pragma unroll
            for (int n = 0; n < 4; ++n) st4(yp + 16 * n, uu[m][n] * (acc[m][n] + bb[m])); }
        __syncthreads();
    }
}

namespace att {
constexpr int QBLK = 32, KVBLK = 64, QB = 128, PITCH = 1024;
constexpr int SHM_V = KVBLK * 128 * 2, SHM_K = 2 * KVBLK * 64 * 2;
constexpr int LDS_WSF = 2 * SHM_V + 2 * SHM_K, LDS_XCH = LDS_WSF + NWAVES * 64 * 4, LDS_BYTES = LDS_XCH + 4 * 16 * 4 * 64 * 4;
constexpr float THR2 = 8.f * LOG2E;
#define KSWZ64(row, colB) ((row) * 128 + ((colB) ^ ((((row) >> 1) & 7) << 4)))
__device__ __forceinline__ int v_st(int k, int c) { const int kk = (k & ~0xC) | ((k & 4) << 1) | ((k & 8) >> 1); return ((kk >> 3) * 4 + (c >> 5)) * 512 + ((kk & 7) * 32 + (c & 31)) * 2; }
__device__ __forceinline__ int v_rd_base(int lane) { return ((lane & 3) << 3) | (((lane >> 2) & 3) << 6) | (((lane >> 4) & 1) << 5) | (((lane >> 5) & 1) << 8); }
constexpr int v_rd_off(int d0, int ks, int half) { return d0 * 512 + ks * 4096 + half * 2048; }
__device__ __forceinline__ int crow(int r, int hi) { return (r & 3) + 8 * (r >> 2) + 4 * hi; }

__device__ __forceinline__ void mask_tile(f32x16& p0, f32x16& p1, int dq) {
    const float NEG = -__builtin_inff();
#pragma unroll
    for (int r = 0; r < 16; ++r) { const int c = (r & 3) + 8 * (r >> 2);
        if (dq - c < 0) p0[r] = NEG;
        if (dq - c - 32 < 0) p1[r] = NEG; }
}
__device__ __forceinline__ void partialSM(f32x16& p0, f32x16& p1, float& m_reg, float& alpha) {
    float pmax = __builtin_fmaxf(__builtin_fmaxf(p0[0], p0[1]), p0[2]);
#pragma unroll
    for (int r = 3; r < 15; r += 2) pmax = __builtin_fmaxf(__builtin_fmaxf(pmax, p0[r]), p0[r + 1]);
    pmax = __builtin_fmaxf(__builtin_fmaxf(pmax, p0[15]), p1[0]);
#pragma unroll
    for (int r = 1; r < 15; r += 2) pmax = __builtin_fmaxf(__builtin_fmaxf(pmax, p1[r]), p1[r + 1]);
    pmax = __builtin_fmaxf(pmax, p1[15]);
    { auto rr = __builtin_amdgcn_permlane32_swap(__float_as_uint(pmax), __float_as_uint(pmax), false, false);
      pmax = fmaxf(__uint_as_float(rr[0]), __uint_as_float(rr[1])); }
    alpha = 1.f;
    if (__builtin_expect(!__all(pmax <= THR2), 0)) { asm volatile("" ::: "memory");
        const float d = fmaxf(pmax, 0.f); m_reg += d; alpha = __builtin_amdgcn_exp2f(-d);
#pragma unroll
        for (int r = 0; r < 16; ++r) { p0[r] -= d; p1[r] -= d; } }
#pragma unroll
    for (int r = 0; r < 16; ++r) p0[r] = __builtin_amdgcn_exp2f(p0[r]);
}
__device__ __forceinline__ void finishSM(f32x16& p0, f32x16& p1, float alpha, float& l_reg, bf16x8& pa0, bf16x8& pa1, bf16x8& pa2, bf16x8& pa3) {
#pragma unroll
    for (int r = 0; r < 16; ++r) p1[r] = __builtin_amdgcn_exp2f(p1[r]);
    float ps = 0;
#pragma unroll
    for (int r = 0; r < 16; ++r) ps += p0[r];
#pragma unroll
    for (int r = 0; r < 16; ++r) ps += p1[r];
    { auto rr = __builtin_amdgcn_permlane32_swap(__float_as_uint(ps), __float_as_uint(ps), false, false);
      ps = __uint_as_float(rr[0]) + __uint_as_float(rr[1]); }
    l_reg = l_reg * alpha + ps;
#define PK4(P, B_, OUT) do { unsigned a0 = cvtpk(P[B_+0], P[B_+1]), a1 = cvtpk(P[B_+2], P[B_+3]);                          \
        unsigned b0 = cvtpk(P[B_+4], P[B_+5]), b1 = cvtpk(P[B_+6], P[B_+7]);                                             \
        auto r0 = __builtin_amdgcn_permlane32_swap(a0, b0, false, false); auto r1 = __builtin_amdgcn_permlane32_swap(a1, b1, false, false); \
        u32x4 w = {r0[0], r1[0], r0[1], r1[1]}; OUT = __builtin_bit_cast(bf16x8, w); } while (0)
    PK4(p0, 0, pa0); PK4(p0, 8, pa1); PK4(p1, 0, pa2); PK4(p1, 8, pa3);
#undef PK4
}
template <int KB>
__device__ __forceinline__ void qkt(f32x16& p0, f32x16& p1, const char* Kmap_lds, int r32, int hi, const bf16x8* qr, bf16x8 kx0, bf16x8 kx1, bf16x8 qx) {
    p0 = __builtin_amdgcn_mfma_f32_32x32x16_bf16(kx0, qx, f32x16{}, 0, 0, 0); p1 = __builtin_amdgcn_mfma_f32_32x32x16_bf16(kx1, qx, f32x16{}, 0, 0, 0);
#pragma unroll
    for (int d0 = 0; d0 < 4; ++d0) { const char* a = Kmap_lds + KB * SHM_K + KSWZ64(r32, (d0 * 16 + hi * 8) * 2);
        const bf16x8 b0 = *reinterpret_cast<const bf16x8*>(a);
        const bf16x8 b1 = *reinterpret_cast<const bf16x8*>(a + 32 * 128);
        p0 = __builtin_amdgcn_mfma_f32_32x32x16_bf16(b0, qr[d0], p0, 0, 0, 0);
        p1 = __builtin_amdgcn_mfma_f32_32x32x16_bf16(b1, qr[d0], p1, 0, 0, 0); }
}
template <int VB>
__device__ __forceinline__ void pv_tile(f32x16* o, int vb0, bf16x8 pa0, bf16x8 pa1, bf16x8 pa2, bf16x8 pa3) {
#define TRRD(dst, off) asm volatile("ds_read_b64_tr_b16 %0, %1 offset:%2" : "=&v"(dst) : "v"(vb0), "i"(off) : "memory")
#define PV_D0(d0) do { s16x4 l0, l1, l2, l3, h0, h1, h2, h3; constexpr int b_ = VB * SHM_V + v_rd_off(d0, 0, 0); \
        TRRD(l0, b_); TRRD(h0, b_ + 2048); TRRD(l1, b_ + 4096); TRRD(h1, b_ + 6144); TRRD(l2, b_ + 8192); TRRD(h2, b_ + 10240); TRRD(l3, b_ + 12288); TRRD(h3, b_ + 14336); \
        asm volatile("s_waitcnt lgkmcnt(0)" ::: "memory"); SBAR();   \
        o[d0] = __builtin_amdgcn_mfma_f32_32x32x16_bf16(pa0, (bf16x8){l0[0], l0[1], l0[2], l0[3], h0[0], h0[1], h0[2], h0[3]}, o[d0], 0, 0, 0);   \
        o[d0] = __builtin_amdgcn_mfma_f32_32x32x16_bf16(pa1, (bf16x8){l1[0], l1[1], l1[2], l1[3], h1[0], h1[1], h1[2], h1[3]}, o[d0], 0, 0, 0);   \
        o[d0] = __builtin_amdgcn_mfma_f32_32x32x16_bf16(pa2, (bf16x8){l2[0], l2[1], l2[2], l2[3], h2[0], h2[1], h2[2], h2[3]}, o[d0], 0, 0, 0);   \
        o[d0] = __builtin_amdgcn_mfma_f32_32x32x16_bf16(pa3, (bf16x8){l3[0], l3[1], l3[2], l3[3], h3[0], h3[1], h3[2], h3[3]}, o[d0], 0, 0, 0); } while (0)
    PV_D0(0); PV_D0(1); PV_D0(2); PV_D0(3);
#undef PV_D0
#undef TRRD
}

__device__ __forceinline__ bf16x8 qx_of(unsigned sdw, float x) {
    const unsigned h_ = cvtpk(x, 0.f) & 0xffffu; const float r1 = x - __uint_as_float(h_ << 16);
    const unsigned m_ = cvtpk(r1, 0.f) & 0xffffu; const float r2 = r1 - __uint_as_float(m_ << 16);
    return __builtin_bit_cast(bf16x8, (u32x4){sdw, h_ | (m_ << 16), cvtpk(r2, 0.f) & 0xffffu, 0u});
}
struct BlockRef { int base; int P0; int jlo; float slope2; };
#define BR_Q(br) ((const bf16_t*)(wsb + WS_Q) + (br).base)
#define BR_K(br) ((const bf16_t*)(wsb + WS_K) + (br).base)
#define BR_V(br) ((const bf16_t*)(wsb + WS_VB) + (br).base)
#define BR_O(br) ((bf16_t*)(wsb + WS_XN) + (br).base)
struct Seam { bf16x8 qr[4]; bf16x8 st_v0, st_v1, st_k0, st_k1; };
#define VMW() asm volatile("s_waitcnt vmcnt(0)" ::: "memory")
#define VMWN(n) asm volatile("s_waitcnt vmcnt(%0)" :: "i"(n) : "memory")
#define BLD(soff) __builtin_bit_cast(bf16x8, __builtin_amdgcn_raw_buffer_load_b128(rsrc, voff, (int)(soff), 0))
#define SLOAD_H(br, k0) do { const unsigned so_ = (unsigned)((br).base + (k0) * PITCH) * 2u;                                  \
                         S.st_v0 = BLD((unsigned)WS_VB + so_); S.st_v1 = BLD((unsigned)WS_VB + so_ + 32u * PITCH * 2u);              \
                         S.st_k0 = BLD((unsigned)WS_K + so_); S.st_k1 = BLD((unsigned)WS_K + so_ + 32u * PITCH * 2u); } while (0)
#define SWRITE_HK(bf) do { *(bf16x8*)(K_lds + (bf) * SHM_K + kws) = S.st_k0; *(bf16x8*)(K_lds + (bf) * SHM_K + kws + 32 * 128) = S.st_k1; } while (0)
#define SWRITE_HV(bf) do { *(bf16x8*)(V_lds + (bf) * SHM_V + vst0) = S.st_v0; *(bf16x8*)(V_lds + (bf) * SHM_V + vst1) = S.st_v1; } while (0)
#define SWRITE_H(bf) do { SWRITE_HV(bf); SWRITE_HK(bf); } while (0)
__device__ __forceinline__ void attn_prime(const unsigned char* wsb, const BlockRef& cur, char* lds, Seam& S) {
    const int tid = threadIdx.x, wid = __builtin_amdgcn_readfirstlane(tid >> 6), lane = tid & 63, r32 = lane & 31, hi = lane >> 5;
    const int map = wid >> 2, rw = wid & 3;
    const int sr = tid >> 4, sc = (tid & 15) * 8, kws = (sc >> 6) * 8192 + KSWZ64(sr, (sc & 63) * 2); char* K_lds = lds + 2 * SHM_V;
    const int voff = (sr * PITCH + sc) * 2; const __amdgpu_buffer_rsrc_t rsrc = __builtin_amdgcn_make_buffer_rsrc((void*)wsb, 0, 0x10000000, 0x00020000);
    const int kb0 = cur.jlo * KVBLK;
#pragma unroll
    for (int d0 = 0; d0 < 4; ++d0) S.qr[d0] = *(const bf16x8*)(BR_Q(cur) + (size_t)(cur.P0 + rw * QBLK + r32) * PITCH + map * 64 + d0 * 16 + hi * 8);
    SLOAD_H(cur, kb0); VMW(); SWRITE_HK(0);
    __syncthreads();
}
__device__ __forceinline__ void attn_block(unsigned char* wsb, const BlockRef& cur, const BlockRef& nxt, char* lds, Seam& S, float lam, const float* subg) {
    const int tid = threadIdx.x, wid = __builtin_amdgcn_readfirstlane(tid >> 6), lane = tid & 63, r32 = lane & 31, hi = lane >> 5;
    const int map = wid >> 2, rw = wid & 3;
    const int j_lo = cur.jlo, j_hi = cur.P0 / KVBLK + 2, NT = j_hi - j_lo;
    const int kbn = nxt.jlo * KVBLK;
    const int qlo = cur.P0 + rw * QBLK, qm = qlo + r32 - 4 * hi;
    const float slope2 = cur.slope2; const int qpos = qlo + r32;
    unsigned sdw; { const unsigned h_ = cvtpk(slope2, 0.f) & 0xffffu; const float lo_ = slope2 - __uint_as_float(h_ << 16); sdw = h_ | (cvtpk(lo_, 0.f) << 16); }
    bf16x8 kx0, kx1; { const unsigned c0 = cvtpk((float)r32, (float)r32), c1 = cvtpk((float)(r32 + 32), (float)(r32 + 32)), one = hi ? 0u : 0x3f803f80u;
        kx0 = __builtin_bit_cast(bf16x8, (u32x4){hi ? 0u : c0, one, one & 0xffffu, 0u}); kx1 = __builtin_bit_cast(bf16x8, (u32x4){hi ? 0u : c1, one, one & 0xffffu, 0u}); }
    char* V_lds = lds; char* K_lds = lds + 2 * SHM_V; const char* Kmap = K_lds + map * 8192;
    float* ws = (float*)(lds + LDS_WSF) + wid * 64; float* li_l = ws, * al_l = ws + 32;
    float m_reg = 0.f, l_reg = 0; f32x16 o[4] = {};
    const int sr = tid >> 4, sc = (tid & 15) * 8, vst0 = v_st(sr, sc), vst1 = v_st(32 + sr, sc), kws = (sc >> 6) * 8192 + KSWZ64(sr, (sc & 63) * 2);
    const int vb0 = (int)(uintptr_t)V_lds + v_rd_base(lane);
    const int voff = (sr * PITCH + sc) * 2; const __amdgpu_buffer_rsrc_t rsrc = __builtin_amdgcn_make_buffer_rsrc((void*)wsb, 0, 0x10000000, 0x00020000);
#define RESC(a) do { if (__any((a) < 1.f)) { if (hi == 0) al_l[r32] = (a); asm volatile("s_waitcnt lgkmcnt(0)" ::: "memory");              \
                     _Pragma("unroll") for (int d_ = 0; d_ < 4; ++d_) _Pragma("unroll") for (int r = 0; r < 16; ++r) o[d_][r] *= al_l[crow(r, hi)]; } } while (0)
#define KBASE(t) ((j_lo + (t)) * KVBLK)
#define MASKT(P0_, P1_, t) do { const int kb_ = KBASE(t); if (kb_ + KVBLK - 1 > qlo) { asm volatile("" ::: "memory"); mask_tile(P0_, P1_, qm - kb_); } } while (0)
#define QX(t) qx_of(sdw, slope2 * (float)(KBASE(t) - qpos) - m_reg)
#define SEAM_K0() do { VMWN(4); SWRITE_HK(0); SBAR(); } while (0)
    f32x16 pA0, pA1, pB0, pB1; float alA, alB; bf16x8 pa0, pa1, pa2, pa3;
    SWRITE_HV(0); SBAR();
    if (NT > 1) { SLOAD_H(cur, KBASE(1)); }
    SBAR(); qkt<0>(pA0, pA1, Kmap, r32, hi, S.qr, kx0, kx1, QX(0));
    MASKT(pA0, pA1, 0); partialSM(pA0, pA1, m_reg, alA);
    if (NT > 1) { VMW(); SWRITE_H(1); }
    __syncthreads();
#define HALF_STEP(PX0, PX1, alX, PY0, PY1, alY, t, KB, VB, SB) do {                                                      \
        SBAR(); qkt<KB>(PX0, PX1, Kmap, r32, hi, S.qr, kx0, kx1, QX(t));                                                           \
        finishSM(PY0, PY1, alY, l_reg, pa0, pa1, pa2, pa3); SBAR();                                                           \
        if ((t) + 1 < NT) { SLOAD_H(cur, KBASE((t) + 1)); SBAR(); }                                               \
        pv_tile<VB>(o, vb0, pa0, pa1, pa2, pa3); MASKT(PX0, PX1, (t)); partialSM(PX0, PX1, m_reg, alX);                                        \
        __syncthreads();                                                                                                      \
        if ((t) + 1 < NT) { VMW(); SWRITE_H(SB); }                                                                          \
        RESC(alX); __syncthreads(); } while (0)
    for (int t = 1; t + 1 < NT; t += 2) {
        HALF_STEP(pB0, pB1, alB, pA0, pA1, alA, t, 1, 0, 0);
        HALF_STEP(pA0, pA1, alA, pB0, pB1, alB, t + 1, 0, 1, 1);
    }
    const bool even = (NT & 1) == 0;
    if (even) { SBAR(); qkt<1>(pB0, pB1, Kmap, r32, hi, S.qr, kx0, kx1, QX(NT - 1)); SBAR(); }
    { const int nmap = map, nrw = rw;
      SLOAD_H(nxt, kbn); SBAR();
#pragma unroll
      for (int d0 = 0; d0 < 4; ++d0) S.qr[d0] = *(const bf16x8*)(BR_Q(nxt) + (size_t)(nxt.P0 + nrw * QBLK + r32) * PITCH + nmap * 64 + d0 * 16 + hi * 8); }
    SBAR();
    finishSM(pA0, pA1, alA, l_reg, pa0, pa1, pa2, pa3); SBAR();
    pv_tile<0>(o, vb0, pa0, pa1, pa2, pa3);
    if (even) { MASKT(pB0, pB1, NT - 1); partialSM(pB0, pB1, m_reg, alB); __syncthreads(); RESC(alB);
        finishSM(pB0, pB1, alB, l_reg, pa0, pa1, pa2, pa3); SBAR(); pv_tile<1>(o, vb0, pa0, pa1, pa2, pa3); }
    SBAR(); SEAM_K0();
    if (hi == 0) li_l[r32] = l_reg; asm volatile("s_waitcnt lgkmcnt(0)" ::: "memory");
    float rli[16];
#pragma unroll
    for (int r = 0; r < 16; ++r) rli[r] = __builtin_amdgcn_rcpf(li_l[crow(r, hi)]);
    float* xch = (float*)(lds + LDS_XCH) + (size_t)rw * (16 * 4 * 64) + lane;
    if (map == 1) {
#pragma unroll
        for (int r = 0; r < 16; ++r)
#pragma unroll
            for (int d0 = 0; d0 < 4; ++d0) xch[(r * 4 + d0) * 64] = o[d0][r] * rli[r];
    }
    __syncthreads();
    if (map == 0) {
        float gsub[4];
#pragma unroll
        for (int d0 = 0; d0 < 4; ++d0) gsub[d0] = subg[d0 * 32 + r32] * (1.f - LAM_INIT);
        int obase = (cur.P0 + rw * QBLK + 4 * hi) * PITCH + r32; asm volatile("" : "+v"(obase));
        bf16_t* Ow = BR_O(cur) + obase;
#pragma unroll
        for (int r = 0; r < 16; ++r) { float d[4]; float ss = 0.f;
#pragma unroll
            for (int d0 = 0; d0 < 4; ++d0) { d[d0] = o[d0][r] * rli[r] - lam * xch[(r * 4 + d0) * 64]; ss += d[d0] * d[d0]; }
            ss += __shfl_xor(ss, 1); ss += __shfl_xor(ss, 2); ss += __shfl_xor(ss, 4); ss += __shfl_xor(ss, 8); ss += __shfl_xor(ss, 16);
            const float rs = rsqrtf(ss * (1.f / 128.f) + EPS); const int orow = (r & 3) + 8 * (r >> 2);
#pragma unroll
            for (int d0 = 0; d0 < 4; ++d0) { const float v = (d[d0] * rs) * gsub[d0]; const float vn = __shfl_xor(v, 1);
                if ((r32 & 1) == 0) *(unsigned*)(Ow + orow * PITCH + d0 * 32) = cvtpk(v, vn); } }
    }
    __syncthreads();
#undef RESC
#undef KBASE
#undef MASKT
#undef QX
#undef SEAM_K0
#undef HALF_STEP
}
#undef BLD
#undef BR_Q
#undef BR_K
#undef BR_V
#undef BR_O
#undef VMW
#undef VMWN
#undef SLOAD_H
#undef SWRITE_HK
#undef SWRITE_HV
#undef SWRITE_H
}


__device__ __forceinline__ att::BlockRef attn_ref(Frame& F, int L) {
    const int ent = ((const int*)(F.ws + WS_ROUTE + RT_ALIST))[L]; const int u = ent & 0xffff, qb = u >> 4, bh = u & 15, b = bh >> 3, h = bh & 7;
    att::BlockRef r; r.base = b * SEQ * 1024 + h * 128;
    r.P0 = qb * 128; r.jlo = ent >> 16; r.slope2 = exp2f(-(float)(h + 1)) * LOG2E;
    return r;
}
__device__ __forceinline__ void p2_attention(Frame& F) {
    const float s1 = wave_sum(F.a->in[I_LQ1][F.lane] * F.a->in[I_LK1][F.lane]), s2 = wave_sum(F.a->in[I_LQ2][F.lane] * F.a->in[I_LK2][F.lane]);
    const float lam = expf(s1) - expf(s2) + LAM_INIT;
    constexpr int NUNITS = 1024;
    volatile LAS int* qs = (volatile LAS int*)(F.lds + 143 * 1024);
    __syncthreads();
    const int v = (F.G % 8 == 0) ? (F.blk % 8) * (F.G / 8) + F.blk / 8 : F.blk;
    int L = v, Ln = 2 * F.G - 1 - v;
    if (L >= NUNITS) return;
    att::BlockRef cur = attn_ref(F, L); att::Seam S;
    att::attn_prime(F.ws, cur, F.ldsg, S);
    for (;;) {
        const bool last = Ln >= NUNITS;
        int nn = 0; if (F.tid == 0 && !last) nn = 2 * F.G + (int)atomicAdd(F.ctl + CW_AQ, 1u);
        const att::BlockRef nxt = last ? cur : attn_ref(F, Ln);
        att::attn_block(F.ws, cur, nxt, F.ldsg, S, lam, F.a->in[I_SUBG]);
        if (last) break;
        if (F.tid == 0) qs[0] = nn;
        __syncthreads();
        cur = nxt; Ln = qs[0];
        __syncthreads();
    }
}

__device__ __forceinline__ void p3_merged(Frame& F) {
    pg8::StaticOrder S; S.init(M, DM, F.G, F.blk);
    { pg8::Gemm g{(const bf16_t*)(F.ws + WS_YA), (const bf16_t*)(F.ws + WS_WUPT), DM, nullptr}; EpiGateT E{(const bf16_t*)F.out, (bf16_t*)(F.ws + WS_T)};
      pg8::gemm_phase<EpiGateT, pg8::StaticOrder, PG8_ALIGN, PG8_SP2, false>(F.lds, g, S, E); }
    { pg8::Gemm g{(const bf16_t*)(F.ws + WS_XN), (const bf16_t*)(F.ws + WS_WUPT) + 1024 * 1024, DM, nullptr}; EpiMerged E{(const bf16_t*)F.out, (const bf16_t*)(F.ws + WS_T), (bf16_t*)(F.ws + WS_Q)};
      pg8::gemm_phase<EpiMerged, pg8::StaticOrder, PG8_ALIGN, PG8_SP2, false>(F.lds, g, S, E); }
}
__device__ __forceinline__ void p4_out(Frame& F) {
    pg8::StaticOrder S; S.init(M, DM, F.G, F.blk);
    pg8::Gemm g{(const bf16_t*)(F.ws + WS_Q), (const bf16_t*)(F.ws + WS_WOUTT), DM, nullptr}; EpiOut E{F.a->in[I_X], F.out};
    pg8::gemm_phase<EpiOut, pg8::StaticOrder, PG8_ALIGN, PG8_SP2, false>(F.lds, g, S, E);
}
__device__ __forceinline__ void h2_row(Frame& F, int t, f32x4 (&h)[4]) {
    const f32x4* xr = (const f32x4*)(F.out + (size_t)t * DM) + F.lane; const f32x4* g4 = (const f32x4*)F.a->in[I_N2G] + F.lane;
    float s = 0.f;
#pragma unroll
    for (int j = 0; j < 4; ++j) { h[j] = xr[64 * j]; s += (h[j][0] * h[j][0] + h[j][1] * h[j][1]) + (h[j][2] * h[j][2] + h[j][3] * h[j][3]); }
    const float r = rsqrtf(wave_sum(s) * (1.f / DM) + EPS);
#pragma unroll
    for (int j = 0; j < 4; ++j) h[j] = (h[j] * r) * g4[64 * j];
}
__device__ __forceinline__ void p5_router(Frame& F) {
    const float* WRT = (const float*)(F.ws + WS_ROUTE + RT_WRT); const float* brg = F.a->in[I_BRG]; const float* bre = F.a->in[I_BRE];
    int* tokpos = (int*)(F.ws + WS_ROUTE + RT_TOKPOS); float* roww = (float*)(F.ws + WS_ROUTE + RT_ROWW); int* rowtok = (int*)(F.ws + WS_ROUTE + RT_ROWTOK);
    LAS float* lg = (LAS float*)(F.lds + 128 * 1024 + (F.wid & 3) * 3072);
    const int i16 = F.lane & 15, kq = F.lane >> 4;
    if (F.wid < 4)
    for (int task = F.blk * 4 + F.wid; task < M / 16; task += F.G * 4) { const int t0 = task * 16;
        const float* xp = F.out + (size_t)(t0 + i16) * DM + 4 * kq; const float* wp = WRT + (size_t)i16 * DM + 4 * kq;
        f32x4 acc0 = {0.f, 0.f, 0.f, 0.f}, acc1 = acc0, acc2 = acc0; float ss = 0.f;
#pragma unroll 4
        for (int s = 0; s < 64; ++s) { const f32x4 xa = *(const f32x4*)(xp + 16 * s);
            const f32x4 w0 = *(const f32x4*)(wp + 16 * s), w1 = *(const f32x4*)(wp + 16 * DM + 16 * s), w2 = *(const f32x4*)(wp + 32 * DM + 16 * s);
            ss += (xa[0] * xa[0] + xa[1] * xa[1]) + (xa[2] * xa[2] + xa[3] * xa[3]);
#pragma unroll
            for (int e = 0; e < 4; ++e) { acc0 = __builtin_amdgcn_mfma_f32_16x16x4f32(xa[e], w0[e], acc0, 0, 0, 0); acc1 = __builtin_amdgcn_mfma_f32_16x16x4f32(xa[e], w1[e], acc1, 0, 0, 0);
                acc2 = __builtin_amdgcn_mfma_f32_16x16x4f32(xa[e], w2[e], acc2, 0, 0, 0); } }
        ss += __shfl_xor(ss, 16); ss += __shfl_xor(ss, 32);
        const float rr = rsqrtf(ss * (1.f / DM) + EPS);
#pragma unroll
        for (int reg = 0; reg < 4; ++reg) { LAS float* p = lg + (4 * kq + reg) * 48 + i16; p[0] = acc0[reg]; p[16] = acc1[reg]; p[32] = acc2[reg]; }
        LDS_WAIT(); asm volatile("" ::: "memory");
        if (F.lane < 16) { const LAS float* p = lg + F.lane * 48;
            float gl[4];
#pragma unroll
            for (int i = 0; i < 4; ++i) gl[i] = p[i] * rr + brg[i];
            int g = 0; float gm = gl[0];
#pragma unroll
            for (int i = 1; i < 4; ++i) if (gl[i] > gm) { gm = gl[i]; g = i; }
            float gs = 0.f;
#pragma unroll
            for (int i = 0; i < 4; ++i) gs += expf(gl[i] - gm);
            const float ggate = 1.f / gs;
            float el[8];
#pragma unroll
            for (int i = 0; i < 8; ++i) el[i] = p[4 + g * 8 + i] * rr + bre[g * 8 + i];
            int i1 = 0; float v1 = el[0];
#pragma unroll
            for (int i = 1; i < 8; ++i) if (el[i] > v1) { v1 = el[i]; i1 = i; }
            int i2 = -1; float v2 = -__builtin_inff();
#pragma unroll
            for (int i = 0; i < 8; ++i) if (i != i1 && el[i] > v2) { v2 = el[i]; i2 = i; }
            const float a = expf(v2 - v1), w1 = 1.f / (1.f + a), w2 = a / (1.f + a);
            const int t = t0 + F.lane, e1 = g * 8 + i1, e2 = g * 8 + i2;
            const int r1 = (int)atomicAdd(F.ctl + CW_CNT + e1 * CW_CNT_STRIDE, 1u), r2 = (int)atomicAdd(F.ctl + CW_CNT + e2 * CW_CNT_STRIDE, 1u);
            rowtok[e1 * ECAP + r1] = t; roww[e1 * ECAP + r1] = ggate * w1; rowtok[e2 * ECAP + r2] = t; roww[e2 * ECAP + r2] = ggate * w2;
            tokpos[2 * t] = (e1 << ECAP_LOG) | r1; tokpos[2 * t + 1] = (e2 << ECAP_LOG) | r2; }
        LDS_WAIT(); asm volatile("" ::: "memory");
    }
    if (F.wid < 4) { bf16_t* H2 = (bf16_t*)(F.ws + WS_H2);
      for (int t0 = (F.blk * 4 + F.wid) * 2; t0 < M; t0 += F.G * 4 * 2) { f32x4 h0[4], h1[4]; h2_row(F, t0, h0); h2_row(F, t0 + 1, h1);
#pragma unroll
          for (int j = 0; j < 4; ++j) { st4(H2 + (size_t)t0 * DM + 4 * F.lane + 256 * j, h0[j]); st4(H2 + (size_t)(t0 + 1) * DM + 4 * F.lane + 256 * j, h1[j]); } } }
    if (F.wid >= 4) {
      LAS float* scr = (LAS float*)(F.lds + (F.wid - 4) * 32768);
      bf16_t* W13T = (bf16_t*)(F.ws + WS_W13T); bf16_t* W2T = (bf16_t*)(F.ws + WS_W2T);
#define XW_SRC(it_) (((it_) % 384) < 128 ? F.a->in[I_W1] + (size_t)((it_) / 384) * 1024 * 256 : ((it_) % 384) < 256 ? F.a->in[I_W3] + (size_t)((it_) / 384) * 1024 * 256 : F.a->in[I_W2] + (size_t)((it_) / 384) * 256 * 1024)
#define XW_STORE(v_, it_, scr_) do { const int e_ = (it_) / 384, r_ = (it_) % 384; \
          if (r_ < 128) tr_store(v_, 256, W13T, 1024, 0, RmW13{e_ * 512}, scr_, r_, F.lane); \
          else if (r_ < 256) tr_store(v_, 256, W13T, 1024, 0, RmW13{e_ * 512 + 128}, scr_, r_ - 128, F.lane); \
          else tr_store(v_, 1024, W2T, 256, 0, RmAdd{e_ * 1024}, scr_, r_ - 256, F.lane); } while (0)
      const int stride = F.G * 4;
      for (int it = F.blk * 4 + (F.wid - 4); it < NE * 384; it += 2 * stride) { const int it2 = it + stride; const bool two = it2 < NE * 384;
          float va[32], vb[32];
          { const int r = it % 384; tr_load(XW_SRC(it), r < 256 ? 256 : 1024, r < 128 ? r : r < 256 ? r - 128 : r - 256, F.lane, va); }
          if (two) { const int r = it2 % 384; tr_load(XW_SRC(it2), r < 256 ? 256 : 1024, r < 128 ? r : r < 256 ? r - 128 : r - 256, F.lane, vb); }
          XW_STORE(va, it, scr);
          if (two) XW_STORE(vb, it2, scr + 64 * 33); }
#undef XW_SRC
#undef XW_STORE
    }
}
__device__ __forceinline__ void moe_offsets(Frame& F, LAS int* offs) {
    __syncthreads();
    if (F.tid < 64) { const int c = F.tid < NE ? (int)__hip_atomic_load(F.ctl + CW_CNT + F.tid * CW_CNT_STRIDE, __ATOMIC_RELAXED, __HIP_MEMORY_SCOPE_AGENT) : 0; const int p = (c + 255) & ~255; int incl = p;
#pragma unroll
        for (int o = 1; o < 32; o <<= 1) { const int v = __shfl_up(incl, o); if ((F.tid & 63) >= o) incl += v; }
        if (F.tid < NE) { offs[F.tid] = incl - p; offs[40 + F.tid] = c; for (int t = (incl - p) >> 8; t < (incl >> 8); ++t) offs[80 + t] = F.tid; } if (F.tid == NE - 1) offs[NE] = incl; }
    __syncthreads();
}
__device__ __forceinline__ int expert_of_row(LAS int* offs, int row) { return offs[80 + (row >> 8)]; }
__device__ __forceinline__ void moe_gemm1(Frame& F, LAS int* offs, int G, int c, int lo, int hi) {
    MoeOrder S{offs, 2, G, c, lo, hi};
    pg8::Gemm g{(const bf16_t*)(F.ws + WS_H2), (const bf16_t*)(F.ws + WS_W13T), DM, (const int*)(F.ws + WS_ROUTE + RT_ROWTOK)}; EpiSwiglu E{(const float*)(F.ws + WS_ROUTE + RT_ROWW), (bf16_t*)(F.ws + WS_HID)};
    pg8::gemm_phase<EpiSwiglu, MoeOrder, PG8_ALIGN, PG8_SP2, false, true>(F.lds, g, S, E);
}
__device__ __forceinline__ void moe_gemm2(Frame& F, LAS int* offs, int G, int c, int lo, int hi) {
    MoeOrder S{offs, 4, G, c, lo, hi};
    int kde = DE; asm volatile("" : "+s"(kde));
    pg8::Gemm g{(const bf16_t*)(F.ws + WS_HID), (const bf16_t*)(F.ws + WS_W2T), kde, nullptr}; EpiY E{(bf16_t*)(F.ws + WS_YBUF)};
    pg8::gemm_phase<EpiY, MoeOrder, PG8_ALIGN, PG8_SP2, false>(F.lds, g, S, E);
}
__device__ __forceinline__ void p7_moe_a(Frame& F) {
    LAS int* offs = (LAS int*)(F.lds + 140 * 1024); moe_offsets(F, offs);
    const int n1 = (offs[NE] / 256) * 2;
    moe_gemm1(F, offs, F.G, F.blk, 0, n1 < F.G ? n1 : F.G);
}
__device__ __forceinline__ void p7_moe_b(Frame& F) {
    LAS int* offs = (LAS int*)(F.lds + 140 * 1024); moe_offsets(F, offs);
    const int T = offs[NE] / 256, n1 = T * 2; int nrem = n1 - F.G; if (nrem < 0) nrem = 0; if (nrem > F.G / 2) nrem = F.G / 2;
    const int t2 = (T < F.G / 2 ? T : F.G / 2) * 4;
    if (F.blk < nrem) moe_gemm1(F, offs, nrem, F.blk, F.G, n1);
    else moe_gemm2(F, offs, F.G - nrem, F.blk - nrem, 0, t2);
}
__device__ __forceinline__ void p8_moe_c(Frame& F) {
    LAS int* offs = (LAS int*)(F.lds + 140 * 1024); moe_offsets(F, offs);
    const int T = offs[NE] / 256;
    moe_gemm2(F, offs, F.G, F.blk, (T < F.G / 2 ? T : F.G / 2) * 4, T * 4);
}
__device__ __forceinline__ void p9_combine(Frame& F) {
    LAS int* offs = (LAS int*)(F.lds + 140 * 1024);
    moe_offsets(F, offs);
    const bf16_t* YB = (const bf16_t*)(F.ws + WS_YBUF); const int* tokpos = (const int*)(F.ws + WS_ROUTE + RT_TOKPOS);
    for (int t0 = F.gw * 4; t0 < M; t0 += F.NGW * 4) { int p[4][2];
#pragma unroll
        for (int q = 0; q < 4; ++q) { const int a0 = tokpos[2 * (t0 + q)], a1 = tokpos[2 * (t0 + q) + 1]; p[q][0] = offs[a0 >> ECAP_LOG] + (a0 & (ECAP - 1)); p[q][1] = offs[a1 >> ECAP_LOG] + (a1 & (ECAP - 1)); }
        f32x4 xv[4][4];
#pragma unroll
        for (int q = 0; q < 4; ++q)
#pragma unroll
            for (int j = 0; j < 4; ++j) xv[q][j] = ((const f32x4*)(F.out + (size_t)(t0 + q) * DM) + F.lane)[64 * j];
#pragma unroll
        for (int q = 0; q < 4; ++q) {
            f32x4 a[4], b[4];
#pragma unroll
            for (int j = 0; j < 4; ++j) { a[j] = ld4(YB + (size_t)p[q][0] * DM + 4 * F.lane + 256 * j); b[j] = ld4(YB + (size_t)p[q][1] * DM + 4 * F.lane + 256 * j); }
#pragma unroll
            for (int j = 0; j < 4; ++j) ((f32x4*)(F.out + (size_t)(t0 + q) * DM) + F.lane)[64 * j] = xv[q][j] + (a[j] + b[j]); } }
}

#define XB_TMO      128
#define XB_XCNT(j)  (256  + 64 * (j))
#define XB_XSUB(j)  (1280 + 64 * (j))
#define XB_XGEN(j)  (2304 + 64 * (j))
#define XB_TOP      3328
#define XB_TOPGEN   3392
#define XCD_BAR_WORDS 3456
#define XB_SPIN_CAP (1u << 22)

__device__ __forceinline__ unsigned xb_ld(unsigned* p)              { return __hip_atomic_load(p, __ATOMIC_RELAXED, __HIP_MEMORY_SCOPE_AGENT); }
__device__ __forceinline__ unsigned xb_add(unsigned* p, unsigned v) { return __hip_atomic_fetch_add(p, v, __ATOMIC_RELAXED, __HIP_MEMORY_SCOPE_AGENT); }
__device__ __forceinline__ unsigned xb_xcc_id() { return (unsigned)__builtin_amdgcn_s_getreg((3 << 11) | 20) & 0xFu; }
#define XB_SPIN(cond, bar) do { unsigned _sp = 0; while (cond) { __builtin_amdgcn_s_sleep(1); \
    if ((++_sp & 255u) == 0u) { if (xb_ld(&(bar)[XB_TMO])) break; if (_sp > XB_SPIN_CAP) { atomicAdd(&(bar)[XB_TMO], 1u); break; } } } } while (0)

struct XcdBarrier {
    unsigned* bar; unsigned x;
    volatile LAS unsigned* st;
};

__device__ __forceinline__ XcdBarrier xcd_barrier_post(unsigned* bar, volatile LAS unsigned* st) {
    XcdBarrier b; b.bar = bar; b.x = xb_xcc_id(); b.st = st;
    if (threadIdx.x == 0) (void)xb_add(&bar[XB_XCNT(b.x)], 1u);
    return b;
}
__device__ __forceinline__ void xcd_barrier_complete(unsigned* bar, unsigned x, unsigned& nloc, unsigned& nx) {
    const unsigned G = gridDim.x * gridDim.y * gridDim.z;
    unsigned sum, cnt, mine, sp = 0u;
    for (;;) {
        sum = 0u; cnt = 0u; mine = 0u;
#pragma unroll
        for (unsigned j = 0; j < 16; ++j) { const unsigned c = xb_ld(&bar[XB_XCNT(j)]); sum += c; cnt += (c > 0u) ? 1u : 0u; mine = (j == x) ? c : mine; }
        if (sum == G) break;
        __builtin_amdgcn_s_sleep(1);
        if ((++sp & 255u) == 0u) { if (xb_ld(&bar[XB_TMO])) break; if (sp > XB_SPIN_CAP) { atomicAdd(&bar[XB_TMO], 1u); break; } }
    }
    nloc = mine > 0u ? mine : 1u; nx = cnt > 0u ? cnt : 1u;
}

__device__ __forceinline__ void xcd_barrier(const XcdBarrier& b) {
    asm volatile("s_waitcnt vmcnt(0)" ::: "memory");
    __syncthreads();
    if (threadIdx.x == 0) {
        unsigned* bar = b.bar;
        __builtin_amdgcn_s_waitcnt(0);
        unsigned nloc = b.st[0], nx = b.st[1];
        if (nloc == 0u) { xcd_barrier_complete(bar, b.x, nloc, nx); b.st[0] = nloc; b.st[1] = nx; }
        const unsigned old = xb_add(&bar[XB_XSUB(b.x)], 1u);
        const unsigned gen = old / nloc;
        if (old + 1u == (gen + 1u) * nloc) {
            __builtin_amdgcn_fence(__ATOMIC_RELEASE, "agent");
            asm volatile("s_waitcnt vmcnt(0)" ::: "memory");
            const unsigned og = xb_add(&bar[XB_TOP], 1u);
            const unsigned tg = og / nx;
            if (og + 1u == (tg + 1u) * nx) xb_add(&bar[XB_TOPGEN], 1u);
            else XB_SPIN(xb_ld(&bar[XB_TOPGEN]) == tg, bar);
            __builtin_amdgcn_fence(__ATOMIC_ACQUIRE, "agent");
            xb_add(&bar[XB_XGEN(b.x)], 1u);
            asm volatile("s_waitcnt vmcnt(0)" ::: "memory");
        } else {
            XB_SPIN(xb_ld(&bar[XB_XGEN(b.x)]) == gen, bar);
            __builtin_amdgcn_fence(__ATOMIC_ACQUIRE, "agent");
            asm volatile("s_waitcnt vmcnt(0)" ::: "memory");
        }
    }
    __syncthreads();
}
constexpr int LDS_BYTES = 147456;
__global__ void __launch_bounds__(NTHREADS, 2) fwd_kernel(Args args) {
    extern __shared__ __attribute__((aligned(16))) unsigned char lds[];
    Frame F;
    F.lds = (LAS unsigned char*)lds; F.ldsg = (char*)lds;
    F.tid = threadIdx.x; F.lane = F.tid & 63; F.wid = __builtin_amdgcn_readfirstlane(F.tid >> 6);
    F.blk = blockIdx.x; F.G = gridDim.x; F.gw = F.blk * NWAVES + F.wid; F.NGW = F.G * NWAVES;
    F.a = &args;
    F.out = args.out; F.ws = args.ws; F.ctl = (unsigned*)(args.ws + WS_CTL);
    const int lo = args.ph_lo, hi = args.ph_hi;
#if MK_ONE_LAUNCH
    cg::grid_group grid = cg::this_grid();
    volatile LAS unsigned* bst = (volatile LAS unsigned*)(F.lds + 144 * 1024 - 16);
    if (F.tid < 2) bst[F.tid] = 0u;
    __syncthreads();
    const XcdBarrier bar = xcd_barrier_post(F.ctl + CW_BAR, bst);
#define SEAM(k) do { if (lo <= (k) && (k) + 1 < hi) { xcd_barrier(bar); } asm volatile("" : "+v"(F.tid), "+v"(F.lane)); } while (0)
    if (hi > NPHASE) grid.sync();
#else
#define SEAM(k) do { } while (0)
#endif
#define IN(k) (lo <= (k) && (k) < hi)
    if (IN(0)) { p0_prologue(F); } SEAM(0);
    if (IN(1)) { p1_proj(F); } SEAM(1);
    if (IN(2)) { p2_mixer_a(F); p2_attention(F); } SEAM(2);
    if (IN(3)) { p3_merged(F); } SEAM(3);
    if (IN(4)) { p4_out(F); } SEAM(4);
    if (IN(5)) { p5_router(F); } SEAM(5);
    if (IN(6)) { p7_moe_a(F); } SEAM(6);
    if (IN(7)) { p7_moe_b(F); } SEAM(7);
    if (IN(8)) { p8_moe_c(F); } SEAM(8);
    if (IN(9)) { p9_combine(F); }
#undef IN
#undef SEAM
}

extern "C" void kernel_launch(void* const* d_in, const int* in_sizes, int n_in, void* d_out, int out_size, void* d_ws, size_t ws_size, hipStream_t stream) {
    static int grid = 0;
    if (grid == 0) {
        if (n_in != 26 || out_size != M * DM || ws_size < WS_END) { fprintf(stderr, "kernel_launch: unexpected shapes (n_in %d out %d ws %zu)\n", n_in, out_size, ws_size); grid = -1; return; }
        int dev = 0, cus = 0, per_cu = 0;
        (void)hipGetDevice(&dev); (void)hipDeviceGetAttribute(&cus, hipDeviceAttributeMultiprocessorCount, dev);
        if (hipFuncSetAttribute((const void*)fwd_kernel, hipFuncAttributeMaxDynamicSharedMemorySize, LDS_BYTES) != hipSuccess) { fprintf(stderr, "kernel_launch: hipFuncSetAttribute failed\n"); grid = -1; return; }
        if (hipOccupancyMaxActiveBlocksPerMultiprocessor(&per_cu, (const void*)fwd_kernel, NTHREADS, LDS_BYTES) != hipSuccess || per_cu < 1) { fprintf(stderr, "kernel_launch: occupancy query says %d\n", per_cu); per_cu = 1; }
        (void)hipGetLastError();
        grid = cus;
    }
    if (grid < 0) return;
    (void)hipMemsetAsync((char*)d_ws + WS_CTL, 0, CTL_ZERO_BYTES, stream);
    Args a{};
    for (int i = 0; i < 26; ++i) a.in[i] = (const float*)d_in[i];
    a.out = (float*)d_out; a.ws = (unsigned char*)d_ws;
#if MK_ONE_LAUNCH
    a.ph_lo = 0; a.ph_hi = NPHASE;
    void* kargs[] = {&a};
    hipError_t e = hipLaunchCooperativeKernel((const void*)fwd_kernel, dim3(grid), dim3(NTHREADS), kargs, LDS_BYTES, stream);
    if (e != hipSuccess) fprintf(stderr, "cooperative launch failed: %s (grid %d)\n", hipGetErrorString(e), grid);
#else
    for (int p = 0; p < NPHASE; ++p) { a.ph_lo = p; a.ph_hi = p + 1; hipLaunchKernelGGL(fwd_kernel, dim3(grid), dim3(NTHREADS), LDS_BYTES, stream, a); }
#endif
}
```

```cpp
#include <hip/hip_runtime.h>
#include <hip/hip_cooperative_groups.h>
#include <cstdio>
#include <cstdint>
namespace cg = cooperative_groups;

#ifndef MK_ONE_LAUNCH
#define MK_ONE_LAUNCH 1
#endif

#define LAS __attribute__((address_space(3)))
typedef unsigned short bf16_t;
typedef short bf16x8 __attribute__((ext_vector_type(8)));
typedef short s16x4 __attribute__((ext_vector_type(4)));
typedef float f32x4 __attribute__((ext_vector_type(4)));
typedef float f32x16 __attribute__((ext_vector_type(16)));
typedef float f32x2 __attribute__((ext_vector_type(2)));
typedef unsigned u32x4 __attribute__((ext_vector_type(4)));
typedef unsigned u32x2 __attribute__((ext_vector_type(2)));
typedef __bf16 bf16x2_t __attribute__((ext_vector_type(2)));

constexpr int NB = 2, SEQ = 8192, DM = 1024, M = NB * SEQ;
constexpr int NH = 8;
constexpr int N1 = 7168;
constexpr int NE = 32, DE = 256;
constexpr float EPS = 1e-6f;
constexpr float LOG2E = 1.4426950408889634f;
constexpr float C2 = 0.125f * LOG2E;
constexpr float LAM_INIT = 0.2f;
constexpr int NWAVES = 8, NTHREADS = 512;
constexpr int NPHASE = 10;
constexpr int ECAP = 16384, ECAP_LOG = 14;

constexpr size_t MiB = 1u << 20;
constexpr size_t WS_CTL = 0;
constexpr size_t CTL_ZERO_BYTES = 65536;
constexpr size_t WS_W1T = 1 * MiB;
constexpr size_t WS_WUPT = 15 * MiB;
constexpr size_t WS_WOUTT = 19 * MiB;
constexpr size_t WS_WST = 21 * MiB;
constexpr size_t WS_ROUTE = 22 * MiB;
constexpr size_t WS_XN = 32 * MiB;
constexpr size_t WS_U = 64 * MiB;
constexpr size_t WS_VA = 96 * MiB;
constexpr size_t WS_Q = 128 * MiB;
constexpr size_t WS_K = 160 * MiB;
constexpr size_t WS_VB = 192 * MiB;
constexpr size_t WS_W13T = 160 * MiB;
constexpr size_t WS_W2T = 192 * MiB;
constexpr size_t WS_HID = 208 * MiB;
constexpr size_t WS_H2 = 32 * MiB;
constexpr size_t WS_YBUF = 64 * MiB;
constexpr size_t WS_YA = 224 * MiB;
constexpr size_t WS_T = 64 * MiB;
constexpr size_t WS_END = 256 * MiB;
constexpr size_t RT_TOKE = 0, RT_TOKW = 256 * 1024, RT_TOKPOS = 512 * 1024, RT_WRT = 1024 * 1024, RT_ALIST = 1536 * 1024, RT_ROWTOK = 2048 * 1024, RT_ROWW = 4096 * 1024, RT_ROWRR = 6144 * 1024;
constexpr int CW_CNT = 8192, CW_CNT_STRIDE = 64, CW_AQ = 512, CW_BAR = 1024;

#define LDS_WAIT() asm volatile("s_waitcnt lgkmcnt(0)" ::: "memory")
#define SBAR() __builtin_amdgcn_sched_barrier(0)
__device__ __forceinline__ unsigned cvtpk(float lo, float hi) { f32x2 v = {lo, hi}; bf16x2_t b = __builtin_convertvector(v, bf16x2_t); return __builtin_bit_cast(unsigned, b); }
__device__ __forceinline__ float bf2f(short b) { return __uint_as_float(((unsigned)(unsigned short)b) << 16); }
__device__ __forceinline__ float wave_sum(float v) {
#pragma unroll
    for (int o = 1; o < 64; o <<= 1) v += __shfl_xor(v, o);
    return v;
}
__device__ __forceinline__ void st4(bf16_t* p, f32x4 v) { u32x2 w; w.x = cvtpk(v[0], v[1]); w.y = cvtpk(v[2], v[3]); *(u32x2*)p = w; }
__device__ __forceinline__ f32x4 ld4(const bf16_t* p) { const u32x2 w = *(const u32x2*)p; f32x4 r; r[0] = __uint_as_float(w.x << 16); r[1] = __uint_as_float(w.x & 0xffff0000u); r[2] = __uint_as_float(w.y << 16); r[3] = __uint_as_float(w.y & 0xffff0000u); return r; }

struct Args { const float* in[26]; float* out; unsigned char* ws; int ph_lo, ph_hi; };

struct Frame {
    LAS unsigned char* lds; char* ldsg;
    int tid, lane, wid, blk, G, gw, NGW;
    const Args* a; float* out; unsigned char* ws; unsigned* ctl;
};
enum { I_X = 0, I_N1G, I_WIN, I_VNG, I_WS, I_BS, I_QNG, I_KNG, I_LQ1, I_LK1, I_LQ2, I_LK2, I_SUBG, I_WUPA, I_WUPB, I_WGATE, I_BGATE, I_WOUT, I_N2G, I_WRG, I_BRG, I_WRE, I_BRE, I_W1, I_W3, I_W2 };

__device__ __forceinline__ void wave_gemm(f32x4 (&acc)[2][4], const bf16_t* ap0, const bf16_t* ap1, const bf16_t* bp0, const bf16_t* bp1, const bf16_t* bp2, const bf16_t* bp3, int K) {
#pragma unroll 2
    for (int k0 = 0; k0 < K; k0 += 32) {
        const bf16x8 a0 = *(const bf16x8*)(ap0 + k0), a1 = *(const bf16x8*)(ap1 + k0);
        const bf16x8 b0 = *(const bf16x8*)(bp0 + k0), b1 = *(const bf16x8*)(bp1 + k0), b2 = *(const bf16x8*)(bp2 + k0), b3 = *(const bf16x8*)(bp3 + k0);
        acc[0][0] = __builtin_amdgcn_mfma_f32_16x16x32_bf16(b0, a0, acc[0][0], 0, 0, 0);
        acc[0][1] = __builtin_amdgcn_mfma_f32_16x16x32_bf16(b1, a0, acc[0][1], 0, 0, 0);
        acc[0][2] = __builtin_amdgcn_mfma_f32_16x16x32_bf16(b2, a0, acc[0][2], 0, 0, 0);
        acc[0][3] = __builtin_amdgcn_mfma_f32_16x16x32_bf16(b3, a0, acc[0][3], 0, 0, 0);
        acc[1][0] = __builtin_amdgcn_mfma_f32_16x16x32_bf16(b0, a1, acc[1][0], 0, 0, 0);
        acc[1][1] = __builtin_amdgcn_mfma_f32_16x16x32_bf16(b1, a1, acc[1][1], 0, 0, 0);
        acc[1][2] = __builtin_amdgcn_mfma_f32_16x16x32_bf16(b2, a1, acc[1][2], 0, 0, 0);
        acc[1][3] = __builtin_amdgcn_mfma_f32_16x16x32_bf16(b3, a1, acc[1][3], 0, 0, 0);
    }
}
__device__ __forceinline__ void acc_zero(f32x4 (&acc)[2][4]) {
#pragma unroll
    for (int m = 0; m < 2; ++m)
#pragma unroll
        for (int n = 0; n < 4; ++n) acc[m][n] = (f32x4){0.f, 0.f, 0.f, 0.f};
}

namespace pg8 {
#define PG8_LAS __attribute__((address_space(3)))
constexpr int BM = 256, BK = 64, HALF = 128, HTB = HALF * BK * 2  , STAGE_BYTES = 8 * HTB, NXCD = 8, WGM = 8;

__host__ __device__ __forceinline__ int lds_byte(int r, int c) { const int st = (r >> 4) * 2 + (c >> 5), rr = r & 15, cc = c & 31, ob = rr * 64 + cc * 2; return st * 1024 + (ob ^ (((ob >> 9) & 1) << 5)); }
__host__ __device__ __forceinline__ void stage_rc(int b, int& R, int& C) { const int st = b / 1024, sb = b % 1024, swz = sb ^ (((sb >> 9) & 1) << 5); R = (st >> 1) * 16 + swz / 64; C = (st & 1) * 32 + (swz % 64) / 2; }
__host__ __device__ __forceinline__ int perm32(int rho) { const int n = rho >> 4, i = rho & 15; return 8 * (i >> 2) + 4 * n + (i & 3); }

struct Unit { int pm, pn, pb, rbase, nvalid; };
struct Gemm { const bf16_t* A; const bf16_t* Bt; int K; const int* rowtok; };

struct StaticOrder {
    int nM, nN, nwg, G, c;
    __host__ __device__ void init(int M, int N, int G_, int c_) { nM = M / BM; nN = N / BM; nwg = nM * nN; G = G_; c = c_; }
    __host__ __device__ bool next(int i, Unit& u) const {
        const long L = (long)i * G + c; if (L >= nwg) return false;
        int wgid = (int)L; { const int q = nwg / NXCD, r = nwg % NXCD, xcd = wgid % NXCD, off = wgid / NXCD; wgid = (xcd < r ? xcd * (q + 1) : r * (q + 1) + (xcd - r) * q) + off; }
        const int nig = WGM * nN, gid = wgid / nig, fm = gid * WGM, gsz = (nM - fm) < WGM ? (nM - fm) : WGM;
        u.pm = fm + ((wgid % nig) % gsz); u.pn = (wgid % nig) / gsz; u.pb = u.pn; u.rbase = 0; u.nvalid = 0; return true;
    }
    __device__ __forceinline__ void a_ready(const Unit&) const {}
    __device__ __forceinline__ void done(const Unit&) const {}
};
template <class Epi, class Sched, bool ALIGN_EPI = false, bool SP2 = false, bool BP64 = false, bool GATHER = false>
__device__ __forceinline__ void gemm_phase(PG8_LAS unsigned char* lds, const Gemm g, const Sched& S, const Epi& E) {
    const int tid = threadIdx.x, wid = __builtin_amdgcn_readfirstlane(tid >> 6), lane = tid & 63, wr = wid >> 2, wc = wid & 3, fr = lane & 15, fq = lane >> 4;
    const int K = g.K, nt = K / BK;
    unsigned voffA[2], voffB[2];
#pragma unroll
    for (int i = 0; i < 2; ++i) { int R, C; stage_rc(tid * 16 + i * 8192, R, C); const int Rp = Epi::PERM ? ((R & ~31) + perm32(R & 31)) : R; const int Rb = BP64 ? (64 * (Rp >> 5) + (Rp & 31)) : Rp;
        voffA[i] = (unsigned)(R * K + C) * 2u; voffB[i] = (unsigned)(Rb * K + C) * 2u; }
    const size_t kstep = (size_t)(BK * 2);
    const size_t hstep = (size_t)HALF * K * 2;
    const size_t tstep = 2 * hstep;
    const size_t bhs = BP64 ? (size_t)32 * K * 2 : hstep;
    const unsigned ldsw = (unsigned)wid * 1024u;
    const int aoff = lds_byte(wr * 64 + fr, fq * 8), boff = lds_byte(wc * 32 + fr, fq * 8);
#define PG8_SA(b, h) (((b) * 2 + (h)) * HTB)
#define PG8_SB(b, h) ((4 + (b) * 2 + (h)) * HTB)
#define PG8_STAGE(bufoff, gbase, voff) do { _Pragma("unroll") for (int _i = 0; _i < 2; ++_i) \
        __builtin_amdgcn_global_load_lds((const unsigned*)((const char*)(gbase) + (voff)[_i]), (PG8_LAS unsigned*)(lds + (bufoff) + ldsw + _i * 8192), 16, 0, 0); } while (0)
#define PG8_LDA(dst, b, h) do { _Pragma("unroll") for (int m = 0; m < 4; ++m) _Pragma("unroll") for (int k = 0; k < 2; ++k) dst[m][k] = *(const PG8_LAS bf16x8*)(lds + PG8_SA(b, h) + aoff + m * 2048 + k * 1024); } while (0)
#define PG8_LDB(dst, b, h) do { _Pragma("unroll") for (int n = 0; n < 2; ++n) _Pragma("unroll") for (int k = 0; k < 2; ++k) dst[n][k] = *(const PG8_LAS bf16x8*)(lds + PG8_SB(b, h) + boff + n * 2048 + k * 1024); } while (0)
#define PG8_MMA(ai, bj, At, Bt) do { __builtin_amdgcn_s_setprio(1); _Pragma("unroll") for (int m = 0; m < 4; ++m) _Pragma("unroll") for (int n = 0; n < 2; ++n) _Pragma("unroll") for (int k = 0; k < 2; ++k) \
        acc[ai][bj][m][n] = __builtin_amdgcn_mfma_f32_16x16x32_bf16(Bt[n][k], At[m][k], acc[ai][bj][m][n], 0, 0, 0); __builtin_amdgcn_s_setprio(0); } while (0)
#define PG8_WAIT_V(n) asm volatile("s_waitcnt vmcnt(" #n ")" ::: "memory")
#define PG8_WAIT_L(n) asm volatile("s_waitcnt lgkmcnt(" #n ")" ::: "memory")
#define PG8_BAR __builtin_amdgcn_s_barrier()
#define PG8_SCHED __builtin_amdgcn_sched_barrier(0)
    Unit cur, nxt; int ui = 0;
    if (!S.next(0, cur)) return;
    static_assert(!GATHER || SP2, "GATHER is written for the SP2 loop");
    unsigned vA0[2] = {0u, 0u}, vA1[2] = {0u, 0u}, nvA0[2] = {0u, 0u}, nvA1[2] = {0u, 0u};
#define PG8_GLOAD(u_, d0_, d1_) do { _Pragma("unroll") for (int _i = 0; _i < 2; ++_i) { int R_, C_; stage_rc(tid * 16 + _i * 8192, R_, C_); \
        const int t0_ = R_ < (u_).nvalid ? g.rowtok[(u_).rbase + R_] : 0, t1_ = HALF + R_ < (u_).nvalid ? g.rowtok[(u_).rbase + HALF + R_] : 0; d0_[_i] = (unsigned)(t0_ * K + C_) * 2u; d1_[_i] = (unsigned)(t1_ * K + C_) * 2u; } } while (0)
#define PG8_STAGE_A(bufoff, ptr, half, vcur0, vcur1) do { if constexpr (GATHER) { PG8_STAGE(bufoff, ptr, (half) ? vcur1 : vcur0); } else { PG8_STAGE(bufoff, (ptr) + ((half) ? hstep : (size_t)0), voffA); } } while (0)
    if constexpr (GATHER) PG8_GLOAD(cur, vA0, vA1);
    f32x4 acc[2][2][4][2];
#pragma unroll
    for (int a = 0; a < 2; ++a)
#pragma unroll
        for (int b = 0; b < 2; ++b)
#pragma unroll
            for (int m = 0; m < 4; ++m)
#pragma unroll
                for (int n = 0; n < 2; ++n) acc[a][b][m][n] = (f32x4){0.f, 0.f, 0.f, 0.f};
    bf16x8 At[4][2], B0[2][2], B1[2][2];
    const char* cA = (const char*)g.A + (GATHER ? (size_t)0 : (size_t)cur.pm * tstep); const char* cB = (const char*)g.Bt + (size_t)cur.pb * tstep;
    S.a_ready(cur);
    if constexpr (SP2) {
        PG8_STAGE(PG8_SB(0, 0), cB, voffB); PG8_STAGE(PG8_SB(0, 1), cB + bhs, voffB); PG8_STAGE_A(PG8_SA(0, 0), cA, 0, vA0, vA1); PG8_STAGE_A(PG8_SA(0, 1), cA, 1, vA0, vA1);
        if (wr == 1) PG8_BAR;
        PG8_WAIT_V(2); PG8_BAR;
        PG8_STAGE(PG8_SB(1, 0), cB + kstep, voffB); PG8_STAGE_A(PG8_SA(1, 0), cA + kstep, 0, vA0, vA1); PG8_STAGE(PG8_SB(1, 1), cB + bhs + kstep, voffB);
        PG8_WAIT_V(6); PG8_BAR;
    } else {
        PG8_STAGE(PG8_SB(0, 0), cB, voffB); PG8_STAGE(PG8_SA(0, 0), cA, voffA); PG8_STAGE(PG8_SB(0, 1), cB + bhs, voffB); PG8_STAGE(PG8_SA(0, 1), cA + hstep, voffA);
        if (wr == 1) PG8_BAR;
        PG8_WAIT_V(4); PG8_BAR;
        PG8_STAGE(PG8_SB(1, 0), cB + kstep, voffB); PG8_STAGE(PG8_SA(1, 0), cA + kstep, voffA); PG8_STAGE(PG8_SB(1, 1), cB + bhs + kstep, voffB);
        PG8_WAIT_V(6); PG8_BAR;
    }
    for (;;) {
        const bool has_next = S.next(ui + 1, nxt);
        const char* nA = (has_next && !GATHER) ? (const char*)g.A + (size_t)nxt.pm * tstep : cA; const char* nB = has_next ? (const char*)g.Bt + (size_t)nxt.pb * tstep : cB;
        if constexpr (GATHER) { if (has_next) { PG8_GLOAD(nxt, nvA0, nvA1); } else { nvA0[0] = vA0[0]; nvA0[1] = vA0[1]; nvA1[0] = vA1[0]; nvA1[1] = vA1[1]; } }
        for (int t = 0; t < nt; t += 2) {
            const bool last = (t == nt - 2);
            const char* a1 = cA + (size_t)(t + 1) * kstep;
            const char* a2 = last ? nA : cA + (size_t)(t + 2) * kstep; const char* b2 = last ? nB : cB + (size_t)(t + 2) * kstep;
            const char* a3 = a2 + kstep; const char* b3 = b2 + kstep;
            if (last && has_next) S.a_ready(nxt);
            unsigned xA0[2], xA1[2];
            if constexpr (GATHER) { xA0[0] = last ? nvA0[0] : vA0[0]; xA0[1] = last ? nvA0[1] : vA0[1]; xA1[0] = last ? nvA1[0] : vA1[0]; xA1[1] = last ? nvA1[1] : vA1[1]; }
            if constexpr (SP2) {
            PG8_LDB(B0, 0, 0); PG8_LDB(B1, 0, 1); PG8_SCHED; PG8_LDA(At, 0, 0); PG8_STAGE_A(PG8_SA(1, 1), a1, 1, vA0, vA1);
            PG8_WAIT_V(8); PG8_WAIT_L(0); PG8_BAR; PG8_MMA(0, 0, At, B0); PG8_MMA(0, 1, At, B1); PG8_BAR; PG8_SCHED;
            PG8_LDA(At, 0, 1); PG8_STAGE(PG8_SB(0, 0), b2, voffB); PG8_STAGE(PG8_SB(0, 1), b2 + bhs, voffB); PG8_STAGE_A(PG8_SA(0, 0), a2, 0, xA0, xA1);
            PG8_WAIT_V(8); PG8_WAIT_L(0); PG8_BAR; PG8_MMA(1, 0, At, B0); PG8_MMA(1, 1, At, B1); PG8_BAR; PG8_SCHED;
            PG8_LDB(B0, 1, 0); PG8_LDB(B1, 1, 1); PG8_SCHED; PG8_LDA(At, 1, 0); PG8_STAGE_A(PG8_SA(0, 1), a2, 1, xA0, xA1);
            PG8_WAIT_V(8); PG8_WAIT_L(0); PG8_BAR; PG8_MMA(0, 0, At, B0); PG8_MMA(0, 1, At, B1); PG8_BAR; PG8_SCHED;
            PG8_LDA(At, 1, 1); PG8_STAGE(PG8_SB(1, 0), b3, voffB); PG8_STAGE(PG8_SB(1, 1), b3 + bhs, voffB); PG8_STAGE_A(PG8_SA(1, 0), a3, 0, xA0, xA1);
            PG8_WAIT_V(8); PG8_WAIT_L(0); PG8_BAR; PG8_MMA(1, 0, At, B0); PG8_MMA(1, 1, At, B1); PG8_BAR; PG8_SCHED;
            } else {
            PG8_LDB(B0, 0, 0); PG8_SCHED; PG8_LDA(At, 0, 0); PG8_STAGE(PG8_SA(1, 1), a1 + hstep, voffA);
            PG8_WAIT_L(8); PG8_BAR; PG8_WAIT_L(0); PG8_MMA(0, 0, At, B0); PG8_BAR; PG8_SCHED;
            PG8_LDB(B1, 0, 1); PG8_STAGE(PG8_SB(0, 0), b2, voffB);
            PG8_BAR; PG8_WAIT_L(0); PG8_MMA(0, 1, At, B1); PG8_BAR;
            PG8_LDA(At, 0, 1); PG8_STAGE(PG8_SA(0, 0), a2, voffA);
            PG8_BAR; PG8_WAIT_L(0); PG8_MMA(1, 0, At, B0); PG8_BAR; PG8_SCHED;
            PG8_STAGE(PG8_SB(0, 1), b2 + bhs, voffB);
            PG8_WAIT_V(6); PG8_BAR; PG8_MMA(1, 1, At, B1); PG8_BAR;
            PG8_LDB(B0, 1, 0); PG8_SCHED; PG8_LDA(At, 1, 0); PG8_STAGE(PG8_SA(0, 1), a2 + hstep, voffA);
            PG8_WAIT_L(8); PG8_BAR; PG8_WAIT_L(0); PG8_MMA(0, 0, At, B0); PG8_BAR; PG8_SCHED;
            PG8_LDB(B1, 1, 1); PG8_STAGE(PG8_SB(1, 0), b3, voffB);
            PG8_BAR; PG8_WAIT_L(0); PG8_MMA(0, 1, At, B1); PG8_BAR;
            PG8_LDA(At, 1, 1); PG8_STAGE(PG8_SA(1, 0), a3, voffA);
            PG8_BAR; PG8_WAIT_L(0); PG8_MMA(1, 0, At, B0); PG8_BAR; PG8_SCHED;
            PG8_STAGE(PG8_SB(1, 1), b3 + bhs, voffB);
            PG8_WAIT_V(6); PG8_BAR; PG8_MMA(1, 1, At, B1); PG8_BAR;
            }
        }
        if constexpr (ALIGN_EPI) { if (wr == 0) PG8_BAR; }
        if constexpr (!Epi::AFTER_DRAIN) { E(acc, cur, wr, wc, fr, fq); S.done(cur); }
        if (!has_next) break;
#pragma unroll
        for (int a = 0; a < 2; ++a)
#pragma unroll
            for (int b = 0; b < 2; ++b)
#pragma unroll
                for (int m = 0; m < 4; ++m)
#pragma unroll
                    for (int n = 0; n < 2; ++n) acc[a][b][m][n] = (f32x4){0.f, 0.f, 0.f, 0.f};
        cur = nxt; cA = nA; cB = nB; ++ui;
        if constexpr (GATHER) { vA0[0] = nvA0[0]; vA0[1] = nvA0[1]; vA1[0] = nvA1[0]; vA1[1] = nvA1[1]; }
        if constexpr (ALIGN_EPI) { if (wr == 1) PG8_BAR; }
    }
    PG8_WAIT_V(0);
    if constexpr (!ALIGN_EPI) { if (wr == 0) PG8_BAR; }
    PG8_BAR;
    if constexpr (Epi::AFTER_DRAIN) { E.fused(acc, cur, wr, wc, fr, fq, lds, wid, lane); S.done(cur); }
#undef PG8_GLOAD
#undef PG8_STAGE_A
#undef PG8_SA
#undef PG8_SB
#undef PG8_STAGE
#undef PG8_LDA
#undef PG8_LDB
#undef PG8_MMA
#undef PG8_WAIT_V
#undef PG8_WAIT_L
#undef PG8_BAR
#undef PG8_SCHED
}
}

#define PG8_SP2 true
#define PG8_ALIGN true
__device__ __forceinline__ void st8(bf16_t* p, f32x4 a, f32x4 b) { u32x4 w; w.x = cvtpk(a[0], a[1]); w.y = cvtpk(a[2], a[3]); w.z = cvtpk(b[0], b[1]); w.w = cvtpk(b[2], b[3]); *(u32x4*)p = w; }
__device__ __forceinline__ void ld8(const bf16_t* p, f32x4& a, f32x4& b) { const u32x4 w = *(const u32x4*)p;
    a[0] = __uint_as_float(w.x << 16); a[1] = __uint_as_float(w.x & 0xffff0000u); a[2] = __uint_as_float(w.y << 16); a[3] = __uint_as_float(w.y & 0xffff0000u);
    b[0] = __uint_as_float(w.z << 16); b[1] = __uint_as_float(w.z & 0xffff0000u); b[2] = __uint_as_float(w.w << 16); b[3] = __uint_as_float(w.w & 0xffff0000u); }
struct EpiProj {
    static constexpr bool PERM = true, AFTER_DRAIN = false;
    unsigned char* ws; bf16_t* GATE; const float *qg, *kg, *bgate;
    __device__ __forceinline__ void operator()(const f32x4 (&acc)[2][2][4][2], const pg8::Unit& u, int wr, int wc, int fr, int fq) const {
        asm volatile("" : "+v"(fr), "+v"(fq));
        const int seg = u.pn >> 2;
        const int row0 = u.pm * 256 + wr * 64 + fr;
        const int cw = (u.pn & 3) * 256 + wc * 64 + 8 * fq;
        if (seg <= 1 || seg == 4) { bf16_t* dst = (bf16_t*)(ws + WS_U + (size_t)seg * (32 * MiB)) + cw;
#pragma unroll
            for (int ai = 0; ai < 2; ++ai)
#pragma unroll
                for (int m = 0; m < 4; ++m) { bf16_t* rp = dst + (size_t)(row0 + ai * 128 + m * 16) * DM;
#pragma unroll
                    for (int bj = 0; bj < 2; ++bj) st8(rp + 32 * bj, acc[ai][bj][m][0], acc[ai][bj][m][1]); }
        } else if (seg == 2 || seg == 3) { const float* g = (seg == 2 ? qg : kg) + 8 * fq; bf16_t* dst = (bf16_t*)(ws + WS_U + (size_t)seg * (32 * MiB)) + cw; const float sc = seg == 2 ? C2 : 1.f;
            f32x4 gv[2][2];
#pragma unroll
            for (int bj = 0; bj < 2; ++bj)
#pragma unroll
                for (int n = 0; n < 2; ++n) gv[bj][n] = *(const f32x4*)(g + 32 * bj + 4 * n) * sc;
#pragma unroll
            for (int ai = 0; ai < 2; ++ai)
#pragma unroll
                for (int m = 0; m < 4; ++m) { float ss = 0.f;
#pragma unroll
                    for (int bj = 0; bj < 2; ++bj)
#pragma unroll
                        for (int n = 0; n < 2; ++n) { const f32x4 a = acc[ai][bj][m][n]; ss += (a[0] * a[0] + a[1] * a[1]) + (a[2] * a[2] + a[3] * a[3]); }
                    ss += __shfl_xor(ss, 16); ss += __shfl_xor(ss, 32);
                    const float r = rsqrtf(ss * (1.f / 64.f) + EPS); bf16_t* rp = dst + (size_t)(row0 + ai * 128 + m * 16) * DM;
#pragma unroll
                    for (int bj = 0; bj < 2; ++bj) st8(rp + 32 * bj, (acc[ai][bj][m][0] * r) * gv[bj][0], (acc[ai][bj][m][1] * r) * gv[bj][1]); }
        } else { const int c = (u.pn - 20) * 256 + wc * 64 + 8 * fq; const float* bg = bgate + c;
#pragma unroll
            for (int bj = 0; bj < 2; ++bj) { const f32x4 b0 = *(const f32x4*)(bg + 32 * bj), b1 = *(const f32x4*)(bg + 32 * bj + 4);
#pragma unroll
                for (int ai = 0; ai < 2; ++ai)
#pragma unroll
                    for (int m = 0; m < 4; ++m) { f32x4 v0 = acc[ai][bj][m][0] + b0, v1 = acc[ai][bj][m][1] + b1;
#pragma unroll
                        for (int j = 0; j < 4; ++j) { v0[j] = __builtin_amdgcn_rcpf(1.f + __builtin_amdgcn_exp2f(-LOG2E * v0[j])); v1[j] = __builtin_amdgcn_rcpf(1.f + __builtin_amdgcn_exp2f(-LOG2E * v1[j])); }
                        st8(GATE + (size_t)(row0 + ai * 128 + m * 16) * 2048 + c + 32 * bj, v0, v1); } }
        }
    }
};

#define EPI_LOOP(...) _Pragma("unroll") for (int ai = 0; ai < 2; ++ai) _Pragma("unroll") for (int m = 0; m < 4; ++m) { const size_t row = (size_t)(u.pm * 256 + wr * 64 + fr + ai * 128 + m * 16); \
        _Pragma("unroll") for (int bj = 0; bj < 2; ++bj) { const int col = u.pn * 256 + bj * 128 + wc * 32 + 8 * fq; const f32x4 a0 = acc[ai][bj][m][0], a1 = acc[ai][bj][m][1]; __VA_ARGS__ } if (m & 1) asm volatile("" ::: "memory"); }
struct EpiGateT {
    static constexpr bool PERM = true, AFTER_DRAIN = false;
    const bf16_t* GATE; bf16_t* T;
    __device__ __forceinline__ void operator()(const f32x4 (&acc)[2][2][4][2], const pg8::Unit& u, int wr, int wc, int fr, int fq) const {
        asm volatile("" : "+v"(fr), "+v"(fq));
        EPI_LOOP( f32x4 g0, g1; ld8(GATE + row * 2048 + col, g0, g1); st8(T + row * DM + col, g0 * a0, g1 * a1); )
    }
};
struct EpiMerged {
    static constexpr bool PERM = true, AFTER_DRAIN = false;
    const bf16_t* GATE; const bf16_t* T; bf16_t* MG;
    __device__ __forceinline__ void operator()(const f32x4 (&acc)[2][2][4][2], const pg8::Unit& u, int wr, int wc, int fr, int fq) const {
        asm volatile("" : "+v"(fr), "+v"(fq));
        EPI_LOOP( f32x4 g0, g1, t0, t1; ld8(GATE + row * 2048 + 1024 + col, g0, g1); ld8(T + row * DM + col, t0, t1); st8(MG + row * DM + col, t0 + g0 * a0, t1 + g1 * a1); )
    }
};
struct EpiOut {
    static constexpr bool PERM = true, AFTER_DRAIN = false;
    const float* x; float* out; const float* g2; bf16_t* H2;
    __device__ __forceinline__ void operator()(const f32x4 (&acc)[2][2][4][2], const pg8::Unit& u, int wr, int wc, int fr, int fq) const {
        asm volatile("" : "+v"(fr), "+v"(fq));
        EPI_LOOP( const float* xp = x + row * DM + col; float* op = out + row * DM + col; const f32x4 x0 = *(const f32x4*)xp + a0, x1 = *(const f32x4*)(xp + 4) + a1; *(f32x4*)op = x0; *(f32x4*)(op + 4) = x1;
                  st8(H2 + row * DM + col, x0 * *(const f32x4*)(g2 + col), x1 * *(const f32x4*)(g2 + col + 4)); )
    }
};
struct EpiY {
    static constexpr bool PERM = true, AFTER_DRAIN = false;
    bf16_t* Y;
    __device__ __forceinline__ void operator()(const f32x4 (&acc)[2][2][4][2], const pg8::Unit& u, int wr, int wc, int fr, int fq) const {
        asm volatile("" : "+v"(fr), "+v"(fq));
        EPI_LOOP( st8(Y + row * DM + col, a0, a1); )
    }
};
struct EpiSwiglu {
    static constexpr bool PERM = true, AFTER_DRAIN = false;
    const float* roww; const float* rowrr; bf16_t* HID;
    __device__ __forceinline__ void operator()(const f32x4 (&acc)[2][2][4][2], const pg8::Unit& u, int wr, int wc, int fr, int fq) const {
        asm volatile("" : "+v"(fr), "+v"(fq));
#pragma unroll
        for (int ai = 0; ai < 2; ++ai)
#pragma unroll
            for (int m = 0; m < 4; ++m) { const int rl = wr * 64 + fr + ai * 128 + m * 16; const size_t row = (size_t)(u.pm * 256 + rl); const float w = rl < u.nvalid ? roww[u.rbase + rl] : 0.f, rr = rl < u.nvalid ? rowrr[u.rbase + rl] : 0.f;
                f32x4 hv[2];
#pragma unroll
                for (int n = 0; n < 2; ++n) { const f32x4 a1 = acc[ai][0][m][n] * rr, a3 = acc[ai][1][m][n] * rr;
#pragma unroll
                    for (int j = 0; j < 4; ++j) hv[n][j] = ((a1[j] * __builtin_amdgcn_rcpf(1.f + __builtin_amdgcn_exp2f(-LOG2E * a1[j]))) * a3[j]) * w; }
                st8(HID + row * DE + u.pn * 128 + wc * 32 + 8 * fq, hv[0], hv[1]); }
    }
};
__device__ __forceinline__ int expert_of_row(LAS int* offs, int row);
struct MoeOrder {
    LAS int* offs; int npn, G, c, lo, hi;
    __device__ __forceinline__ bool next(int i, pg8::Unit& u) const { const int L = lo + i * G + c; if (L >= hi || c < 0) return false;
        const int tile = L / npn, pn = L - tile * npn, e = expert_of_row(offs, tile * 256), lr0 = tile * 256 - offs[e], nv = offs[40 + e] - lr0;
        u.pm = tile; u.pn = pn; u.pb = e * npn + pn; u.rbase = e * ECAP + lr0; u.nvalid = nv < 256 ? nv : 256; return true; }
    __device__ __forceinline__ void a_ready(const pg8::Unit&) const {}
    __device__ __forceinline__ void done(const pg8::Unit&) const {}
};

__device__ __forceinline__ float attn_dmin_unit(const float* qg, const float* kg) {
    const int ln = threadIdx.x & 63; float a = fabsf(qg[ln]), b = fabsf(kg[ln]);
#pragma unroll
    for (int o = 1; o < 64; o <<= 1) { a = fmaxf(a, __shfl_xor(a, o)); b = fmaxf(b, __shfl_xor(b, o)); }
    return 2.02f * (8.f * a * b) + 106.f;
}
__device__ __forceinline__ int attn_jlo(float dmin1, int h, int qb) {
    const float dmin = dmin1 * exp2f((float)(h + 1)); const float lowk = (float)(qb * 128) - dmin;
    return lowk > 0.f ? ((int)lowk) >> 6 : 0;
}
__device__ __forceinline__ void tr_load(const float* W, int N, int item, int lane, float (&v)[32]) {
    const int nblk = N / 32, kb = item / nblk, nb = item % nblk, k0 = 64 * kb, n0 = 32 * nb;
    const float* wp = W + (size_t)(k0 + (lane >> 5)) * N + n0 + (lane & 31);
#pragma unroll
    for (int i = 0; i < 32; ++i) v[i] = wp[(size_t)(2 * i) * N];
}
template <class RM>
__device__ __forceinline__ void tr_store(const float (&v)[32], int N, bf16_t* WT, int ldt, int koff, RM rm, LAS float* scr, int item, int lane) {
    const int nblk = N / 32, kb = item / nblk, nb = item % nblk, k0 = 64 * kb, n0 = 32 * nb;
    { LAS float* sp = scr + (lane >> 5) * 33 + (lane & 31);
#pragma unroll
      for (int i = 0; i < 32; ++i) sp[2 * i * 33] = v[i]; }
    LDS_WAIT(); asm volatile("" ::: "memory");
    const int c = lane & 7;
#pragma unroll
    for (int j = 0; j < 4; ++j) { const int n = (lane >> 3) + 8 * j; const LAS float* s = scr + (8 * c) * 33 + n;
        u32x4 o; o.x = cvtpk(s[0 * 33], s[1 * 33]); o.y = cvtpk(s[2 * 33], s[3 * 33]); o.z = cvtpk(s[4 * 33], s[5 * 33]); o.w = cvtpk(s[6 * 33], s[7 * 33]);
        *(u32x4*)(WT + (size_t)rm(n0 + n) * ldt + koff + k0 + 8 * c) = o; }
    LDS_WAIT(); asm volatile("" ::: "memory");
}
template <class RM>
__device__ __forceinline__ void transpose_item(const float* W, int N, bf16_t* WT, int ldt, int koff, RM rm, LAS float* scr, int item, int lane) {
    float v[32]; tr_load(W, N, item, lane, v); tr_store(v, N, WT, ldt, koff, rm, scr, item, lane);
}
template <class RM>
__device__ __forceinline__ void transpose_block_item(const float* W, int N, int k0, int n0, bf16_t* WT, int ldt, int koff, RM rm, LAS unsigned char* lds, int tid) {
    const int w = tid >> 6, lane = tid & 63;
    f32x4 v[8];
#pragma unroll
    for (int r = 0; r < 8; ++r) v[r] = *(const f32x4*)(W + (size_t)(k0 + 8 * w + r) * N + n0 + 4 * lane);
#pragma unroll
    for (int c = 0; c < 4; ++c) { u32x4 o; o.x = cvtpk(v[0][c], v[1][c]); o.y = cvtpk(v[2][c], v[3][c]); o.z = cvtpk(v[4][c], v[5][c]); o.w = cvtpk(v[6][c], v[7][c]);
        *(LAS u32x4*)(lds + (4 * lane + c) * 144 + 16 * w) = o; }
    __syncthreads();
#pragma unroll
    for (int i = 0; i < 4; ++i) { const int q = tid + 512 * i, row = q >> 3, ch = q & 7;
        *(u32x4*)(WT + (size_t)rm(n0 + row) * ldt + koff + k0 + 8 * ch) = *(const LAS u32x4*)(lds + row * 144 + 16 * ch); }
    __syncthreads();
}
struct RmAdd { int off; __device__ __forceinline__ int operator()(int n) const { return off + n; } };
struct RmW13 { int off; __device__ __forceinline__ int operator()(int n) const { return off + (n >> 7) * 256 + (n & 127); } };

__device__ __forceinline__ void p0_prologue(Frame& F) {
    bf16_t* W1T = (bf16_t*)(F.ws + WS_W1T); bf16_t* WUPT = (bf16_t*)(F.ws + WS_WUPT); bf16_t* WOUTT = (bf16_t*)(F.ws + WS_WOUTT);
    { constexpr int I_A = 16 * 20, I_B = 16 * 8, I_C = 16 * 4; constexpr int NITEMS = I_A + I_B + 3 * I_C;
      for (int it = F.blk; it < NITEMS; it += F.G) { int r = it;
          if (r < I_A) { transpose_block_item(F.a->in[I_WIN], 5120, 64 * (r / 20), 256 * (r % 20), W1T, 1024, 0, RmAdd{0}, F.lds, F.tid); continue; } r -= I_A;
          if (r < I_B) { transpose_block_item(F.a->in[I_WGATE], 2048, 64 * (r / 8), 256 * (r % 8), W1T, 1024, 0, RmAdd{5120}, F.lds, F.tid); continue; } r -= I_B;
          if (r < I_C) { transpose_block_item(F.a->in[I_WUPA], 1024, 64 * (r / 4), 256 * (r % 4), WUPT, 1024, 0, RmAdd{0}, F.lds, F.tid); continue; } r -= I_C;
          if (r < I_C) { transpose_block_item(F.a->in[I_WUPB], 1024, 64 * (r / 4), 256 * (r % 4), WUPT, 1024, 0, RmAdd{1024}, F.lds, F.tid); continue; } r -= I_C;
          transpose_block_item(F.a->in[I_WOUT], 1024, 64 * (r / 4), 256 * (r % 4), WOUTT, 1024, 0, RmAdd{0}, F.lds, F.tid); } }
    { bf16_t* WST = (bf16_t*)(F.ws + WS_WST); const float* ws_ = F.a->in[I_WS];
      for (int i = F.blk * NTHREADS + F.tid; i < 8 * 128 * 128 / 2; i += F.G * NTHREADS) { const int e = 2 * i, s = e & 127, t = (e >> 7) & 127;
          const float a = (s <= t) ? ws_[e] : 0.f, b = (s + 1 <= t) ? ws_[e + 1] : 0.f; *(unsigned*)(WST + e) = cvtpk(a, b); } }
    { float* WRT = (float*)(F.ws + WS_ROUTE + RT_WRT); const float* g2 = F.a->in[I_N2G]; const float* wrg = F.a->in[I_WRG]; const float* wre = F.a->in[I_WRE];
      for (int i = F.blk * NTHREADS + F.tid; i < 48 * 1024; i += F.G * NTHREADS) { const int j = i >> 10, k = i & 1023;
          const float w = j < 4 ? wrg[k * 4 + j] : (j < 36 ? wre[k * 32 + (j - 4)] : 0.f); WRT[i] = g2[k] * w; } }
    if (F.blk == 0) { LAS int* hist = (LAS int*)(F.lds + 136 * 1024); LAS int* gt = hist + 160;
        for (int i = F.tid; i < 320; i += NTHREADS) hist[i] = 0;
        __syncthreads();
        const float dmin1 = attn_dmin_unit(F.a->in[I_QNG], F.a->in[I_KNG]);
        int w[2], jl[2];
#pragma unroll
        for (int q = 0; q < 2; ++q) { const int u = F.tid + q * NTHREADS, qb = u >> 4; jl[q] = attn_jlo(dmin1, u & 7, qb); w[q] = 2 * qb + 2 - jl[q]; atomicAdd((int*)(hist + w[q]), 1); }
        __syncthreads();
        if (F.tid < 64) { int h0 = 0, h1 = 0, h2 = 0; const int i0 = 3 * F.tid;
            if (i0 < 160) h0 = hist[i0]; if (i0 + 1 < 160) h1 = hist[i0 + 1]; if (i0 + 2 < 160) h2 = hist[i0 + 2];
            const int tot = h0 + h1 + h2; int suf = tot;
#pragma unroll
            for (int o = 1; o < 64; o <<= 1) { const int vv = __shfl_down(suf, o); if (F.tid + o < 64) suf += vv; }
            const int above = suf - tot;
            if (i0 + 2 < 160) gt[i0 + 2] = above; if (i0 + 1 < 160) gt[i0 + 1] = above + h2; if (i0 < 160) gt[i0] = above + h2 + h1; }
        __syncthreads();
#pragma unroll
        for (int q = 0; q < 2; ++q) { const int u = F.tid + q * NTHREADS; const int rank = atomicAdd((int*)(gt + w[q]), 1);
            ((int*)(F.ws + WS_ROUTE + RT_ALIST))[rank] = u | (jl[q] << 16); }
        __syncthreads(); }
    { bf16_t* XN = (bf16_t*)(F.ws + WS_XN); const float* x = F.a->in[I_X]; const f32x4* g4 = (const f32x4*)F.a->in[I_N1G] + F.lane;
      for (int m0 = F.gw * 4; m0 < M; m0 += F.NGW * 4) { f32x4 v[4][4];
#pragma unroll
          for (int q = 0; q < 4; ++q) { const f32x4* xr = (const f32x4*)(x + (size_t)(m0 + q) * DM) + F.lane;
#pragma unroll
              for (int j = 0; j < 4; ++j) v[q][j] = xr[64 * j]; }
#pragma unroll
          for (int q = 0; q < 4; ++q) { float s = 0.f;
#pragma unroll
              for (int j = 0; j < 4; ++j) s += (v[q][j][0] * v[q][j][0] + v[q][j][1] * v[q][j][1]) + (v[q][j][2] * v[q][j][2] + v[q][j][3] * v[q][j][3]);
              const float r = rsqrtf(wave_sum(s) * (1.f / DM) + EPS);
#pragma unroll
              for (int j = 0; j < 4; ++j) { const f32x4 g = g4[64 * j]; st4(XN + (size_t)(m0 + q) * DM + 4 * F.lane + 256 * j, (v[q][j] * r) * g); } } } }
}

__device__ __forceinline__ void p1_proj(Frame& F) {
    pg8::Gemm g{(const bf16_t*)(F.ws + WS_XN), (const bf16_t*)(F.ws + WS_W1T), DM, nullptr};
    pg8::StaticOrder S; S.init(M, N1, F.G, F.blk);
    static_assert(WS_VA == WS_U + 32 * MiB && WS_Q == WS_U + 64 * MiB && WS_K == WS_U + 96 * MiB && WS_VB == WS_U + 128 * MiB, "EpiProj layout");
    EpiProj E{F.ws, (bf16_t*)F.out, F.a->in[I_QNG], F.a->in[I_KNG], F.a->in[I_BGATE]};
    pg8::gemm_phase<EpiProj, pg8::StaticOrder, PG8_ALIGN, PG8_SP2, true>(F.lds, g, S, E);
}

__device__ __forceinline__ void p2_mixer_a(Frame& F) {
    const bf16_t* VA = (const bf16_t*)(F.ws + WS_VA); const bf16_t* U = (const bf16_t*)(F.ws + WS_U); bf16_t* YA = (bf16_t*)(F.ws + WS_YA); const bf16_t* WST = (const bf16_t*)(F.ws + WS_WST);
    const float* gv = F.a->in[I_VNG]; const float* bs = F.a->in[I_BS];
    bf16_t* vT = (bf16_t*)F.ldsg;
    bf16_t* wS = (bf16_t*)(F.ldsg + 128 * 136 * 2);
    const int fr = F.lane & 15, fq = F.lane >> 4, wm = F.wid >> 1, wn = F.wid & 1;
    const int s_ = F.tid >> 2, ds = (F.tid & 3) * 32;
    int gstaged = -1;
    bf16x8 v[4];
    if (F.blk < 1024) { const int c = F.blk >> 3, g = F.blk & 7; const bf16_t* src = VA + (size_t)(c * 128 + s_) * DM + g * 128 + ds;
#pragma unroll
        for (int i = 0; i < 4; ++i) v[i] = *(const bf16x8*)(src + 8 * i); }
    for (int L = F.blk; L < 1024; L += F.G) {
        const int c = L >> 3, g = L & 7;
        if (g != gstaged) { __syncthreads();
#pragma unroll
            for (int i = 0; i < 4; ++i) { const int q = F.tid + 512 * i, t = q >> 4, ch = q & 15; *(bf16x8*)(wS + t * 136 + 8 * ch) = *(const bf16x8*)(WST + g * 16384 + t * 128 + 8 * ch); }
            gstaged = g; }
        { float ss = 0.f;
#pragma unroll
          for (int i = 0; i < 4; ++i)
#pragma unroll
              for (int j = 0; j < 8; ++j) { const float x = bf2f(v[i][j]); ss += x * x; }
          ss += __shfl_xor(ss, 1); ss += __shfl_xor(ss, 2);
          const float r = rsqrtf(ss * (1.f / 128.f) + EPS);
#pragma unroll
          for (int i = 0; i < 4; ++i)
#pragma unroll
              for (int j = 0; j < 8; ++j) { const int d = ds + 8 * i + j; const float x = (bf2f(v[i][j]) * r) * gv[g * 128 + d]; vT[d * 136 + s_] = (bf16_t)(cvtpk(x, 0.f) & 0xffffu); } }
        __syncthreads();
        const int Ln = L + F.G;
        if (Ln < 1024) { const bf16_t* src = VA + (size_t)((Ln >> 3) * 128 + s_) * DM + (Ln & 7) * 128 + ds;
#pragma unroll
            for (int i = 0; i < 4; ++i) v[i] = *(const bf16x8*)(src + 8 * i); }
        f32x4 uu[2][4]; float bb[2];
#pragma unroll
        for (int m = 0; m < 2; ++m) { const int t = 32 * wm + 16 * m + fr; bb[m] = bs[g * 128 + t]; const bf16_t* up = U + (size_t)(c * 128 + t) * DM + g * 128 + 64 * wn + 4 * fq;
#pragma unroll
            for (int n = 0; n < 4; ++n) uu[m][n] = ld4(up + 16 * n); }
        const bf16_t* ap = wS + (32 * wm + fr) * 136 + 8 * fq; const bf16_t* bp = vT + (64 * wn + fr) * 136 + 8 * fq;
        f32x4 acc[2][4]; acc_zero(acc);
        wave_gemm(acc, ap, ap + 16 * 136, bp, bp + 16 * 136, bp + 32 * 136, bp + 48 * 136, 32 * (wm + 1));
#pragma unroll
        for (int m = 0; m < 2; ++m) { const int t = 32 * wm + 16 * m + fr; bf16_t* yp = YA + (size_t)(c * 128 + t) * DM + g * 128 + 64 * wn + 4 * fq;
#pragma unroll
            for (int n = 0; n < 4; ++n) st4(yp + 16 * n, uu[m][n] * (acc[m][n] + bb[m])); }
        __syncthreads();
    }
}

namespace att {
constexpr int QBLK = 32, KVBLK = 64, QB = 128, PITCH = 1024;
constexpr int SHM_V = KVBLK * 128 * 2, SHM_K = 2 * KVBLK * 64 * 2;
constexpr int LDS_WSF = 2 * SHM_V + 2 * SHM_K, LDS_XCH = LDS_WSF + NWAVES * 64 * 4, LDS_BYTES = LDS_XCH + 4 * 16 * 4 * 64 * 4;
constexpr float THR2 = 8.f * LOG2E;
#define KSWZ64(row, colB) ((row) * 128 + ((colB) ^ ((((row) >> 1) & 7) << 4)))
__device__ __forceinline__ int v_st(int k, int c) { const int kk = (k & ~0xC) | ((k & 4) << 1) | ((k & 8) >> 1); return ((kk >> 3) * 4 + (c >> 5)) * 512 + ((kk & 7) * 32 + (c & 31)) * 2; }
__device__ __forceinline__ int v_rd_base(int lane) { return ((lane & 3) << 3) | (((lane >> 2) & 3) << 6) | (((lane >> 4) & 1) << 5) | (((lane >> 5) & 1) << 8); }
constexpr int v_rd_off(int d0, int ks, int half) { return d0 * 512 + ks * 4096 + half * 2048; }
__device__ __forceinline__ int crow(int r, int hi) { return (r & 3) + 8 * (r >> 2) + 4 * hi; }

__device__ __forceinline__ void mask_tile(f32x16& p0, f32x16& p1, int dq) {
    const float NEG = -__builtin_inff();
#pragma unroll
    for (int r = 0; r < 16; ++r) { const int c = (r & 3) + 8 * (r >> 2);
        if (dq - c < 0) p0[r] = NEG;
        if (dq - c - 32 < 0) p1[r] = NEG; }
}
__device__ __forceinline__ void partialSM(f32x16& p0, f32x16& p1, float& m_reg, float& alpha) {
    float pmax = __builtin_fmaxf(__builtin_fmaxf(p0[0], p0[1]), p0[2]);
#pragma unroll
    for (int r = 3; r < 15; r += 2) pmax = __builtin_fmaxf(__builtin_fmaxf(pmax, p0[r]), p0[r + 1]);
    pmax = __builtin_fmaxf(__builtin_fmaxf(pmax, p0[15]), p1[0]);
#pragma unroll
    for (int r = 1; r < 15; r += 2) pmax = __builtin_fmaxf(__builtin_fmaxf(pmax, p1[r]), p1[r + 1]);
    pmax = __builtin_fmaxf(pmax, p1[15]);
    { auto rr = __builtin_amdgcn_permlane32_swap(__float_as_uint(pmax), __float_as_uint(pmax), false, false);
      pmax = fmaxf(__uint_as_float(rr[0]), __uint_as_float(rr[1])); }
    alpha = 1.f;
    if (__builtin_expect(!__all(pmax <= THR2), 0)) { asm volatile("" ::: "memory");
        const float d = fmaxf(pmax, 0.f); m_reg += d; alpha = __builtin_amdgcn_exp2f(-d);
#pragma unroll
        for (int r = 0; r < 16; ++r) { p0[r] -= d; p1[r] -= d; } }
#pragma unroll
    for (int r = 0; r < 16; ++r) p0[r] = __builtin_amdgcn_exp2f(p0[r]);
}
__device__ __forceinline__ void finishSM(f32x16& p0, f32x16& p1, float alpha, float& l_reg, bf16x8& pa0, bf16x8& pa1, bf16x8& pa2, bf16x8& pa3) {
#pragma unroll
    for (int r = 0; r < 16; ++r) p1[r] = __builtin_amdgcn_exp2f(p1[r]);
    float ps = 0;
#pragma unroll
    for (int r = 0; r < 16; ++r) ps += p0[r];
#pragma unroll
    for (int r = 0; r < 16; ++r) ps += p1[r];
    { auto rr = __builtin_amdgcn_permlane32_swap(__float_as_uint(ps), __float_as_uint(ps), false, false);
      ps = __uint_as_float(rr[0]) + __uint_as_float(rr[1]); }
    l_reg = l_reg * alpha + ps;
#define PK4(P, B_, OUT) do { unsigned a0 = cvtpk(P[B_+0], P[B_+1]), a1 = cvtpk(P[B_+2], P[B_+3]);                          \
        unsigned b0 = cvtpk(P[B_+4], P[B_+5]), b1 = cvtpk(P[B_+6], P[B_+7]);                                             \
        auto r0 = __builtin_amdgcn_permlane32_swap(a0, b0, false, false); auto r1 = __builtin_amdgcn_permlane32_swap(a1, b1, false, false); \
        u32x4 w = {r0[0], r1[0], r0[1], r1[1]}; OUT = __builtin_bit_cast(bf16x8, w); } while (0)
    PK4(p0, 0, pa0); PK4(p0, 8, pa1); PK4(p1, 0, pa2); PK4(p1, 8, pa3);
#undef PK4
}
template <int KB>
__device__ __forceinline__ void qkt(f32x16& p0, f32x16& p1, const char* Kmap_lds, int r32, int hi, const bf16x8* qr, bf16x8 kx0, bf16x8 kx1, bf16x8 qx) {
    p0 = __builtin_amdgcn_mfma_f32_32x32x16_bf16(kx0, qx, f32x16{}, 0, 0, 0); p1 = __builtin_amdgcn_mfma_f32_32x32x16_bf16(kx1, qx, f32x16{}, 0, 0, 0);
#pragma unroll
    for (int d0 = 0; d0 < 4; ++d0) { const char* a = Kmap_lds + KB * SHM_K + KSWZ64(r32, (d0 * 16 + hi * 8) * 2);
        const bf16x8 b0 = *reinterpret_cast<const bf16x8*>(a);
        const bf16x8 b1 = *reinterpret_cast<const bf16x8*>(a + 32 * 128);
        p0 = __builtin_amdgcn_mfma_f32_32x32x16_bf16(b0, qr[d0], p0, 0, 0, 0);
        p1 = __builtin_amdgcn_mfma_f32_32x32x16_bf16(b1, qr[d0], p1, 0, 0, 0); }
}
template <int VB>
__device__ __forceinline__ void pv_tile(f32x16* o, int vb0, bf16x8 pa0, bf16x8 pa1, bf16x8 pa2, bf16x8 pa3) {
#define TRRD(dst, off) asm volatile("ds_read_b64_tr_b16 %0, %1 offset:%2" : "=&v"(dst) : "v"(vb0), "i"(off) : "memory")
#define PV_D0(d0) do { s16x4 l0, l1, l2, l3, h0, h1, h2, h3; constexpr int b_ = VB * SHM_V + v_rd_off(d0, 0, 0); \
        TRRD(l0, b_); TRRD(h0, b_ + 2048); TRRD(l1, b_ + 4096); TRRD(h1, b_ + 6144); TRRD(l2, b_ + 8192); TRRD(h2, b_ + 10240); TRRD(l3, b_ + 12288); TRRD(h3, b_ + 14336); \
        asm volatile("s_waitcnt lgkmcnt(0)" ::: "memory"); SBAR();   \
        o[d0] = __builtin_amdgcn_mfma_f32_32x32x16_bf16(pa0, (bf16x8){l0[0], l0[1], l0[2], l0[3], h0[0], h0[1], h0[2], h0[3]}, o[d0], 0, 0, 0);   \
        o[d0] = __builtin_amdgcn_mfma_f32_32x32x16_bf16(pa1, (bf16x8){l1[0], l1[1], l1[2], l1[3], h1[0], h1[1], h1[2], h1[3]}, o[d0], 0, 0, 0);   \
        o[d0] = __builtin_amdgcn_mfma_f32_32x32x16_bf16(pa2, (bf16x8){l2[0], l2[1], l2[2], l2[3], h2[0], h2[1], h2[2], h2[3]}, o[d0], 0, 0, 0);   \
        o[d0] = __builtin_amdgcn_mfma_f32_32x32x16_bf16(pa3, (bf16x8){l3[0], l3[1], l3[2], l3[3], h3[0], h3[1], h3[2], h3[3]}, o[d0], 0, 0, 0); } while (0)
    PV_D0(0); PV_D0(1); PV_D0(2); PV_D0(3);
#undef PV_D0
#undef TRRD
}

__device__ __forceinline__ bf16x8 qx_of(unsigned sdw, float x) {
    const unsigned h_ = cvtpk(x, 0.f) & 0xffffu; const float r1 = x - __uint_as_float(h_ << 16);
    const unsigned m_ = cvtpk(r1, 0.f) & 0xffffu; const float r2 = r1 - __uint_as_float(m_ << 16);
    return __builtin_bit_cast(bf16x8, (u32x4){sdw, h_ | (m_ << 16), cvtpk(r2, 0.f) & 0xffffu, 0u});
}
struct BlockRef { int base; int P0; int jlo; float slope2; };
#define BR_Q(br) ((const bf16_t*)(wsb + WS_Q) + (br).base)
#define BR_K(br) ((const bf16_t*)(wsb + WS_K) + (br).base)
#define BR_V(br) ((const bf16_t*)(wsb + WS_VB) + (br).base)
#define BR_O(br) ((bf16_t*)(wsb + WS_XN) + (br).base)
struct Seam { bf16x8 qr[4]; bf16x8 st_v0, st_v1, st_k0, st_k1; };
#define VMW() asm volatile("s_waitcnt vmcnt(0)" ::: "memory")
#define VMWN(n) asm volatile("s_waitcnt vmcnt(%0)" :: "i"(n) : "memory")
#define BLD(soff) __builtin_bit_cast(bf16x8, __builtin_amdgcn_raw_buffer_load_b128(rsrc, voff, (int)(soff), 0))
#define SLOAD_H(br, k0) do { const unsigned so_ = (unsigned)((br).base + (k0) * PITCH) * 2u;                                  \
                         S.st_v0 = BLD((unsigned)WS_VB + so_); S.st_v1 = BLD((unsigned)WS_VB + so_ + 32u * PITCH * 2u);              \
                         S.st_k0 = BLD((unsigned)WS_K + so_); S.st_k1 = BLD((unsigned)WS_K + so_ + 32u * PITCH * 2u); } while (0)
#define SWRITE_HK(bf) do { *(bf16x8*)(K_lds + (bf) * SHM_K + kws) = S.st_k0; *(bf16x8*)(K_lds + (bf) * SHM_K + kws + 32 * 128) = S.st_k1; } while (0)
#define SWRITE_HV(bf) do { *(bf16x8*)(V_lds + (bf) * SHM_V + vst0) = S.st_v0; *(bf16x8*)(V_lds + (bf) * SHM_V + vst1) = S.st_v1; } while (0)
#define SWRITE_H(bf) do { SWRITE_HV(bf); SWRITE_HK(bf); } while (0)
__device__ __forceinline__ void attn_prime(const unsigned char* wsb, const BlockRef& cur, char* lds, Seam& S) {
    const int tid = threadIdx.x, wid = __builtin_amdgcn_readfirstlane(tid >> 6), lane = tid & 63, r32 = lane & 31, hi = lane >> 5;
    const int map = wid >> 2, rw = wid & 3;
    const int sr = tid >> 4, sc = (tid & 15) * 8, kws = (sc >> 6) * 8192 + KSWZ64(sr, (sc & 63) * 2); char* K_lds = lds + 2 * SHM_V;
    const int voff = (sr * PITCH + sc) * 2; const __amdgpu_buffer_rsrc_t rsrc = __builtin_amdgcn_make_buffer_rsrc((void*)wsb, 0, 0x10000000, 0x00020000);
    const int kb0 = cur.jlo * KVBLK;
#pragma unroll
    for (int d0 = 0; d0 < 4; ++d0) S.qr[d0] = *(const bf16x8*)(BR_Q(cur) + (size_t)(cur.P0 + rw * QBLK + r32) * PITCH + map * 64 + d0 * 16 + hi * 8);
    SLOAD_H(cur, kb0); VMW(); SWRITE_HK(0);
    __syncthreads();
}
__device__ __forceinline__ void attn_block(unsigned char* wsb, const BlockRef& cur, const BlockRef& nxt, char* lds, Seam& S, float lam, const float* subg) {
    const int tid = threadIdx.x, wid = __builtin_amdgcn_readfirstlane(tid >> 6), lane = tid & 63, r32 = lane & 31, hi = lane >> 5;
    const int map = wid >> 2, rw = wid & 3;
    const int j_lo = cur.jlo, j_hi = cur.P0 / KVBLK + 2, NT = j_hi - j_lo;
    const int kbn = nxt.jlo * KVBLK;
    const int qlo = cur.P0 + rw * QBLK, qm = qlo + r32 - 4 * hi;
    const float slope2 = cur.slope2; const int qpos = qlo + r32;
    unsigned sdw; { const unsigned h_ = cvtpk(slope2, 0.f) & 0xffffu; const float lo_ = slope2 - __uint_as_float(h_ << 16); sdw = h_ | (cvtpk(lo_, 0.f) << 16); }
    bf16x8 kx0, kx1; { const unsigned c0 = cvtpk((float)r32, (float)r32), c1 = cvtpk((float)(r32 + 32), (float)(r32 + 32)), one = hi ? 0u : 0x3f803f80u;
        kx0 = __builtin_bit_cast(bf16x8, (u32x4){hi ? 0u : c0, one, one & 0xffffu, 0u}); kx1 = __builtin_bit_cast(bf16x8, (u32x4){hi ? 0u : c1, one, one & 0xffffu, 0u}); }
    char* V_lds = lds; char* K_lds = lds + 2 * SHM_V; const char* Kmap = K_lds + map * 8192;
    float* ws = (float*)(lds + LDS_WSF) + wid * 64; float* li_l = ws, * al_l = ws + 32;
    float m_reg = 0.f, l_reg = 0; f32x16 o[4] = {};
    const int sr = tid >> 4, sc = (tid & 15) * 8, vst0 = v_st(sr, sc), vst1 = v_st(32 + sr, sc), kws = (sc >> 6) * 8192 + KSWZ64(sr, (sc & 63) * 2);
    const int vb0 = (int)(uintptr_t)V_lds + v_rd_base(lane);
    const int voff = (sr * PITCH + sc) * 2; const __amdgpu_buffer_rsrc_t rsrc = __builtin_amdgcn_make_buffer_rsrc((void*)wsb, 0, 0x10000000, 0x00020000);
#define RESC(a) do { if (__any((a) < 1.f)) { if (hi == 0) al_l[r32] = (a); asm volatile("s_waitcnt lgkmcnt(0)" ::: "memory");              \
                     _Pragma("unroll") for (int d_ = 0; d_ < 4; ++d_) _Pragma("unroll") for (int r = 0; r < 16; ++r) o[d_][r] *= al_l[crow(r, hi)]; } } while (0)
#define KBASE(t) ((j_lo + (t)) * KVBLK)
#define MASKT(P0_, P1_, t) do { const int kb_ = KBASE(t); if (kb_ + KVBLK - 1 > qlo) { asm volatile("" ::: "memory"); mask_tile(P0_, P1_, qm - kb_); } } while (0)
#define QX(t) qx_of(sdw, slope2 * (float)(KBASE(t) - qpos) - m_reg)
#define SEAM_K0() do { VMWN(4); SWRITE_HK(0); SBAR(); } while (0)
    f32x16 pA0, pA1, pB0, pB1; float alA, alB; bf16x8 pa0, pa1, pa2, pa3;
    SWRITE_HV(0); SBAR();
    if (NT > 1) { SLOAD_H(cur, KBASE(1)); }
    SBAR(); qkt<0>(pA0, pA1, Kmap, r32, hi, S.qr, kx0, kx1, QX(0));
    MASKT(pA0, pA1, 0); partialSM(pA0, pA1, m_reg, alA);
    if (NT > 1) { VMW(); SWRITE_H(1); }
    __syncthreads();
#define HALF_STEP(PX0, PX1, alX, PY0, PY1, alY, t, KB, VB, SB) do {                                                      \
        SBAR(); qkt<KB>(PX0, PX1, Kmap, r32, hi, S.qr, kx0, kx1, QX(t));                                                           \
        finishSM(PY0, PY1, alY, l_reg, pa0, pa1, pa2, pa3); SBAR();                                                           \
        if ((t) + 1 < NT) { SLOAD_H(cur, KBASE((t) + 1)); SBAR(); }                                               \
        pv_tile<VB>(o, vb0, pa0, pa1, pa2, pa3); MASKT(PX0, PX1, (t)); partialSM(PX0, PX1, m_reg, alX);                                        \
        __syncthreads();                                                                                                      \
        if ((t) + 1 < NT) { VMW(); SWRITE_H(SB); }                                                                          \
        RESC(alX); __syncthreads(); } while (0)
    for (int t = 1; t + 1 < NT; t += 2) {
        HALF_STEP(pB0, pB1, alB, pA0, pA1, alA, t, 1, 0, 0);
        HALF_STEP(pA0, pA1, alA, pB0, pB1, alB, t + 1, 0, 1, 1);
    }
    const bool even = (NT & 1) == 0;
    if (even) { SBAR(); qkt<1>(pB0, pB1, Kmap, r32, hi, S.qr, kx0, kx1, QX(NT - 1)); SBAR(); }
    { const int nmap = map, nrw = rw;
      SLOAD_H(nxt, kbn); SBAR();
#pragma unroll
      for (int d0 = 0; d0 < 4; ++d0) S.qr[d0] = *(const bf16x8*)(BR_Q(nxt) + (size_t)(nxt.P0 + nrw * QBLK + r32) * PITCH + nmap * 64 + d0 * 16 + hi * 8); }
    SBAR();
    finishSM(pA0, pA1, alA, l_reg, pa0, pa1, pa2, pa3); SBAR();
    pv_tile<0>(o, vb0, pa0, pa1, pa2, pa3);
    if (even) { MASKT(pB0, pB1, NT - 1); partialSM(pB0, pB1, m_reg, alB); __syncthreads(); RESC(alB);
        finishSM(pB0, pB1, alB, l_reg, pa0, pa1, pa2, pa3); SBAR(); pv_tile<1>(o, vb0, pa0, pa1, pa2, pa3); }
    SBAR(); SEAM_K0();
    if (hi == 0) li_l[r32] = l_reg; asm volatile("s_waitcnt lgkmcnt(0)" ::: "memory");
    float rli[16];
#pragma unroll
    for (int r = 0; r < 16; ++r) rli[r] = __builtin_amdgcn_rcpf(li_l[crow(r, hi)]);
    float* xch = (float*)(lds + LDS_XCH) + (size_t)rw * (16 * 4 * 64) + lane;
    if (map == 1) {
#pragma unroll
        for (int r = 0; r < 16; ++r)
#pragma unroll
            for (int d0 = 0; d0 < 4; ++d0) xch[(r * 4 + d0) * 64] = o[d0][r] * rli[r];
    }
    __syncthreads();
    if (map == 0) {
        float gsub[4];
#pragma unroll
        for (int d0 = 0; d0 < 4; ++d0) gsub[d0] = subg[d0 * 32 + r32] * (1.f - LAM_INIT);
        int obase = (cur.P0 + rw * QBLK + 4 * hi) * PITCH + r32; asm volatile("" : "+v"(obase));
        bf16_t* Ow = BR_O(cur) + obase;
#pragma unroll
        for (int r = 0; r < 16; ++r) { float d[4]; float ss = 0.f;
#pragma unroll
            for (int d0 = 0; d0 < 4; ++d0) { d[d0] = o[d0][r] * rli[r] - lam * xch[(r * 4 + d0) * 64]; ss += d[d0] * d[d0]; }
            ss += __shfl_xor(ss, 1); ss += __shfl_xor(ss, 2); ss += __shfl_xor(ss, 4); ss += __shfl_xor(ss, 8); ss += __shfl_xor(ss, 16);
            const float rs = rsqrtf(ss * (1.f / 128.f) + EPS); const int orow = (r & 3) + 8 * (r >> 2);
#pragma unroll
            for (int d0 = 0; d0 < 4; ++d0) { const float v = (d[d0] * rs) * gsub[d0]; const float vn = __shfl_xor(v, 1);
                if ((r32 & 1) == 0) *(unsigned*)(Ow + orow * PITCH + d0 * 32) = cvtpk(v, vn); } }
    }
    __syncthreads();
#undef RESC
#undef KBASE
#undef MASKT
#undef QX
#undef SEAM_K0
#undef HALF_STEP
}
#undef BLD
#undef BR_Q
#undef BR_K
#undef BR_V
#undef BR_O
#undef VMW
#undef VMWN
#undef SLOAD_H
#undef SWRITE_HK
#undef SWRITE_HV
#undef SWRITE_H
}


__device__ __forceinline__ att::BlockRef attn_ref(Frame& F, int L) {
    const int ent = ((const int*)(F.ws + WS_ROUTE + RT_ALIST))[L]; const int u = ent & 0xffff, qb = u >> 4, bh = u & 15, b = bh >> 3, h = bh & 7;
    att::BlockRef r; r.base = b * SEQ * 1024 + h * 128;
    r.P0 = qb * 128; r.jlo = ent >> 16; r.slope2 = exp2f(-(float)(h + 1)) * LOG2E;
    return r;
}
__device__ __forceinline__ void p2_attention(Frame& F) {
    const float s1 = wave_sum(F.a->in[I_LQ1][F.lane] * F.a->in[I_LK1][F.lane]), s2 = wave_sum(F.a->in[I_LQ2][F.lane] * F.a->in[I_LK2][F.lane]);
    const float lam = expf(s1) - expf(s2) + LAM_INIT;
    constexpr int NUNITS = 1024;
    volatile LAS int* qs = (volatile LAS int*)(F.lds + 143 * 1024);
    __syncthreads();
    const int v = (F.G % 8 == 0) ? (F.blk % 8) * (F.G / 8) + F.blk / 8 : F.blk;
    int L = v, Ln = 2 * F.G - 1 - v;
    if (L >= NUNITS) return;
    att::BlockRef cur = attn_ref(F, L); att::Seam S;
    att::attn_prime(F.ws, cur, F.ldsg, S);
    for (;;) {
        const bool last = Ln >= NUNITS;
        int nn = 0; if (F.tid == 0 && !last) nn = 2 * F.G + (int)atomicAdd(F.ctl + CW_AQ, 1u);
        const att::BlockRef nxt = last ? cur : attn_ref(F, Ln);
        att::attn_block(F.ws, cur, nxt, F.ldsg, S, lam, F.a->in[I_SUBG]);
        if (last) break;
        if (F.tid == 0) qs[0] = nn;
        __syncthreads();
        cur = nxt; Ln = qs[0];
        __syncthreads();
    }
}

__device__ __forceinline__ void p3_merged(Frame& F) {
    pg8::StaticOrder S; S.init(M, DM, F.G, F.blk);
    { pg8::Gemm g{(const bf16_t*)(F.ws + WS_YA), (const bf16_t*)(F.ws + WS_WUPT), DM, nullptr}; EpiGateT E{(const bf16_t*)F.out, (bf16_t*)(F.ws + WS_T)};
      pg8::gemm_phase<EpiGateT, pg8::StaticOrder, PG8_ALIGN, PG8_SP2, false>(F.lds, g, S, E); }
    { pg8::Gemm g{(const bf16_t*)(F.ws + WS_XN), (const bf16_t*)(F.ws + WS_WUPT) + 1024 * 1024, DM, nullptr}; EpiMerged E{(const bf16_t*)F.out, (const bf16_t*)(F.ws + WS_T), (bf16_t*)(F.ws + WS_Q)};
      pg8::gemm_phase<EpiMerged, pg8::StaticOrder, PG8_ALIGN, PG8_SP2, false>(F.lds, g, S, E); }
}
__device__ __forceinline__ void p4_out(Frame& F) {
    pg8::StaticOrder S; S.init(M, DM, F.G, F.blk);
    pg8::Gemm g{(const bf16_t*)(F.ws + WS_Q), (const bf16_t*)(F.ws + WS_WOUTT), DM, nullptr}; EpiOut E{F.a->in[I_X], F.out, F.a->in[I_N2G], (bf16_t*)(F.ws + WS_H2)};
    pg8::gemm_phase<EpiOut, pg8::StaticOrder, PG8_ALIGN, PG8_SP2, false>(F.lds, g, S, E);
}
__device__ __forceinline__ void h2_row(Frame& F, int t, f32x4 (&h)[4]) {
    const f32x4* xr = (const f32x4*)(F.out + (size_t)t * DM) + F.lane; const f32x4* g4 = (const f32x4*)F.a->in[I_N2G] + F.lane;
    float s = 0.f;
#pragma unroll
    for (int j = 0; j < 4; ++j) { h[j] = xr[64 * j]; s += (h[j][0] * h[j][0] + h[j][1] * h[j][1]) + (h[j][2] * h[j][2] + h[j][3] * h[j][3]); }
    const float r = rsqrtf(wave_sum(s) * (1.f / DM) + EPS);
#pragma unroll
    for (int j = 0; j < 4; ++j) h[j] = (h[j] * r) * g4[64 * j];
}
__device__ __forceinline__ void p5_router(Frame& F) {
    const float* WRT = (const float*)(F.ws + WS_ROUTE + RT_WRT); const float* brg = F.a->in[I_BRG]; const float* bre = F.a->in[I_BRE];
    int* tokpos = (int*)(F.ws + WS_ROUTE + RT_TOKPOS); float* roww = (float*)(F.ws + WS_ROUTE + RT_ROWW); float* rowrr = (float*)(F.ws + WS_ROUTE + RT_ROWRR); int* rowtok = (int*)(F.ws + WS_ROUTE + RT_ROWTOK);
    LAS float* lg = (LAS float*)(F.lds + 128 * 1024 + (F.wid & 3) * 3072);
    const int i16 = F.lane & 15, kq = F.lane >> 4;
    if (F.wid < 4)
    for (int task = F.blk * 4 + F.wid; task < M / 16; task += F.G * 4) { const int t0 = task * 16;
        const float* xp = F.out + (size_t)(t0 + i16) * DM + 4 * kq; const float* wp = WRT + (size_t)i16 * DM + 4 * kq;
        f32x4 acc0 = {0.f, 0.f, 0.f, 0.f}, acc1 = acc0, acc2 = acc0; float ss = 0.f;
#pragma unroll 4
        for (int s = 0; s < 64; ++s) { const f32x4 xa = *(const f32x4*)(xp + 16 * s);
            const f32x4 w0 = *(const f32x4*)(wp + 16 * s), w1 = *(const f32x4*)(wp + 16 * DM + 16 * s), w2 = *(const f32x4*)(wp + 32 * DM + 16 * s);
            ss += (xa[0] * xa[0] + xa[1] * xa[1]) + (xa[2] * xa[2] + xa[3] * xa[3]);
#pragma unroll
            for (int e = 0; e < 4; ++e) { acc0 = __builtin_amdgcn_mfma_f32_16x16x4f32(xa[e], w0[e], acc0, 0, 0, 0); acc1 = __builtin_amdgcn_mfma_f32_16x16x4f32(xa[e], w1[e], acc1, 0, 0, 0);
                acc2 = __builtin_amdgcn_mfma_f32_16x16x4f32(xa[e], w2[e], acc2, 0, 0, 0); } }
        ss += __shfl_xor(ss, 16); ss += __shfl_xor(ss, 32);
        const float rr = rsqrtf(ss * (1.f / DM) + EPS);
#pragma unroll
        for (int reg = 0; reg < 4; ++reg) { LAS float* p = lg + (4 * kq + reg) * 48 + i16; p[0] = acc0[reg]; p[16] = acc1[reg]; p[32] = acc2[reg]; }
        LDS_WAIT(); asm volatile("" ::: "memory");
        if (F.lane < 16) { const LAS float* p = lg + F.lane * 48;
            float gl[4];
#pragma unroll
            for (int i = 0; i < 4; ++i) gl[i] = p[i] * rr + brg[i];
            int g = 0; float gm = gl[0];
#pragma unroll
            for (int i = 1; i < 4; ++i) if (gl[i] > gm) { gm = gl[i]; g = i; }
            float gs = 0.f;
#pragma unroll
            for (int i = 0; i < 4; ++i) gs += expf(gl[i] - gm);
            const float ggate = 1.f / gs;
            float el[8];
#pragma unroll
            for (int i = 0; i < 8; ++i) el[i] = p[4 + g * 8 + i] * rr + bre[g * 8 + i];
            int i1 = 0; float v1 = el[0];
#pragma unroll
            for (int i = 1; i < 8; ++i) if (el[i] > v1) { v1 = el[i]; i1 = i; }
            int i2 = -1; float v2 = -__builtin_inff();
#pragma unroll
            for (int i = 0; i < 8; ++i) if (i != i1 && el[i] > v2) { v2 = el[i]; i2 = i; }
            const float a = expf(v2 - v1), w1 = 1.f / (1.f + a), w2 = a / (1.f + a);
            const int t = t0 + F.lane, e1 = g * 8 + i1, e2 = g * 8 + i2;
            const int r1 = (int)atomicAdd(F.ctl + CW_CNT + e1 * CW_CNT_STRIDE, 1u), r2 = (int)atomicAdd(F.ctl + CW_CNT + e2 * CW_CNT_STRIDE, 1u);
            rowtok[e1 * ECAP + r1] = t; roww[e1 * ECAP + r1] = ggate * w1; rowrr[e1 * ECAP + r1] = rr; rowtok[e2 * ECAP + r2] = t; roww[e2 * ECAP + r2] = ggate * w2; rowrr[e2 * ECAP + r2] = rr;
            tokpos[2 * t] = (e1 << ECAP_LOG) | r1; tokpos[2 * t + 1] = (e2 << ECAP_LOG) | r2; }
        LDS_WAIT(); asm volatile("" ::: "memory");
    }
    if (F.wid >= 4) {
      LAS float* scr = (LAS float*)(F.lds + (F.wid - 4) * 32768);
      bf16_t* W13T = (bf16_t*)(F.ws + WS_W13T); bf16_t* W2T = (bf16_t*)(F.ws + WS_W2T);
#define XW_SRC(it_) (((it_) % 384) < 128 ? F.a->in[I_W1] + (size_t)((it_) / 384) * 1024 * 256 : ((it_) % 384) < 256 ? F.a->in[I_W3] + (size_t)((it_) / 384) * 1024 * 256 : F.a->in[I_W2] + (size_t)((it_) / 384) * 256 * 1024)
#define XW_STORE(v_, it_, scr_) do { const int e_ = (it_) / 384, r_ = (it_) % 384; \
          if (r_ < 128) tr_store(v_, 256, W13T, 1024, 0, RmW13{e_ * 512}, scr_, r_, F.lane); \
          else if (r_ < 256) tr_store(v_, 256, W13T, 1024, 0, RmW13{e_ * 512 + 128}, scr_, r_ - 128, F.lane); \
          else tr_store(v_, 1024, W2T, 256, 0, RmAdd{e_ * 1024}, scr_, r_ - 256, F.lane); } while (0)
      const int stride = F.G * 4;
      for (int it = F.blk * 4 + (F.wid - 4); it < NE * 384; it += 2 * stride) { const int it2 = it + stride; const bool two = it2 < NE * 384;
          float va[32], vb[32];
          { const int r = it % 384; tr_load(XW_SRC(it), r < 256 ? 256 : 1024, r < 128 ? r : r < 256 ? r - 128 : r - 256, F.lane, va); }
          if (two) { const int r = it2 % 384; tr_load(XW_SRC(it2), r < 256 ? 256 : 1024, r < 128 ? r : r < 256 ? r - 128 : r - 256, F.lane, vb); }
          XW_STORE(va, it, scr);
          if (two) XW_STORE(vb, it2, scr + 64 * 33); }
#undef XW_SRC
#undef XW_STORE
    }
}
__device__ __forceinline__ void moe_offsets(Frame& F, LAS int* offs) {
    __syncthreads();
    if (F.tid < 64) { const int c = F.tid < NE ? (int)__hip_atomic_load(F.ctl + CW_CNT + F.tid * CW_CNT_STRIDE, __ATOMIC_RELAXED, __HIP_MEMORY_SCOPE_AGENT) : 0; const int p = (c + 255) & ~255; int incl = p;
#pragma unroll
        for (int o = 1; o < 32; o <<= 1) { const int v = __shfl_up(incl, o); if ((F.tid & 63) >= o) incl += v; }
        if (F.tid < NE) { offs[F.tid] = incl - p; offs[40 + F.tid] = c; for (int t = (incl - p) >> 8; t < (incl >> 8); ++t) offs[80 + t] = F.tid; } if (F.tid == NE - 1) offs[NE] = incl; }
    __syncthreads();
}
__device__ __forceinline__ int expert_of_row(LAS int* offs, int row) { return offs[80 + (row >> 8)]; }
__device__ __forceinline__ void moe_gemm1(Frame& F, LAS int* offs, int G, int c, int lo, int hi) {
    MoeOrder S{offs, 2, G, c, lo, hi};
    pg8::Gemm g{(const bf16_t*)(F.ws + WS_H2), (const bf16_t*)(F.ws + WS_W13T), DM, (const int*)(F.ws + WS_ROUTE + RT_ROWTOK)}; EpiSwiglu E{(const float*)(F.ws + WS_ROUTE + RT_ROWW), (const float*)(F.ws + WS_ROUTE + RT_ROWRR), (bf16_t*)(F.ws + WS_HID)};
    pg8::gemm_phase<EpiSwiglu, MoeOrder, PG8_ALIGN, PG8_SP2, false, true>(F.lds, g, S, E);
}
__device__ __forceinline__ void moe_gemm2(Frame& F, LAS int* offs, int G, int c, int lo, int hi) {
    MoeOrder S{offs, 4, G, c, lo, hi};
    int kde = DE; asm volatile("" : "+s"(kde));
    pg8::Gemm g{(const bf16_t*)(F.ws + WS_HID), (const bf16_t*)(F.ws + WS_W2T), kde, nullptr}; EpiY E{(bf16_t*)(F.ws + WS_YBUF)};
    pg8::gemm_phase<EpiY, MoeOrder, PG8_ALIGN, PG8_SP2, false>(F.lds, g, S, E);
}
__device__ __forceinline__ void p7_moe_a(Frame& F) {
    LAS int* offs = (LAS int*)(F.lds + 140 * 1024); moe_offsets(F, offs);
    const int n1 = (offs[NE] / 256) * 2;
    moe_gemm1(F, offs, F.G, F.blk, 0, n1 < F.G ? n1 : F.G);
}
__device__ __forceinline__ void p7_moe_b(Frame& F) {
    LAS int* offs = (LAS int*)(F.lds + 140 * 1024); moe_offsets(F, offs);
    const int T = offs[NE] / 256, n1 = T * 2; int nrem = n1 - F.G; if (nrem < 0) nrem = 0; if (nrem > F.G / 2) nrem = F.G / 2;
    const int t2 = (T < F.G / 2 ? T : F.G / 2) * 4;
    if (F.blk < nrem) moe_gemm1(F, offs, nrem, F.blk, F.G, n1);
    else moe_gemm2(F, offs, F.G - nrem, F.blk - nrem, 0, t2);
}
__device__ __forceinline__ void p8_moe_c(Frame& F) {
    LAS int* offs = (LAS int*)(F.lds + 140 * 1024); moe_offsets(F, offs);
    const int T = offs[NE] / 256;
    moe_gemm2(F, offs, F.G, F.blk, (T < F.G / 2 ? T : F.G / 2) * 4, T * 4);
}
__device__ __forceinline__ void p9_combine(Frame& F) {
    LAS int* offs = (LAS int*)(F.lds + 140 * 1024);
    moe_offsets(F, offs);
    const bf16_t* YB = (const bf16_t*)(F.ws + WS_YBUF); const int* tokpos = (const int*)(F.ws + WS_ROUTE + RT_TOKPOS);
    for (int t0 = F.gw * 4; t0 < M; t0 += F.NGW * 4) { int p[4][2];
#pragma unroll
        for (int q = 0; q < 4; ++q) { const int a0 = tokpos[2 * (t0 + q)], a1 = tokpos[2 * (t0 + q) + 1]; p[q][0] = offs[a0 >> ECAP_LOG] + (a0 & (ECAP - 1)); p[q][1] = offs[a1 >> ECAP_LOG] + (a1 & (ECAP - 1)); }
        f32x4 xv[4][4];
#pragma unroll
        for (int q = 0; q < 4; ++q)
#pragma unroll
            for (int j = 0; j < 4; ++j) xv[q][j] = ((const f32x4*)(F.out + (size_t)(t0 + q) * DM) + F.lane)[64 * j];
#pragma unroll
        for (int q = 0; q < 4; ++q) {
            f32x4 a[4], b[4];
#pragma unroll
            for (int j = 0; j < 4; ++j) { a[j] = ld4(YB + (size_t)p[q][0] * DM + 4 * F.lane + 256 * j); b[j] = ld4(YB + (size_t)p[q][1] * DM + 4 * F.lane + 256 * j); }
#pragma unroll
            for (int j = 0; j < 4; ++j) ((f32x4*)(F.out + (size_t)(t0 + q) * DM) + F.lane)[64 * j] = xv[q][j] + (a[j] + b[j]); } }
}

#define XB_TMO      128
#define XB_XCNT(j)  (256  + 64 * (j))
#define XB_XSUB(j)  (1280 + 64 * (j))
#define XB_XGEN(j)  (2304 + 64 * (j))
#define XB_TOP      3328
#define XB_TOPGEN   3392
#define XCD_BAR_WORDS 3456
#define XB_SPIN_CAP (1u << 22)

__device__ __forceinline__ unsigned xb_ld(unsigned* p)              { return __hip_atomic_load(p, __ATOMIC_RELAXED, __HIP_MEMORY_SCOPE_AGENT); }
__device__ __forceinline__ unsigned xb_add(unsigned* p, unsigned v) { return __hip_atomic_fetch_add(p, v, __ATOMIC_RELAXED, __HIP_MEMORY_SCOPE_AGENT); }
__device__ __forceinline__ unsigned xb_xcc_id() { return (unsigned)__builtin_amdgcn_s_getreg((3 << 11) | 20) & 0xFu; }
#define XB_SPIN(cond, bar) do { unsigned _sp = 0; while (cond) { __builtin_amdgcn_s_sleep(1); \
    if ((++_sp & 255u) == 0u) { if (xb_ld(&(bar)[XB_TMO])) break; if (_sp > XB_SPIN_CAP) { atomicAdd(&(bar)[XB_TMO], 1u); break; } } } } while (0)

struct XcdBarrier {
    unsigned* bar; unsigned x;
    volatile LAS unsigned* st;
};

__device__ __forceinline__ XcdBarrier xcd_barrier_post(unsigned* bar, volatile LAS unsigned* st) {
    XcdBarrier b; b.bar = bar; b.x = xb_xcc_id(); b.st = st;
    if (threadIdx.x == 0) (void)xb_add(&bar[XB_XCNT(b.x)], 1u);
    return b;
}
__device__ __forceinline__ void xcd_barrier_complete(unsigned* bar, unsigned x, unsigned& nloc, unsigned& nx) {
    const unsigned G = gridDim.x * gridDim.y * gridDim.z;
    unsigned sum, cnt, mine, sp = 0u;
    for (;;) {
        sum = 0u; cnt = 0u; mine = 0u;
#pragma unroll
        for (unsigned j = 0; j < 16; ++j) { const unsigned c = xb_ld(&bar[XB_XCNT(j)]); sum += c; cnt += (c > 0u) ? 1u : 0u; mine = (j == x) ? c : mine; }
        if (sum == G) break;
        __builtin_amdgcn_s_sleep(1);
        if ((++sp & 255u) == 0u) { if (xb_ld(&bar[XB_TMO])) break; if (sp > XB_SPIN_CAP) { atomicAdd(&bar[XB_TMO], 1u); break; } }
    }
    nloc = mine > 0u ? mine : 1u; nx = cnt > 0u ? cnt : 1u;
}

__device__ __forceinline__ void xcd_barrier(const XcdBarrier& b) {
    asm volatile("s_waitcnt vmcnt(0)" ::: "memory");
    __syncthreads();
    if (threadIdx.x == 0) {
        unsigned* bar = b.bar;
        __builtin_amdgcn_s_waitcnt(0);
        unsigned nloc = b.st[0], nx = b.st[1];
        if (nloc == 0u) { xcd_barrier_complete(bar, b.x, nloc, nx); b.st[0] = nloc; b.st[1] = nx; }
        const unsigned old = xb_add(&bar[XB_XSUB(b.x)], 1u);
        const unsigned gen = old / nloc;
        if (old + 1u == (gen + 1u) * nloc) {
            __builtin_amdgcn_fence(__ATOMIC_RELEASE, "agent");
            asm volatile("s_waitcnt vmcnt(0)" ::: "memory");
            const unsigned og = xb_add(&bar[XB_TOP], 1u);
            const unsigned tg = og / nx;
            if (og + 1u == (tg + 1u) * nx) xb_add(&bar[XB_TOPGEN], 1u);
            else XB_SPIN(xb_ld(&bar[XB_TOPGEN]) == tg, bar);
            __builtin_amdgcn_fence(__ATOMIC_ACQUIRE, "agent");
            xb_add(&bar[XB_XGEN(b.x)], 1u);
            asm volatile("s_waitcnt vmcnt(0)" ::: "memory");
        } else {
            XB_SPIN(xb_ld(&bar[XB_XGEN(b.x)]) == gen, bar);
            __builtin_amdgcn_fence(__ATOMIC_ACQUIRE, "agent");
            asm volatile("s_waitcnt vmcnt(0)" ::: "memory");
        }
    }
    __syncthreads();
}
constexpr int LDS_BYTES = 147456;
__global__ void __launch_bounds__(NTHREADS, 2) fwd_kernel(Args args) {
    extern __shared__ __attribute__((aligned(16))) unsigned char lds[];
    Frame F;
    F.lds = (LAS unsigned char*)lds; F.ldsg = (char*)lds;
    F.tid = threadIdx.x; F.lane = F.tid & 63; F.wid = __builtin_amdgcn_readfirstlane(F.tid >> 6);
    F.blk = blockIdx.x; F.G = gridDim.x; F.gw = F.blk * NWAVES + F.wid; F.NGW = F.G * NWAVES;
    F.a = &args;
    F.out = args.out; F.ws = args.ws; F.ctl = (unsigned*)(args.ws + WS_CTL);
    const int lo = args.ph_lo, hi = args.ph_hi;
#if MK_ONE_LAUNCH
    cg::grid_group grid = cg::this_grid();
    volatile LAS unsigned* bst = (volatile LAS unsigned*)(F.lds + 144 * 1024 - 16);
    if (F.tid < 2) bst[F.tid] = 0u;
    __syncthreads();
    const XcdBarrier bar = xcd_barrier_post(F.ctl + CW_BAR, bst);
#define SEAM(k) do { if (lo <= (k) && (k) + 1 < hi) { xcd_barrier(bar); } asm volatile("" : "+v"(F.tid), "+v"(F.lane)); } while (0)
    if (hi > NPHASE) grid.sync();
#else
#define SEAM(k) do { } while (0)
#endif
#define IN(k) (lo <= (k) && (k) < hi)
    if (IN(0)) { p0_prologue(F); } SEAM(0);
    if (IN(1)) { p1_proj(F); } SEAM(1);
    if (IN(2)) { p2_mixer_a(F); p2_attention(F); } SEAM(2);
    if (IN(3)) { p3_merged(F); } SEAM(3);
    if (IN(4)) { p4_out(F); } SEAM(4);
    if (IN(5)) { p5_router(F); } SEAM(5);
    if (IN(6)) { p7_moe_a(F); } SEAM(6);
    if (IN(7)) { p7_moe_b(F); } SEAM(7);
    if (IN(8)) { p8_moe_c(F); } SEAM(8);
    if (IN(9)) { p9_combine(F); }
#undef IN
#undef SEAM
}

extern "C" void kernel_launch(void* const* d_in, const int* in_sizes, int n_in, void* d_out, int out_size, void* d_ws, size_t ws_size, hipStream_t stream) {
    static int grid = 0;
    if (grid == 0) {
        if (n_in != 26 || out_size != M * DM || ws_size < WS_END) { fprintf(stderr, "kernel_launch: unexpected shapes (n_in %d out %d ws %zu)\n", n_in, out_size, ws_size); grid = -1; return; }
        int dev = 0, cus = 0, per_cu = 0;
        (void)hipGetDevice(&dev); (void)hipDeviceGetAttribute(&cus, hipDeviceAttributeMultiprocessorCount, dev);
        if (hipFuncSetAttribute((const void*)fwd_kernel, hipFuncAttributeMaxDynamicSharedMemorySize, LDS_BYTES) != hipSuccess) { fprintf(stderr, "kernel_launch: hipFuncSetAttribute failed\n"); grid = -1; return; }
        if (hipOccupancyMaxActiveBlocksPerMultiprocessor(&per_cu, (const void*)fwd_kernel, NTHREADS, LDS_BYTES) != hipSuccess || per_cu < 1) { fprintf(stderr, "kernel_launch: occupancy query says %d\n", per_cu); per_cu = 1; }
        (void)hipGetLastError();
        grid = cus;
    }
    if (grid < 0) return;
    (void)hipMemsetAsync((char*)d_ws + WS_CTL, 0, CTL_ZERO_BYTES, stream);
    Args a{};
    for (int i = 0; i < 26; ++i) a.in[i] = (const float*)d_in[i];
    a.out = (float*)d_out; a.ws = (unsigned char*)d_ws;
#if MK_ONE_LAUNCH
    a.ph_lo = 0; a.ph_hi = NPHASE;
    void* kargs[] = {&a};
    hipError_t e = hipLaunchCooperativeKernel((const void*)fwd_kernel, dim3(grid), dim3(NTHREADS), kargs, LDS_BYTES, stream);
    if (e != hipSuccess) fprintf(stderr, "cooperative launch failed: %s (grid %d)\n", hipGetErrorString(e), grid);
#else
    for (int p = 0; p < NPHASE; ++p) { a.ph_lo = p; a.ph_hi = p + 1; hipLaunchKernelGGL(fwd_kernel, dim3(grid), dim3(NTHREADS), LDS_BYTES, stream, a); }
#endif
}
```

```cpp
#include <hip/hip_runtime.h>
#include <hip/hip_cooperative_groups.h>
#include <cstdio>
#include <cstdint>
namespace cg = cooperative_groups;

#ifndef MK_ONE_LAUNCH
#define MK_ONE_LAUNCH 1
#endif

#define LAS __attribute__((address_space(3)))
typedef unsigned short bf16_t;
typedef short bf16x8 __attribute__((ext_vector_type(8)));
typedef short s16x4 __attribute__((ext_vector_type(4)));
typedef float f32x4 __attribute__((ext_vector_type(4)));
typedef float f32x16 __attribute__((ext_vector_type(16)));
typedef float f32x2 __attribute__((ext_vector_type(2)));
typedef unsigned u32x4 __attribute__((ext_vector_type(4)));
typedef unsigned u32x2 __attribute__((ext_vector_type(2)));
typedef __bf16 bf16x2_t __attribute__((ext_vector_type(2)));

constexpr int NB = 2, SEQ = 8192, DM = 1024, M = NB * SEQ;
constexpr int NH = 8;
constexpr int N1 = 7168;
constexpr int NE = 32, DE = 256;
constexpr float EPS = 1e-6f;
constexpr float LOG2E = 1.4426950408889634f;
constexpr float C2 = 0.125f * LOG2E;
constexpr float LAM_INIT = 0.2f;
constexpr int NWAVES = 8, NTHREADS = 512;
constexpr int NPHASE = 10;
constexpr int ECAP = 16384, ECAP_LOG = 14;

constexpr size_t MiB = 1u << 20;
constexpr size_t WS_CTL = 0;
constexpr size_t CTL_ZERO_BYTES = 65536;
constexpr size_t WS_W1T = 1 * MiB;
constexpr size_t WS_WUPT = 15 * MiB;
constexpr size_t WS_WOUTT = 19 * MiB;
constexpr size_t WS_WST = 21 * MiB;
constexpr size_t WS_ROUTE = 22 * MiB;
constexpr size_t WS_XN = 32 * MiB;
constexpr size_t WS_U = 64 * MiB;
constexpr size_t WS_VA = 96 * MiB;
constexpr size_t WS_Q = 128 * MiB;
constexpr size_t WS_K = 160 * MiB;
constexpr size_t WS_VB = 192 * MiB;
constexpr size_t WS_W13T = 160 * MiB;
constexpr size_t WS_W2T = 192 * MiB;
constexpr size_t WS_HID = 208 * MiB;
constexpr size_t WS_H2 = 32 * MiB;
constexpr size_t WS_YBUF = 64 * MiB;
constexpr size_t WS_YA = 224 * MiB;
constexpr size_t WS_T = 64 * MiB;
constexpr size_t WS_END = 256 * MiB;
constexpr size_t RT_TOKE = 0, RT_TOKW = 256 * 1024, RT_TOKPOS = 512 * 1024, RT_WRT = 1024 * 1024, RT_ALIST = 1536 * 1024, RT_ROWTOK = 2048 * 1024, RT_ROWW = 4096 * 1024, RT_ROWRR = 6144 * 1024;
constexpr int CW_CNT = 8192, CW_CNT_STRIDE = 64, CW_AQ = 512, CW_BAR = 1024;

#define LDS_WAIT() asm volatile("s_waitcnt lgkmcnt(0)" ::: "memory")
#define SBAR() __builtin_amdgcn_sched_barrier(0)
__device__ __forceinline__ unsigned cvtpk(float lo, float hi) { f32x2 v = {lo, hi}; bf16x2_t b = __builtin_convertvector(v, bf16x2_t); return __builtin_bit_cast(unsigned, b); }
__device__ __forceinline__ float bf2f(short b) { return __uint_as_float(((unsigned)(unsigned short)b) << 16); }
__device__ __forceinline__ float wave_sum(float v) {
#pragma unroll
    for (int o = 1; o < 64; o <<= 1) v += __shfl_xor(v, o);
    return v;
}
__device__ __forceinline__ void st4(bf16_t* p, f32x4 v) { u32x2 w; w.x = cvtpk(v[0], v[1]); w.y = cvtpk(v[2], v[3]); *(u32x2*)p = w; }
__device__ __forceinline__ f32x4 ld4(const bf16_t* p) { const u32x2 w = *(const u32x2*)p; f32x4 r; r[0] = __uint_as_float(w.x << 16); r[1] = __uint_as_float(w.x & 0xffff0000u); r[2] = __uint_as_float(w.y << 16); r[3] = __uint_as_float(w.y & 0xffff0000u); return r; }

struct Args { const float* in[26]; float* out; unsigned char* ws; int ph_lo, ph_hi; };

struct Frame {
    LAS unsigned char* lds; char* ldsg;
    int tid, lane, wid, blk, G, gw, NGW;
    const Args* a; float* out; unsigned char* ws; unsigned* ctl;
};
enum { I_X = 0, I_N1G, I_WIN, I_VNG, I_WS, I_BS, I_QNG, I_KNG, I_LQ1, I_LK1, I_LQ2, I_LK2, I_SUBG, I_WUPA, I_WUPB, I_WGATE, I_BGATE, I_WOUT, I_N2G, I_WRG, I_BRG, I_WRE, I_BRE, I_W1, I_W3, I_W2 };

__device__ __forceinline__ void wave_gemm(f32x4 (&acc)[2][4], const bf16_t* ap0, const bf16_t* ap1, const bf16_t* bp0, const bf16_t* bp1, const bf16_t* bp2, const bf16_t* bp3, int K) {
#pragma unroll 2
    for (int k0 = 0; k0 < K; k0 += 32) {
        const bf16x8 a0 = *(const bf16x8*)(ap0 + k0), a1 = *(const bf16x8*)(ap1 + k0);
        const bf16x8 b0 = *(const bf16x8*)(bp0 + k0), b1 = *(const bf16x8*)(bp1 + k0), b2 = *(const bf16x8*)(bp2 + k0), b3 = *(const bf16x8*)(bp3 + k0);
        acc[0][0] = __builtin_amdgcn_mfma_f32_16x16x32_bf16(b0, a0, acc[0][0], 0, 0, 0);
        acc[0][1] = __builtin_amdgcn_mfma_f32_16x16x32_bf16(b1, a0, acc[0][1], 0, 0, 0);
        acc[0][2] = __builtin_amdgcn_mfma_f32_16x16x32_bf16(b2, a0, acc[0][2], 0, 0, 0);
        acc[0][3] = __builtin_amdgcn_mfma_f32_16x16x32_bf16(b3, a0, acc[0][3], 0, 0, 0);
        acc[1][0] = __builtin_amdgcn_mfma_f32_16x16x32_bf16(b0, a1, acc[1][0], 0, 0, 0);
        acc[1][1] = __builtin_amdgcn_mfma_f32_16x16x32_bf16(b1, a1, acc[1][1], 0, 0, 0);
        acc[1][2] = __builtin_amdgcn_mfma_f32_16x16x32_bf16(b2, a1, acc[1][2], 0, 0, 0);
        acc[1][3] = __builtin_amdgcn_mfma_f32_16x16x32_bf16(b3, a1, acc[1][3], 0, 0, 0);
    }
}
__device__ __forceinline__ void acc_zero(f32x4 (&acc)[2][4]) {
#pragma unroll
    for (int m = 0; m < 2; ++m)
#pragma unroll
        for (int n = 0; n < 4; ++n) acc[m][n] = (f32x4){0.f, 0.f, 0.f, 0.f};
}

namespace pg8 {
#define PG8_LAS __attribute__((address_space(3)))
constexpr int BM = 256, BK = 64, HALF = 128, HTB = HALF * BK * 2  , STAGE_BYTES = 8 * HTB, NXCD = 8, WGM = 4;

__host__ __device__ __forceinline__ int lds_byte(int r, int c) { const int st = (r >> 4) * 2 + (c >> 5), rr = r & 15, cc = c & 31, ob = rr * 64 + cc * 2; return st * 1024 + (ob ^ (((ob >> 9) & 1) << 5)); }
__host__ __device__ __forceinline__ void stage_rc(int b, int& R, int& C) { const int st = b / 1024, sb = b % 1024, swz = sb ^ (((sb >> 9) & 1) << 5); R = (st >> 1) * 16 + swz / 64; C = (st & 1) * 32 + (swz % 64) / 2; }
__host__ __device__ __forceinline__ int perm32(int rho) { const int n = rho >> 4, i = rho & 15; return 8 * (i >> 2) + 4 * n + (i & 3); }

struct Unit { int pm, pn, pb, rbase, nvalid; };
struct Gemm { const bf16_t* A; const bf16_t* Bt; int K; const int* rowtok; };

struct StaticOrder {
    int nM, nN, nwg, G, c;
    __host__ __device__ void init(int M, int N, int G_, int c_) { nM = M / BM; nN = N / BM; nwg = nM * nN; G = G_; c = c_; }
    __host__ __device__ bool next(int i, Unit& u) const {
        const long L = (long)i * G + c; if (L >= nwg) return false;
        int wgid = (int)L; { const int q = nwg / NXCD, r = nwg % NXCD, xcd = wgid % NXCD, off = wgid / NXCD; wgid = (xcd < r ? xcd * (q + 1) : r * (q + 1) + (xcd - r) * q) + off; }
        const int nig = WGM * nN, gid = wgid / nig, fm = gid * WGM, gsz = (nM - fm) < WGM ? (nM - fm) : WGM;
        u.pm = fm + ((wgid % nig) % gsz); u.pn = (wgid % nig) / gsz; u.pb = u.pn; u.rbase = 0; u.nvalid = 0; return true;
    }
    __device__ __forceinline__ void a_ready(const Unit&) const {}
    __device__ __forceinline__ void done(const Unit&) const {}
};
template <class Epi, class Sched, bool ALIGN_EPI = false, bool SP2 = false, bool BP64 = false, bool GATHER = false>
__device__ __forceinline__ void gemm_phase(PG8_LAS unsigned char* lds, const Gemm g, const Sched& S, const Epi& E) {
    const int tid = threadIdx.x, wid = __builtin_amdgcn_readfirstlane(tid >> 6), lane = tid & 63, wr = wid >> 2, wc = wid & 3, fr = lane & 15, fq = lane >> 4;
    const int K = g.K, nt = K / BK;
    unsigned voffA[2], voffB[2];
#pragma unroll
    for (int i = 0; i < 2; ++i) { int R, C; stage_rc(tid * 16 + i * 8192, R, C); const int Rp = Epi::PERM ? ((R & ~31) + perm32(R & 31)) : R; const int Rb = BP64 ? (64 * (Rp >> 5) + (Rp & 31)) : Rp;
        voffA[i] = (unsigned)(R * K + C) * 2u; voffB[i] = (unsigned)(Rb * K + C) * 2u; }
    const size_t kstep = (size_t)(BK * 2);
    const size_t hstep = (size_t)HALF * K * 2;
    const size_t tstep = 2 * hstep;
    const size_t bhs = BP64 ? (size_t)32 * K * 2 : hstep;
    const unsigned ldsw = (unsigned)wid * 1024u;
    const int aoff = lds_byte(wr * 64 + fr, fq * 8), boff = lds_byte(wc * 32 + fr, fq * 8);
#define PG8_SA(b, h) (((b) * 2 + (h)) * HTB)
#define PG8_SB(b, h) ((4 + (b) * 2 + (h)) * HTB)
#define PG8_STAGE(bufoff, gbase, voff) do { _Pragma("unroll") for (int _i = 0; _i < 2; ++_i) \
        __builtin_amdgcn_global_load_lds((const unsigned*)((const char*)(gbase) + (voff)[_i]), (PG8_LAS unsigned*)(lds + (bufoff) + ldsw + _i * 8192), 16, 0, 0); } while (0)
#define PG8_LDA(dst, b, h) do { _Pragma("unroll") for (int m = 0; m < 4; ++m) _Pragma("unroll") for (int k = 0; k < 2; ++k) dst[m][k] = *(const PG8_LAS bf16x8*)(lds + PG8_SA(b, h) + aoff + m * 2048 + k * 1024); } while (0)
#define PG8_LDB(dst, b, h) do { _Pragma("unroll") for (int n = 0; n < 2; ++n) _Pragma("unroll") for (int k = 0; k < 2; ++k) dst[n][k] = *(const PG8_LAS bf16x8*)(lds + PG8_SB(b, h) + boff + n * 2048 + k * 1024); } while (0)
#define PG8_MMA(ai, bj, At, Bt) do { __builtin_amdgcn_s_setprio(1); _Pragma("unroll") for (int m = 0; m < 4; ++m) _Pragma("unroll") for (int n = 0; n < 2; ++n) _Pragma("unroll") for (int k = 0; k < 2; ++k) \
        acc[ai][bj][m][n] = __builtin_amdgcn_mfma_f32_16x16x32_bf16(Bt[n][k], At[m][k], acc[ai][bj][m][n], 0, 0, 0); __builtin_amdgcn_s_setprio(0); } while (0)
#define PG8_WAIT_V(n) asm volatile("s_waitcnt vmcnt(" #n ")" ::: "memory")
#define PG8_WAIT_L(n) asm volatile("s_waitcnt lgkmcnt(" #n ")" ::: "memory")
#define PG8_BAR __builtin_amdgcn_s_barrier()
#define PG8_SCHED __builtin_amdgcn_sched_barrier(0)
    Unit cur, nxt; int ui = 0;
    if (!S.next(0, cur)) return;
    static_assert(!GATHER || SP2, "GATHER is written for the SP2 loop");
    unsigned vA0[2] = {0u, 0u}, vA1[2] = {0u, 0u}, nvA0[2] = {0u, 0u}, nvA1[2] = {0u, 0u};
#define PG8_GLOAD(u_, d0_, d1_) do { _Pragma("unroll") for (int _i = 0; _i < 2; ++_i) { int R_, C_; stage_rc(tid * 16 + _i * 8192, R_, C_); \
        const int t0_ = R_ < (u_).nvalid ? g.rowtok[(u_).rbase + R_] : 0, t1_ = HALF + R_ < (u_).nvalid ? g.rowtok[(u_).rbase + HALF + R_] : 0; d0_[_i] = (unsigned)(t0_ * K + C_) * 2u; d1_[_i] = (unsigned)(t1_ * K + C_) * 2u; } } while (0)
#define PG8_STAGE_A(bufoff, ptr, half, vcur0, vcur1) do { if constexpr (GATHER) { PG8_STAGE(bufoff, ptr, (half) ? vcur1 : vcur0); } else { PG8_STAGE(bufoff, (ptr) + ((half) ? hstep : (size_t)0), voffA); } } while (0)
    if constexpr (GATHER) PG8_GLOAD(cur, vA0, vA1);
    f32x4 acc[2][2][4][2];
#pragma unroll
    for (int a = 0; a < 2; ++a)
#pragma unroll
        for (int b = 0; b < 2; ++b)
#pragma unroll
            for (int m = 0; m < 4; ++m)
#pragma unroll
                for (int n = 0; n < 2; ++n) acc[a][b][m][n] = (f32x4){0.f, 0.f, 0.f, 0.f};
    bf16x8 At[4][2], B0[2][2], B1[2][2];
    const char* cA = (const char*)g.A + (GATHER ? (size_t)0 : (size_t)cur.pm * tstep); const char* cB = (const char*)g.Bt + (size_t)cur.pb * tstep;
    S.a_ready(cur);
    if constexpr (SP2) {
        PG8_STAGE(PG8_SB(0, 0), cB, voffB); PG8_STAGE(PG8_SB(0, 1), cB + bhs, voffB); PG8_STAGE_A(PG8_SA(0, 0), cA, 0, vA0, vA1); PG8_STAGE_A(PG8_SA(0, 1), cA, 1, vA0, vA1);
        if (wr == 1) PG8_BAR;
        PG8_WAIT_V(2); PG8_BAR;
        PG8_STAGE(PG8_SB(1, 0), cB + kstep, voffB); PG8_STAGE_A(PG8_SA(1, 0), cA + kstep, 0, vA0, vA1); PG8_STAGE(PG8_SB(1, 1), cB + bhs + kstep, voffB);
        PG8_WAIT_V(6); PG8_BAR;
    } else {
        PG8_STAGE(PG8_SB(0, 0), cB, voffB); PG8_STAGE(PG8_SA(0, 0), cA, voffA); PG8_STAGE(PG8_SB(0, 1), cB + bhs, voffB); PG8_STAGE(PG8_SA(0, 1), cA + hstep, voffA);
        if (wr == 1) PG8_BAR;
        PG8_WAIT_V(4); PG8_BAR;
        PG8_STAGE(PG8_SB(1, 0), cB + kstep, voffB); PG8_STAGE(PG8_SA(1, 0), cA + kstep, voffA); PG8_STAGE(PG8_SB(1, 1), cB + bhs + kstep, voffB);
        PG8_WAIT_V(6); PG8_BAR;
    }
    for (;;) {
        const bool has_next = S.next(ui + 1, nxt);
        const char* nA = (has_next && !GATHER) ? (const char*)g.A + (size_t)nxt.pm * tstep : cA; const char* nB = has_next ? (const char*)g.Bt + (size_t)nxt.pb * tstep : cB;
        if constexpr (GATHER) { if (has_next) { PG8_GLOAD(nxt, nvA0, nvA1); } else { nvA0[0] = vA0[0]; nvA0[1] = vA0[1]; nvA1[0] = vA1[0]; nvA1[1] = vA1[1]; } }
        for (int t = 0; t < nt; t += 2) {
            const bool last = (t == nt - 2);
            const char* a1 = cA + (size_t)(t + 1) * kstep;
            const char* a2 = last ? nA : cA + (size_t)(t + 2) * kstep; const char* b2 = last ? nB : cB + (size_t)(t + 2) * kstep;
            const char* a3 = a2 + kstep; const char* b3 = b2 + kstep;
            if (last && has_next) S.a_ready(nxt);
            unsigned xA0[2], xA1[2];
            if constexpr (GATHER) { xA0[0] = last ? nvA0[0] : vA0[0]; xA0[1] = last ? nvA0[1] : vA0[1]; xA1[0] = last ? nvA1[0] : vA1[0]; xA1[1] = last ? nvA1[1] : vA1[1]; }
            if constexpr (SP2) {
            PG8_LDB(B0, 0, 0); PG8_LDB(B1, 0, 1); PG8_SCHED; PG8_LDA(At, 0, 0); PG8_STAGE_A(PG8_SA(1, 1), a1, 1, vA0, vA1);
            PG8_WAIT_V(8); PG8_WAIT_L(0); PG8_BAR; PG8_MMA(0, 0, At, B0); PG8_MMA(0, 1, At, B1); PG8_BAR; PG8_SCHED;
            PG8_LDA(At, 0, 1); PG8_STAGE(PG8_SB(0, 0), b2, voffB); PG8_STAGE(PG8_SB(0, 1), b2 + bhs, voffB); PG8_STAGE_A(PG8_SA(0, 0), a2, 0, xA0, xA1);
            PG8_WAIT_V(8); PG8_WAIT_L(0); PG8_BAR; PG8_MMA(1, 0, At, B0); PG8_MMA(1, 1, At, B1); PG8_BAR; PG8_SCHED;
            PG8_LDB(B0, 1, 0); PG8_LDB(B1, 1, 1); PG8_SCHED; PG8_LDA(At, 1, 0); PG8_STAGE_A(PG8_SA(0, 1), a2, 1, xA0, xA1);
            PG8_WAIT_V(8); PG8_WAIT_L(0); PG8_BAR; PG8_MMA(0, 0, At, B0); PG8_MMA(0, 1, At, B1); PG8_BAR; PG8_SCHED;
            PG8_LDA(At, 1, 1); PG8_STAGE(PG8_SB(1, 0), b3, voffB); PG8_STAGE(PG8_SB(1, 1), b3 + bhs, voffB); PG8_STAGE_A(PG8_SA(1, 0), a3, 0, xA0, xA1);
            PG8_WAIT_V(8); PG8_WAIT_L(0); PG8_BAR; PG8_MMA(1, 0, At, B0); PG8_MMA(1, 1, At, B1); PG8_BAR; PG8_SCHED;
            } else {
            PG8_LDB(B0, 0, 0); PG8_SCHED; PG8_LDA(At, 0, 0); PG8_STAGE(PG8_SA(1, 1), a1 + hstep, voffA);
            PG8_WAIT_L(8); PG8_BAR; PG8_WAIT_L(0); PG8_MMA(0, 0, At, B0); PG8_BAR; PG8_SCHED;
            PG8_LDB(B1, 0, 1); PG8_STAGE(PG8_SB(0, 0), b2, voffB);
            PG8_BAR; PG8_WAIT_L(0); PG8_MMA(0, 1, At, B1); PG8_BAR;
            PG8_LDA(At, 0, 1); PG8_STAGE(PG8_SA(0, 0), a2, voffA);
            PG8_BAR; PG8_WAIT_L(0); PG8_MMA(1, 0, At, B0); PG8_BAR; PG8_SCHED;
            PG8_STAGE(PG8_SB(0, 1), b2 + bhs, voffB);
            PG8_WAIT_V(6); PG8_BAR; PG8_MMA(1, 1, At, B1); PG8_BAR;
            PG8_LDB(B0, 1, 0); PG8_SCHED; PG8_LDA(At, 1, 0); PG8_STAGE(PG8_SA(0, 1), a2 + hstep, voffA);
            PG8_WAIT_L(8); PG8_BAR; PG8_WAIT_L(0); PG8_MMA(0, 0, At, B0); PG8_BAR; PG8_SCHED;
            PG8_LDB(B1, 1, 1); PG8_STAGE(PG8_SB(1, 0), b3, voffB);
            PG8_BAR; PG8_WAIT_L(0); PG8_MMA(0, 1, At, B1); PG8_BAR;
            PG8_LDA(At, 1, 1); PG8_STAGE(PG8_SA(1, 0), a3, voffA);
            PG8_BAR; PG8_WAIT_L(0); PG8_MMA(1, 0, At, B0); PG8_BAR; PG8_SCHED;
            PG8_STAGE(PG8_SB(1, 1), b3 + bhs, voffB);
            PG8_WAIT_V(6); PG8_BAR; PG8_MMA(1, 1, At, B1); PG8_BAR;
            }
        }
        if constexpr (ALIGN_EPI) { if (wr == 0) PG8_BAR; }
        if constexpr (!Epi::AFTER_DRAIN) { E(acc, cur, wr, wc, fr, fq); S.done(cur); }
        if (!has_next) break;
#pragma unroll
        for (int a = 0; a < 2; ++a)
#pragma unroll
            for (int b = 0; b < 2; ++b)
#pragma unroll
                for (int m = 0; m < 4; ++m)
#pragma unroll
                    for (int n = 0; n < 2; ++n) acc[a][b][m][n] = (f32x4){0.f, 0.f, 0.f, 0.f};
        cur = nxt; cA = nA; cB = nB; ++ui;
        if constexpr (GATHER) { vA0[0] = nvA0[0]; vA0[1] = nvA0[1]; vA1[0] = nvA1[0]; vA1[1] = nvA1[1]; }
        if constexpr (ALIGN_EPI) { if (wr == 1) PG8_BAR; }
    }
    PG8_WAIT_V(0);
    if constexpr (!ALIGN_EPI) { if (wr == 0) PG8_BAR; }
    PG8_BAR;
    if constexpr (Epi::AFTER_DRAIN) { E.fused(acc, cur, wr, wc, fr, fq, lds, wid, lane); S.done(cur); }
#undef PG8_GLOAD
#undef PG8_STAGE_A
#undef PG8_SA
#undef PG8_SB
#undef PG8_STAGE
#undef PG8_LDA
#undef PG8_LDB
#undef PG8_MMA
#undef PG8_WAIT_V
#undef PG8_WAIT_L
#undef PG8_BAR
#undef PG8_SCHED
}
}

#define PG8_SP2 true
#define PG8_ALIGN true
__device__ __forceinline__ void st8(bf16_t* p, f32x4 a, f32x4 b) { u32x4 w; w.x = cvtpk(a[0], a[1]); w.y = cvtpk(a[2], a[3]); w.z = cvtpk(b[0], b[1]); w.w = cvtpk(b[2], b[3]); *(u32x4*)p = w; }
__device__ __forceinline__ void ld8(const bf16_t* p, f32x4& a, f32x4& b) { const u32x4 w = *(const u32x4*)p;
    a[0] = __uint_as_float(w.x << 16); a[1] = __uint_as_float(w.x & 0xffff0000u); a[2] = __uint_as_float(w.y << 16); a[3] = __uint_as_float(w.y & 0xffff0000u);
    b[0] = __uint_as_float(w.z << 16); b[1] = __uint_as_float(w.z & 0xffff0000u); b[2] = __uint_as_float(w.w << 16); b[3] = __uint_as_float(w.w & 0xffff0000u); }
struct EpiProj {
    static constexpr bool PERM = true, AFTER_DRAIN = false;
    unsigned char* ws; bf16_t* GATE; const float *qg, *kg, *bgate;
    __device__ __forceinline__ void operator()(const f32x4 (&acc)[2][2][4][2], const pg8::Unit& u, int wr, int wc, int fr, int fq) const {
        asm volatile("" : "+v"(fr), "+v"(fq));
        const int seg = u.pn >> 2;
        const int row0 = u.pm * 256 + wr * 64 + fr;
        const int cw = (u.pn & 3) * 256 + wc * 64 + 8 * fq;
        if (seg <= 1 || seg == 4) { bf16_t* dst = (bf16_t*)(ws + WS_U + (size_t)seg * (32 * MiB)) + cw;
#pragma unroll
            for (int ai = 0; ai < 2; ++ai)
#pragma unroll
                for (int m = 0; m < 4; ++m) { bf16_t* rp = dst + (size_t)(row0 + ai * 128 + m * 16) * DM;
#pragma unroll
                    for (int bj = 0; bj < 2; ++bj) st8(rp + 32 * bj, acc[ai][bj][m][0], acc[ai][bj][m][1]); }
        } else if (seg == 2 || seg == 3) { const float* g = (seg == 2 ? qg : kg) + 8 * fq; bf16_t* dst = (bf16_t*)(ws + WS_U + (size_t)seg * (32 * MiB)) + cw; const float sc = seg == 2 ? C2 : 1.f;
            f32x4 gv[2][2];
#pragma unroll
            for (int bj = 0; bj < 2; ++bj)
#pragma unroll
                for (int n = 0; n < 2; ++n) gv[bj][n] = *(const f32x4*)(g + 32 * bj + 4 * n) * sc;
#pragma unroll
            for (int ai = 0; ai < 2; ++ai)
#pragma unroll
                for (int m = 0; m < 4; ++m) { float ss = 0.f;
#pragma unroll
                    for (int bj = 0; bj < 2; ++bj)
#pragma unroll
                        for (int n = 0; n < 2; ++n) { const f32x4 a = acc[ai][bj][m][n]; ss += (a[0] * a[0] + a[1] * a[1]) + (a[2] * a[2] + a[3] * a[3]); }
                    ss += __shfl_xor(ss, 16); ss += __shfl_xor(ss, 32);
                    const float r = rsqrtf(ss * (1.f / 64.f) + EPS); bf16_t* rp = dst + (size_t)(row0 + ai * 128 + m * 16) * DM;
#pragma unroll
                    for (int bj = 0; bj < 2; ++bj) st8(rp + 32 * bj, (acc[ai][bj][m][0] * r) * gv[bj][0], (acc[ai][bj][m][1] * r) * gv[bj][1]); }
        } else { const int c = (u.pn - 20) * 256 + wc * 64 + 8 * fq; const float* bg = bgate + c;
#pragma unroll
            for (int bj = 0; bj < 2; ++bj) { const f32x4 b0 = *(const f32x4*)(bg + 32 * bj), b1 = *(const f32x4*)(bg + 32 * bj + 4);
#pragma unroll
                for (int ai = 0; ai < 2; ++ai)
#pragma unroll
                    for (int m = 0; m < 4; ++m) { f32x4 v0 = acc[ai][bj][m][0] + b0, v1 = acc[ai][bj][m][1] + b1;
#pragma unroll
                        for (int j = 0; j < 4; ++j) { v0[j] = __builtin_amdgcn_rcpf(1.f + __builtin_amdgcn_exp2f(-LOG2E * v0[j])); v1[j] = __builtin_amdgcn_rcpf(1.f + __builtin_amdgcn_exp2f(-LOG2E * v1[j])); }
                        st8(GATE + (size_t)(row0 + ai * 128 + m * 16) * 2048 + c + 32 * bj, v0, v1); } }
        }
    }
};

#define EPI_LOOP(...) _Pragma("unroll") for (int ai = 0; ai < 2; ++ai) _Pragma("unroll") for (int m = 0; m < 4; ++m) { const size_t row = (size_t)(u.pm * 256 + wr * 64 + fr + ai * 128 + m * 16); \
        _Pragma("unroll") for (int bj = 0; bj < 2; ++bj) { const int col = u.pn * 256 + bj * 128 + wc * 32 + 8 * fq; const f32x4 a0 = acc[ai][bj][m][0], a1 = acc[ai][bj][m][1]; __VA_ARGS__ } if (m & 1) asm volatile("" ::: "memory"); }
struct EpiGateT {
    static constexpr bool PERM = true, AFTER_DRAIN = false;
    const bf16_t* GATE; bf16_t* T;
    __device__ __forceinline__ void operator()(const f32x4 (&acc)[2][2][4][2], const pg8::Unit& u, int wr, int wc, int fr, int fq) const {
        asm volatile("" : "+v"(fr), "+v"(fq));
        EPI_LOOP( f32x4 g0, g1; ld8(GATE + row * 2048 + col, g0, g1); st8(T + row * DM + col, g0 * a0, g1 * a1); )
    }
};
struct EpiMerged {
    static constexpr bool PERM = true, AFTER_DRAIN = false;
    const bf16_t* GATE; const bf16_t* T; bf16_t* MG;
    __device__ __forceinline__ void operator()(const f32x4 (&acc)[2][2][4][2], const pg8::Unit& u, int wr, int wc, int fr, int fq) const {
        asm volatile("" : "+v"(fr), "+v"(fq));
        EPI_LOOP( f32x4 g0, g1, t0, t1; ld8(GATE + row * 2048 + 1024 + col, g0, g1); ld8(T + row * DM + col, t0, t1); st8(MG + row * DM + col, t0 + g0 * a0, t1 + g1 * a1); )
    }
};
struct EpiOut {
    static constexpr bool PERM = true, AFTER_DRAIN = false;
    const float* x; float* out; const float* g2; bf16_t* H2;
    __device__ __forceinline__ void operator()(const f32x4 (&acc)[2][2][4][2], const pg8::Unit& u, int wr, int wc, int fr, int fq) const {
        asm volatile("" : "+v"(fr), "+v"(fq));
        EPI_LOOP( const float* xp = x + row * DM + col; float* op = out + row * DM + col; const f32x4 x0 = *(const f32x4*)xp + a0, x1 = *(const f32x4*)(xp + 4) + a1; *(f32x4*)op = x0; *(f32x4*)(op + 4) = x1;
                  st8(H2 + row * DM + col, x0 * *(const f32x4*)(g2 + col), x1 * *(const f32x4*)(g2 + col + 4)); )
    }
};
struct EpiY {
    static constexpr bool PERM = true, AFTER_DRAIN = false;
    bf16_t* Y;
    __device__ __forceinline__ void operator()(const f32x4 (&acc)[2][2][4][2], const pg8::Unit& u, int wr, int wc, int fr, int fq) const {
        asm volatile("" : "+v"(fr), "+v"(fq));
        EPI_LOOP( st8(Y + row * DM + col, a0, a1); )
    }
};
struct EpiSwiglu {
    static constexpr bool PERM = true, AFTER_DRAIN = false;
    const float* roww; const float* rowrr; bf16_t* HID;
    __device__ __forceinline__ void operator()(const f32x4 (&acc)[2][2][4][2], const pg8::Unit& u, int wr, int wc, int fr, int fq) const {
        asm volatile("" : "+v"(fr), "+v"(fq));
#pragma unroll
        for (int ai = 0; ai < 2; ++ai)
#pragma unroll
            for (int m = 0; m < 4; ++m) { const int rl = wr * 64 + fr + ai * 128 + m * 16; const size_t row = (size_t)(u.pm * 256 + rl); const float w = rl < u.nvalid ? roww[u.rbase + rl] : 0.f, rr = rl < u.nvalid ? rowrr[u.rbase + rl] : 0.f;
                f32x4 hv[2];
#pragma unroll
                for (int n = 0; n < 2; ++n) { const f32x4 a1 = acc[ai][0][m][n] * rr, a3 = acc[ai][1][m][n] * rr;
#pragma unroll
                    for (int j = 0; j < 4; ++j) hv[n][j] = ((a1[j] * __builtin_amdgcn_rcpf(1.f + __builtin_amdgcn_exp2f(-LOG2E * a1[j]))) * a3[j]) * w; }
                st8(HID + row * DE + u.pn * 128 + wc * 32 + 8 * fq, hv[0], hv[1]); }
    }
};
__device__ __forceinline__ int expert_of_row(LAS int* offs, int row);
struct MoeOrder {
    LAS int* offs; int npn, G, c, lo, hi;
    __device__ __forceinline__ bool next(int i, pg8::Unit& u) const { const int L = lo + i * G + c; if (L >= hi || c < 0) return false;
        const int tile = L / npn, pn = L - tile * npn, e = expert_of_row(offs, tile * 256), lr0 = tile * 256 - offs[e], nv = offs[40 + e] - lr0;
        u.pm = tile; u.pn = pn; u.pb = e * npn + pn; u.rbase = e * ECAP + lr0; u.nvalid = nv < 256 ? nv : 256; return true; }
    __device__ __forceinline__ void a_ready(const pg8::Unit&) const {}
    __device__ __forceinline__ void done(const pg8::Unit&) const {}
};

__device__ __forceinline__ float attn_dmin_unit(const float* qg, const float* kg) {
    const int ln = threadIdx.x & 63; float a = fabsf(qg[ln]), b = fabsf(kg[ln]);
#pragma unroll
    for (int o = 1; o < 64; o <<= 1) { a = fmaxf(a, __shfl_xor(a, o)); b = fmaxf(b, __shfl_xor(b, o)); }
    return 2.02f * (8.f * a * b) + 106.f;
}
__device__ __forceinline__ int attn_jlo(float dmin1, int h, int qb) {
    const float dmin = dmin1 * exp2f((float)(h + 1)); const float lowk = (float)(qb * 128) - dmin;
    return lowk > 0.f ? ((int)lowk) >> 6 : 0;
}
__device__ __forceinline__ void tr_load(const float* W, int N, int item, int lane, float (&v)[32]) {
    const int nblk = N / 32, kb = item / nblk, nb = item % nblk, k0 = 64 * kb, n0 = 32 * nb;
    const float* wp = W + (size_t)(k0 + (lane >> 5)) * N + n0 + (lane & 31);
#pragma unroll
    for (int i = 0; i < 32; ++i) v[i] = wp[(size_t)(2 * i) * N];
}
template <class RM>
__device__ __forceinline__ void tr_store(const float (&v)[32], int N, bf16_t* WT, int ldt, int koff, RM rm, LAS float* scr, int item, int lane) {
    const int nblk = N / 32, kb = item / nblk, nb = item % nblk, k0 = 64 * kb, n0 = 32 * nb;
    { LAS float* sp = scr + (lane >> 5) * 33 + (lane & 31);
#pragma unroll
      for (int i = 0; i < 32; ++i) sp[2 * i * 33] = v[i]; }
    LDS_WAIT(); asm volatile("" ::: "memory");
    const int c = lane & 7;
#pragma unroll
    for (int j = 0; j < 4; ++j) { const int n = (lane >> 3) + 8 * j; const LAS float* s = scr + (8 * c) * 33 + n;
        u32x4 o; o.x = cvtpk(s[0 * 33], s[1 * 33]); o.y = cvtpk(s[2 * 33], s[3 * 33]); o.z = cvtpk(s[4 * 33], s[5 * 33]); o.w = cvtpk(s[6 * 33], s[7 * 33]);
        *(u32x4*)(WT + (size_t)rm(n0 + n) * ldt + koff + k0 + 8 * c) = o; }
    LDS_WAIT(); asm volatile("" ::: "memory");
}
template <class RM>
__device__ __forceinline__ void transpose_item(const float* W, int N, bf16_t* WT, int ldt, int koff, RM rm, LAS float* scr, int item, int lane) {
    float v[32]; tr_load(W, N, item, lane, v); tr_store(v, N, WT, ldt, koff, rm, scr, item, lane);
}
template <class RM>
__device__ __forceinline__ void transpose_block_item(const float* W, int N, int k0, int n0, bf16_t* WT, int ldt, int koff, RM rm, LAS unsigned char* lds, int tid) {
    const int w = tid >> 6, lane = tid & 63;
    f32x4 v[8];
#pragma unroll
    for (int r = 0; r < 8; ++r) v[r] = *(const f32x4*)(W + (size_t)(k0 + 8 * w + r) * N + n0 + 4 * lane);
#pragma unroll
    for (int c = 0; c < 4; ++c) { u32x4 o; o.x = cvtpk(v[0][c], v[1][c]); o.y = cvtpk(v[2][c], v[3][c]); o.z = cvtpk(v[4][c], v[5][c]); o.w = cvtpk(v[6][c], v[7][c]);
        *(LAS u32x4*)(lds + (4 * lane + c) * 144 + 16 * w) = o; }
    __syncthreads();
#pragma unroll
    for (int i = 0; i < 4; ++i) { const int q = tid + 512 * i, row = q >> 3, ch = q & 7;
        *(u32x4*)(WT + (size_t)rm(n0 + row) * ldt + koff + k0 + 8 * ch) = *(const LAS u32x4*)(lds + row * 144 + 16 * ch); }
    __syncthreads();
}
struct RmAdd { int off; __device__ __forceinline__ int operator()(int n) const { return off + n; } };
struct RmW13 { int off; __device__ __forceinline__ int operator()(int n) const { return off + (n >> 7) * 256 + (n & 127); } };

__device__ __forceinline__ void p0_prologue(Frame& F) {
    bf16_t* W1T = (bf16_t*)(F.ws + WS_W1T); bf16_t* WUPT = (bf16_t*)(F.ws + WS_WUPT); bf16_t* WOUTT = (bf16_t*)(F.ws + WS_WOUTT);
    { constexpr int I_A = 16 * 20, I_B = 16 * 8, I_C = 16 * 4; constexpr int NITEMS = I_A + I_B + 3 * I_C;
      for (int it = F.blk; it < NITEMS; it += F.G) { int r = it;
          if (r < I_A) { transpose_block_item(F.a->in[I_WIN], 5120, 64 * (r / 20), 256 * (r % 20), W1T, 1024, 0, RmAdd{0}, F.lds, F.tid); continue; } r -= I_A;
          if (r < I_B) { transpose_block_item(F.a->in[I_WGATE], 2048, 64 * (r / 8), 256 * (r % 8), W1T, 1024, 0, RmAdd{5120}, F.lds, F.tid); continue; } r -= I_B;
          if (r < I_C) { transpose_block_item(F.a->in[I_WUPA], 1024, 64 * (r / 4), 256 * (r % 4), WUPT, 1024, 0, RmAdd{0}, F.lds, F.tid); continue; } r -= I_C;
          if (r < I_C) { transpose_block_item(F.a->in[I_WUPB], 1024, 64 * (r / 4), 256 * (r % 4), WUPT, 1024, 0, RmAdd{1024}, F.lds, F.tid); continue; } r -= I_C;
          transpose_block_item(F.a->in[I_WOUT], 1024, 64 * (r / 4), 256 * (r % 4), WOUTT, 1024, 0, RmAdd{0}, F.lds, F.tid); } }
    { bf16_t* WST = (bf16_t*)(F.ws + WS_WST); const float* ws_ = F.a->in[I_WS];
      for (int i = F.blk * NTHREADS + F.tid; i < 8 * 128 * 128 / 2; i += F.G * NTHREADS) { const int e = 2 * i, s = e & 127, t = (e >> 7) & 127;
          const float a = (s <= t) ? ws_[e] : 0.f, b = (s + 1 <= t) ? ws_[e + 1] : 0.f; *(unsigned*)(WST + e) = cvtpk(a, b); } }
    { float* WRT = (float*)(F.ws + WS_ROUTE + RT_WRT); const float* g2 = F.a->in[I_N2G]; const float* wrg = F.a->in[I_WRG]; const float* wre = F.a->in[I_WRE];
      for (int i = F.blk * NTHREADS + F.tid; i < 48 * 1024; i += F.G * NTHREADS) { const int j = i >> 10, k = i & 1023;
          const float w = j < 4 ? wrg[k * 4 + j] : (j < 36 ? wre[k * 32 + (j - 4)] : 0.f); WRT[i] = g2[k] * w; } }
    if (F.blk == 0) { LAS int* hist = (LAS int*)(F.lds + 136 * 1024); LAS int* gt = hist + 160;
        for (int i = F.tid; i < 320; i += NTHREADS) hist[i] = 0;
        __syncthreads();
        const float dmin1 = attn_dmin_unit(F.a->in[I_QNG], F.a->in[I_KNG]);
        int w[2], jl[2];
#pragma unroll
        for (int q = 0; q < 2; ++q) { const int u = F.tid + q * NTHREADS, qb = u >> 4; jl[q] = attn_jlo(dmin1, u & 7, qb); w[q] = 2 * qb + 2 - jl[q]; atomicAdd((int*)(hist + w[q]), 1); }
        __syncthreads();
        if (F.tid < 64) { int h0 = 0, h1 = 0, h2 = 0; const int i0 = 3 * F.tid;
            if (i0 < 160) h0 = hist[i0]; if (i0 + 1 < 160) h1 = hist[i0 + 1]; if (i0 + 2 < 160) h2 = hist[i0 + 2];
            const int tot = h0 + h1 + h2; int suf = tot;
#pragma unroll
            for (int o = 1; o < 64; o <<= 1) { const int vv = __shfl_down(suf, o); if (F.tid + o < 64) suf += vv; }
            const int above = suf - tot;
            if (i0 + 2 < 160) gt[i0 + 2] = above; if (i0 + 1 < 160) gt[i0 + 1] = above + h2; if (i0 < 160) gt[i0] = above + h2 + h1; }
        __syncthreads();
#pragma unroll
        for (int q = 0; q < 2; ++q) { const int u = F.tid + q * NTHREADS; const int rank = atomicAdd((int*)(gt + w[q]), 1);
            ((int*)(F.ws + WS_ROUTE + RT_ALIST))[rank] = u | (jl[q] << 16); }
        __syncthreads(); }
    { bf16_t* XN = (bf16_t*)(F.ws + WS_XN); const float* x = F.a->in[I_X]; const f32x4* g4 = (const f32x4*)F.a->in[I_N1G] + F.lane;
      for (int m0 = F.gw * 4; m0 < M; m0 += F.NGW * 4) { f32x4 v[4][4];
#pragma unroll
          for (int q = 0; q < 4; ++q) { const f32x4* xr = (const f32x4*)(x + (size_t)(m0 + q) * DM) + F.lane;
#pragma unroll
              for (int j = 0; j < 4; ++j) v[q][j] = xr[64 * j]; }
#pragma unroll
          for (int q = 0; q < 4; ++q) { float s = 0.f;
#pragma unroll
              for (int j = 0; j < 4; ++j) s += (v[q][j][0] * v[q][j][0] + v[q][j][1] * v[q][j][1]) + (v[q][j][2] * v[q][j][2] + v[q][j][3] * v[q][j][3]);
              const float r = rsqrtf(wave_sum(s) * (1.f / DM) + EPS);
#pragma unroll
              for (int j = 0; j < 4; ++j) { const f32x4 g = g4[64 * j]; st4(XN + (size_t)(m0 + q) * DM + 4 * F.lane + 256 * j, (v[q][j] * r) * g); } } } }
}

__device__ __forceinline__ void p1_proj(Frame& F) {
    pg8::Gemm g{(const bf16_t*)(F.ws + WS_XN), (const bf16_t*)(F.ws + WS_W1T), DM, nullptr};
    pg8::StaticOrder S; S.init(M, N1, F.G, F.blk);
    static_assert(WS_VA == WS_U + 32 * MiB && WS_Q == WS_U + 64 * MiB && WS_K == WS_U + 96 * MiB && WS_VB == WS_U + 128 * MiB, "EpiProj layout");
    EpiProj E{F.ws, (bf16_t*)F.out, F.a->in[I_QNG], F.a->in[I_KNG], F.a->in[I_BGATE]};
    pg8::gemm_phase<EpiProj, pg8::StaticOrder, PG8_ALIGN, PG8_SP2, true>(F.lds, g, S, E);
}

__device__ __forceinline__ void p2_mixer_a(Frame& F) {
    const bf16_t* VA = (const bf16_t*)(F.ws + WS_VA); const bf16_t* U = (const bf16_t*)(F.ws + WS_U); bf16_t* YA = (bf16_t*)(F.ws + WS_YA); const bf16_t* WST = (const bf16_t*)(F.ws + WS_WST);
    const float* gv = F.a->in[I_VNG]; const float* bs = F.a->in[I_BS];
    bf16_t* vT = (bf16_t*)F.ldsg;
    bf16_t* wS = (bf16_t*)(F.ldsg + 128 * 136 * 2);
    const int fr = F.lane & 15, fq = F.lane >> 4, wm = F.wid >> 1, wn = F.wid & 1;
    const int s_ = F.tid >> 2, ds = (F.tid & 3) * 32;
    int gstaged = -1;
    bf16x8 v[4];
    if (F.blk < 1024) { const int c = F.blk >> 3, g = F.blk & 7; const bf16_t* src = VA + (size_t)(c * 128 + s_) * DM + g * 128 + ds;
#pragma unroll
        for (int i = 0; i < 4; ++i) v[i] = *(const bf16x8*)(src + 8 * i); }
    for (int L = F.blk; L < 1024; L += F.G) {
        const int c = L >> 3, g = L & 7;
        if (g != gstaged) { __syncthreads();
#pragma unroll
            for (int i = 0; i < 4; ++i) { const int q = F.tid + 512 * i, t = q >> 4, ch = q & 15; *(bf16x8*)(wS + t * 136 + 8 * ch) = *(const bf16x8*)(WST + g * 16384 + t * 128 + 8 * ch); }
            gstaged = g; }
        { float ss = 0.f;
#pragma unroll
          for (int i = 0; i < 4; ++i)
#pragma unroll
              for (int j = 0; j < 8; ++j) { const float x = bf2f(v[i][j]); ss += x * x; }
          ss += __shfl_xor(ss, 1); ss += __shfl_xor(ss, 2);
          const float r = rsqrtf(ss * (1.f / 128.f) + EPS);
#pragma unroll
          for (int i = 0; i < 4; ++i)
#pragma unroll
              for (int j = 0; j < 8; ++j) { const int d = ds + 8 * i + j; const float x = (bf2f(v[i][j]) * r) * gv[g * 128 + d]; vT[d * 136 + s_] = (bf16_t)(cvtpk(x, 0.f) & 0xffffu); } }
        __syncthreads();
        const int Ln = L + F.G;
        if (Ln < 1024) { const bf16_t* src = VA + (size_t)((Ln >> 3) * 128 + s_) * DM + (Ln & 7) * 128 + ds;
#pragma unroll
            for (int i = 0; i < 4; ++i) v[i] = *(const bf16x8*)(src + 8 * i); }
        f32x4 uu[2][4]; float bb[2];
#pragma unroll
        for (int m = 0; m < 2; ++m) { const int t = 32 * wm + 16 * m + fr; bb[m] = bs[g * 128 + t]; const bf16_t* up = U + (size_t)(c * 128 + t) * DM + g * 128 + 64 * wn + 4 * fq;
#pragma unroll
            for (int n = 0; n < 4; ++n) uu[m][n] = ld4(up + 16 * n); }
        const bf16_t* ap = wS + (32 * wm + fr) * 136 + 8 * fq; const bf16_t* bp = vT + (64 * wn + fr) * 136 + 8 * fq;
        f32x4 acc[2][4]; acc_zero(acc);
        wave_gemm(acc, ap, ap + 16 * 136, bp, bp + 16 * 136, bp + 32 * 136, bp + 48 * 136, 32 * (wm + 1));
#pragma unroll
        for (int m = 0; m < 2; ++m) { const int t = 32 * wm + 16 * m + fr; bf16_t* yp = YA + (size_t)(c * 128 + t) * DM + g * 128 + 64 * wn + 4 * fq;
#pragma unroll
            for (int n = 0; n < 4; ++n) st4(yp + 16 * n, uu[m][n] * (acc[m][n] + bb[m])); }
        __syncthreads();
    }
}

namespace att {
constexpr int QBLK = 32, KVBLK = 64, QB = 128, PITCH = 1024;
constexpr int SHM_V = KVBLK * 128 * 2, SHM_K = 2 * KVBLK * 64 * 2;
constexpr int LDS_WSF = 2 * SHM_V + 2 * SHM_K, LDS_XCH = LDS_WSF + NWAVES * 64 * 4, LDS_BYTES = LDS_XCH + 4 * 16 * 4 * 64 * 4;
constexpr float THR2 = 8.f * LOG2E;
#define KSWZ64(row, colB) ((row) * 128 + ((colB) ^ ((((row) >> 1) & 7) << 4)))
__device__ __forceinline__ int v_st(int k, int c) { const int kk = (k & ~0xC) | ((k & 4) << 1) | ((k & 8) >> 1); return ((kk >> 3) * 4 + (c >> 5)) * 512 + ((kk & 7) * 32 + (c & 31)) * 2; }
__device__ __forceinline__ int v_rd_base(int lane) { return ((lane & 3) << 3) | (((lane >> 2) & 3) << 6) | (((lane >> 4) & 1) << 5) | (((lane >> 5) & 1) << 8); }
constexpr int v_rd_off(int d0, int ks, int half) { return d0 * 512 + ks * 4096 + half * 2048; }
__device__ __forceinline__ int crow(int r, int hi) { return (r & 3) + 8 * (r >> 2) + 4 * hi; }

__device__ __forceinline__ void mask_tile(f32x16& p0, f32x16& p1, int dq) {
    const float NEG = -__builtin_inff();
#pragma unroll
    for (int r = 0; r < 16; ++r) { const int c = (r & 3) + 8 * (r >> 2);
        if (dq - c < 0) p0[r] = NEG;
        if (dq - c - 32 < 0) p1[r] = NEG; }
}
__device__ __forceinline__ void partialSM(f32x16& p0, f32x16& p1, float& m_reg, float& alpha) {
    float pmax = __builtin_fmaxf(__builtin_fmaxf(p0[0], p0[1]), p0[2]);
#pragma unroll
    for (int r = 3; r < 15; r += 2) pmax = __builtin_fmaxf(__builtin_fmaxf(pmax, p0[r]), p0[r + 1]);
    pmax = __builtin_fmaxf(__builtin_fmaxf(pmax, p0[15]), p1[0]);
#pragma unroll
    for (int r = 1; r < 15; r += 2) pmax = __builtin_fmaxf(__builtin_fmaxf(pmax, p1[r]), p1[r + 1]);
    pmax = __builtin_fmaxf(pmax, p1[15]);
    { auto rr = __builtin_amdgcn_permlane32_swap(__float_as_uint(pmax), __float_as_uint(pmax), false, false);
      pmax = fmaxf(__uint_as_float(rr[0]), __uint_as_float(rr[1])); }
    alpha = 1.f;
    if (__builtin_expect(!__all(pmax <= THR2), 0)) { asm volatile("" ::: "memory");
        const float d = fmaxf(pmax, 0.f); m_reg += d; alpha = __builtin_amdgcn_exp2f(-d);
#pragma unroll
        for (int r = 0; r < 16; ++r) { p0[r] -= d; p1[r] -= d; } }
#pragma unroll
    for (int r = 0; r < 16; ++r) p0[r] = __builtin_amdgcn_exp2f(p0[r]);
}
__device__ __forceinline__ void finishSM(f32x16& p0, f32x16& p1, float alpha, float& l_reg, bf16x8& pa0, bf16x8& pa1, bf16x8& pa2, bf16x8& pa3) {
#pragma unroll
    for (int r = 0; r < 16; ++r) p1[r] = __builtin_amdgcn_exp2f(p1[r]);
    float ps = 0;
#pragma unroll
    for (int r = 0; r < 16; ++r) ps += p0[r];
#pragma unroll
    for (int r = 0; r < 16; ++r) ps += p1[r];
    { auto rr = __builtin_amdgcn_permlane32_swap(__float_as_uint(ps), __float_as_uint(ps), false, false);
      ps = __uint_as_float(rr[0]) + __uint_as_float(rr[1]); }
    l_reg = l_reg * alpha + ps;
#define PK4(P, B_, OUT) do { unsigned a0 = cvtpk(P[B_+0], P[B_+1]), a1 = cvtpk(P[B_+2], P[B_+3]);                          \
        unsigned b0 = cvtpk(P[B_+4], P[B_+5]), b1 = cvtpk(P[B_+6], P[B_+7]);                                             \
        auto r0 = __builtin_amdgcn_permlane32_swap(a0, b0, false, false); auto r1 = __builtin_amdgcn_permlane32_swap(a1, b1, false, false); \
        u32x4 w = {r0[0], r1[0], r0[1], r1[1]}; OUT = __builtin_bit_cast(bf16x8, w); } while (0)
    PK4(p0, 0, pa0); PK4(p0, 8, pa1); PK4(p1, 0, pa2); PK4(p1, 8, pa3);
#undef PK4
}
template <int KB>
__device__ __forceinline__ void qkt(f32x16& p0, f32x16& p1, const char* Kmap_lds, int r32, int hi, const bf16x8* qr, bf16x8 kx0, bf16x8 kx1, bf16x8 qx) {
    p0 = __builtin_amdgcn_mfma_f32_32x32x16_bf16(kx0, qx, f32x16{}, 0, 0, 0); p1 = __builtin_amdgcn_mfma_f32_32x32x16_bf16(kx1, qx, f32x16{}, 0, 0, 0);
#pragma unroll
    for (int d0 = 0; d0 < 4; ++d0) { const char* a = Kmap_lds + KB * SHM_K + KSWZ64(r32, (d0 * 16 + hi * 8) * 2);
        const bf16x8 b0 = *reinterpret_cast<const bf16x8*>(a);
        const bf16x8 b1 = *reinterpret_cast<const bf16x8*>(a + 32 * 128);
        p0 = __builtin_amdgcn_mfma_f32_32x32x16_bf16(b0, qr[d0], p0, 0, 0, 0);
        p1 = __builtin_amdgcn_mfma_f32_32x32x16_bf16(b1, qr[d0], p1, 0, 0, 0); }
}
template <int VB>
__device__ __forceinline__ void pv_tile(f32x16* o, int vb0, bf16x8 pa0, bf16x8 pa1, bf16x8 pa2, bf16x8 pa3) {
#define TRRD(dst, off) asm volatile("ds_read_b64_tr_b16 %0, %1 offset:%2" : "=&v"(dst) : "v"(vb0), "i"(off) : "memory")
#define PV_D0(d0) do { s16x4 l0, l1, l2, l3, h0, h1, h2, h3; constexpr int b_ = VB * SHM_V + v_rd_off(d0, 0, 0); \
        TRRD(l0, b_); TRRD(h0, b_ + 2048); TRRD(l1, b_ + 4096); TRRD(h1, b_ + 6144); TRRD(l2, b_ + 8192); TRRD(h2, b_ + 10240); TRRD(l3, b_ + 12288); TRRD(h3, b_ + 14336); \
        asm volatile("s_waitcnt lgkmcnt(0)" ::: "memory"); SBAR();   \
        o[d0] = __builtin_amdgcn_mfma_f32_32x32x16_bf16(pa0, (bf16x8){l0[0], l0[1], l0[2], l0[3], h0[0], h0[1], h0[2], h0[3]}, o[d0], 0, 0, 0);   \
        o[d0] = __builtin_amdgcn_mfma_f32_32x32x16_bf16(pa1, (bf16x8){l1[0], l1[1], l1[2], l1[3], h1[0], h1[1], h1[2], h1[3]}, o[d0], 0, 0, 0);   \
        o[d0] = __builtin_amdgcn_mfma_f32_32x32x16_bf16(pa2, (bf16x8){l2[0], l2[1], l2[2], l2[3], h2[0], h2[1], h2[2], h2[3]}, o[d0], 0, 0, 0);   \
        o[d0] = __builtin_amdgcn_mfma_f32_32x32x16_bf16(pa3, (bf16x8){l3[0], l3[1], l3[2], l3[3], h3[0], h3[1], h3[2], h3[3]}, o[d0], 0, 0, 0); } while (0)
    PV_D0(0); PV_D0(1); PV_D0(2); PV_D0(3);
#undef PV_D0
#undef TRRD
}

__device__ __forceinline__ bf16x8 qx_of(unsigned sdw, float x) {
    const unsigned h_ = cvtpk(x, 0.f) & 0xffffu; const float r1 = x - __uint_as_float(h_ << 16);
    const unsigned m_ = cvtpk(r1, 0.f) & 0xffffu; const float r2 = r1 - __uint_as_float(m_ << 16);
    return __builtin_bit_cast(bf16x8, (u32x4){sdw, h_ | (m_ << 16), cvtpk(r2, 0.f) & 0xffffu, 0u});
}
struct BlockRef { int base; int P0; int jlo; float slope2; };
#define BR_Q(br) ((const bf16_t*)(wsb + WS_Q) + (br).base)
#define BR_K(br) ((const bf16_t*)(wsb + WS_K) + (br).base)
#define BR_V(br) ((const bf16_t*)(wsb + WS_VB) + (br).base)
#define BR_O(br) ((bf16_t*)(wsb + WS_XN) + (br).base)
struct Seam { bf16x8 qr[4]; bf16x8 st_v0, st_v1, st_k0, st_k1; };
#define VMW() asm volatile("s_waitcnt vmcnt(0)" ::: "memory")
#define VMWN(n) asm volatile("s_waitcnt vmcnt(%0)" :: "i"(n) : "memory")
#define BLD(soff) __builtin_bit_cast(bf16x8, __builtin_amdgcn_raw_buffer_load_b128(rsrc, voff, (int)(soff), 0))
#define SLOAD_H(br, k0) do { const unsigned so_ = (unsigned)((br).base + (k0) * PITCH) * 2u;                                  \
                         S.st_v0 = BLD((unsigned)WS_VB + so_); S.st_v1 = BLD((unsigned)WS_VB + so_ + 32u * PITCH * 2u);              \
                         S.st_k0 = BLD((unsigned)WS_K + so_); S.st_k1 = BLD((unsigned)WS_K + so_ + 32u * PITCH * 2u); } while (0)
#define SWRITE_HK(bf) do { *(bf16x8*)(K_lds + (bf) * SHM_K + kws) = S.st_k0; *(bf16x8*)(K_lds + (bf) * SHM_K + kws + 32 * 128) = S.st_k1; } while (0)
#define SWRITE_HV(bf) do { *(bf16x8*)(V_lds + (bf) * SHM_V + vst0) = S.st_v0; *(bf16x8*)(V_lds + (bf) * SHM_V + vst1) = S.st_v1; } while (0)
#define SWRITE_H(bf) do { SWRITE_HV(bf); SWRITE_HK(bf); } while (0)
__device__ __forceinline__ void attn_prime(const unsigned char* wsb, const BlockRef& cur, char* lds, Seam& S) {
    const int tid = threadIdx.x, wid = __builtin_amdgcn_readfirstlane(tid >> 6), lane = tid & 63, r32 = lane & 31, hi = lane >> 5;
    const int map = wid >> 2, rw = wid & 3;
    const int sr = tid >> 4, sc = (tid & 15) * 8, kws = (sc >> 6) * 8192 + KSWZ64(sr, (sc & 63) * 2); char* K_lds = lds + 2 * SHM_V;
    const int voff = (sr * PITCH + sc) * 2; const __amdgpu_buffer_rsrc_t rsrc = __builtin_amdgcn_make_buffer_rsrc((void*)wsb, 0, 0x10000000, 0x00020000);
    const int kb0 = cur.jlo * KVBLK;
#pragma unroll
    for (int d0 = 0; d0 < 4; ++d0) S.qr[d0] = *(const bf16x8*)(BR_Q(cur) + (size_t)(cur.P0 + rw * QBLK + r32) * PITCH + map * 64 + d0 * 16 + hi * 8);
    SLOAD_H(cur, kb0); VMW(); SWRITE_HK(0);
    __syncthreads();
}
__device__ __forceinline__ void attn_block(unsigned char* wsb, const BlockRef& cur, const BlockRef& nxt, char* lds, Seam& S, float lam, const float* subg) {
    const int tid = threadIdx.x, wid = __builtin_amdgcn_readfirstlane(tid >> 6), lane = tid & 63, r32 = lane & 31, hi = lane >> 5;
    const int map = wid >> 2, rw = wid & 3;
    const int j_lo = cur.jlo, j_hi = cur.P0 / KVBLK + 2, NT = j_hi - j_lo;
    const int kbn = nxt.jlo * KVBLK;
    const int qlo = cur.P0 + rw * QBLK, qm = qlo + r32 - 4 * hi;
    const float slope2 = cur.slope2; const int qpos = qlo + r32;
    unsigned sdw; { const unsigned h_ = cvtpk(slope2, 0.f) & 0xffffu; const float lo_ = slope2 - __uint_as_float(h_ << 16); sdw = h_ | (cvtpk(lo_, 0.f) << 16); }
    bf16x8 kx0, kx1; { const unsigned c0 = cvtpk((float)r32, (float)r32), c1 = cvtpk((float)(r32 + 32), (float)(r32 + 32)), one = hi ? 0u : 0x3f803f80u;
        kx0 = __builtin_bit_cast(bf16x8, (u32x4){hi ? 0u : c0, one, one & 0xffffu, 0u}); kx1 = __builtin_bit_cast(bf16x8, (u32x4){hi ? 0u : c1, one, one & 0xffffu, 0u}); }
    char* V_lds = lds; char* K_lds = lds + 2 * SHM_V; const char* Kmap = K_lds + map * 8192;
    float* ws = (float*)(lds + LDS_WSF) + wid * 64; float* li_l = ws, * al_l = ws + 32;
    float m_reg = 0.f, l_reg = 0; f32x16 o[4] = {};
    const int sr = tid >> 4, sc = (tid & 15) * 8, vst0 = v_st(sr, sc), vst1 = v_st(32 + sr, sc), kws = (sc >> 6) * 8192 + KSWZ64(sr, (sc & 63) * 2);
    const int vb0 = (int)(uintptr_t)V_lds + v_rd_base(lane);
    const int voff = (sr * PITCH + sc) * 2; const __amdgpu_buffer_rsrc_t rsrc = __builtin_amdgcn_make_buffer_rsrc((void*)wsb, 0, 0x10000000, 0x00020000);
#define RESC(a) do { if (__any((a) < 1.f)) { if (hi == 0) al_l[r32] = (a); asm volatile("s_waitcnt lgkmcnt(0)" ::: "memory");              \
                     _Pragma("unroll") for (int d_ = 0; d_ < 4; ++d_) _Pragma("unroll") for (int r = 0; r < 16; ++r) o[d_][r] *= al_l[crow(r, hi)]; } } while (0)
#define KBASE(t) ((j_lo + (t)) * KVBLK)
#define MASKT(P0_, P1_, t) do { const int kb_ = KBASE(t); if (kb_ + KVBLK - 1 > qlo) { asm volatile("" ::: "memory"); mask_tile(P0_, P1_, qm - kb_); } } while (0)
#define QX(t) qx_of(sdw, slope2 * (float)(KBASE(t) - qpos) - m_reg)
#define SEAM_K0() do { VMWN(4); SWRITE_HK(0); SBAR(); } while (0)
    f32x16 pA0, pA1, pB0, pB1; float alA, alB; bf16x8 pa0, pa1, pa2, pa3;
    SWRITE_HV(0); SBAR();
    if (NT > 1) { SLOAD_H(cur, KBASE(1)); }
    SBAR(); qkt<0>(pA0, pA1, Kmap, r32, hi, S.qr, kx0, kx1, QX(0));
    MASKT(pA0, pA1, 0); partialSM(pA0, pA1, m_reg, alA);
    if (NT > 1) { VMW(); SWRITE_H(1); }
    __syncthreads();
#define HALF_STEP(PX0, PX1, alX, PY0, PY1, alY, t, KB, VB, SB) do {                                                      \
        SBAR(); qkt<KB>(PX0, PX1, Kmap, r32, hi, S.qr, kx0, kx1, QX(t));                                                           \
        finishSM(PY0, PY1, alY, l_reg, pa0, pa1, pa2, pa3); SBAR();                                                           \
        if ((t) + 1 < NT) { SLOAD_H(cur, KBASE((t) + 1)); SBAR(); }                                               \
        pv_tile<VB>(o, vb0, pa0, pa1, pa2, pa3); MASKT(PX0, PX1, (t)); partialSM(PX0, PX1, m_reg, alX);                                        \
        __syncthreads();                                                                                                      \
        if ((t) + 1 < NT) { VMW(); SWRITE_H(SB); }                                                                          \
        RESC(alX); __syncthreads(); } while (0)
    for (int t = 1; t + 1 < NT; t += 2) {
        HALF_STEP(pB0, pB1, alB, pA0, pA1, alA, t, 1, 0, 0);
        HALF_STEP(pA0, pA1, alA, pB0, pB1, alB, t + 1, 0, 1, 1);
    }
    const bool even = (NT & 1) == 0;
    if (even) { SBAR(); qkt<1>(pB0, pB1, Kmap, r32, hi, S.qr, kx0, kx1, QX(NT - 1)); SBAR(); }
    { const int nmap = map, nrw = rw;
      SLOAD_H(nxt, kbn); SBAR();
#pragma unroll
      for (int d0 = 0; d0 < 4; ++d0) S.qr[d0] = *(const bf16x8*)(BR_Q(nxt) + (size_t)(nxt.P0 + nrw * QBLK + r32) * PITCH + nmap * 64 + d0 * 16 + hi * 8); }
    SBAR();
    finishSM(pA0, pA1, alA, l_reg, pa0, pa1, pa2, pa3); SBAR();
    pv_tile<0>(o, vb0, pa0, pa1, pa2, pa3);
    if (even) { MASKT(pB0, pB1, NT - 1); partialSM(pB0, pB1, m_reg, alB); __syncthreads(); RESC(alB);
        finishSM(pB0, pB1, alB, l_reg, pa0, pa1, pa2, pa3); SBAR(); pv_tile<1>(o, vb0, pa0, pa1, pa2, pa3); }
    SBAR(); SEAM_K0();
    if (hi == 0) li_l[r32] = l_reg; asm volatile("s_waitcnt lgkmcnt(0)" ::: "memory");
    float rli[16];
#pragma unroll
    for (int r = 0; r < 16; ++r) rli[r] = __builtin_amdgcn_rcpf(li_l[crow(r, hi)]);
    float* xch = (float*)(lds + LDS_XCH) + (size_t)rw * (16 * 4 * 64) + lane;
    if (map == 1) {
#pragma unroll
        for (int r = 0; r < 16; ++r)
#pragma unroll
            for (int d0 = 0; d0 < 4; ++d0) xch[(r * 4 + d0) * 64] = o[d0][r] * rli[r];
    }
    __syncthreads();
    if (map == 0) {
        float gsub[4];
#pragma unroll
        for (int d0 = 0; d0 < 4; ++d0) gsub[d0] = subg[d0 * 32 + r32] * (1.f - LAM_INIT);
        int obase = (cur.P0 + rw * QBLK + 4 * hi) * PITCH + r32; asm volatile("" : "+v"(obase));
        bf16_t* Ow = BR_O(cur) + obase;
#pragma unroll
        for (int r = 0; r < 16; ++r) { float d[4]; float ss = 0.f;
#pragma unroll
            for (int d0 = 0; d0 < 4; ++d0) { d[d0] = o[d0][r] * rli[r] - lam * xch[(r * 4 + d0) * 64]; ss += d[d0] * d[d0]; }
            ss += __shfl_xor(ss, 1); ss += __shfl_xor(ss, 2); ss += __shfl_xor(ss, 4); ss += __shfl_xor(ss, 8); ss += __shfl_xor(ss, 16);
            const float rs = rsqrtf(ss * (1.f / 128.f) + EPS); const int orow = (r & 3) + 8 * (r >> 2);
#pragma unroll
            for (int d0 = 0; d0 < 4; ++d0) { const float v = (d[d0] * rs) * gsub[d0]; const float vn = __shfl_xor(v, 1);
                if ((r32 & 1) == 0) *(unsigned*)(Ow + orow * PITCH + d0 * 32) = cvtpk(v, vn); } }
    }
    __syncthreads();
#undef RESC
#undef KBASE
#undef MASKT
#undef QX
#undef SEAM_K0
#undef HALF_STEP
}
#undef BLD
#undef BR_Q
#undef BR_K
#undef BR_V
#undef BR_O
#undef VMW
#undef VMWN
#undef SLOAD_H
#undef SWRITE_HK
#undef SWRITE_HV
#undef SWRITE_H
}


__device__ __forceinline__ att::BlockRef attn_ref(Frame& F, int L) {
    const int ent = ((const int*)(F.ws + WS_ROUTE + RT_ALIST))[L]; const int u = ent & 0xffff, qb = u >> 4, bh = u & 15, b = bh >> 3, h = bh & 7;
    att::BlockRef r; r.base = b * SEQ * 1024 + h * 128;
    r.P0 = qb * 128; r.jlo = ent >> 16; r.slope2 = exp2f(-(float)(h + 1)) * LOG2E;
    return r;
}
__device__ __forceinline__ void p2_attention(Frame& F) {
    const float s1 = wave_sum(F.a->in[I_LQ1][F.lane] * F.a->in[I_LK1][F.lane]), s2 = wave_sum(F.a->in[I_LQ2][F.lane] * F.a->in[I_LK2][F.lane]);
    const float lam = expf(s1) - expf(s2) + LAM_INIT;
    constexpr int NUNITS = 1024;
    volatile LAS int* qs = (volatile LAS int*)(F.lds + 143 * 1024);
    __syncthreads();
    const int v = (F.G % 8 == 0) ? (F.blk % 8) * (F.G / 8) + F.blk / 8 : F.blk;
    int L = v, Ln = 2 * F.G - 1 - v;
    if (L >= NUNITS) return;
    att::BlockRef cur = attn_ref(F, L); att::Seam S;
    att::attn_prime(F.ws, cur, F.ldsg, S);
    for (;;) {
        const bool last = Ln >= NUNITS;
        int nn = 0; if (F.tid == 0 && !last) nn = 2 * F.G + (int)atomicAdd(F.ctl + CW_AQ, 1u);
        const att::BlockRef nxt = last ? cur : attn_ref(F, Ln);
        att::attn_block(F.ws, cur, nxt, F.ldsg, S, lam, F.a->in[I_SUBG]);
        if (last) break;
        if (F.tid == 0) qs[0] = nn;
        __syncthreads();
        cur = nxt; Ln = qs[0];
        __syncthreads();
    }
}

__device__ __forceinline__ void p3_merged(Frame& F) {
    pg8::StaticOrder S; S.init(M, DM, F.G, F.blk);
    { pg8::Gemm g{(const bf16_t*)(F.ws + WS_YA), (const bf16_t*)(F.ws + WS_WUPT), DM, nullptr}; EpiGateT E{(const bf16_t*)F.out, (bf16_t*)(F.ws + WS_T)};
      pg8::gemm_phase<EpiGateT, pg8::StaticOrder, PG8_ALIGN, PG8_SP2, false>(F.lds, g, S, E); }
    { pg8::Gemm g{(const bf16_t*)(F.ws + WS_XN), (const bf16_t*)(F.ws + WS_WUPT) + 1024 * 1024, DM, nullptr}; EpiMerged E{(const bf16_t*)F.out, (const bf16_t*)(F.ws + WS_T), (bf16_t*)(F.ws + WS_Q)};
      pg8::gemm_phase<EpiMerged, pg8::StaticOrder, PG8_ALIGN, PG8_SP2, false>(F.lds, g, S, E); }
}
__device__ __forceinline__ void p4_out(Frame& F) {
    pg8::StaticOrder S; S.init(M, DM, F.G, F.blk);
    pg8::Gemm g{(const bf16_t*)(F.ws + WS_Q), (const bf16_t*)(F.ws + WS_WOUTT), DM, nullptr}; EpiOut E{F.a->in[I_X], F.out, F.a->in[I_N2G], (bf16_t*)(F.ws + WS_H2)};
    pg8::gemm_phase<EpiOut, pg8::StaticOrder, PG8_ALIGN, PG8_SP2, false>(F.lds, g, S, E);
}
__device__ __forceinline__ void h2_row(Frame& F, int t, f32x4 (&h)[4]) {
    const f32x4* xr = (const f32x4*)(F.out + (size_t)t * DM) + F.lane; const f32x4* g4 = (const f32x4*)F.a->in[I_N2G] + F.lane;
    float s = 0.f;
#pragma unroll
    for (int j = 0; j < 4; ++j) { h[j] = xr[64 * j]; s += (h[j][0] * h[j][0] + h[j][1] * h[j][1]) + (h[j][2] * h[j][2] + h[j][3] * h[j][3]); }
    const float r = rsqrtf(wave_sum(s) * (1.f / DM) + EPS);
#pragma unroll
    for (int j = 0; j < 4; ++j) h[j] = (h[j] * r) * g4[64 * j];
}
__device__ __forceinline__ void p5_router(Frame& F) {
    const float* WRT = (const float*)(F.ws + WS_ROUTE + RT_WRT); const float* brg = F.a->in[I_BRG]; const float* bre = F.a->in[I_BRE];
    int* tokpos = (int*)(F.ws + WS_ROUTE + RT_TOKPOS); float* roww = (float*)(F.ws + WS_ROUTE + RT_ROWW); float* rowrr = (float*)(F.ws + WS_ROUTE + RT_ROWRR); int* rowtok = (int*)(F.ws + WS_ROUTE + RT_ROWTOK);
    LAS float* lg = (LAS float*)(F.lds + 128 * 1024 + (F.wid & 3) * 3072);
    const int i16 = F.lane & 15, kq = F.lane >> 4;
    if (F.wid < 4)
    for (int task = F.blk * 4 + F.wid; task < M / 16; task += F.G * 4) { const int t0 = task * 16;
        const float* xp = F.out + (size_t)(t0 + i16) * DM + 4 * kq; const float* wp = WRT + (size_t)i16 * DM + 4 * kq;
        f32x4 acc0 = {0.f, 0.f, 0.f, 0.f}, acc1 = acc0, acc2 = acc0; float ss = 0.f;
#pragma unroll 4
        for (int s = 0; s < 64; ++s) { const f32x4 xa = *(const f32x4*)(xp + 16 * s);
            const f32x4 w0 = *(const f32x4*)(wp + 16 * s), w1 = *(const f32x4*)(wp + 16 * DM + 16 * s), w2 = *(const f32x4*)(wp + 32 * DM + 16 * s);
            ss += (xa[0] * xa[0] + xa[1] * xa[1]) + (xa[2] * xa[2] + xa[3] * xa[3]);
#pragma unroll
            for (int e = 0; e < 4; ++e) { acc0 = __builtin_amdgcn_mfma_f32_16x16x4f32(xa[e], w0[e], acc0, 0, 0, 0); acc1 = __builtin_amdgcn_mfma_f32_16x16x4f32(xa[e], w1[e], acc1, 0, 0, 0);
                acc2 = __builtin_amdgcn_mfma_f32_16x16x4f32(xa[e], w2[e], acc2, 0, 0, 0); } }
        ss += __shfl_xor(ss, 16); ss += __shfl_xor(ss, 32);
        const float rr = rsqrtf(ss * (1.f / DM) + EPS);
#pragma unroll
        for (int reg = 0; reg < 4; ++reg) { LAS float* p = lg + (4 * kq + reg) * 48 + i16; p[0] = acc0[reg]; p[16] = acc1[reg]; p[32] = acc2[reg]; }
        LDS_WAIT(); asm volatile("" ::: "memory");
        if (F.lane < 16) { const LAS float* p = lg + F.lane * 48;
            float gl[4];
#pragma unroll
            for (int i = 0; i < 4; ++i) gl[i] = p[i] * rr + brg[i];
            int g = 0; float gm = gl[0];
#pragma unroll
            for (int i = 1; i < 4; ++i) if (gl[i] > gm) { gm = gl[i]; g = i; }
            float gs = 0.f;
#pragma unroll
            for (int i = 0; i < 4; ++i) gs += expf(gl[i] - gm);
            const float ggate = 1.f / gs;
            float el[8];
#pragma unroll
            for (int i = 0; i < 8; ++i) el[i] = p[4 + g * 8 + i] * rr + bre[g * 8 + i];
            int i1 = 0; float v1 = el[0];
#pragma unroll
            for (int i = 1; i < 8; ++i) if (el[i] > v1) { v1 = el[i]; i1 = i; }
            int i2 = -1; float v2 = -__builtin_inff();
#pragma unroll
            for (int i = 0; i < 8; ++i) if (i != i1 && el[i] > v2) { v2 = el[i]; i2 = i; }
            const float a = expf(v2 - v1), w1 = 1.f / (1.f + a), w2 = a / (1.f + a);
            const int t = t0 + F.lane, e1 = g * 8 + i1, e2 = g * 8 + i2;
            const int r1 = (int)atomicAdd(F.ctl + CW_CNT + e1 * CW_CNT_STRIDE, 1u), r2 = (int)atomicAdd(F.ctl + CW_CNT + e2 * CW_CNT_STRIDE, 1u);
            rowtok[e1 * ECAP + r1] = t; roww[e1 * ECAP + r1] = ggate * w1; rowrr[e1 * ECAP + r1] = rr; rowtok[e2 * ECAP + r2] = t; roww[e2 * ECAP + r2] = ggate * w2; rowrr[e2 * ECAP + r2] = rr;
            tokpos[2 * t] = (e1 << ECAP_LOG) | r1; tokpos[2 * t + 1] = (e2 << ECAP_LOG) | r2; }
        LDS_WAIT(); asm volatile("" ::: "memory");
    }
    if (F.wid >= 4) {
      LAS float* scr = (LAS float*)(F.lds + (F.wid - 4) * 32768);
      bf16_t* W13T = (bf16_t*)(F.ws + WS_W13T); bf16_t* W2T = (bf16_t*)(F.ws + WS_W2T);
#define XW_SRC(it_) (((it_) % 384) < 128 ? F.a->in[I_W1] + (size_t)((it_) / 384) * 1024 * 256 : ((it_) % 384) < 256 ? F.a->in[I_W3] + (size_t)((it_) / 384) * 1024 * 256 : F.a->in[I_W2] + (size_t)((it_) / 384) * 256 * 1024)
#define XW_STORE(v_, it_, scr_) do { const int e_ = (it_) / 384, r_ = (it_) % 384; \
          if (r_ < 128) tr_store(v_, 256, W13T, 1024, 0, RmW13{e_ * 512}, scr_, r_, F.lane); \
          else if (r_ < 256) tr_store(v_, 256, W13T, 1024, 0, RmW13{e_ * 512 + 128}, scr_, r_ - 128, F.lane); \
          else tr_store(v_, 1024, W2T, 256, 0, RmAdd{e_ * 1024}, scr_, r_ - 256, F.lane); } while (0)
      const int stride = F.G * 4;
      for (int it = F.blk * 4 + (F.wid - 4); it < NE * 384; it += 2 * stride) { const int it2 = it + stride; const bool two = it2 < NE * 384;
          float va[32], vb[32];
          { const int r = it % 384; tr_load(XW_SRC(it), r < 256 ? 256 : 1024, r < 128 ? r : r < 256 ? r - 128 : r - 256, F.lane, va); }
          if (two) { const int r = it2 % 384; tr_load(XW_SRC(it2), r < 256 ? 256 : 1024, r < 128 ? r : r < 256 ? r - 128 : r - 256, F.lane, vb); }
          XW_STORE(va, it, scr);
          if (two) XW_STORE(vb, it2, scr + 64 * 33); }
#undef XW_SRC
#undef XW_STORE
    }
}
__device__ __forceinline__ void moe_offsets(Frame& F, LAS int* offs) {
    __syncthreads();
    if (F.tid < 64) { const int c = F.tid < NE ? (int)__hip_atomic_load(F.ctl + CW_CNT + F.tid * CW_CNT_STRIDE, __ATOMIC_RELAXED, __HIP_MEMORY_SCOPE_AGENT) : 0; const int p = (c + 255) & ~255; int incl = p;
#pragma unroll
        for (int o = 1; o < 32; o <<= 1) { const int v = __shfl_up(incl, o); if ((F.tid & 63) >= o) incl += v; }
        if (F.tid < NE) { offs[F.tid] = incl - p; offs[40 + F.tid] = c; for (int t = (incl - p) >> 8; t < (incl >> 8); ++t) offs[80 + t] = F.tid; } if (F.tid == NE - 1) offs[NE] = incl; }
    __syncthreads();
}
__device__ __forceinline__ int expert_of_row(LAS int* offs, int row) { return offs[80 + (row >> 8)]; }
__device__ __forceinline__ void moe_gemm1(Frame& F, LAS int* offs, int G, int c, int lo, int hi) {
    MoeOrder S{offs, 2, G, c, lo, hi};
    pg8::Gemm g{(const bf16_t*)(F.ws + WS_H2), (const bf16_t*)(F.ws + WS_W13T), DM, (const int*)(F.ws + WS_ROUTE + RT_ROWTOK)}; EpiSwiglu E{(const float*)(F.ws + WS_ROUTE + RT_ROWW), (const float*)(F.ws + WS_ROUTE + RT_ROWRR), (bf16_t*)(F.ws + WS_HID)};
    pg8::gemm_phase<EpiSwiglu, MoeOrder, PG8_ALIGN, PG8_SP2, false, true>(F.lds, g, S, E);
}
__device__ __forceinline__ void moe_gemm2(Frame& F, LAS int* offs, int G, int c, int lo, int hi) {
    MoeOrder S{offs, 4, G, c, lo, hi};
    int kde = DE; asm volatile("" : "+s"(kde));
    pg8::Gemm g{(const bf16_t*)(F.ws + WS_HID), (const bf16_t*)(F.ws + WS_W2T), kde, nullptr}; EpiY E{(bf16_t*)(F.ws + WS_YBUF)};
    pg8::gemm_phase<EpiY, MoeOrder, PG8_ALIGN, PG8_SP2, false>(F.lds, g, S, E);
}
__device__ __forceinline__ void p7_moe_a(Frame& F) {
    LAS int* offs = (LAS int*)(F.lds + 140 * 1024); moe_offsets(F, offs);
    const int n1 = (offs[NE] / 256) * 2;
    moe_gemm1(F, offs, F.G, F.blk, 0, n1 < F.G ? n1 : F.G);
}
__device__ __forceinline__ void p7_moe_b(Frame& F) {
    LAS int* offs = (LAS int*)(F.lds + 140 * 1024); moe_offsets(F, offs);
    const int T = offs[NE] / 256, n1 = T * 2; int nrem = n1 - F.G; if (nrem < 0) nrem = 0; if (nrem > F.G / 2) nrem = F.G / 2;
    const int t2 = (T < F.G / 2 ? T : F.G / 2) * 4;
    if (F.blk < nrem) moe_gemm1(F, offs, nrem, F.blk, F.G, n1);
    else moe_gemm2(F, offs, F.G - nrem, F.blk - nrem, 0, t2);
}
__device__ __forceinline__ void p8_moe_c(Frame& F) {
    LAS int* offs = (LAS int*)(F.lds + 140 * 1024); moe_offsets(F, offs);
    const int T = offs[NE] / 256;
    moe_gemm2(F, offs, F.G, F.blk, (T < F.G / 2 ? T : F.G / 2) * 4, T * 4);
}
__device__ __forceinline__ void p9_combine(Frame& F) {
    LAS int* offs = (LAS int*)(F.lds + 140 * 1024);
    moe_offsets(F, offs);
    const bf16_t* YB = (const bf16_t*)(F.ws + WS_YBUF); const int* tokpos = (const int*)(F.ws + WS_ROUTE + RT_TOKPOS);
    for (int t0 = F.gw * 4; t0 < M; t0 += F.NGW * 4) { int p[4][2];
#pragma unroll
        for (int q = 0; q < 4; ++q) { const int a0 = tokpos[2 * (t0 + q)], a1 = tokpos[2 * (t0 + q) + 1]; p[q][0] = offs[a0 >> ECAP_LOG] + (a0 & (ECAP - 1)); p[q][1] = offs[a1 >> ECAP_LOG] + (a1 & (ECAP - 1)); }
        f32x4 xv[4][4];
#pragma unroll
        for (int q = 0; q < 4; ++q)
#pragma unroll
            for (int j = 0; j < 4; ++j) xv[q][j] = ((const f32x4*)(F.out + (size_t)(t0 + q) * DM) + F.lane)[64 * j];
#pragma unroll
        for (int q = 0; q < 4; ++q) {
            f32x4 a[4], b[4];
#pragma unroll
            for (int j = 0; j < 4; ++j) { a[j] = ld4(YB + (size_t)p[q][0] * DM + 4 * F.lane + 256 * j); b[j] = ld4(YB + (size_t)p[q][1] * DM + 4 * F.lane + 256 * j); }
#pragma unroll
            for (int j = 0; j < 4; ++j) ((f32x4*)(F.out + (size_t)(t0 + q) * DM) + F.lane)[64 * j] = xv[q][j] + (a[j] + b[j]); } }
}

#define XB_TMO      128
#define XB_XCNT(j)  (256  + 64 * (j))
#define XB_XSUB(j)  (1280 + 64 * (j))
#define XB_XGEN(j)  (2304 + 64 * (j))
#define XB_TOP      3328
#define XB_TOPGEN   3392
#define XCD_BAR_WORDS 3456
#define XB_SPIN_CAP (1u << 22)

__device__ __forceinline__ unsigned xb_ld(unsigned* p)              { return __hip_atomic_load(p, __ATOMIC_RELAXED, __HIP_MEMORY_SCOPE_AGENT); }
__device__ __forceinline__ unsigned xb_add(unsigned* p, unsigned v) { return __hip_atomic_fetch_add(p, v, __ATOMIC_RELAXED, __HIP_MEMORY_SCOPE_AGENT); }
__device__ __forceinline__ unsigned xb_xcc_id() { return (unsigned)__builtin_amdgcn_s_getreg((3 << 11) | 20) & 0xFu; }
#define XB_SPIN(cond, bar) do { unsigned _sp = 0; while (cond) { __builtin_amdgcn_s_sleep(1); \
    if ((++_sp & 255u) == 0u) { if (xb_ld(&(bar)[XB_TMO])) break; if (_sp > XB_SPIN_CAP) { atomicAdd(&(bar)[XB_TMO], 1u); break; } } } } while (0)

struct XcdBarrier {
    unsigned* bar; unsigned x;
    volatile LAS unsigned* st;
};

__device__ __forceinline__ XcdBarrier xcd_barrier_post(unsigned* bar, volatile LAS unsigned* st) {
    XcdBarrier b; b.bar = bar; b.x = xb_xcc_id(); b.st = st;
    if (threadIdx.x == 0) (void)xb_add(&bar[XB_XCNT(b.x)], 1u);
    return b;
}
__device__ __forceinline__ void xcd_barrier_complete(unsigned* bar, unsigned x, unsigned& nloc, unsigned& nx) {
    const unsigned G = gridDim.x * gridDim.y * gridDim.z;
    unsigned sum, cnt, mine, sp = 0u;
    for (;;) {
        sum = 0u; cnt = 0u; mine = 0u;
#pragma unroll
        for (unsigned j = 0; j < 16; ++j) { const unsigned c = xb_ld(&bar[XB_XCNT(j)]); sum += c; cnt += (c > 0u) ? 1u : 0u; mine = (j == x) ? c : mine; }
        if (sum == G) break;
        __builtin_amdgcn_s_sleep(1);
        if ((++sp & 255u) == 0u) { if (xb_ld(&bar[XB_TMO])) break; if (sp > XB_SPIN_CAP) { atomicAdd(&bar[XB_TMO], 1u); break; } }
    }
    nloc = mine > 0u ? mine : 1u; nx = cnt > 0u ? cnt : 1u;
}

__device__ __forceinline__ void xcd_barrier(const XcdBarrier& b) {
    asm volatile("s_waitcnt vmcnt(0)" ::: "memory");
    __syncthreads();
    if (threadIdx.x == 0) {
        unsigned* bar = b.bar;
        __builtin_amdgcn_s_waitcnt(0);
        unsigned nloc = b.st[0], nx = b.st[1];
        if (nloc == 0u) { xcd_barrier_complete(bar, b.x, nloc, nx); b.st[0] = nloc; b.st[1] = nx; }
        const unsigned old = xb_add(&bar[XB_XSUB(b.x)], 1u);
        const unsigned gen = old / nloc;
        if (old + 1u == (gen + 1u) * nloc) {
            __builtin_amdgcn_fence(__ATOMIC_RELEASE, "agent");
            asm volatile("s_waitcnt vmcnt(0)" ::: "memory");
            const unsigned og = xb_add(&bar[XB_TOP], 1u);
            const unsigned tg = og / nx;
            if (og + 1u == (tg + 1u) * nx) xb_add(&bar[XB_TOPGEN], 1u);
            else XB_SPIN(xb_ld(&bar[XB_TOPGEN]) == tg, bar);
            __builtin_amdgcn_fence(__ATOMIC_ACQUIRE, "agent");
            xb_add(&bar[XB_XGEN(b.x)], 1u);
            asm volatile("s_waitcnt vmcnt(0)" ::: "memory");
        } else {
            XB_SPIN(xb_ld(&bar[XB_XGEN(b.x)]) == gen, bar);
            __builtin_amdgcn_fence(__ATOMIC_ACQUIRE, "agent");
            asm volatile("s_waitcnt vmcnt(0)" ::: "memory");
        }
    }
    __syncthreads();
}
constexpr int LDS_BYTES = 147456;
__global__ void __launch_bounds__(NTHREADS, 2) fwd_kernel(Args args) {
    extern __shared__ __attribute__((aligned(16))) unsigned char lds[];
    Frame F;
    F.lds = (LAS unsigned char*)lds; F.ldsg = (char*)lds;
    F.tid = threadIdx.x; F.lane = F.tid & 63; F.wid = __builtin_amdgcn_readfirstlane(F.tid >> 6);
    F.blk = blockIdx.x; F.G = gridDim.x; F.gw = F.blk * NWAVES + F.wid; F.NGW = F.G * NWAVES;
    F.a = &args;
    F.out = args.out; F.ws = args.ws; F.ctl = (unsigned*)(args.ws + WS_CTL);
    const int lo = args.ph_lo, hi = args.ph_hi;
#if MK_ONE_LAUNCH
    cg::grid_group grid = cg::this_grid();
    volatile LAS unsigned* bst = (volatile LAS unsigned*)(F.lds + 144 * 1024 - 16);
    if (F.tid < 2) bst[F.tid] = 0u;
    __syncthreads();
    const XcdBarrier bar = xcd_barrier_post(F.ctl + CW_BAR, bst);
#define SEAM(k) do { if (lo <= (k) && (k) + 1 < hi) { xcd_barrier(bar); } asm volatile("" : "+v"(F.tid), "+v"(F.lane)); } while (0)
    if (hi > NPHASE) grid.sync();
#else
#define SEAM(k) do { } while (0)
#endif
#define IN(k) (lo <= (k) && (k) < hi)
    if (IN(0)) { p0_prologue(F); } SEAM(0);
    if (IN(1)) { p1_proj(F); } SEAM(1);
    if (IN(2)) { p2_mixer_a(F); p2_attention(F); } SEAM(2);
    if (IN(3)) { p3_merged(F); } SEAM(3);
    if (IN(4)) { p4_out(F); } SEAM(4);
    if (IN(5)) { p5_router(F); } SEAM(5);
    if (IN(6)) { p7_moe_a(F); } SEAM(6);
    if (IN(7)) { p7_moe_b(F); } SEAM(7);
    if (IN(8)) { p8_moe_c(F); } SEAM(8);
    if (IN(9)) { p9_combine(F); }
#undef IN
#undef SEAM
}

extern "C" void kernel_launch(void* const* d_in, const int* in_sizes, int n_in, void* d_out, int out_size, void* d_ws, size_t ws_size, hipStream_t stream) {
    static int grid = 0;
    if (grid == 0) {
        if (n_in != 26 || out_size != M * DM || ws_size < WS_END) { fprintf(stderr, "kernel_launch: unexpected shapes (n_in %d out %d ws %zu)\n", n_in, out_size, ws_size); grid = -1; return; }
        int dev = 0, cus = 0, per_cu = 0;
        (void)hipGetDevice(&dev); (void)hipDeviceGetAttribute(&cus, hipDeviceAttributeMultiprocessorCount, dev);
        if (hipFuncSetAttribute((const void*)fwd_kernel, hipFuncAttributeMaxDynamicSharedMemorySize, LDS_BYTES) != hipSuccess) { fprintf(stderr, "kernel_launch: hipFuncSetAttribute failed\n"); grid = -1; return; }
        if (hipOccupancyMaxActiveBlocksPerMultiprocessor(&per_cu, (const void*)fwd_kernel, NTHREADS, LDS_BYTES) != hipSuccess || per_cu < 1) { fprintf(stderr, "kernel_launch: occupancy query says %d\n", per_cu); per_cu = 1; }
        (void)hipGetLastError();
        grid = cus;
    }
    if (grid < 0) return;
    (void)hipMemsetAsync((char*)d_ws + WS_CTL, 0, CTL_ZERO_BYTES, stream);
    Args a{};
    for (int i = 0; i < 26; ++i) a.in[i] = (const float*)d_in[i];
    a.out = (float*)d_out; a.ws = (unsigned char*)d_ws;
#if MK_ONE_LAUNCH
    a.ph_lo = 0; a.ph_hi = NPHASE;
    void* kargs[] = {&a};
    hipError_t e = hipLaunchCooperativeKernel((const void*)fwd_kernel, dim3(grid), dim3(NTHREADS), kargs, LDS_BYTES, stream);
    if (e != hipSuccess) fprintf(stderr, "cooperative launch failed: %s (grid %d)\n", hipGetErrorString(e), grid);
#else
    for (int p = 0; p < NPHASE; ++p) { a.ph_lo = p; a.ph_hi = p + 1; hipLaunchKernelGGL(fwd_kernel, dim3(grid), dim3(NTHREADS), LDS_BYTES, stream, a); }
#endif
}
```

```cpp
#include <hip/hip_runtime.h>
#include <hip/hip_cooperative_groups.h>
#include <cstdio>
#include <cstdint>
namespace cg = cooperative_groups;

#ifndef MK_ONE_LAUNCH
#define MK_ONE_LAUNCH 1
#endif

#define LAS __attribute__((address_space(3)))
typedef unsigned short bf16_t;
typedef short bf16x8 __attribute__((ext_vector_type(8)));
typedef short s16x4 __attribute__((ext_vector_type(4)));
typedef float f32x4 __attribute__((ext_vector_type(4)));
typedef float f32x16 __attribute__((ext_vector_type(16)));
typedef float f32x2 __attribute__((ext_vector_type(2)));
typedef unsigned u32x4 __attribute__((ext_vector_type(4)));
typedef unsigned u32x2 __attribute__((ext_vector_type(2)));
typedef __bf16 bf16x2_t __attribute__((ext_vector_type(2)));

constexpr int NB = 2, SEQ = 8192, DM = 1024, M = NB * SEQ;
constexpr int NH = 8;
constexpr int N1 = 7168;
constexpr int NE = 32, DE = 256;
constexpr float EPS = 1e-6f;
constexpr float LOG2E = 1.4426950408889634f;
constexpr float C2 = 0.125f * LOG2E;
constexpr float LAM_INIT = 0.2f;
constexpr int NWAVES = 8, NTHREADS = 512;
constexpr int NPHASE = 10;
constexpr int ECAP = 16384, ECAP_LOG = 14;

constexpr size_t MiB = 1u << 20;
constexpr size_t WS_CTL = 0;
constexpr size_t CTL_ZERO_BYTES = 65536;
constexpr size_t WS_W1T = 1 * MiB;
constexpr size_t WS_WUPT = 15 * MiB;
constexpr size_t WS_WOUTT = 19 * MiB;
constexpr size_t WS_WST = 21 * MiB;
constexpr size_t WS_ROUTE = 22 * MiB;
constexpr size_t WS_XN = 32 * MiB;
constexpr size_t WS_U = 64 * MiB;
constexpr size_t WS_VA = 96 * MiB;
constexpr size_t WS_Q = 128 * MiB;
constexpr size_t WS_K = 160 * MiB;
constexpr size_t WS_VB = 192 * MiB;
constexpr size_t WS_W13T = 160 * MiB;
constexpr size_t WS_W2T = 192 * MiB;
constexpr size_t WS_HID = 208 * MiB;
constexpr size_t WS_H2 = 32 * MiB;
constexpr size_t WS_YBUF = 64 * MiB;
constexpr size_t WS_YA = 224 * MiB;
constexpr size_t WS_T = 64 * MiB;
constexpr size_t WS_END = 256 * MiB;
constexpr size_t RT_TOKE = 0, RT_TOKW = 256 * 1024, RT_TOKPOS = 512 * 1024, RT_WRT = 1024 * 1024, RT_ALIST = 1536 * 1024, RT_ROWTOK = 2048 * 1024, RT_ROWW = 4096 * 1024, RT_ROWRR = 6144 * 1024;
constexpr int CW_CNT = 8192, CW_CNT_STRIDE = 64, CW_AQ = 512, CW_BAR = 1024;

#define LDS_WAIT() asm volatile("s_waitcnt lgkmcnt(0)" ::: "memory")
#define SBAR() __builtin_amdgcn_sched_barrier(0)
__device__ __forceinline__ unsigned cvtpk(float lo, float hi) { f32x2 v = {lo, hi}; bf16x2_t b = __builtin_convertvector(v, bf16x2_t); return __builtin_bit_cast(unsigned, b); }
__device__ __forceinline__ float bf2f(short b) { return __uint_as_float(((unsigned)(unsigned short)b) << 16); }
__device__ __forceinline__ float wave_sum(float v) {
#pragma unroll
    for (int o = 1; o < 64; o <<= 1) v += __shfl_xor(v, o);
    return v;
}
__device__ __forceinline__ void st4(bf16_t* p, f32x4 v) { u32x2 w; w.x = cvtpk(v[0], v[1]); w.y = cvtpk(v[2], v[3]); *(u32x2*)p = w; }
__device__ __forceinline__ f32x4 ld4(const bf16_t* p) { const u32x2 w = *(const u32x2*)p; f32x4 r; r[0] = __uint_as_float(w.x << 16); r[1] = __uint_as_float(w.x & 0xffff0000u); r[2] = __uint_as_float(w.y << 16); r[3] = __uint_as_float(w.y & 0xffff0000u); return r; }

struct Args { const float* in[26]; float* out; unsigned char* ws; int ph_lo, ph_hi; };

struct Frame {
    LAS unsigned char* lds; char* ldsg;
    int tid, lane, wid, blk, G, gw, NGW;
    const Args* a; float* out; unsigned char* ws; unsigned* ctl;
};
enum { I_X = 0, I_N1G, I_WIN, I_VNG, I_WS, I_BS, I_QNG, I_KNG, I_LQ1, I_LK1, I_LQ2, I_LK2, I_SUBG, I_WUPA, I_WUPB, I_WGATE, I_BGATE, I_WOUT, I_N2G, I_WRG, I_BRG, I_WRE, I_BRE, I_W1, I_W3, I_W2 };

__device__ __forceinline__ void wave_gemm(f32x4 (&acc)[2][4], const bf16_t* ap0, const bf16_t* ap1, const bf16_t* bp0, const bf16_t* bp1, const bf16_t* bp2, const bf16_t* bp3, int K) {
#pragma unroll 2
    for (int k0 = 0; k0 < K; k0 += 32) {
        const bf16x8 a0 = *(const bf16x8*)(ap0 + k0), a1 = *(const bf16x8*)(ap1 + k0);
        const bf16x8 b0 = *(const bf16x8*)(bp0 + k0), b1 = *(const bf16x8*)(bp1 + k0), b2 = *(const bf16x8*)(bp2 + k0), b3 = *(const bf16x8*)(bp3 + k0);
        acc[0][0] = __builtin_amdgcn_mfma_f32_16x16x32_bf16(b0, a0, acc[0][0], 0, 0, 0);
        acc[0][1] = __builtin_amdgcn_mfma_f32_16x16x32_bf16(b1, a0, acc[0][1], 0, 0, 0);
        acc[0][2] = __builtin_amdgcn_mfma_f32_16x16x32_bf16(b2, a0, acc[0][2], 0, 0, 0);
        acc[0][3] = __builtin_amdgcn_mfma_f32_16x16x32_bf16(b3, a0, acc[0][3], 0, 0, 0);
        acc[1][0] = __builtin_amdgcn_mfma_f32_16x16x32_bf16(b0, a1, acc[1][0], 0, 0, 0);
        acc[1][1] = __builtin_amdgcn_mfma_f32_16x16x32_bf16(b1, a1, acc[1][1], 0, 0, 0);
        acc[1][2] = __builtin_amdgcn_mfma_f32_16x16x32_bf16(b2, a1, acc[1][2], 0, 0, 0);
        acc[1][3] = __builtin_amdgcn_mfma_f32_16x16x32_bf16(b3, a1, acc[1][3], 0, 0, 0);
    }
}
__device__ __forceinline__ void acc_zero(f32x4 (&acc)[2][4]) {
#pragma unroll
    for (int m = 0; m < 2; ++m)
#pragma unroll
        for (int n = 0; n < 4; ++n) acc[m][n] = (f32x4){0.f, 0.f, 0.f, 0.f};
}

namespace pg8 {
#define PG8_LAS __attribute__((address_space(3)))
constexpr int BM = 256, BK = 64, HALF = 128, HTB = HALF * BK * 2  , STAGE_BYTES = 8 * HTB, NXCD = 8, WGM = 4;

__host__ __device__ __forceinline__ int lds_byte(int r, int c) { const int st = (r >> 4) * 2 + (c >> 5), rr = r & 15, cc = c & 31, ob = rr * 64 + cc * 2; return st * 1024 + (ob ^ (((ob >> 9) & 1) << 5)); }
__host__ __device__ __forceinline__ void stage_rc(int b, int& R, int& C) { const int st = b / 1024, sb = b % 1024, swz = sb ^ (((sb >> 9) & 1) << 5); R = (st >> 1) * 16 + swz / 64; C = (st & 1) * 32 + (swz % 64) / 2; }
__host__ __device__ __forceinline__ int perm32(int rho) { const int n = rho >> 4, i = rho & 15; return 8 * (i >> 2) + 4 * n + (i & 3); }

struct Unit { int pm, pn, pb, rbase, nvalid; };
struct Gemm { const bf16_t* A; const bf16_t* Bt; int K; const int* rowtok; };

struct StaticOrder {
    int nM, nN, nwg, G, c;
    __host__ __device__ void init(int M, int N, int G_, int c_) { nM = M / BM; nN = N / BM; nwg = nM * nN; G = G_; c = c_; }
    __host__ __device__ bool next(int i, Unit& u) const {
        const long L = (long)i * G + c; if (L >= nwg) return false;
        int wgid = (int)L; { const int q = nwg / NXCD, r = nwg % NXCD, xcd = wgid % NXCD, off = wgid / NXCD; wgid = (xcd < r ? xcd * (q + 1) : r * (q + 1) + (xcd - r) * q) + off; }
        const int nig = WGM * nN, gid = wgid / nig, fm = gid * WGM, gsz = (nM - fm) < WGM ? (nM - fm) : WGM;
        u.pm = fm + ((wgid % nig) % gsz); u.pn = (wgid % nig) / gsz; u.pb = u.pn; u.rbase = 0; u.nvalid = 0; return true;
    }
    __device__ __forceinline__ void a_ready(const Unit&) const {}
    __device__ __forceinline__ void done(const Unit&) const {}
};
template <class Epi, class Sched, bool ALIGN_EPI = false, bool SP2 = false, bool BP64 = false, bool GATHER = false>
__device__ __forceinline__ void gemm_phase(PG8_LAS unsigned char* lds, const Gemm g, const Sched& S, const Epi& E) {
    const int tid = threadIdx.x, wid = __builtin_amdgcn_readfirstlane(tid >> 6), lane = tid & 63, wr = wid >> 2, wc = wid & 3, fr = lane & 15, fq = lane >> 4;
    const int K = g.K, nt = K / BK;
    unsigned voffA[2], voffB[2];
#pragma unroll
    for (int i = 0; i < 2; ++i) { int R, C; stage_rc(tid * 16 + i * 8192, R, C); const int Rp = Epi::PERM ? ((R & ~31) + perm32(R & 31)) : R; const int Rb = BP64 ? (64 * (Rp >> 5) + (Rp & 31)) : Rp;
        voffA[i] = (unsigned)(R * K + C) * 2u; voffB[i] = (unsigned)(Rb * K + C) * 2u; }
    const size_t kstep = (size_t)(BK * 2);
    const size_t hstep = (size_t)HALF * K * 2;
    const size_t tstep = 2 * hstep;
    const size_t bhs = BP64 ? (size_t)32 * K * 2 : hstep;
    const unsigned ldsw = (unsigned)wid * 1024u;
    const int aoff = lds_byte(wr * 64 + fr, fq * 8), boff = lds_byte(wc * 32 + fr, fq * 8);
#define PG8_SA(b, h) (((b) * 2 + (h)) * HTB)
#define PG8_SB(b, h) ((4 + (b) * 2 + (h)) * HTB)
#define PG8_STAGE(bufoff, gbase, voff) do { _Pragma("unroll") for (int _i = 0; _i < 2; ++_i) \
        __builtin_amdgcn_global_load_lds((const unsigned*)((const char*)(gbase) + (voff)[_i]), (PG8_LAS unsigned*)(lds + (bufoff) + ldsw + _i * 8192), 16, 0, 0); } while (0)
#define PG8_LDA(dst, b, h) do { _Pragma("unroll") for (int m = 0; m < 4; ++m) _Pragma("unroll") for (int k = 0; k < 2; ++k) dst[m][k] = *(const PG8_LAS bf16x8*)(lds + PG8_SA(b, h) + aoff + m * 2048 + k * 1024); } while (0)
#define PG8_LDB(dst, b, h) do { _Pragma("unroll") for (int n = 0; n < 2; ++n) _Pragma("unroll") for (int k = 0; k < 2; ++k) dst[n][k] = *(const PG8_LAS bf16x8*)(lds + PG8_SB(b, h) + boff + n * 2048 + k * 1024); } while (0)
#define PG8_MMA(ai, bj, At, Bt) do { __builtin_amdgcn_s_setprio(1); _Pragma("unroll") for (int m = 0; m < 4; ++m) _Pragma("unroll") for (int n = 0; n < 2; ++n) _Pragma("unroll") for (int k = 0; k < 2; ++k) \
        acc[ai][bj][m][n] = __builtin_amdgcn_mfma_f32_16x16x32_bf16(Bt[n][k], At[m][k], acc[ai][bj][m][n], 0, 0, 0); __builtin_amdgcn_s_setprio(0); } while (0)
#define PG8_WAIT_V(n) asm volatile("s_waitcnt vmcnt(" #n ")" ::: "memory")
#define PG8_WAIT_L(n) asm volatile("s_waitcnt lgkmcnt(" #n ")" ::: "memory")
#define PG8_BAR __builtin_amdgcn_s_barrier()
#define PG8_SCHED __builtin_amdgcn_sched_barrier(0)
    Unit cur, nxt; int ui = 0;
    if (!S.next(0, cur)) return;
    static_assert(!GATHER || SP2, "GATHER is written for the SP2 loop");
    unsigned vA0[2] = {0u, 0u}, vA1[2] = {0u, 0u}, nvA0[2] = {0u, 0u}, nvA1[2] = {0u, 0u};
#define PG8_GLOAD(u_, d0_, d1_) do { _Pragma("unroll") for (int _i = 0; _i < 2; ++_i) { int R_, C_; stage_rc(tid * 16 + _i * 8192, R_, C_); \
        const int t0_ = R_ < (u_).nvalid ? g.rowtok[(u_).rbase + R_] : 0, t1_ = HALF + R_ < (u_).nvalid ? g.rowtok[(u_).rbase + HALF + R_] : 0; d0_[_i] = (unsigned)(t0_ * K + C_) * 2u; d1_[_i] = (unsigned)(t1_ * K + C_) * 2u; } } while (0)
#define PG8_STAGE_A(bufoff, ptr, half, vcur0, vcur1) do { if constexpr (GATHER) { PG8_STAGE(bufoff, ptr, (half) ? vcur1 : vcur0); } else { PG8_STAGE(bufoff, (ptr) + ((half) ? hstep : (size_t)0), voffA); } } while (0)
    if constexpr (GATHER) PG8_GLOAD(cur, vA0, vA1);
    f32x4 acc[2][2][4][2];
#pragma unroll
    for (int a = 0; a < 2; ++a)
#pragma unroll
        for (int b = 0; b < 2; ++b)
#pragma unroll
            for (int m = 0; m < 4; ++m)
#pragma unroll
                for (int n = 0; n < 2; ++n) acc[a][b][m][n] = (f32x4){0.f, 0.f, 0.f, 0.f};
    bf16x8 At[4][2], B0[2][2], B1[2][2];
    const char* cA = (const char*)g.A + (GATHER ? (size_t)0 : (size_t)cur.pm * tstep); const char* cB = (const char*)g.Bt + (size_t)cur.pb * tstep;
    S.a_ready(cur);
    if constexpr (SP2) {
        PG8_STAGE(PG8_SB(0, 0), cB, voffB); PG8_STAGE(PG8_SB(0, 1), cB + bhs, voffB); PG8_STAGE_A(PG8_SA(0, 0), cA, 0, vA0, vA1); PG8_STAGE_A(PG8_SA(0, 1), cA, 1, vA0, vA1);
        if (wr == 1) PG8_BAR;
        PG8_WAIT_V(2); PG8_BAR;
        PG8_STAGE(PG8_SB(1, 0), cB + kstep, voffB); PG8_STAGE_A(PG8_SA(1, 0), cA + kstep, 0, vA0, vA1); PG8_STAGE(PG8_SB(1, 1), cB + bhs + kstep, voffB);
        PG8_WAIT_V(6); PG8_BAR;
    } else {
        PG8_STAGE(PG8_SB(0, 0), cB, voffB); PG8_STAGE(PG8_SA(0, 0), cA, voffA); PG8_STAGE(PG8_SB(0, 1), cB + bhs, voffB); PG8_STAGE(PG8_SA(0, 1), cA + hstep, voffA);
        if (wr == 1) PG8_BAR;
        PG8_WAIT_V(4); PG8_BAR;
        PG8_STAGE(PG8_SB(1, 0), cB + kstep, voffB); PG8_STAGE(PG8_SA(1, 0), cA + kstep, voffA); PG8_STAGE(PG8_SB(1, 1), cB + bhs + kstep, voffB);
        PG8_WAIT_V(6); PG8_BAR;
    }
    for (;;) {
        const bool has_next = S.next(ui + 1, nxt);
        const char* nA = (has_next && !GATHER) ? (const char*)g.A + (size_t)nxt.pm * tstep : cA; const char* nB = has_next ? (const char*)g.Bt + (size_t)nxt.pb * tstep : cB;
        if constexpr (GATHER) { if (has_next) { PG8_GLOAD(nxt, nvA0, nvA1); } else { nvA0[0] = vA0[0]; nvA0[1] = vA0[1]; nvA1[0] = vA1[0]; nvA1[1] = vA1[1]; } }
        for (int t = 0; t < nt; t += 2) {
            const bool last = (t == nt - 2);
            const char* a1 = cA + (size_t)(t + 1) * kstep;
            const char* a2 = last ? nA : cA + (size_t)(t + 2) * kstep; const char* b2 = last ? nB : cB + (size_t)(t + 2) * kstep;
            const char* a3 = a2 + kstep; const char* b3 = b2 + kstep;
            if (last && has_next) S.a_ready(nxt);
            unsigned xA0[2], xA1[2];
            if constexpr (GATHER) { xA0[0] = last ? nvA0[0] : vA0[0]; xA0[1] = last ? nvA0[1] : vA0[1]; xA1[0] = last ? nvA1[0] : vA1[0]; xA1[1] = last ? nvA1[1] : vA1[1]; }
            if constexpr (SP2) {
            PG8_LDB(B0, 0, 0); PG8_LDB(B1, 0, 1); PG8_SCHED; PG8_LDA(At, 0, 0); PG8_STAGE_A(PG8_SA(1, 1), a1, 1, vA0, vA1);
            PG8_WAIT_V(8); PG8_WAIT_L(0); PG8_BAR; PG8_MMA(0, 0, At, B0); PG8_MMA(0, 1, At, B1); PG8_BAR; PG8_SCHED;
            PG8_LDA(At, 0, 1); PG8_STAGE(PG8_SB(0, 0), b2, voffB); PG8_STAGE(PG8_SB(0, 1), b2 + bhs, voffB); PG8_STAGE_A(PG8_SA(0, 0), a2, 0, xA0, xA1);
            PG8_WAIT_V(8); PG8_WAIT_L(0); PG8_BAR; PG8_MMA(1, 0, At, B0); PG8_MMA(1, 1, At, B1); PG8_BAR; PG8_SCHED;
            PG8_LDB(B0, 1, 0); PG8_LDB(B1, 1, 1); PG8_SCHED; PG8_LDA(At, 1, 0); PG8_STAGE_A(PG8_SA(0, 1), a2, 1, xA0, xA1);
            PG8_WAIT_V(8); PG8_WAIT_L(0); PG8_BAR; PG8_MMA(0, 0, At, B0); PG8_MMA(0, 1, At, B1); PG8_BAR; PG8_SCHED;
            PG8_LDA(At, 1, 1); PG8_STAGE(PG8_SB(1, 0), b3, voffB); PG8_STAGE(PG8_SB(1, 1), b3 + bhs, voffB); PG8_STAGE_A(PG8_SA(1, 0), a3, 0, xA0, xA1);
            PG8_WAIT_V(8); PG8_WAIT_L(0); PG8_BAR; PG8_MMA(1, 0, At, B0); PG8_MMA(1, 1, At, B1); PG8_BAR; PG8_SCHED;
            } else {
            PG8_LDB(B0, 0, 0); PG8_SCHED; PG8_LDA(At, 0, 0); PG8_STAGE(PG8_SA(1, 1), a1 + hstep, voffA);
            PG8_WAIT_L(8); PG8_BAR; PG8_WAIT_L(0); PG8_MMA(0, 0, At, B0); PG8_BAR; PG8_SCHED;
            PG8_LDB(B1, 0, 1); PG8_STAGE(PG8_SB(0, 0), b2, voffB);
            PG8_BAR; PG8_WAIT_L(0); PG8_MMA(0, 1, At, B1); PG8_BAR;
            PG8_LDA(At, 0, 1); PG8_STAGE(PG8_SA(0, 0), a2, voffA);
            PG8_BAR; PG8_WAIT_L(0); PG8_MMA(1, 0, At, B0); PG8_BAR; PG8_SCHED;
            PG8_STAGE(PG8_SB(0, 1), b2 + bhs, voffB);
            PG8_WAIT_V(6); PG8_BAR; PG8_MMA(1, 1, At, B1); PG8_BAR;
            PG8_LDB(B0, 1, 0); PG8_SCHED; PG8_LDA(At, 1, 0); PG8_STAGE(PG8_SA(0, 1), a2 + hstep, voffA);
            PG8_WAIT_L(8); PG8_BAR; PG8_WAIT_L(0); PG8_MMA(0, 0, At, B0); PG8_BAR; PG8_SCHED;
            PG8_LDB(B1, 1, 1); PG8_STAGE(PG8_SB(1, 0), b3, voffB);
            PG8_BAR; PG8_WAIT_L(0); PG8_MMA(0, 1, At, B1); PG8_BAR;
            PG8_LDA(At, 1, 1); PG8_STAGE(PG8_SA(1, 0), a3, voffA);
            PG8_BAR; PG8_WAIT_L(0); PG8_MMA(1, 0, At, B0); PG8_BAR; PG8_SCHED;
            PG8_STAGE(PG8_SB(1, 1), b3 + bhs, voffB);
            PG8_WAIT_V(6); PG8_BAR; PG8_MMA(1, 1, At, B1); PG8_BAR;
            }
        }
        if constexpr (ALIGN_EPI) { if (wr == 0) PG8_BAR; }
        if constexpr (!Epi::AFTER_DRAIN) { E(acc, cur, wr, wc, fr, fq); S.done(cur); }
        if (!has_next) break;
#pragma unroll
        for (int a = 0; a < 2; ++a)
#pragma unroll
            for (int b = 0; b < 2; ++b)
#pragma unroll
                for (int m = 0; m < 4; ++m)
#pragma unroll
                    for (int n = 0; n < 2; ++n) acc[a][b][m][n] = (f32x4){0.f, 0.f, 0.f, 0.f};
        cur = nxt; cA = nA; cB = nB; ++ui;
        if constexpr (GATHER) { vA0[0] = nvA0[0]; vA0[1] = nvA0[1]; vA1[0] = nvA1[0]; vA1[1] = nvA1[1]; }
        if constexpr (ALIGN_EPI) { if (wr == 1) PG8_BAR; }
    }
    PG8_WAIT_V(0);
    if constexpr (!ALIGN_EPI) { if (wr == 0) PG8_BAR; }
    PG8_BAR;
    if constexpr (Epi::AFTER_DRAIN) { E.fused(acc, cur, wr, wc, fr, fq, lds, wid, lane); S.done(cur); }
#undef PG8_GLOAD
#undef PG8_STAGE_A
#undef PG8_SA
#undef PG8_SB
#undef PG8_STAGE
#undef PG8_LDA
#undef PG8_LDB
#undef PG8_MMA
#undef PG8_WAIT_V
#undef PG8_WAIT_L
#undef PG8_BAR
#undef PG8_SCHED
}
}

#define PG8_SP2 true
#define PG8_ALIGN true
__device__ __forceinline__ void st8nt(bf16_t* p, f32x4 a, f32x4 b) { u32x4 w; w.x = cvtpk(a[0], a[1]); w.y = cvtpk(a[2], a[3]); w.z = cvtpk(b[0], b[1]); w.w = cvtpk(b[2], b[3]); __builtin_nontemporal_store(w, (u32x4*)p); }
__device__ __forceinline__ void st8(bf16_t* p, f32x4 a, f32x4 b) { u32x4 w; w.x = cvtpk(a[0], a[1]); w.y = cvtpk(a[2], a[3]); w.z = cvtpk(b[0], b[1]); w.w = cvtpk(b[2], b[3]); *(u32x4*)p = w; }
__device__ __forceinline__ void ld8(const bf16_t* p, f32x4& a, f32x4& b) { const u32x4 w = *(const u32x4*)p;
    a[0] = __uint_as_float(w.x << 16); a[1] = __uint_as_float(w.x & 0xffff0000u); a[2] = __uint_as_float(w.y << 16); a[3] = __uint_as_float(w.y & 0xffff0000u);
    b[0] = __uint_as_float(w.z << 16); b[1] = __uint_as_float(w.z & 0xffff0000u); b[2] = __uint_as_float(w.w << 16); b[3] = __uint_as_float(w.w & 0xffff0000u); }
struct EpiProj {
    static constexpr bool PERM = true, AFTER_DRAIN = false;
    unsigned char* ws; bf16_t* GATE; const float *qg, *kg, *bgate;
    __device__ __forceinline__ void operator()(const f32x4 (&acc)[2][2][4][2], const pg8::Unit& u, int wr, int wc, int fr, int fq) const {
        asm volatile("" : "+v"(fr), "+v"(fq));
        const int seg = u.pn >> 2;
        const int row0 = u.pm * 256 + wr * 64 + fr;
        const int cw = (u.pn & 3) * 256 + wc * 64 + 8 * fq;
        if (seg <= 1 || seg == 4) { bf16_t* dst = (bf16_t*)(ws + WS_U + (size_t)seg * (32 * MiB)) + cw;
#pragma unroll
            for (int ai = 0; ai < 2; ++ai)
#pragma unroll
                for (int m = 0; m < 4; ++m) { bf16_t* rp = dst + (size_t)(row0 + ai * 128 + m * 16) * DM;
#pragma unroll
                    for (int bj = 0; bj < 2; ++bj) st8nt(rp + 32 * bj, acc[ai][bj][m][0], acc[ai][bj][m][1]); }
        } else if (seg == 2 || seg == 3) { const float* g = (seg == 2 ? qg : kg) + 8 * fq; bf16_t* dst = (bf16_t*)(ws + WS_U + (size_t)seg * (32 * MiB)) + cw; const float sc = seg == 2 ? C2 : 1.f;
            f32x4 gv[2][2];
#pragma unroll
            for (int bj = 0; bj < 2; ++bj)
#pragma unroll
                for (int n = 0; n < 2; ++n) gv[bj][n] = *(const f32x4*)(g + 32 * bj + 4 * n) * sc;
#pragma unroll
            for (int ai = 0; ai < 2; ++ai)
#pragma unroll
                for (int m = 0; m < 4; ++m) { float ss = 0.f;
#pragma unroll
                    for (int bj = 0; bj < 2; ++bj)
#pragma unroll
                        for (int n = 0; n < 2; ++n) { const f32x4 a = acc[ai][bj][m][n]; ss += (a[0] * a[0] + a[1] * a[1]) + (a[2] * a[2] + a[3] * a[3]); }
                    ss += __shfl_xor(ss, 16); ss += __shfl_xor(ss, 32);
                    const float r = rsqrtf(ss * (1.f / 64.f) + EPS); bf16_t* rp = dst + (size_t)(row0 + ai * 128 + m * 16) * DM;
#pragma unroll
                    for (int bj = 0; bj < 2; ++bj) st8nt(rp + 32 * bj, (acc[ai][bj][m][0] * r) * gv[bj][0], (acc[ai][bj][m][1] * r) * gv[bj][1]); }
        } else { const int c = (u.pn - 20) * 256 + wc * 64 + 8 * fq; const float* bg = bgate + c;
#pragma unroll
            for (int bj = 0; bj < 2; ++bj) { const f32x4 b0 = *(const f32x4*)(bg + 32 * bj), b1 = *(const f32x4*)(bg + 32 * bj + 4);
#pragma unroll
                for (int ai = 0; ai < 2; ++ai)
#pragma unroll
                    for (int m = 0; m < 4; ++m) { f32x4 v0 = acc[ai][bj][m][0] + b0, v1 = acc[ai][bj][m][1] + b1;
#pragma unroll
                        for (int j = 0; j < 4; ++j) { v0[j] = __builtin_amdgcn_rcpf(1.f + __builtin_amdgcn_exp2f(-LOG2E * v0[j])); v1[j] = __builtin_amdgcn_rcpf(1.f + __builtin_amdgcn_exp2f(-LOG2E * v1[j])); }
                        st8nt(GATE + (size_t)(row0 + ai * 128 + m * 16) * 2048 + c + 32 * bj, v0, v1); } }
        }
    }
};

#define EPI_LOOP(...) _Pragma("unroll") for (int ai = 0; ai < 2; ++ai) _Pragma("unroll") for (int m = 0; m < 4; ++m) { const size_t row = (size_t)(u.pm * 256 + wr * 64 + fr + ai * 128 + m * 16); \
        _Pragma("unroll") for (int bj = 0; bj < 2; ++bj) { const int col = u.pn * 256 + bj * 128 + wc * 32 + 8 * fq; const f32x4 a0 = acc[ai][bj][m][0], a1 = acc[ai][bj][m][1]; __VA_ARGS__ } if (m & 1) asm volatile("" ::: "memory"); }
struct EpiGateT {
    static constexpr bool PERM = true, AFTER_DRAIN = false;
    const bf16_t* GATE; bf16_t* T;
    __device__ __forceinline__ void operator()(const f32x4 (&acc)[2][2][4][2], const pg8::Unit& u, int wr, int wc, int fr, int fq) const {
        asm volatile("" : "+v"(fr), "+v"(fq));
        EPI_LOOP( f32x4 g0, g1; ld8(GATE + row * 2048 + col, g0, g1); st8(T + row * DM + col, g0 * a0, g1 * a1); )
    }
};
struct EpiMerged {
    static constexpr bool PERM = true, AFTER_DRAIN = false;
    const bf16_t* GATE; const bf16_t* T; bf16_t* MG;
    __device__ __forceinline__ void operator()(const f32x4 (&acc)[2][2][4][2], const pg8::Unit& u, int wr, int wc, int fr, int fq) const {
        asm volatile("" : "+v"(fr), "+v"(fq));
        EPI_LOOP( f32x4 g0, g1, t0, t1; ld8(GATE + row * 2048 + 1024 + col, g0, g1); ld8(T + row * DM + col, t0, t1); st8(MG + row * DM + col, t0 + g0 * a0, t1 + g1 * a1); )
    }
};
struct EpiOut {
    static constexpr bool PERM = true, AFTER_DRAIN = false;
    const float* x; float* out; const float* g2; bf16_t* H2;
    __device__ __forceinline__ void operator()(const f32x4 (&acc)[2][2][4][2], const pg8::Unit& u, int wr, int wc, int fr, int fq) const {
        asm volatile("" : "+v"(fr), "+v"(fq));
        EPI_LOOP( const float* xp = x + row * DM + col; float* op = out + row * DM + col; const f32x4 x0 = __builtin_nontemporal_load((const f32x4*)xp) + a0, x1 = __builtin_nontemporal_load((const f32x4*)(xp + 4)) + a1; *(f32x4*)op = x0; *(f32x4*)(op + 4) = x1;
                  st8(H2 + row * DM + col, x0 * *(const f32x4*)(g2 + col), x1 * *(const f32x4*)(g2 + col + 4)); )
    }
};
struct EpiY {
    static constexpr bool PERM = true, AFTER_DRAIN = false;
    bf16_t* Y;
    __device__ __forceinline__ void operator()(const f32x4 (&acc)[2][2][4][2], const pg8::Unit& u, int wr, int wc, int fr, int fq) const {
        asm volatile("" : "+v"(fr), "+v"(fq));
        EPI_LOOP( st8(Y + row * DM + col, a0, a1); )
    }
};
struct EpiSwiglu {
    static constexpr bool PERM = true, AFTER_DRAIN = false;
    const float* roww; const float* rowrr; bf16_t* HID;
    __device__ __forceinline__ void operator()(const f32x4 (&acc)[2][2][4][2], const pg8::Unit& u, int wr, int wc, int fr, int fq) const {
        asm volatile("" : "+v"(fr), "+v"(fq));
#pragma unroll
        for (int ai = 0; ai < 2; ++ai)
#pragma unroll
            for (int m = 0; m < 4; ++m) { const int rl = wr * 64 + fr + ai * 128 + m * 16; const size_t row = (size_t)(u.pm * 256 + rl); const float w = rl < u.nvalid ? roww[u.rbase + rl] : 0.f, rr = rl < u.nvalid ? rowrr[u.rbase + rl] : 0.f;
                f32x4 hv[2];
#pragma unroll
                for (int n = 0; n < 2; ++n) { const f32x4 a1 = acc[ai][0][m][n] * rr, a3 = acc[ai][1][m][n] * rr;
#pragma unroll
                    for (int j = 0; j < 4; ++j) hv[n][j] = ((a1[j] * __builtin_amdgcn_rcpf(1.f + __builtin_amdgcn_exp2f(-LOG2E * a1[j]))) * a3[j]) * w; }
                st8(HID + row * DE + u.pn * 128 + wc * 32 + 8 * fq, hv[0], hv[1]); }
    }
};
__device__ __forceinline__ int expert_of_row(LAS int* offs, int row);
struct MoeOrder {
    LAS int* offs; int npn, G, c, lo, hi;
    __device__ __forceinline__ bool next(int i, pg8::Unit& u) const { const int L = lo + i * G + c; if (L >= hi || c < 0) return false;
        const int tile = L / npn, pn = L - tile * npn, e = expert_of_row(offs, tile * 256), lr0 = tile * 256 - offs[e], nv = offs[40 + e] - lr0;
        u.pm = tile; u.pn = pn; u.pb = e * npn + pn; u.rbase = e * ECAP + lr0; u.nvalid = nv < 256 ? nv : 256; return true; }
    __device__ __forceinline__ void a_ready(const pg8::Unit&) const {}
    __device__ __forceinline__ void done(const pg8::Unit&) const {}
};

__device__ __forceinline__ float attn_dmin_unit(const float* qg, const float* kg) {
    const int ln = threadIdx.x & 63; float a = fabsf(qg[ln]), b = fabsf(kg[ln]);
#pragma unroll
    for (int o = 1; o < 64; o <<= 1) { a = fmaxf(a, __shfl_xor(a, o)); b = fmaxf(b, __shfl_xor(b, o)); }
    return 2.02f * (8.f * a * b) + 106.f;
}
__device__ __forceinline__ int attn_jlo(float dmin1, int h, int qb) {
    const float dmin = dmin1 * exp2f((float)(h + 1)); const float lowk = (float)(qb * 128) - dmin;
    return lowk > 0.f ? ((int)lowk) >> 6 : 0;
}
__device__ __forceinline__ void tr_load(const float* W, int N, int item, int lane, float (&v)[32]) {
    const int nblk = N / 32, kb = item / nblk, nb = item % nblk, k0 = 64 * kb, n0 = 32 * nb;
    const float* wp = W + (size_t)(k0 + (lane >> 5)) * N + n0 + (lane & 31);
#pragma unroll
    for (int i = 0; i < 32; ++i) v[i] = __builtin_nontemporal_load(wp + (size_t)(2 * i) * N);
}
template <class RM>
__device__ __forceinline__ void tr_store(const float (&v)[32], int N, bf16_t* WT, int ldt, int koff, RM rm, LAS float* scr, int item, int lane) {
    const int nblk = N / 32, kb = item / nblk, nb = item % nblk, k0 = 64 * kb, n0 = 32 * nb;
    { LAS float* sp = scr + (lane >> 5) * 33 + (lane & 31);
#pragma unroll
      for (int i = 0; i < 32; ++i) sp[2 * i * 33] = v[i]; }
    LDS_WAIT(); asm volatile("" ::: "memory");
    const int c = lane & 7;
#pragma unroll
    for (int j = 0; j < 4; ++j) { const int n = (lane >> 3) + 8 * j; const LAS float* s = scr + (8 * c) * 33 + n;
        u32x4 o; o.x = cvtpk(s[0 * 33], s[1 * 33]); o.y = cvtpk(s[2 * 33], s[3 * 33]); o.z = cvtpk(s[4 * 33], s[5 * 33]); o.w = cvtpk(s[6 * 33], s[7 * 33]);
        *(u32x4*)(WT + (size_t)rm(n0 + n) * ldt + koff + k0 + 8 * c) = o; }
    LDS_WAIT(); asm volatile("" ::: "memory");
}
template <class RM>
__device__ __forceinline__ void transpose_item(const float* W, int N, bf16_t* WT, int ldt, int koff, RM rm, LAS float* scr, int item, int lane) {
    float v[32]; tr_load(W, N, item, lane, v); tr_store(v, N, WT, ldt, koff, rm, scr, item, lane);
}
template <class RM>
__device__ __forceinline__ void transpose_block_item(const float* W, int N, int k0, int n0, bf16_t* WT, int ldt, int koff, RM rm, LAS unsigned char* lds, int tid) {
    const int w = tid >> 6, lane = tid & 63;
    f32x4 v[8];
#pragma unroll
    for (int r = 0; r < 8; ++r) v[r] = __builtin_nontemporal_load((const f32x4*)(W + (size_t)(k0 + 8 * w + r) * N + n0 + 4 * lane));
#pragma unroll
    for (int c = 0; c < 4; ++c) { u32x4 o; o.x = cvtpk(v[0][c], v[1][c]); o.y = cvtpk(v[2][c], v[3][c]); o.z = cvtpk(v[4][c], v[5][c]); o.w = cvtpk(v[6][c], v[7][c]);
        *(LAS u32x4*)(lds + (4 * lane + c) * 144 + 16 * w) = o; }
    __syncthreads();
#pragma unroll
    for (int i = 0; i < 4; ++i) { const int q = tid + 512 * i, row = q >> 3, ch = q & 7;
        *(u32x4*)(WT + (size_t)rm(n0 + row) * ldt + koff + k0 + 8 * ch) = *(const LAS u32x4*)(lds + row * 144 + 16 * ch); }
    __syncthreads();
}
struct RmAdd { int off; __device__ __forceinline__ int operator()(int n) const { return off + n; } };
struct RmW13 { int off; __device__ __forceinline__ int operator()(int n) const { return off + (n >> 7) * 256 + (n & 127); } };

__device__ __forceinline__ void p0_prologue(Frame& F) {
    bf16_t* W1T = (bf16_t*)(F.ws + WS_W1T); bf16_t* WUPT = (bf16_t*)(F.ws + WS_WUPT); bf16_t* WOUTT = (bf16_t*)(F.ws + WS_WOUTT);
    { constexpr int I_A = 16 * 20, I_B = 16 * 8, I_C = 16 * 4; constexpr int NITEMS = I_A + I_B + 3 * I_C;
      for (int it = F.blk; it < NITEMS; it += F.G) { int r = it;
          if (r < I_A) { transpose_block_item(F.a->in[I_WIN], 5120, 64 * (r / 20), 256 * (r % 20), W1T, 1024, 0, RmAdd{0}, F.lds, F.tid); continue; } r -= I_A;
          if (r < I_B) { transpose_block_item(F.a->in[I_WGATE], 2048, 64 * (r / 8), 256 * (r % 8), W1T, 1024, 0, RmAdd{5120}, F.lds, F.tid); continue; } r -= I_B;
          if (r < I_C) { transpose_block_item(F.a->in[I_WUPA], 1024, 64 * (r / 4), 256 * (r % 4), WUPT, 1024, 0, RmAdd{0}, F.lds, F.tid); continue; } r -= I_C;
          if (r < I_C) { transpose_block_item(F.a->in[I_WUPB], 1024, 64 * (r / 4), 256 * (r % 4), WUPT, 1024, 0, RmAdd{1024}, F.lds, F.tid); continue; } r -= I_C;
          transpose_block_item(F.a->in[I_WOUT], 1024, 64 * (r / 4), 256 * (r % 4), WOUTT, 1024, 0, RmAdd{0}, F.lds, F.tid); } }
    { bf16_t* WST = (bf16_t*)(F.ws + WS_WST); const float* ws_ = F.a->in[I_WS];
      for (int i = F.blk * NTHREADS + F.tid; i < 8 * 128 * 128 / 2; i += F.G * NTHREADS) { const int e = 2 * i, s = e & 127, t = (e >> 7) & 127;
          const float a = (s <= t) ? ws_[e] : 0.f, b = (s + 1 <= t) ? ws_[e + 1] : 0.f; *(unsigned*)(WST + e) = cvtpk(a, b); } }
    { float* WRT = (float*)(F.ws + WS_ROUTE + RT_WRT); const float* g2 = F.a->in[I_N2G]; const float* wrg = F.a->in[I_WRG]; const float* wre = F.a->in[I_WRE];
      for (int i = F.blk * NTHREADS + F.tid; i < 48 * 1024; i += F.G * NTHREADS) { const int j = i >> 10, k = i & 1023;
          const float w = j < 4 ? wrg[k * 4 + j] : (j < 36 ? wre[k * 32 + (j - 4)] : 0.f); WRT[i] = g2[k] * w; } }
    if (F.blk == 0) { LAS int* hist = (LAS int*)(F.lds + 136 * 1024); LAS int* gt = hist + 160;
        for (int i = F.tid; i < 320; i += NTHREADS) hist[i] = 0;
        __syncthreads();
        const float dmin1 = attn_dmin_unit(F.a->in[I_QNG], F.a->in[I_KNG]);
        int w[2], jl[2];
#pragma unroll
        for (int q = 0; q < 2; ++q) { const int u = F.tid + q * NTHREADS, qb = u >> 4; jl[q] = attn_jlo(dmin1, u & 7, qb); w[q] = 2 * qb + 2 - jl[q]; atomicAdd((int*)(hist + w[q]), 1); }
        __syncthreads();
        if (F.tid < 64) { int h0 = 0, h1 = 0, h2 = 0; const int i0 = 3 * F.tid;
            if (i0 < 160) h0 = hist[i0]; if (i0 + 1 < 160) h1 = hist[i0 + 1]; if (i0 + 2 < 160) h2 = hist[i0 + 2];
            const int tot = h0 + h1 + h2; int suf = tot;
#pragma unroll
            for (int o = 1; o < 64; o <<= 1) { const int vv = __shfl_down(suf, o); if (F.tid + o < 64) suf += vv; }
            const int above = suf - tot;
            if (i0 + 2 < 160) gt[i0 + 2] = above; if (i0 + 1 < 160) gt[i0 + 1] = above + h2; if (i0 < 160) gt[i0] = above + h2 + h1; }
        __syncthreads();
#pragma unroll
        for (int q = 0; q < 2; ++q) { const int u = F.tid + q * NTHREADS; const int rank = atomicAdd((int*)(gt + w[q]), 1);
            ((int*)(F.ws + WS_ROUTE + RT_ALIST))[rank] = u | (jl[q] << 16); }
        __syncthreads(); }
    { bf16_t* XN = (bf16_t*)(F.ws + WS_XN); const float* x = F.a->in[I_X]; const f32x4* g4 = (const f32x4*)F.a->in[I_N1G] + F.lane;
      for (int m0 = F.gw * 4; m0 < M; m0 += F.NGW * 4) { f32x4 v[4][4];
#pragma unroll
          for (int q = 0; q < 4; ++q) { const f32x4* xr = (const f32x4*)(x + (size_t)(m0 + q) * DM) + F.lane;
#pragma unroll
              for (int j = 0; j < 4; ++j) v[q][j] = __builtin_nontemporal_load(xr + 64 * j); }
#pragma unroll
          for (int q = 0; q < 4; ++q) { float s = 0.f;
#pragma unroll
              for (int j = 0; j < 4; ++j) s += (v[q][j][0] * v[q][j][0] + v[q][j][1] * v[q][j][1]) + (v[q][j][2] * v[q][j][2] + v[q][j][3] * v[q][j][3]);
              const float r = rsqrtf(wave_sum(s) * (1.f / DM) + EPS);
#pragma unroll
              for (int j = 0; j < 4; ++j) { const f32x4 g = g4[64 * j]; st4(XN + (size_t)(m0 + q) * DM + 4 * F.lane + 256 * j, (v[q][j] * r) * g); } } } }
}

__device__ __forceinline__ void p1_proj(Frame& F) {
    pg8::Gemm g{(const bf16_t*)(F.ws + WS_XN), (const bf16_t*)(F.ws + WS_W1T), DM, nullptr};
    pg8::StaticOrder S; S.init(M, N1, F.G, F.blk);
    static_assert(WS_VA == WS_U + 32 * MiB && WS_Q == WS_U + 64 * MiB && WS_K == WS_U + 96 * MiB && WS_VB == WS_U + 128 * MiB, "EpiProj layout");
    EpiProj E{F.ws, (bf16_t*)F.out, F.a->in[I_QNG], F.a->in[I_KNG], F.a->in[I_BGATE]};
    pg8::gemm_phase<EpiProj, pg8::StaticOrder, PG8_ALIGN, PG8_SP2, true>(F.lds, g, S, E);
}

__device__ __forceinline__ void p2_mixer_a(Frame& F) {
    const bf16_t* VA = (const bf16_t*)(F.ws + WS_VA); const bf16_t* U = (const bf16_t*)(F.ws + WS_U); bf16_t* YA = (bf16_t*)(F.ws + WS_YA); const bf16_t* WST = (const bf16_t*)(F.ws + WS_WST);
    const float* gv = F.a->in[I_VNG]; const float* bs = F.a->in[I_BS];
    bf16_t* vT = (bf16_t*)F.ldsg;
    bf16_t* wS = (bf16_t*)(F.ldsg + 128 * 136 * 2);
    const int fr = F.lane & 15, fq = F.lane >> 4, wm = F.wid >> 1, wn = F.wid & 1;
    const int s_ = F.tid >> 2, ds = (F.tid & 3) * 32;
    int gstaged = -1;
    bf16x8 v[4];
    if (F.blk < 1024) { const int c = F.blk >> 3, g = F.blk & 7; const bf16_t* src = VA + (size_t)(c * 128 + s_) * DM + g * 128 + ds;
#pragma unroll
        for (int i = 0; i < 4; ++i) v[i] = *(const bf16x8*)(src + 8 * i); }
    for (int L = F.blk; L < 1024; L += F.G) {
        const int c = L >> 3, g = L & 7;
        if (g != gstaged) { __syncthreads();
#pragma unroll
            for (int i = 0; i < 4; ++i) { const int q = F.tid + 512 * i, t = q >> 4, ch = q & 15; *(bf16x8*)(wS + t * 136 + 8 * ch) = *(const bf16x8*)(WST + g * 16384 + t * 128 + 8 * ch); }
            gstaged = g; }
        { float ss = 0.f;
#pragma unroll
          for (int i = 0; i < 4; ++i)
#pragma unroll
              for (int j = 0; j < 8; ++j) { const float x = bf2f(v[i][j]); ss += x * x; }
          ss += __shfl_xor(ss, 1); ss += __shfl_xor(ss, 2);
          const float r = rsqrtf(ss * (1.f / 128.f) + EPS);
#pragma unroll
          for (int i = 0; i < 4; ++i)
#pragma unroll
              for (int j = 0; j < 8; ++j) { const int d = ds + 8 * i + j; const float x = (bf2f(v[i][j]) * r) * gv[g * 128 + d]; vT[d * 136 + s_] = (bf16_t)(cvtpk(x, 0.f) & 0xffffu); } }
        __syncthreads();
        const int Ln = L + F.G;
        if (Ln < 1024) { const bf16_t* src = VA + (size_t)((Ln >> 3) * 128 + s_) * DM + (Ln & 7) * 128 + ds;
#pragma unroll
            for (int i = 0; i < 4; ++i) v[i] = *(const bf16x8*)(src + 8 * i); }
        f32x4 uu[2][4]; float bb[2];
#pragma unroll
        for (int m = 0; m < 2; ++m) { const int t = 32 * wm + 16 * m + fr; bb[m] = bs[g * 128 + t]; const bf16_t* up = U + (size_t)(c * 128 + t) * DM + g * 128 + 64 * wn + 4 * fq;
#pragma unroll
            for (int n = 0; n < 4; ++n) uu[m][n] = ld4(up + 16 * n); }
        const bf16_t* ap = wS + (32 * wm + fr) * 136 + 8 * fq; const bf16_t* bp = vT + (64 * wn + fr) * 136 + 8 * fq;
        f32x4 acc[2][4]; acc_zero(acc);
        wave_gemm(acc, ap, ap + 16 * 136, bp, bp + 16 * 136, bp + 32 * 136, bp + 48 * 136, 32 * (wm + 1));
#pragma unroll
        for (int m = 0; m < 2; ++m) { const int t = 32 * wm + 16 * m + fr; bf16_t* yp = YA + (size_t)(c * 128 + t) * DM + g * 128 + 64 * wn + 4 * fq;
#pragma unroll
            for (int n = 0; n < 4; ++n) st4(yp + 16 * n, uu[m][n] * (acc[m][n] + bb[m])); }
        __syncthreads();
    }
}

namespace att {
constexpr int QBLK = 32, KVBLK = 64, QB = 128, PITCH = 1024;
constexpr int SHM_V = KVBLK * 128 * 2, SHM_K = 2 * KVBLK * 64 * 2;
constexpr int LDS_WSF = 2 * SHM_V + 2 * SHM_K, LDS_XCH = LDS_WSF + NWAVES * 64 * 4, LDS_BYTES = LDS_XCH + 4 * 16 * 4 * 64 * 4;
constexpr float THR2 = 8.f * LOG2E;
#define KSWZ64(row, colB) ((row) * 128 + ((colB) ^ ((((row) >> 1) & 7) << 4)))
__device__ __forceinline__ int v_st(int k, int c) { const int kk = (k & ~0xC) | ((k & 4) << 1) | ((k & 8) >> 1); return ((kk >> 3) * 4 + (c >> 5)) * 512 + ((kk & 7) * 32 + (c & 31)) * 2; }
__device__ __forceinline__ int v_rd_base(int lane) { return ((lane & 3) << 3) | (((lane >> 2) & 3) << 6) | (((lane >> 4) & 1) << 5) | (((lane >> 5) & 1) << 8); }
constexpr int v_rd_off(int d0, int ks, int half) { return d0 * 512 + ks * 4096 + half * 2048; }
__device__ __forceinline__ int crow(int r, int hi) { return (r & 3) + 8 * (r >> 2) + 4 * hi; }

__device__ __forceinline__ void mask_tile(f32x16& p0, f32x16& p1, int dq) {
    const float NEG = -__builtin_inff();
#pragma unroll
    for (int r = 0; r < 16; ++r) { const int c = (r & 3) + 8 * (r >> 2);
        if (dq - c < 0) p0[r] = NEG;
        if (dq - c - 32 < 0) p1[r] = NEG; }
}
__device__ __forceinline__ void partialSM(f32x16& p0, f32x16& p1, float& m_reg, float& alpha) {
    float pmax = __builtin_fmaxf(__builtin_fmaxf(p0[0], p0[1]), p0[2]);
#pragma unroll
    for (int r = 3; r < 15; r += 2) pmax = __builtin_fmaxf(__builtin_fmaxf(pmax, p0[r]), p0[r + 1]);
    pmax = __builtin_fmaxf(__builtin_fmaxf(pmax, p0[15]), p1[0]);
#pragma unroll
    for (int r = 1; r < 15; r += 2) pmax = __builtin_fmaxf(__builtin_fmaxf(pmax, p1[r]), p1[r + 1]);
    pmax = __builtin_fmaxf(pmax, p1[15]);
    { auto rr = __builtin_amdgcn_permlane32_swap(__float_as_uint(pmax), __float_as_uint(pmax), false, false);
      pmax = fmaxf(__uint_as_float(rr[0]), __uint_as_float(rr[1])); }
    alpha = 1.f;
    if (__builtin_expect(!__all(pmax <= THR2), 0)) { asm volatile("" ::: "memory");
        const float d = fmaxf(pmax, 0.f); m_reg += d; alpha = __builtin_amdgcn_exp2f(-d);
#pragma unroll
        for (int r = 0; r < 16; ++r) { p0[r] -= d; p1[r] -= d; } }
#pragma unroll
    for (int r = 0; r < 16; ++r) p0[r] = __builtin_amdgcn_exp2f(p0[r]);
}
__device__ __forceinline__ void finishSM(f32x16& p0, f32x16& p1, float alpha, float& l_reg, bf16x8& pa0, bf16x8& pa1, bf16x8& pa2, bf16x8& pa3) {
#pragma unroll
    for (int r = 0; r < 16; ++r) p1[r] = __builtin_amdgcn_exp2f(p1[r]);
    float ps = 0;
#pragma unroll
    for (int r = 0; r < 16; ++r) ps += p0[r];
#pragma unroll
    for (int r = 0; r < 16; ++r) ps += p1[r];
    { auto rr = __builtin_amdgcn_permlane32_swap(__float_as_uint(ps), __float_as_uint(ps), false, false);
      ps = __uint_as_float(rr[0]) + __uint_as_float(rr[1]); }
    l_reg = l_reg * alpha + ps;
#define PK4(P, B_, OUT) do { unsigned a0 = cvtpk(P[B_+0], P[B_+1]), a1 = cvtpk(P[B_+2], P[B_+3]);                          \
        unsigned b0 = cvtpk(P[B_+4], P[B_+5]), b1 = cvtpk(P[B_+6], P[B_+7]);                                             \
        auto r0 = __builtin_amdgcn_permlane32_swap(a0, b0, false, false); auto r1 = __builtin_amdgcn_permlane32_swap(a1, b1, false, false); \
        u32x4 w = {r0[0], r1[0], r0[1], r1[1]}; OUT = __builtin_bit_cast(bf16x8, w); } while (0)
    PK4(p0, 0, pa0); PK4(p0, 8, pa1); PK4(p1, 0, pa2); PK4(p1, 8, pa3);
#undef PK4
}
template <int KB>
__device__ __forceinline__ void qkt(f32x16& p0, f32x16& p1, const char* Kmap_lds, int r32, int hi, const bf16x8* qr, bf16x8 kx0, bf16x8 kx1, bf16x8 qx) {
    p0 = __builtin_amdgcn_mfma_f32_32x32x16_bf16(kx0, qx, f32x16{}, 0, 0, 0); p1 = __builtin_amdgcn_mfma_f32_32x32x16_bf16(kx1, qx, f32x16{}, 0, 0, 0);
#pragma unroll
    for (int d0 = 0; d0 < 4; ++d0) { const char* a = Kmap_lds + KB * SHM_K + KSWZ64(r32, (d0 * 16 + hi * 8) * 2);
        const bf16x8 b0 = *reinterpret_cast<const bf16x8*>(a);
        const bf16x8 b1 = *reinterpret_cast<const bf16x8*>(a + 32 * 128);
        p0 = __builtin_amdgcn_mfma_f32_32x32x16_bf16(b0, qr[d0], p0, 0, 0, 0);
        p1 = __builtin_amdgcn_mfma_f32_32x32x16_bf16(b1, qr[d0], p1, 0, 0, 0); }
}
template <int VB>
__device__ __forceinline__ void pv_tile(f32x16* o, int vb0, bf16x8 pa0, bf16x8 pa1, bf16x8 pa2, bf16x8 pa3) {
#define TRRD(dst, off) asm volatile("ds_read_b64_tr_b16 %0, %1 offset:%2" : "=&v"(dst) : "v"(vb0), "i"(off) : "memory")
#define PV_D0(d0) do { s16x4 l0, l1, l2, l3, h0, h1, h2, h3; constexpr int b_ = VB * SHM_V + v_rd_off(d0, 0, 0); \
        TRRD(l0, b_); TRRD(h0, b_ + 2048); TRRD(l1, b_ + 4096); TRRD(h1, b_ + 6144); TRRD(l2, b_ + 8192); TRRD(h2, b_ + 10240); TRRD(l3, b_ + 12288); TRRD(h3, b_ + 14336); \
        asm volatile("s_waitcnt lgkmcnt(0)" ::: "memory"); SBAR();   \
        o[d0] = __builtin_amdgcn_mfma_f32_32x32x16_bf16(pa0, (bf16x8){l0[0], l0[1], l0[2], l0[3], h0[0], h0[1], h0[2], h0[3]}, o[d0], 0, 0, 0);   \
        o[d0] = __builtin_amdgcn_mfma_f32_32x32x16_bf16(pa1, (bf16x8){l1[0], l1[1], l1[2], l1[3], h1[0], h1[1], h1[2], h1[3]}, o[d0], 0, 0, 0);   \
        o[d0] = __builtin_amdgcn_mfma_f32_32x32x16_bf16(pa2, (bf16x8){l2[0], l2[1], l2[2], l2[3], h2[0], h2[1], h2[2], h2[3]}, o[d0], 0, 0, 0);   \
        o[d0] = __builtin_amdgcn_mfma_f32_32x32x16_bf16(pa3, (bf16x8){l3[0], l3[1], l3[2], l3[3], h3[0], h3[1], h3[2], h3[3]}, o[d0], 0, 0, 0); } while (0)
    PV_D0(0); PV_D0(1); PV_D0(2); PV_D0(3);
#undef PV_D0
#undef TRRD
}

__device__ __forceinline__ bf16x8 qx_of(unsigned sdw, float x) {
    const unsigned h_ = cvtpk(x, 0.f) & 0xffffu; const float r1 = x - __uint_as_float(h_ << 16);
    const unsigned m_ = cvtpk(r1, 0.f) & 0xffffu; const float r2 = r1 - __uint_as_float(m_ << 16);
    return __builtin_bit_cast(bf16x8, (u32x4){sdw, h_ | (m_ << 16), cvtpk(r2, 0.f) & 0xffffu, 0u});
}
struct BlockRef { int base; int P0; int jlo; float slope2; };
#define BR_Q(br) ((const bf16_t*)(wsb + WS_Q) + (br).base)
#define BR_K(br) ((const bf16_t*)(wsb + WS_K) + (br).base)
#define BR_V(br) ((const bf16_t*)(wsb + WS_VB) + (br).base)
#define BR_O(br) ((bf16_t*)(wsb + WS_XN) + (br).base)
struct Seam { bf16x8 qr[4]; bf16x8 st_v0, st_v1, st_k0, st_k1; };
#define VMW() asm volatile("s_waitcnt vmcnt(0)" ::: "memory")
#define VMWN(n) asm volatile("s_waitcnt vmcnt(%0)" :: "i"(n) : "memory")
#define BLD(soff) __builtin_bit_cast(bf16x8, __builtin_amdgcn_raw_buffer_load_b128(rsrc, voff, (int)(soff), 0))
#define SLOAD_H(br, k0) do { const unsigned so_ = (unsigned)((br).base + (k0) * PITCH) * 2u;                                  \
                         S.st_v0 = BLD((unsigned)WS_VB + so_); S.st_v1 = BLD((unsigned)WS_VB + so_ + 32u * PITCH * 2u);              \
                         S.st_k0 = BLD((unsigned)WS_K + so_); S.st_k1 = BLD((unsigned)WS_K + so_ + 32u * PITCH * 2u); } while (0)
#define SWRITE_HK(bf) do { *(bf16x8*)(K_lds + (bf) * SHM_K + kws) = S.st_k0; *(bf16x8*)(K_lds + (bf) * SHM_K + kws + 32 * 128) = S.st_k1; } while (0)
#define SWRITE_HV(bf) do { *(bf16x8*)(V_lds + (bf) * SHM_V + vst0) = S.st_v0; *(bf16x8*)(V_lds + (bf) * SHM_V + vst1) = S.st_v1; } while (0)
#define SWRITE_H(bf) do { SWRITE_HV(bf); SWRITE_HK(bf); } while (0)
__device__ __forceinline__ void attn_prime(const unsigned char* wsb, const BlockRef& cur, char* lds, Seam& S) {
    const int tid = threadIdx.x, wid = __builtin_amdgcn_readfirstlane(tid >> 6), lane = tid & 63, r32 = lane & 31, hi = lane >> 5;
    const int map = wid >> 2, rw = wid & 3;
    const int sr = tid >> 4, sc = (tid & 15) * 8, kws = (sc >> 6) * 8192 + KSWZ64(sr, (sc & 63) * 2); char* K_lds = lds + 2 * SHM_V;
    const int voff = (sr * PITCH + sc) * 2; const __amdgpu_buffer_rsrc_t rsrc = __builtin_amdgcn_make_buffer_rsrc((void*)wsb, 0, 0x10000000, 0x00020000);
    const int kb0 = cur.jlo * KVBLK;
#pragma unroll
    for (int d0 = 0; d0 < 4; ++d0) S.qr[d0] = *(const bf16x8*)(BR_Q(cur) + (size_t)(cur.P0 + rw * QBLK + r32) * PITCH + map * 64 + d0 * 16 + hi * 8);
    SLOAD_H(cur, kb0); VMW(); SWRITE_HK(0);
    __syncthreads();
}
__device__ __forceinline__ void attn_block(unsigned char* wsb, const BlockRef& cur, const BlockRef& nxt, char* lds, Seam& S, float lam, const float* subg) {
    const int tid = threadIdx.x, wid = __builtin_amdgcn_readfirstlane(tid >> 6), lane = tid & 63, r32 = lane & 31, hi = lane >> 5;
    const int map = wid >> 2, rw = wid & 3;
    const int j_lo = cur.jlo, j_hi = cur.P0 / KVBLK + 2, NT = j_hi - j_lo;
    const int kbn = nxt.jlo * KVBLK;
    const int qlo = cur.P0 + rw * QBLK, qm = qlo + r32 - 4 * hi;
    const float slope2 = cur.slope2; const int qpos = qlo + r32;
    unsigned sdw; { const unsigned h_ = cvtpk(slope2, 0.f) & 0xffffu; const float lo_ = slope2 - __uint_as_float(h_ << 16); sdw = h_ | (cvtpk(lo_, 0.f) << 16); }
    bf16x8 kx0, kx1; { const unsigned c0 = cvtpk((float)r32, (float)r32), c1 = cvtpk((float)(r32 + 32), (float)(r32 + 32)), one = hi ? 0u : 0x3f803f80u;
        kx0 = __builtin_bit_cast(bf16x8, (u32x4){hi ? 0u : c0, one, one & 0xffffu, 0u}); kx1 = __builtin_bit_cast(bf16x8, (u32x4){hi ? 0u : c1, one, one & 0xffffu, 0u}); }
    char* V_lds = lds; char* K_lds = lds + 2 * SHM_V; const char* Kmap = K_lds + map * 8192;
    float* ws = (float*)(lds + LDS_WSF) + wid * 64; float* li_l = ws, * al_l = ws + 32;
    float m_reg = 0.f, l_reg = 0; f32x16 o[4] = {};
    const int sr = tid >> 4, sc = (tid & 15) * 8, vst0 = v_st(sr, sc), vst1 = v_st(32 + sr, sc), kws = (sc >> 6) * 8192 + KSWZ64(sr, (sc & 63) * 2);
    const int vb0 = (int)(uintptr_t)V_lds + v_rd_base(lane);
    const int voff = (sr * PITCH + sc) * 2; const __amdgpu_buffer_rsrc_t rsrc = __builtin_amdgcn_make_buffer_rsrc((void*)wsb, 0, 0x10000000, 0x00020000);
#define RESC(a) do { if (__any((a) < 1.f)) { if (hi == 0) al_l[r32] = (a); asm volatile("s_waitcnt lgkmcnt(0)" ::: "memory");              \
                     _Pragma("unroll") for (int d_ = 0; d_ < 4; ++d_) _Pragma("unroll") for (int r = 0; r < 16; ++r) o[d_][r] *= al_l[crow(r, hi)]; } } while (0)
#define KBASE(t) ((j_lo + (t)) * KVBLK)
#define MASKT(P0_, P1_, t) do { const int kb_ = KBASE(t); if (kb_ + KVBLK - 1 > qlo) { asm volatile("" ::: "memory"); mask_tile(P0_, P1_, qm - kb_); } } while (0)
#define QX(t) qx_of(sdw, slope2 * (float)(KBASE(t) - qpos) - m_reg)
#define SEAM_K0() do { VMWN(4); SWRITE_HK(0); SBAR(); } while (0)
    f32x16 pA0, pA1, pB0, pB1; float alA, alB; bf16x8 pa0, pa1, pa2, pa3;
    SWRITE_HV(0); SBAR();
    if (NT > 1) { SLOAD_H(cur, KBASE(1)); }
    SBAR(); qkt<0>(pA0, pA1, Kmap, r32, hi, S.qr, kx0, kx1, QX(0));
    MASKT(pA0, pA1, 0); partialSM(pA0, pA1, m_reg, alA);
    if (NT > 1) { VMW(); SWRITE_H(1); }
    __syncthreads();
#define HALF_STEP(PX0, PX1, alX, PY0, PY1, alY, t, KB, VB, SB) do {                                                      \
        SBAR(); qkt<KB>(PX0, PX1, Kmap, r32, hi, S.qr, kx0, kx1, QX(t));                                                           \
        finishSM(PY0, PY1, alY, l_reg, pa0, pa1, pa2, pa3); SBAR();                                                           \
        if ((t) + 1 < NT) { SLOAD_H(cur, KBASE((t) + 1)); SBAR(); }                                               \
        pv_tile<VB>(o, vb0, pa0, pa1, pa2, pa3); MASKT(PX0, PX1, (t)); partialSM(PX0, PX1, m_reg, alX);                                        \
        __syncthreads();                                                                                                      \
        if ((t) + 1 < NT) { VMW(); SWRITE_H(SB); }                                                                          \
        RESC(alX); __syncthreads(); } while (0)
    for (int t = 1; t + 1 < NT; t += 2) {
        HALF_STEP(pB0, pB1, alB, pA0, pA1, alA, t, 1, 0, 0);
        HALF_STEP(pA0, pA1, alA, pB0, pB1, alB, t + 1, 0, 1, 1);
    }
    const bool even = (NT & 1) == 0;
    if (even) { SBAR(); qkt<1>(pB0, pB1, Kmap, r32, hi, S.qr, kx0, kx1, QX(NT - 1)); SBAR(); }
    { const int nmap = map, nrw = rw;
      SLOAD_H(nxt, kbn); SBAR();
#pragma unroll
      for (int d0 = 0; d0 < 4; ++d0) S.qr[d0] = *(const bf16x8*)(BR_Q(nxt) + (size_t)(nxt.P0 + nrw * QBLK + r32) * PITCH + nmap * 64 + d0 * 16 + hi * 8); }
    SBAR();
    finishSM(pA0, pA1, alA, l_reg, pa0, pa1, pa2, pa3); SBAR();
    pv_tile<0>(o, vb0, pa0, pa1, pa2, pa3);
    if (even) { MASKT(pB0, pB1, NT - 1); partialSM(pB0, pB1, m_reg, alB); __syncthreads(); RESC(alB);
        finishSM(pB0, pB1, alB, l_reg, pa0, pa1, pa2, pa3); SBAR(); pv_tile<1>(o, vb0, pa0, pa1, pa2, pa3); }
    SBAR(); SEAM_K0();
    if (hi == 0) li_l[r32] = l_reg; asm volatile("s_waitcnt lgkmcnt(0)" ::: "memory");
    float rli[16];
#pragma unroll
    for (int r = 0; r < 16; ++r) rli[r] = __builtin_amdgcn_rcpf(li_l[crow(r, hi)]);
    float* xch = (float*)(lds + LDS_XCH) + (size_t)rw * (16 * 4 * 64) + lane;
    if (map == 1) {
#pragma unroll
        for (int r = 0; r < 16; ++r)
#pragma unroll
            for (int d0 = 0; d0 < 4; ++d0) xch[(r * 4 + d0) * 64] = o[d0][r] * rli[r];
    }
    __syncthreads();
    if (map == 0) {
        float gsub[4];
#pragma unroll
        for (int d0 = 0; d0 < 4; ++d0) gsub[d0] = subg[d0 * 32 + r32] * (1.f - LAM_INIT);
        int obase = (cur.P0 + rw * QBLK + 4 * hi) * PITCH + r32; asm volatile("" : "+v"(obase));
        bf16_t* Ow = BR_O(cur) + obase;
#pragma unroll
        for (int r = 0; r < 16; ++r) { float d[4]; float ss = 0.f;
#pragma unroll
            for (int d0 = 0; d0 < 4; ++d0) { d[d0] = o[d0][r] * rli[r] - lam * xch[(r * 4 + d0) * 64]; ss += d[d0] * d[d0]; }
            ss += __shfl_xor(ss, 1); ss += __shfl_xor(ss, 2); ss += __shfl_xor(ss, 4); ss += __shfl_xor(ss, 8); ss += __shfl_xor(ss, 16);
            const float rs = rsqrtf(ss * (1.f / 128.f) + EPS); const int orow = (r & 3) + 8 * (r >> 2);
#pragma unroll
            for (int d0 = 0; d0 < 4; ++d0) { const float v = (d[d0] * rs) * gsub[d0]; const float vn = __shfl_xor(v, 1);
                if ((r32 & 1) == 0) *(unsigned*)(Ow + orow * PITCH + d0 * 32) = cvtpk(v, vn); } }
    }
    __syncthreads();
#undef RESC
#undef KBASE
#undef MASKT
#undef QX
#undef SEAM_K0
#undef HALF_STEP
}
#undef BLD
#undef BR_Q
#undef BR_K
#undef BR_V
#undef BR_O
#undef VMW
#undef VMWN
#undef SLOAD_H
#undef SWRITE_HK
#undef SWRITE_HV
#undef SWRITE_H
}


__device__ __forceinline__ att::BlockRef attn_ref(Frame& F, int L) {
    const int ent = ((const int*)(F.ws + WS_ROUTE + RT_ALIST))[L]; const int u = ent & 0xffff, qb = u >> 4, bh = u & 15, b = bh >> 3, h = bh & 7;
    att::BlockRef r; r.base = b * SEQ * 1024 + h * 128;
    r.P0 = qb * 128; r.jlo = ent >> 16; r.slope2 = exp2f(-(float)(h + 1)) * LOG2E;
    return r;
}
__device__ __forceinline__ void p2_attention(Frame& F) {
    const float s1 = wave_sum(F.a->in[I_LQ1][F.lane] * F.a->in[I_LK1][F.lane]), s2 = wave_sum(F.a->in[I_LQ2][F.lane] * F.a->in[I_LK2][F.lane]);
    const float lam = expf(s1) - expf(s2) + LAM_INIT;
    constexpr int NUNITS = 1024;
    volatile LAS int* qs = (volatile LAS int*)(F.lds + 143 * 1024);
    __syncthreads();
    const int v = (F.G % 8 == 0) ? (F.blk % 8) * (F.G / 8) + F.blk / 8 : F.blk;
    int L = v, Ln = 2 * F.G - 1 - v;
    if (L >= NUNITS) return;
    att::BlockRef cur = attn_ref(F, L); att::Seam S;
    att::attn_prime(F.ws, cur, F.ldsg, S);
    for (;;) {
        const bool last = Ln >= NUNITS;
        int nn = 0; if (F.tid == 0 && !last) nn = 2 * F.G + (int)atomicAdd(F.ctl + CW_AQ, 1u);
        const att::BlockRef nxt = last ? cur : attn_ref(F, Ln);
        att::attn_block(F.ws, cur, nxt, F.ldsg, S, lam, F.a->in[I_SUBG]);
        if (last) break;
        if (F.tid == 0) qs[0] = nn;
        __syncthreads();
        cur = nxt; Ln = qs[0];
        __syncthreads();
    }
}

__device__ __forceinline__ void p3_merged(Frame& F) {
    pg8::StaticOrder S; S.init(M, DM, F.G, F.blk);
    { pg8::Gemm g{(const bf16_t*)(F.ws + WS_YA), (const bf16_t*)(F.ws + WS_WUPT), DM, nullptr}; EpiGateT E{(const bf16_t*)F.out, (bf16_t*)(F.ws + WS_T)};
      pg8::gemm_phase<EpiGateT, pg8::StaticOrder, PG8_ALIGN, PG8_SP2, false>(F.lds, g, S, E); }
    { pg8::Gemm g{(const bf16_t*)(F.ws + WS_XN), (const bf16_t*)(F.ws + WS_WUPT) + 1024 * 1024, DM, nullptr}; EpiMerged E{(const bf16_t*)F.out, (const bf16_t*)(F.ws + WS_T), (bf16_t*)(F.ws + WS_Q)};
      pg8::gemm_phase<EpiMerged, pg8::StaticOrder, PG8_ALIGN, PG8_SP2, false>(F.lds, g, S, E); }
}
__device__ __forceinline__ void p4_out(Frame& F) {
    pg8::StaticOrder S; S.init(M, DM, F.G, F.blk);
    pg8::Gemm g{(const bf16_t*)(F.ws + WS_Q), (const bf16_t*)(F.ws + WS_WOUTT), DM, nullptr}; EpiOut E{F.a->in[I_X], F.out, F.a->in[I_N2G], (bf16_t*)(F.ws + WS_H2)};
    pg8::gemm_phase<EpiOut, pg8::StaticOrder, PG8_ALIGN, PG8_SP2, false>(F.lds, g, S, E);
}
__device__ __forceinline__ void h2_row(Frame& F, int t, f32x4 (&h)[4]) {
    const f32x4* xr = (const f32x4*)(F.out + (size_t)t * DM) + F.lane; const f32x4* g4 = (const f32x4*)F.a->in[I_N2G] + F.lane;
    float s = 0.f;
#pragma unroll
    for (int j = 0; j < 4; ++j) { h[j] = xr[64 * j]; s += (h[j][0] * h[j][0] + h[j][1] * h[j][1]) + (h[j][2] * h[j][2] + h[j][3] * h[j][3]); }
    const float r = rsqrtf(wave_sum(s) * (1.f / DM) + EPS);
#pragma unroll
    for (int j = 0; j < 4; ++j) h[j] = (h[j] * r) * g4[64 * j];
}
__device__ __forceinline__ void p5_router(Frame& F) {
    const float* WRT = (const float*)(F.ws + WS_ROUTE + RT_WRT); const float* brg = F.a->in[I_BRG]; const float* bre = F.a->in[I_BRE];
    int* tokpos = (int*)(F.ws + WS_ROUTE + RT_TOKPOS); float* roww = (float*)(F.ws + WS_ROUTE + RT_ROWW); float* rowrr = (float*)(F.ws + WS_ROUTE + RT_ROWRR); int* rowtok = (int*)(F.ws + WS_ROUTE + RT_ROWTOK);
    LAS float* lg = (LAS float*)(F.lds + 128 * 1024 + (F.wid & 3) * 3072);
    const int i16 = F.lane & 15, kq = F.lane >> 4;
    if (F.wid < 4)
    for (int task = F.blk * 4 + F.wid; task < M / 16; task += F.G * 4) { const int t0 = task * 16;
        const float* xp = F.out + (size_t)(t0 + i16) * DM + 4 * kq; const float* wp = WRT + (size_t)i16 * DM + 4 * kq;
        f32x4 acc0 = {0.f, 0.f, 0.f, 0.f}, acc1 = acc0, acc2 = acc0; float ss = 0.f;
#pragma unroll 4
        for (int s = 0; s < 64; ++s) { const f32x4 xa = *(const f32x4*)(xp + 16 * s);
            const f32x4 w0 = *(const f32x4*)(wp + 16 * s), w1 = *(const f32x4*)(wp + 16 * DM + 16 * s), w2 = *(const f32x4*)(wp + 32 * DM + 16 * s);
            ss += (xa[0] * xa[0] + xa[1] * xa[1]) + (xa[2] * xa[2] + xa[3] * xa[3]);
#pragma unroll
            for (int e = 0; e < 4; ++e) { acc0 = __builtin_amdgcn_mfma_f32_16x16x4f32(xa[e], w0[e], acc0, 0, 0, 0); acc1 = __builtin_amdgcn_mfma_f32_16x16x4f32(xa[e], w1[e], acc1, 0, 0, 0);
                acc2 = __builtin_amdgcn_mfma_f32_16x16x4f32(xa[e], w2[e], acc2, 0, 0, 0); } }
        ss += __shfl_xor(ss, 16); ss += __shfl_xor(ss, 32);
        const float rr = rsqrtf(ss * (1.f / DM) + EPS);
#pragma unroll
        for (int reg = 0; reg < 4; ++reg) { LAS float* p = lg + (4 * kq + reg) * 48 + i16; p[0] = acc0[reg]; p[16] = acc1[reg]; p[32] = acc2[reg]; }
        LDS_WAIT(); asm volatile("" ::: "memory");
        if (F.lane < 16) { const LAS float* p = lg + F.lane * 48;
            float gl[4];
#pragma unroll
            for (int i = 0; i < 4; ++i) gl[i] = p[i] * rr + brg[i];
            int g = 0; float gm = gl[0];
#pragma unroll
            for (int i = 1; i < 4; ++i) if (gl[i] > gm) { gm = gl[i]; g = i; }
            float gs = 0.f;
#pragma unroll
            for (int i = 0; i < 4; ++i) gs += expf(gl[i] - gm);
            const float ggate = 1.f / gs;
            float el[8];
#pragma unroll
            for (int i = 0; i < 8; ++i) el[i] = p[4 + g * 8 + i] * rr + bre[g * 8 + i];
            int i1 = 0; float v1 = el[0];
#pragma unroll
            for (int i = 1; i < 8; ++i) if (el[i] > v1) { v1 = el[i]; i1 = i; }
            int i2 = -1; float v2 = -__builtin_inff();
#pragma unroll
            for (int i = 0; i < 8; ++i) if (i != i1 && el[i] > v2) { v2 = el[i]; i2 = i; }
            const float a = expf(v2 - v1), w1 = 1.f / (1.f + a), w2 = a / (1.f + a);
            const int t = t0 + F.lane, e1 = g * 8 + i1, e2 = g * 8 + i2;
            const int r1 = (int)atomicAdd(F.ctl + CW_CNT + e1 * CW_CNT_STRIDE, 1u), r2 = (int)atomicAdd(F.ctl + CW_CNT + e2 * CW_CNT_STRIDE, 1u);
            rowtok[e1 * ECAP + r1] = t; roww[e1 * ECAP + r1] = ggate * w1; rowrr[e1 * ECAP + r1] = rr; rowtok[e2 * ECAP + r2] = t; roww[e2 * ECAP + r2] = ggate * w2; rowrr[e2 * ECAP + r2] = rr;
            tokpos[2 * t] = (e1 << ECAP_LOG) | r1; tokpos[2 * t + 1] = (e2 << ECAP_LOG) | r2; }
        LDS_WAIT(); asm volatile("" ::: "memory");
    }
    if (F.wid >= 4) {
      LAS float* scr = (LAS float*)(F.lds + (F.wid - 4) * 32768);
      bf16_t* W13T = (bf16_t*)(F.ws + WS_W13T); bf16_t* W2T = (bf16_t*)(F.ws + WS_W2T);
#define XW_SRC(it_) (((it_) % 384) < 128 ? F.a->in[I_W1] + (size_t)((it_) / 384) * 1024 * 256 : ((it_) % 384) < 256 ? F.a->in[I_W3] + (size_t)((it_) / 384) * 1024 * 256 : F.a->in[I_W2] + (size_t)((it_) / 384) * 256 * 1024)
#define XW_STORE(v_, it_, scr_) do { const int e_ = (it_) / 384, r_ = (it_) % 384; \
          if (r_ < 128) tr_store(v_, 256, W13T, 1024, 0, RmW13{e_ * 512}, scr_, r_, F.lane); \
          else if (r_ < 256) tr_store(v_, 256, W13T, 1024, 0, RmW13{e_ * 512 + 128}, scr_, r_ - 128, F.lane); \
          else tr_store(v_, 1024, W2T, 256, 0, RmAdd{e_ * 1024}, scr_, r_ - 256, F.lane); } while (0)
      const int stride = F.G * 4;
      for (int it = F.blk * 4 + (F.wid - 4); it < NE * 384; it += 2 * stride) { const int it2 = it + stride; const bool two = it2 < NE * 384;
          float va[32], vb[32];
          { const int r = it % 384; tr_load(XW_SRC(it), r < 256 ? 256 : 1024, r < 128 ? r : r < 256 ? r - 128 : r - 256, F.lane, va); }
          if (two) { const int r = it2 % 384; tr_load(XW_SRC(it2), r < 256 ? 256 : 1024, r < 128 ? r : r < 256 ? r - 128 : r - 256, F.lane, vb); }
          XW_STORE(va, it, scr);
          if (two) XW_STORE(vb, it2, scr + 64 * 33); }
#undef XW_SRC
#undef XW_STORE
    }
}
__device__ __forceinline__ void moe_offsets(Frame& F, LAS int* offs) {
    __syncthreads();
    if (F.tid < 64) { const int c = F.tid < NE ? (int)__hip_atomic_load(F.ctl + CW_CNT + F.tid * CW_CNT_STRIDE, __ATOMIC_RELAXED, __HIP_MEMORY_SCOPE_AGENT) : 0; const int p = (c + 255) & ~255; int incl = p;
#pragma unroll
        for (int o = 1; o < 32; o <<= 1) { const int v = __shfl_up(incl, o); if ((F.tid & 63) >= o) incl += v; }
        if (F.tid < NE) { offs[F.tid] = incl - p; offs[40 + F.tid] = c; for (int t = (incl - p) >> 8; t < (incl >> 8); ++t) offs[80 + t] = F.tid; } if (F.tid == NE - 1) offs[NE] = incl; }
    __syncthreads();
}
__device__ __forceinline__ int expert_of_row(LAS int* offs, int row) { return offs[80 + (row >> 8)]; }
__device__ __forceinline__ void moe_gemm1(Frame& F, LAS int* offs, int G, int c, int lo, int hi) {
    MoeOrder S{offs, 2, G, c, lo, hi};
    pg8::Gemm g{(const bf16_t*)(F.ws + WS_H2), (const bf16_t*)(F.ws + WS_W13T), DM, (const int*)(F.ws + WS_ROUTE + RT_ROWTOK)}; EpiSwiglu E{(const float*)(F.ws + WS_ROUTE + RT_ROWW), (const float*)(F.ws + WS_ROUTE + RT_ROWRR), (bf16_t*)(F.ws + WS_HID)};
    pg8::gemm_phase<EpiSwiglu, MoeOrder, PG8_ALIGN, PG8_SP2, false, true>(F.lds, g, S, E);
}
__device__ __forceinline__ void moe_gemm2(Frame& F, LAS int* offs, int G, int c, int lo, int hi) {
    MoeOrder S{offs, 4, G, c, lo, hi};
    int kde = DE; asm volatile("" : "+s"(kde));
    pg8::Gemm g{(const bf16_t*)(F.ws + WS_HID), (const bf16_t*)(F.ws + WS_W2T), kde, nullptr}; EpiY E{(bf16_t*)(F.ws + WS_YBUF)};
    pg8::gemm_phase<EpiY, MoeOrder, PG8_ALIGN, PG8_SP2, false>(F.lds, g, S, E);
}
__device__ __forceinline__ int moe_vblk(Frame& F) { return (F.G % 8 == 0) ? (F.blk % 8) * (F.G / 8) + F.blk / 8 : F.blk; }
__device__ __forceinline__ void p7_moe_a(Frame& F) {
    LAS int* offs = (LAS int*)(F.lds + 140 * 1024); moe_offsets(F, offs);
    const int n1 = (offs[NE] / 256) * 2;
    moe_gemm1(F, offs, F.G, moe_vblk(F), 0, n1 < F.G ? n1 : F.G);
}
__device__ __forceinline__ void p7_moe_b(Frame& F) {
    LAS int* offs = (LAS int*)(F.lds + 140 * 1024); moe_offsets(F, offs);
    const int T = offs[NE] / 256, n1 = T * 2; int nrem = n1 - F.G; if (nrem < 0) nrem = 0; if (nrem > F.G / 2) nrem = F.G / 2;
    const int t2 = (T < F.G / 2 ? T : F.G / 2) * 4;
    const int vb = moe_vblk(F);
    if (vb < nrem) moe_gemm1(F, offs, nrem, vb, F.G, n1);
    else moe_gemm2(F, offs, F.G - nrem, vb - nrem, 0, t2);
}
__device__ __forceinline__ void p8_moe_c(Frame& F) {
    LAS int* offs = (LAS int*)(F.lds + 140 * 1024); moe_offsets(F, offs);
    const int T = offs[NE] / 256;
    moe_gemm2(F, offs, F.G, moe_vblk(F), (T < F.G / 2 ? T : F.G / 2) * 4, T * 4);
}
__device__ __forceinline__ void p9_combine(Frame& F) {
    LAS int* offs = (LAS int*)(F.lds + 140 * 1024);
    moe_offsets(F, offs);
    const bf16_t* YB = (const bf16_t*)(F.ws + WS_YBUF); const int* tokpos = (const int*)(F.ws + WS_ROUTE + RT_TOKPOS);
    for (int t0 = F.gw * 4; t0 < M; t0 += F.NGW * 4) { int p[4][2];
#pragma unroll
        for (int q = 0; q < 4; ++q) { const int a0 = tokpos[2 * (t0 + q)], a1 = tokpos[2 * (t0 + q) + 1]; p[q][0] = offs[a0 >> ECAP_LOG] + (a0 & (ECAP - 1)); p[q][1] = offs[a1 >> ECAP_LOG] + (a1 & (ECAP - 1)); }
        f32x4 xv[4][4];
#pragma unroll
        for (int q = 0; q < 4; ++q)
#pragma unroll
            for (int j = 0; j < 4; ++j) xv[q][j] = __builtin_nontemporal_load((const f32x4*)(F.out + (size_t)(t0 + q) * DM) + F.lane + 64 * j);
#pragma unroll
        for (int q = 0; q < 4; ++q) {
            f32x4 a[4], b[4];
#pragma unroll
            for (int j = 0; j < 4; ++j) { a[j] = ld4(YB + (size_t)p[q][0] * DM + 4 * F.lane + 256 * j); b[j] = ld4(YB + (size_t)p[q][1] * DM + 4 * F.lane + 256 * j); }
#pragma unroll
            for (int j = 0; j < 4; ++j) __builtin_nontemporal_store(xv[q][j] + (a[j] + b[j]), (f32x4*)(F.out + (size_t)(t0 + q) * DM) + F.lane + 64 * j); } }
}

#define XB_TMO      128
#define XB_XCNT(j)  (256  + 64 * (j))
#define XB_XSUB(j)  (1280 + 64 * (j))
#define XB_XGEN(j)  (2304 + 64 * (j))
#define XB_TOP      3328
#define XB_TOPGEN   3392
#define XCD_BAR_WORDS 3456
#define XB_SPIN_CAP (1u << 22)

__device__ __forceinline__ unsigned xb_ld(unsigned* p)              { return __hip_atomic_load(p, __ATOMIC_RELAXED, __HIP_MEMORY_SCOPE_AGENT); }
__device__ __forceinline__ unsigned xb_add(unsigned* p, unsigned v) { return __hip_atomic_fetch_add(p, v, __ATOMIC_RELAXED, __HIP_MEMORY_SCOPE_AGENT); }
__device__ __forceinline__ unsigned xb_xcc_id() { return (unsigned)__builtin_amdgcn_s_getreg((3 << 11) | 20) & 0xFu; }
#define XB_SPIN(cond, bar) do { unsigned _sp = 0; while (cond) { __builtin_amdgcn_s_sleep(1); \
    if ((++_sp & 255u) == 0u) { if (xb_ld(&(bar)[XB_TMO])) break; if (_sp > XB_SPIN_CAP) { atomicAdd(&(bar)[XB_TMO], 1u); break; } } } } while (0)

struct XcdBarrier {
    unsigned* bar; unsigned x;
    volatile LAS unsigned* st;
};

__device__ __forceinline__ XcdBarrier xcd_barrier_post(unsigned* bar, volatile LAS unsigned* st) {
    XcdBarrier b; b.bar = bar; b.x = xb_xcc_id(); b.st = st;
    if (threadIdx.x == 0) (void)xb_add(&bar[XB_XCNT(b.x)], 1u);
    return b;
}
__device__ __forceinline__ void xcd_barrier_complete(unsigned* bar, unsigned x, unsigned& nloc, unsigned& nx) {
    const unsigned G = gridDim.x * gridDim.y * gridDim.z;
    unsigned sum, cnt, mine, sp = 0u;
    for (;;) {
        sum = 0u; cnt = 0u; mine = 0u;
#pragma unroll
        for (unsigned j = 0; j < 16; ++j) { const unsigned c = xb_ld(&bar[XB_XCNT(j)]); sum += c; cnt += (c > 0u) ? 1u : 0u; mine = (j == x) ? c : mine; }
        if (sum == G) break;
        __builtin_amdgcn_s_sleep(1);
        if ((++sp & 255u) == 0u) { if (xb_ld(&bar[XB_TMO])) break; if (sp > XB_SPIN_CAP) { atomicAdd(&bar[XB_TMO], 1u); break; } }
    }
    nloc = mine > 0u ? mine : 1u; nx = cnt > 0u ? cnt : 1u;
}

__device__ __forceinline__ void xcd_barrier(const XcdBarrier& b) {
    asm volatile("s_waitcnt vmcnt(0)" ::: "memory");
    __syncthreads();
    if (threadIdx.x == 0) {
        unsigned* bar = b.bar;
        __builtin_amdgcn_s_waitcnt(0);
        unsigned nloc = b.st[0], nx = b.st[1];
        if (nloc == 0u) { xcd_barrier_complete(bar, b.x, nloc, nx); b.st[0] = nloc; b.st[1] = nx; }
        const unsigned old = xb_add(&bar[XB_XSUB(b.x)], 1u);
        const unsigned gen = old / nloc;
        if (old + 1u == (gen + 1u) * nloc) {
            __builtin_amdgcn_fence(__ATOMIC_RELEASE, "agent");
            asm volatile("s_waitcnt vmcnt(0)" ::: "memory");
            const unsigned og = xb_add(&bar[XB_TOP], 1u);
            const unsigned tg = og / nx;
            if (og + 1u == (tg + 1u) * nx) xb_add(&bar[XB_TOPGEN], 1u);
            else XB_SPIN(xb_ld(&bar[XB_TOPGEN]) == tg, bar);
            __builtin_amdgcn_fence(__ATOMIC_ACQUIRE, "agent");
            xb_add(&bar[XB_XGEN(b.x)], 1u);
            asm volatile("s_waitcnt vmcnt(0)" ::: "memory");
        } else {
            XB_SPIN(xb_ld(&bar[XB_XGEN(b.x)]) == gen, bar);
            __builtin_amdgcn_fence(__ATOMIC_ACQUIRE, "agent");
            asm volatile("s_waitcnt vmcnt(0)" ::: "memory");
        }
    }
    __syncthreads();
}
constexpr int LDS_BYTES = 147456;
__global__ void __launch_bounds__(NTHREADS, 2) fwd_kernel(Args args) {
    extern __shared__ __attribute__((aligned(16))) unsigned char lds[];
    Frame F;
    F.lds = (LAS unsigned char*)lds; F.ldsg = (char*)lds;
    F.tid = threadIdx.x; F.lane = F.tid & 63; F.wid = __builtin_amdgcn_readfirstlane(F.tid >> 6);
    F.blk = blockIdx.x; F.G = gridDim.x; F.gw = F.blk * NWAVES + F.wid; F.NGW = F.G * NWAVES;
    F.a = &args;
    F.out = args.out; F.ws = args.ws; F.ctl = (unsigned*)(args.ws + WS_CTL);
    const int lo = args.ph_lo, hi = args.ph_hi;
#if MK_ONE_LAUNCH
    cg::grid_group grid = cg::this_grid();
    volatile LAS unsigned* bst = (volatile LAS unsigned*)(F.lds + 144 * 1024 - 16);
    if (F.tid < 2) bst[F.tid] = 0u;
    __syncthreads();
    const XcdBarrier bar = xcd_barrier_post(F.ctl + CW_BAR, bst);
#define SEAM(k) do { if (lo <= (k) && (k) + 1 < hi) { xcd_barrier(bar); } asm volatile("" : "+v"(F.tid), "+v"(F.lane)); } while (0)
    if (hi > NPHASE) grid.sync();
#else
#define SEAM(k) do { } while (0)
#endif
#define IN(k) (lo <= (k) && (k) < hi)
    if (IN(0)) { p0_prologue(F); } SEAM(0);
    if (IN(1)) { p1_proj(F); } SEAM(1);
    if (IN(2)) { p2_mixer_a(F); p2_attention(F); } SEAM(2);
    if (IN(3)) { p3_merged(F); } SEAM(3);
    if (IN(4)) { p4_out(F); } SEAM(4);
    if (IN(5)) { p5_router(F); } SEAM(5);
    if (IN(6)) { p7_moe_a(F); } SEAM(6);
    if (IN(7)) { p7_moe_b(F); } SEAM(7);
    if (IN(8)) { p8_moe_c(F); } SEAM(8);
    if (IN(9)) { p9_combine(F); }
#undef IN
#undef SEAM
}

extern "C" void kernel_launch(void* const* d_in, const int* in_sizes, int n_in, void* d_out, int out_size, void* d_ws, size_t ws_size, hipStream_t stream) {
    static int grid = 0;
    if (grid == 0) {
        if (n_in != 26 || out_size != M * DM || ws_size < WS_END) { fprintf(stderr, "kernel_launch: unexpected shapes (n_in %d out %d ws %zu)\n", n_in, out_size, ws_size); grid = -1; return; }
        int dev = 0, cus = 0, per_cu = 0;
        (void)hipGetDevice(&dev); (void)hipDeviceGetAttribute(&cus, hipDeviceAttributeMultiprocessorCount, dev);
        if (hipFuncSetAttribute((const void*)fwd_kernel, hipFuncAttributeMaxDynamicSharedMemorySize, LDS_BYTES) != hipSuccess) { fprintf(stderr, "kernel_launch: hipFuncSetAttribute failed\n"); grid = -1; return; }
        if (hipOccupancyMaxActiveBlocksPerMultiprocessor(&per_cu, (const void*)fwd_kernel, NTHREADS, LDS_BYTES) != hipSuccess || per_cu < 1) { fprintf(stderr, "kernel_launch: occupancy query says %d\n", per_cu); per_cu = 1; }
        (void)hipGetLastError();
        grid = cus;
    }
    if (grid < 0) return;
    (void)hipMemsetAsync((char*)d_ws + WS_CTL, 0, CTL_ZERO_BYTES, stream);
    Args a{};
    for (int i = 0; i < 26; ++i) a.in[i] = (const float*)d_in[i];
    a.out = (float*)d_out; a.ws = (unsigned char*)d_ws;
#if MK_ONE_LAUNCH
    a.ph_lo = 0; a.ph_hi = NPHASE;
    void* kargs[] = {&a};
    hipError_t e = hipLaunchCooperativeKernel((const void*)fwd_kernel, dim3(grid), dim3(NTHREADS), kargs, LDS_BYTES, stream);
    if (e != hipSuccess) fprintf(stderr, "cooperative launch failed: %s (grid %d)\n", hipGetErrorString(e), grid);
#else
    for (int p = 0; p < NPHASE; ++p) { a.ph_lo = p; a.ph_hi = p + 1; hipLaunchKernelGGL(fwd_kernel, dim3(grid), dim3(NTHREADS), LDS_BYTES, stream, a); }
#endif
}
```

```cpp
#include <hip/hip_runtime.h>
#include <hip/hip_cooperative_groups.h>
#include <cstdio>
#include <cstdint>
namespace cg = cooperative_groups;

#ifndef MK_ONE_LAUNCH
#define MK_ONE_LAUNCH 1
#endif

#define LAS __attribute__((address_space(3)))
typedef unsigned short bf16_t;
typedef short bf16x8 __attribute__((ext_vector_type(8)));
typedef short s16x4 __attribute__((ext_vector_type(4)));
typedef float f32x4 __attribute__((ext_vector_type(4)));
typedef float f32x16 __attribute__((ext_vector_type(16)));
typedef float f32x2 __attribute__((ext_vector_type(2)));
typedef unsigned u32x4 __attribute__((ext_vector_type(4)));
typedef unsigned u32x2 __attribute__((ext_vector_type(2)));
typedef __bf16 bf16x2_t __attribute__((ext_vector_type(2)));

constexpr int NB = 2, SEQ = 8192, DM = 1024, M = NB * SEQ;
constexpr int NH = 8;
constexpr int N1 = 7168;
constexpr int NE = 32, DE = 256;
constexpr float EPS = 1e-6f;
constexpr float LOG2E = 1.4426950408889634f;
constexpr float C2 = 0.125f * LOG2E;
constexpr float LAM_INIT = 0.2f;
constexpr int NWAVES = 8, NTHREADS = 512;
constexpr int NPHASE = 10;
constexpr int ECAP = 16384, ECAP_LOG = 14;

constexpr size_t MiB = 1u << 20;
constexpr size_t WS_CTL = 0;
constexpr size_t CTL_ZERO_BYTES = 65536;
constexpr size_t WS_W1T = 1 * MiB;
constexpr size_t WS_WUPT = 15 * MiB;
constexpr size_t WS_WOUTT = 19 * MiB;
constexpr size_t WS_WST = 21 * MiB;
constexpr size_t WS_ROUTE = 22 * MiB;
constexpr size_t WS_XN = 32 * MiB;
constexpr size_t WS_U = 64 * MiB;
constexpr size_t WS_VA = 96 * MiB;
constexpr size_t WS_Q = 128 * MiB;
constexpr size_t WS_K = 160 * MiB;
constexpr size_t WS_VB = 192 * MiB;
constexpr size_t WS_W13T = 160 * MiB;
constexpr size_t WS_W2T = 192 * MiB;
constexpr size_t WS_HID = 208 * MiB;
constexpr size_t WS_H2 = 32 * MiB;
constexpr size_t WS_YBUF = 64 * MiB;
constexpr size_t WS_YA = 224 * MiB;
constexpr size_t WS_T = 64 * MiB;
constexpr size_t WS_END = 256 * MiB;
constexpr size_t RT_TOKE = 0, RT_TOKW = 256 * 1024, RT_TOKPOS = 512 * 1024, RT_WRT = 1024 * 1024, RT_ALIST = 1536 * 1024, RT_ROWTOK = 2048 * 1024, RT_ROWW = 4096 * 1024, RT_ROWRR = 6144 * 1024;
constexpr int CW_CNT = 8192, CW_CNT_STRIDE = 64, CW_AQ = 512, CW_BAR = 1024;

#define LDS_WAIT() asm volatile("s_waitcnt lgkmcnt(0)" ::: "memory")
#define SBAR() __builtin_amdgcn_sched_barrier(0)
__device__ __forceinline__ unsigned cvtpk(float lo, float hi) { f32x2 v = {lo, hi}; bf16x2_t b = __builtin_convertvector(v, bf16x2_t); return __builtin_bit_cast(unsigned, b); }
__device__ __forceinline__ float bf2f(short b) { return __uint_as_float(((unsigned)(unsigned short)b) << 16); }
__device__ __forceinline__ float wave_sum(float v) {
#pragma unroll
    for (int o = 1; o < 64; o <<= 1) v += __shfl_xor(v, o);
    return v;
}
__device__ __forceinline__ void st4(bf16_t* p, f32x4 v) { u32x2 w; w.x = cvtpk(v[0], v[1]); w.y = cvtpk(v[2], v[3]); *(u32x2*)p = w; }
__device__ __forceinline__ f32x4 ld4(const bf16_t* p) { const u32x2 w = *(const u32x2*)p; f32x4 r; r[0] = __uint_as_float(w.x << 16); r[1] = __uint_as_float(w.x & 0xffff0000u); r[2] = __uint_as_float(w.y << 16); r[3] = __uint_as_float(w.y & 0xffff0000u); return r; }

struct Args { const float* in[26]; float* out; unsigned char* ws; int ph_lo, ph_hi; };

struct Frame {
    LAS unsigned char* lds; char* ldsg;
    int tid, lane, wid, blk, G, gw, NGW;
    const Args* a; float* out; unsigned char* ws; unsigned* ctl;
};
enum { I_X = 0, I_N1G, I_WIN, I_VNG, I_WS, I_BS, I_QNG, I_KNG, I_LQ1, I_LK1, I_LQ2, I_LK2, I_SUBG, I_WUPA, I_WUPB, I_WGATE, I_BGATE, I_WOUT, I_N2G, I_WRG, I_BRG, I_WRE, I_BRE, I_W1, I_W3, I_W2 };

__device__ __forceinline__ void wave_gemm(f32x4 (&acc)[2][4], const bf16_t* ap0, const bf16_t* ap1, const bf16_t* bp0, const bf16_t* bp1, const bf16_t* bp2, const bf16_t* bp3, int K) {
#pragma unroll 2
    for (int k0 = 0; k0 < K; k0 += 32) {
        const bf16x8 a0 = *(const bf16x8*)(ap0 + k0), a1 = *(const bf16x8*)(ap1 + k0);
        const bf16x8 b0 = *(const bf16x8*)(bp0 + k0), b1 = *(const bf16x8*)(bp1 + k0), b2 = *(const bf16x8*)(bp2 + k0), b3 = *(const bf16x8*)(bp3 + k0);
        acc[0][0] = __builtin_amdgcn_mfma_f32_16x16x32_bf16(b0, a0, acc[0][0], 0, 0, 0);
        acc[0][1] = __builtin_amdgcn_mfma_f32_16x16x32_bf16(b1, a0, acc[0][1], 0, 0, 0);
        acc[0][2] = __builtin_amdgcn_mfma_f32_16x16x32_bf16(b2, a0, acc[0][2], 0, 0, 0);
        acc[0][3] = __builtin_amdgcn_mfma_f32_16x16x32_bf16(b3, a0, acc[0][3], 0, 0, 0);
        acc[1][0] = __builtin_amdgcn_mfma_f32_16x16x32_bf16(b0, a1, acc[1][0], 0, 0, 0);
        acc[1][1] = __builtin_amdgcn_mfma_f32_16x16x32_bf16(b1, a1, acc[1][1], 0, 0, 0);
        acc[1][2] = __builtin_amdgcn_mfma_f32_16x16x32_bf16(b2, a1, acc[1][2], 0, 0, 0);
        acc[1][3] = __builtin_amdgcn_mfma_f32_16x16x32_bf16(b3, a1, acc[1][3], 0, 0, 0);
    }
}
__device__ __forceinline__ void acc_zero(f32x4 (&acc)[2][4]) {
#pragma unroll
    for (int m = 0; m < 2; ++m)
#pragma unroll
        for (int n = 0; n < 4; ++n) acc[m][n] = (f32x4){0.f, 0.f, 0.f, 0.f};
}

namespace pg8 {
#define PG8_LAS __attribute__((address_space(3)))
constexpr int BM = 256, BK = 64, HALF = 128, HTB = HALF * BK * 2  , STAGE_BYTES = 8 * HTB, NXCD = 8, WGM = 4;

__host__ __device__ __forceinline__ int lds_byte(int r, int c) { const int st = (r >> 4) * 2 + (c >> 5), rr = r & 15, cc = c & 31, ob = rr * 64 + cc * 2; return st * 1024 + (ob ^ (((ob >> 9) & 1) << 5)); }
__host__ __device__ __forceinline__ void stage_rc(int b, int& R, int& C) { const int st = b / 1024, sb = b % 1024, swz = sb ^ (((sb >> 9) & 1) << 5); R = (st >> 1) * 16 + swz / 64; C = (st & 1) * 32 + (swz % 64) / 2; }
__host__ __device__ __forceinline__ int perm32(int rho) { const int n = rho >> 4, i = rho & 15; return 8 * (i >> 2) + 4 * n + (i & 3); }

struct Unit { int pm, pn, pb, rbase, nvalid; };
struct Gemm { const bf16_t* A; const bf16_t* Bt; int K; const int* rowtok; };

struct StaticOrder {
    int nM, nN, nwg, G, c;
    __host__ __device__ void init(int M, int N, int G_, int c_) { nM = M / BM; nN = N / BM; nwg = nM * nN; G = G_; c = c_; }
    __host__ __device__ bool next(int i, Unit& u) const {
        const long L = (long)i * G + c; if (L >= nwg) return false;
        int wgid = (int)L; { const int q = nwg / NXCD, r = nwg % NXCD, xcd = wgid % NXCD, off = wgid / NXCD; wgid = (xcd < r ? xcd * (q + 1) : r * (q + 1) + (xcd - r) * q) + off; }
        const int nig = WGM * nN, gid = wgid / nig, fm = gid * WGM, gsz = (nM - fm) < WGM ? (nM - fm) : WGM;
        u.pm = fm + ((wgid % nig) % gsz); u.pn = (wgid % nig) / gsz; u.pb = u.pn; u.rbase = 0; u.nvalid = 0; return true;
    }
    __device__ __forceinline__ void a_ready(const Unit&) const {}
    __device__ __forceinline__ void done(const Unit&) const {}
};
template <class Epi, class Sched, bool ALIGN_EPI = false, bool SP2 = false, bool BP64 = false, bool GATHER = false>
__device__ __forceinline__ void gemm_phase(PG8_LAS unsigned char* lds, const Gemm g, const Sched& S, const Epi& E) {
    const int tid = threadIdx.x, wid = __builtin_amdgcn_readfirstlane(tid >> 6), lane = tid & 63, wr = wid >> 2, wc = wid & 3, fr = lane & 15, fq = lane >> 4;
    const int K = g.K, nt = K / BK;
    unsigned voffA[2], voffB[2];
#pragma unroll
    for (int i = 0; i < 2; ++i) { int R, C; stage_rc(tid * 16 + i * 8192, R, C); const int Rp = Epi::PERM ? ((R & ~31) + perm32(R & 31)) : R; const int Rb = BP64 ? (64 * (Rp >> 5) + (Rp & 31)) : Rp;
        voffA[i] = (unsigned)(R * K + C) * 2u; voffB[i] = (unsigned)(Rb * K + C) * 2u; }
    const size_t kstep = (size_t)(BK * 2);
    const size_t hstep = (size_t)HALF * K * 2;
    const size_t tstep = 2 * hstep;
    const size_t bhs = BP64 ? (size_t)32 * K * 2 : hstep;
    const unsigned ldsw = (unsigned)wid * 1024u;
    const int aoff = lds_byte(wr * 64 + fr, fq * 8), boff = lds_byte(wc * 32 + fr, fq * 8);
#define PG8_SA(b, h) (((b) * 2 + (h)) * HTB)
#define PG8_SB(b, h) ((4 + (b) * 2 + (h)) * HTB)
#define PG8_STAGE(bufoff, gbase, voff) do { _Pragma("unroll") for (int _i = 0; _i < 2; ++_i) \
        __builtin_amdgcn_global_load_lds((const unsigned*)((const char*)(gbase) + (voff)[_i]), (PG8_LAS unsigned*)(lds + (bufoff) + ldsw + _i * 8192), 16, 0, 0); } while (0)
#define PG8_LDA(dst, b, h) do { _Pragma("unroll") for (int m = 0; m < 4; ++m) _Pragma("unroll") for (int k = 0; k < 2; ++k) dst[m][k] = *(const PG8_LAS bf16x8*)(lds + PG8_SA(b, h) + aoff + m * 2048 + k * 1024); } while (0)
#define PG8_LDB(dst, b, h) do { _Pragma("unroll") for (int n = 0; n < 2; ++n) _Pragma("unroll") for (int k = 0; k < 2; ++k) dst[n][k] = *(const PG8_LAS bf16x8*)(lds + PG8_SB(b, h) + boff + n * 2048 + k * 1024); } while (0)
#define PG8_MMA(ai, bj, At, Bt) do { __builtin_amdgcn_s_setprio(1); _Pragma("unroll") for (int m = 0; m < 4; ++m) _Pragma("unroll") for (int n = 0; n < 2; ++n) _Pragma("unroll") for (int k = 0; k < 2; ++k) \
        acc[ai][bj][m][n] = __builtin_amdgcn_mfma_f32_16x16x32_bf16(Bt[n][k], At[m][k], acc[ai][bj][m][n], 0, 0, 0); __builtin_amdgcn_s_setprio(0); } while (0)
#define PG8_WAIT_V(n) asm volatile("s_waitcnt vmcnt(" #n ")" ::: "memory")
#define PG8_WAIT_L(n) asm volatile("s_waitcnt lgkmcnt(" #n ")" ::: "memory")
#define PG8_BAR __builtin_amdgcn_s_barrier()
#define PG8_SCHED __builtin_amdgcn_sched_barrier(0)
    Unit cur, nxt; int ui = 0;
    if (!S.next(0, cur)) return;
    static_assert(!GATHER || SP2, "GATHER is written for the SP2 loop");
    unsigned vA0[2] = {0u, 0u}, vA1[2] = {0u, 0u}, nvA0[2] = {0u, 0u}, nvA1[2] = {0u, 0u};
#define PG8_GLOAD(u_, d0_, d1_) do { _Pragma("unroll") for (int _i = 0; _i < 2; ++_i) { int R_, C_; stage_rc(tid * 16 + _i * 8192, R_, C_); \
        const int t0_ = R_ < (u_).nvalid ? g.rowtok[(u_).rbase + R_] : 0, t1_ = HALF + R_ < (u_).nvalid ? g.rowtok[(u_).rbase + HALF + R_] : 0; d0_[_i] = (unsigned)(t0_ * K + C_) * 2u; d1_[_i] = (unsigned)(t1_ * K + C_) * 2u; } } while (0)
#define PG8_STAGE_A(bufoff, ptr, half, vcur0, vcur1) do { if constexpr (GATHER) { PG8_STAGE(bufoff, ptr, (half) ? vcur1 : vcur0); } else { PG8_STAGE(bufoff, (ptr) + ((half) ? hstep : (size_t)0), voffA); } } while (0)
    if constexpr (GATHER) PG8_GLOAD(cur, vA0, vA1);
    f32x4 acc[2][2][4][2];
#pragma unroll
    for (int a = 0; a < 2; ++a)
#pragma unroll
        for (int b = 0; b < 2; ++b)
#pragma unroll
            for (int m = 0; m < 4; ++m)
#pragma unroll
                for (int n = 0; n < 2; ++n) acc[a][b][m][n] = (f32x4){0.f, 0.f, 0.f, 0.f};
    bf16x8 At[4][2], B0[2][2], B1[2][2];
    const char* cA = (const char*)g.A + (GATHER ? (size_t)0 : (size_t)cur.pm * tstep); const char* cB = (const char*)g.Bt + (size_t)cur.pb * tstep;
    S.a_ready(cur);
    if constexpr (SP2) {
        PG8_STAGE(PG8_SB(0, 0), cB, voffB); PG8_STAGE(PG8_SB(0, 1), cB + bhs, voffB); PG8_STAGE_A(PG8_SA(0, 0), cA, 0, vA0, vA1); PG8_STAGE_A(PG8_SA(0, 1), cA, 1, vA0, vA1);
        if (wr == 1) PG8_BAR;
        PG8_WAIT_V(2); PG8_BAR;
        PG8_STAGE(PG8_SB(1, 0), cB + kstep, voffB); PG8_STAGE_A(PG8_SA(1, 0), cA + kstep, 0, vA0, vA1); PG8_STAGE(PG8_SB(1, 1), cB + bhs + kstep, voffB);
        PG8_WAIT_V(6); PG8_BAR;
    } else {
        PG8_STAGE(PG8_SB(0, 0), cB, voffB); PG8_STAGE(PG8_SA(0, 0), cA, voffA); PG8_STAGE(PG8_SB(0, 1), cB + bhs, voffB); PG8_STAGE(PG8_SA(0, 1), cA + hstep, voffA);
        if (wr == 1) PG8_BAR;
        PG8_WAIT_V(4); PG8_BAR;
        PG8_STAGE(PG8_SB(1, 0), cB + kstep, voffB); PG8_STAGE(PG8_SA(1, 0), cA + kstep, voffA); PG8_STAGE(PG8_SB(1, 1), cB + bhs + kstep, voffB);
        PG8_WAIT_V(6); PG8_BAR;
    }
    for (;;) {
        const bool has_next = S.next(ui + 1, nxt);
        const char* nA = (has_next && !GATHER) ? (const char*)g.A + (size_t)nxt.pm * tstep : cA; const char* nB = has_next ? (const char*)g.Bt + (size_t)nxt.pb * tstep : cB;
        if constexpr (GATHER) { if (has_next) { PG8_GLOAD(nxt, nvA0, nvA1); } else { nvA0[0] = vA0[0]; nvA0[1] = vA0[1]; nvA1[0] = vA1[0]; nvA1[1] = vA1[1]; } }
        for (int t = 0; t < nt; t += 2) {
            const bool last = (t == nt - 2);
            const char* a1 = cA + (size_t)(t + 1) * kstep;
            const char* a2 = last ? nA : cA + (size_t)(t + 2) * kstep; const char* b2 = last ? nB : cB + (size_t)(t + 2) * kstep;
            const char* a3 = a2 + kstep; const char* b3 = b2 + kstep;
            if (last && has_next) S.a_ready(nxt);
            unsigned xA0[2], xA1[2];
            if constexpr (GATHER) { xA0[0] = last ? nvA0[0] : vA0[0]; xA0[1] = last ? nvA0[1] : vA0[1]; xA1[0] = last ? nvA1[0] : vA1[0]; xA1[1] = last ? nvA1[1] : vA1[1]; }
            if constexpr (SP2) {
            PG8_LDB(B0, 0, 0); PG8_LDB(B1, 0, 1); PG8_SCHED; PG8_LDA(At, 0, 0); PG8_STAGE_A(PG8_SA(1, 1), a1, 1, vA0, vA1);
            PG8_WAIT_V(8); PG8_WAIT_L(0); PG8_BAR; PG8_MMA(0, 0, At, B0); PG8_MMA(0, 1, At, B1); PG8_BAR; PG8_SCHED;
            PG8_LDA(At, 0, 1); PG8_STAGE(PG8_SB(0, 0), b2, voffB); PG8_STAGE(PG8_SB(0, 1), b2 + bhs, voffB); PG8_STAGE_A(PG8_SA(0, 0), a2, 0, xA0, xA1);
            PG8_WAIT_V(8); PG8_WAIT_L(0); PG8_BAR; PG8_MMA(1, 0, At, B0); PG8_MMA(1, 1, At, B1); PG8_BAR; PG8_SCHED;
            PG8_LDB(B0, 1, 0); PG8_LDB(B1, 1, 1); PG8_SCHED; PG8_LDA(At, 1, 0); PG8_STAGE_A(PG8_SA(0, 1), a2, 1, xA0, xA1);
            PG8_WAIT_V(8); PG8_WAIT_L(0); PG8_BAR; PG8_MMA(0, 0, At, B0); PG8_MMA(0, 1, At, B1); PG8_BAR; PG8_SCHED;
            PG8_LDA(At, 1, 1); PG8_STAGE(PG8_SB(1, 0), b3, voffB); PG8_STAGE(PG8_SB(1, 1), b3 + bhs, voffB); PG8_STAGE_A(PG8_SA(1, 0), a3, 0, xA0, xA1);
            PG8_WAIT_V(8); PG8_WAIT_L(0); PG8_BAR; PG8_MMA(1, 0, At, B0); PG8_MMA(1, 1, At, B1); PG8_BAR; PG8_SCHED;
            } else {
            PG8_LDB(B0, 0, 0); PG8_SCHED; PG8_LDA(At, 0, 0); PG8_STAGE(PG8_SA(1, 1), a1 + hstep, voffA);
            PG8_WAIT_L(8); PG8_BAR; PG8_WAIT_L(0); PG8_MMA(0, 0, At, B0); PG8_BAR; PG8_SCHED;
            PG8_LDB(B1, 0, 1); PG8_STAGE(PG8_SB(0, 0), b2, voffB);
            PG8_BAR; PG8_WAIT_L(0); PG8_MMA(0, 1, At, B1); PG8_BAR;
            PG8_LDA(At, 0, 1); PG8_STAGE(PG8_SA(0, 0), a2, voffA);
            PG8_BAR; PG8_WAIT_L(0); PG8_MMA(1, 0, At, B0); PG8_BAR; PG8_SCHED;
            PG8_STAGE(PG8_SB(0, 1), b2 + bhs, voffB);
            PG8_WAIT_V(6); PG8_BAR; PG8_MMA(1, 1, At, B1); PG8_BAR;
            PG8_LDB(B0, 1, 0); PG8_SCHED; PG8_LDA(At, 1, 0); PG8_STAGE(PG8_SA(0, 1), a2 + hstep, voffA);
            PG8_WAIT_L(8); PG8_BAR; PG8_WAIT_L(0); PG8_MMA(0, 0, At, B0); PG8_BAR; PG8_SCHED;
            PG8_LDB(B1, 1, 1); PG8_STAGE(PG8_SB(1, 0), b3, voffB);
            PG8_BAR; PG8_WAIT_L(0); PG8_MMA(0, 1, At, B1); PG8_BAR;
            PG8_LDA(At, 1, 1); PG8_STAGE(PG8_SA(1, 0), a3, voffA);
            PG8_BAR; PG8_WAIT_L(0); PG8_MMA(1, 0, At, B0); PG8_BAR; PG8_SCHED;
            PG8_STAGE(PG8_SB(1, 1), b3 + bhs, voffB);
            PG8_WAIT_V(6); PG8_BAR; PG8_MMA(1, 1, At, B1); PG8_BAR;
            }
        }
        if constexpr (ALIGN_EPI) { if (wr == 0) PG8_BAR; }
        if constexpr (!Epi::AFTER_DRAIN) { E(acc, cur, wr, wc, fr, fq); S.done(cur); }
        if (!has_next) break;
#pragma unroll
        for (int a = 0; a < 2; ++a)
#pragma unroll
            for (int b = 0; b < 2; ++b)
#pragma unroll
                for (int m = 0; m < 4; ++m)
#pragma unroll
                    for (int n = 0; n < 2; ++n) acc[a][b][m][n] = (f32x4){0.f, 0.f, 0.f, 0.f};
        cur = nxt; cA = nA; cB = nB; ++ui;
        if constexpr (GATHER) { vA0[0] = nvA0[0]; vA0[1] = nvA0[1]; vA1[0] = nvA1[0]; vA1[1] = nvA1[1]; }
        if constexpr (ALIGN_EPI) { if (wr == 1) PG8_BAR; }
    }
    PG8_WAIT_V(0);
    if constexpr (!ALIGN_EPI) { if (wr == 0) PG8_BAR; }
    PG8_BAR;
    if constexpr (Epi::AFTER_DRAIN) { E.fused(acc, cur, wr, wc, fr, fq, lds, wid, lane); S.done(cur); }
#undef PG8_GLOAD
#undef PG8_STAGE_A
#undef PG8_SA
#undef PG8_SB
#undef PG8_STAGE
#undef PG8_LDA
#undef PG8_LDB
#undef PG8_MMA
#undef PG8_WAIT_V
#undef PG8_WAIT_L
#undef PG8_BAR
#undef PG8_SCHED
}
}

#define PG8_SP2 true
#define PG8_ALIGN true
__device__ __forceinline__ void st8nt(bf16_t* p, f32x4 a, f32x4 b) { u32x4 w; w.x = cvtpk(a[0], a[1]); w.y = cvtpk(a[2], a[3]); w.z = cvtpk(b[0], b[1]); w.w = cvtpk(b[2], b[3]); __builtin_nontemporal_store(w, (u32x4*)p); }
__device__ __forceinline__ void st8(bf16_t* p, f32x4 a, f32x4 b) { u32x4 w; w.x = cvtpk(a[0], a[1]); w.y = cvtpk(a[2], a[3]); w.z = cvtpk(b[0], b[1]); w.w = cvtpk(b[2], b[3]); *(u32x4*)p = w; }
__device__ __forceinline__ void ld8(const bf16_t* p, f32x4& a, f32x4& b) { const u32x4 w = *(const u32x4*)p;
    a[0] = __uint_as_float(w.x << 16); a[1] = __uint_as_float(w.x & 0xffff0000u); a[2] = __uint_as_float(w.y << 16); a[3] = __uint_as_float(w.y & 0xffff0000u);
    b[0] = __uint_as_float(w.z << 16); b[1] = __uint_as_float(w.z & 0xffff0000u); b[2] = __uint_as_float(w.w << 16); b[3] = __uint_as_float(w.w & 0xffff0000u); }
struct EpiProj {
    static constexpr bool PERM = true, AFTER_DRAIN = false;
    unsigned char* ws; bf16_t* GATE; const float *qg, *kg, *bgate;
    __device__ __forceinline__ void operator()(const f32x4 (&acc)[2][2][4][2], const pg8::Unit& u, int wr, int wc, int fr, int fq) const {
        asm volatile("" : "+v"(fr), "+v"(fq));
        const int seg = u.pn >> 2;
        const int row0 = u.pm * 256 + wr * 64 + fr;
        const int cw = (u.pn & 3) * 256 + wc * 64 + 8 * fq;
        if (seg <= 1 || seg == 4) { bf16_t* dst = (bf16_t*)(ws + WS_U + (size_t)seg * (32 * MiB)) + cw;
#pragma unroll
            for (int ai = 0; ai < 2; ++ai)
#pragma unroll
                for (int m = 0; m < 4; ++m) { bf16_t* rp = dst + (size_t)(row0 + ai * 128 + m * 16) * DM;
#pragma unroll
                    for (int bj = 0; bj < 2; ++bj) st8nt(rp + 32 * bj, acc[ai][bj][m][0], acc[ai][bj][m][1]); }
        } else if (seg == 2 || seg == 3) { const float* g = (seg == 2 ? qg : kg) + 8 * fq; bf16_t* dst = (bf16_t*)(ws + WS_U + (size_t)seg * (32 * MiB)) + cw; const float sc = seg == 2 ? C2 : 1.f;
            f32x4 gv[2][2];
#pragma unroll
            for (int bj = 0; bj < 2; ++bj)
#pragma unroll
                for (int n = 0; n < 2; ++n) gv[bj][n] = *(const f32x4*)(g + 32 * bj + 4 * n) * sc;
#pragma unroll
            for (int ai = 0; ai < 2; ++ai)
#pragma unroll
                for (int m = 0; m < 4; ++m) { float ss = 0.f;
#pragma unroll
                    for (int bj = 0; bj < 2; ++bj)
#pragma unroll
                        for (int n = 0; n < 2; ++n) { const f32x4 a = acc[ai][bj][m][n]; ss += (a[0] * a[0] + a[1] * a[1]) + (a[2] * a[2] + a[3] * a[3]); }
                    ss += __shfl_xor(ss, 16); ss += __shfl_xor(ss, 32);
                    const float r = rsqrtf(ss * (1.f / 64.f) + EPS); bf16_t* rp = dst + (size_t)(row0 + ai * 128 + m * 16) * DM;
#pragma unroll
                    for (int bj = 0; bj < 2; ++bj) st8nt(rp + 32 * bj, (acc[ai][bj][m][0] * r) * gv[bj][0], (acc[ai][bj][m][1] * r) * gv[bj][1]); }
        } else { const int c = (u.pn - 20) * 256 + wc * 64 + 8 * fq; const float* bg = bgate + c;
#pragma unroll
            for (int bj = 0; bj < 2; ++bj) { const f32x4 b0 = *(const f32x4*)(bg + 32 * bj), b1 = *(const f32x4*)(bg + 32 * bj + 4);
#pragma unroll
                for (int ai = 0; ai < 2; ++ai)
#pragma unroll
                    for (int m = 0; m < 4; ++m) { f32x4 v0 = acc[ai][bj][m][0] + b0, v1 = acc[ai][bj][m][1] + b1;
#pragma unroll
                        for (int j = 0; j < 4; ++j) { v0[j] = __builtin_amdgcn_rcpf(1.f + __builtin_amdgcn_exp2f(-LOG2E * v0[j])); v1[j] = __builtin_amdgcn_rcpf(1.f + __builtin_amdgcn_exp2f(-LOG2E * v1[j])); }
                        st8nt(GATE + (size_t)(row0 + ai * 128 + m * 16) * 2048 + c + 32 * bj, v0, v1); } }
        }
    }
};

#define EPI_LOOP(...) _Pragma("unroll") for (int ai = 0; ai < 2; ++ai) _Pragma("unroll") for (int m = 0; m < 4; ++m) { const size_t row = (size_t)(u.pm * 256 + wr * 64 + fr + ai * 128 + m * 16); \
        _Pragma("unroll") for (int bj = 0; bj < 2; ++bj) { const int col = u.pn * 256 + bj * 128 + wc * 32 + 8 * fq; const f32x4 a0 = acc[ai][bj][m][0], a1 = acc[ai][bj][m][1]; __VA_ARGS__ } if (m & 1) asm volatile("" ::: "memory"); }
struct EpiGateT {
    static constexpr bool PERM = true, AFTER_DRAIN = false;
    const bf16_t* GATE; bf16_t* T;
    __device__ __forceinline__ void operator()(const f32x4 (&acc)[2][2][4][2], const pg8::Unit& u, int wr, int wc, int fr, int fq) const {
        asm volatile("" : "+v"(fr), "+v"(fq));
        EPI_LOOP( f32x4 g0, g1; ld8(GATE + row * 2048 + col, g0, g1); st8(T + row * DM + col, g0 * a0, g1 * a1); )
    }
};
struct EpiMerged {
    static constexpr bool PERM = true, AFTER_DRAIN = false;
    const bf16_t* GATE; const bf16_t* T; bf16_t* MG;
    __device__ __forceinline__ void operator()(const f32x4 (&acc)[2][2][4][2], const pg8::Unit& u, int wr, int wc, int fr, int fq) const {
        asm volatile("" : "+v"(fr), "+v"(fq));
        EPI_LOOP( f32x4 g0, g1, t0, t1; ld8(GATE + row * 2048 + 1024 + col, g0, g1); ld8(T + row * DM + col, t0, t1); st8(MG + row * DM + col, t0 + g0 * a0, t1 + g1 * a1); )
    }
};
struct EpiOut {
    static constexpr bool PERM = true, AFTER_DRAIN = false;
    const float* x; float* out; const float* g2; bf16_t* H2;
    __device__ __forceinline__ void operator()(const f32x4 (&acc)[2][2][4][2], const pg8::Unit& u, int wr, int wc, int fr, int fq) const {
        asm volatile("" : "+v"(fr), "+v"(fq));
        EPI_LOOP( const float* xp = x + row * DM + col; float* op = out + row * DM + col; const f32x4 x0 = __builtin_nontemporal_load((const f32x4*)xp) + a0, x1 = __builtin_nontemporal_load((const f32x4*)(xp + 4)) + a1; *(f32x4*)op = x0; *(f32x4*)(op + 4) = x1;
                  st8(H2 + row * DM + col, x0 * *(const f32x4*)(g2 + col), x1 * *(const f32x4*)(g2 + col + 4)); )
    }
};
struct EpiY {
    static constexpr bool PERM = true, AFTER_DRAIN = false;
    bf16_t* Y;
    __device__ __forceinline__ void operator()(const f32x4 (&acc)[2][2][4][2], const pg8::Unit& u, int wr, int wc, int fr, int fq) const {
        asm volatile("" : "+v"(fr), "+v"(fq));
        EPI_LOOP( st8(Y + row * DM + col, a0, a1); )
    }
};
struct EpiSwiglu {
    static constexpr bool PERM = true, AFTER_DRAIN = false;
    const float* roww; const float* rowrr; bf16_t* HID;
    __device__ __forceinline__ void operator()(const f32x4 (&acc)[2][2][4][2], const pg8::Unit& u, int wr, int wc, int fr, int fq) const {
        asm volatile("" : "+v"(fr), "+v"(fq));
#pragma unroll
        for (int ai = 0; ai < 2; ++ai)
#pragma unroll
            for (int m = 0; m < 4; ++m) { const int rl = wr * 64 + fr + ai * 128 + m * 16; const size_t row = (size_t)(u.pm * 256 + rl); const float w = rl < u.nvalid ? roww[u.rbase + rl] : 0.f, rr = rl < u.nvalid ? rowrr[u.rbase + rl] : 0.f;
                f32x4 hv[2];
#pragma unroll
                for (int n = 0; n < 2; ++n) { const f32x4 a1 = acc[ai][0][m][n] * rr, a3 = acc[ai][1][m][n] * rr;
#pragma unroll
                    for (int j = 0; j < 4; ++j) hv[n][j] = ((a1[j] * __builtin_amdgcn_rcpf(1.f + __builtin_amdgcn_exp2f(-LOG2E * a1[j]))) * a3[j]) * w; }
                st8(HID + row * DE + u.pn * 128 + wc * 32 + 8 * fq, hv[0], hv[1]); }
    }
};
__device__ __forceinline__ int expert_of_row(LAS int* offs, int row);
struct MoeOrder {
    LAS int* offs; int npn, G, c, lo, hi;
    __device__ __forceinline__ bool next(int i, pg8::Unit& u) const { const int L = lo + i * G + c; if (L >= hi || c < 0) return false;
        const int tile = L / npn, pn = L - tile * npn, e = expert_of_row(offs, tile * 256), lr0 = tile * 256 - offs[e], nv = offs[40 + e] - lr0;
        u.pm = tile; u.pn = pn; u.pb = e * npn + pn; u.rbase = e * ECAP + lr0; u.nvalid = nv < 256 ? nv : 256; return true; }
    __device__ __forceinline__ void a_ready(const pg8::Unit&) const {}
    __device__ __forceinline__ void done(const pg8::Unit&) const {}
};

__device__ __forceinline__ float attn_dmin_unit(const float* qg, const float* kg) {
    const int ln = threadIdx.x & 63; float a = fabsf(qg[ln]), b = fabsf(kg[ln]);
#pragma unroll
    for (int o = 1; o < 64; o <<= 1) { a = fmaxf(a, __shfl_xor(a, o)); b = fmaxf(b, __shfl_xor(b, o)); }
    return 2.02f * (8.f * a * b) + 106.f;
}
__device__ __forceinline__ int attn_jlo(float dmin1, int h, int qb) {
    const float dmin = dmin1 * exp2f((float)(h + 1)); const float lowk = (float)(qb * 128) - dmin;
    return lowk > 0.f ? ((int)lowk) >> 6 : 0;
}
__device__ __forceinline__ void tr_load(const float* W, int N, int item, int lane, float (&v)[32]) {
    const int nblk = N / 32, kb = item / nblk, nb = item % nblk, k0 = 64 * kb, n0 = 32 * nb;
    const float* wp = W + (size_t)(k0 + (lane >> 5)) * N + n0 + (lane & 31);
#pragma unroll
    for (int i = 0; i < 32; ++i) v[i] = __builtin_nontemporal_load(wp + (size_t)(2 * i) * N);
}
template <class RM>
__device__ __forceinline__ void tr_store(const float (&v)[32], int N, bf16_t* WT, int ldt, int koff, RM rm, LAS float* scr, int item, int lane) {
    const int nblk = N / 32, kb = item / nblk, nb = item % nblk, k0 = 64 * kb, n0 = 32 * nb;
    { LAS float* sp = scr + (lane >> 5) * 33 + (lane & 31);
#pragma unroll
      for (int i = 0; i < 32; ++i) sp[2 * i * 33] = v[i]; }
    LDS_WAIT(); asm volatile("" ::: "memory");
    const int c = lane & 7;
#pragma unroll
    for (int j = 0; j < 4; ++j) { const int n = (lane >> 3) + 8 * j; const LAS float* s = scr + (8 * c) * 33 + n;
        u32x4 o; o.x = cvtpk(s[0 * 33], s[1 * 33]); o.y = cvtpk(s[2 * 33], s[3 * 33]); o.z = cvtpk(s[4 * 33], s[5 * 33]); o.w = cvtpk(s[6 * 33], s[7 * 33]);
        *(u32x4*)(WT + (size_t)rm(n0 + n) * ldt + koff + k0 + 8 * c) = o; }
    LDS_WAIT(); asm volatile("" ::: "memory");
}
template <class RM>
__device__ __forceinline__ void transpose_item(const float* W, int N, bf16_t* WT, int ldt, int koff, RM rm, LAS float* scr, int item, int lane) {
    float v[32]; tr_load(W, N, item, lane, v); tr_store(v, N, WT, ldt, koff, rm, scr, item, lane);
}
template <class RM>
__device__ __forceinline__ void transpose_block_item(const float* W, int N, int k0, int n0, bf16_t* WT, int ldt, int koff, RM rm, LAS unsigned char* lds, int tid) {
    const int w = tid >> 6, lane = tid & 63;
    f32x4 v[8];
#pragma unroll
    for (int r = 0; r < 8; ++r) v[r] = __builtin_nontemporal_load((const f32x4*)(W + (size_t)(k0 + 8 * w + r) * N + n0 + 4 * lane));
#pragma unroll
    for (int c = 0; c < 4; ++c) { u32x4 o; o.x = cvtpk(v[0][c], v[1][c]); o.y = cvtpk(v[2][c], v[3][c]); o.z = cvtpk(v[4][c], v[5][c]); o.w = cvtpk(v[6][c], v[7][c]);
        *(LAS u32x4*)(lds + (4 * lane + c) * 144 + 16 * w) = o; }
    __syncthreads();
#pragma unroll
    for (int i = 0; i < 4; ++i) { const int q = tid + 512 * i, row = q >> 3, ch = q & 7;
        *(u32x4*)(WT + (size_t)rm(n0 + row) * ldt + koff + k0 + 8 * ch) = *(const LAS u32x4*)(lds + row * 144 + 16 * ch); }
    __syncthreads();
}
struct RmAdd { int off; __device__ __forceinline__ int operator()(int n) const { return off + n; } };
struct RmW13 { int off; __device__ __forceinline__ int operator()(int n) const { return off + (n >> 7) * 256 + (n & 127); } };

__device__ __forceinline__ void p0_prologue(Frame& F) {
    bf16_t* W1T = (bf16_t*)(F.ws + WS_W1T); bf16_t* WUPT = (bf16_t*)(F.ws + WS_WUPT); bf16_t* WOUTT = (bf16_t*)(F.ws + WS_WOUTT);
    { constexpr int I_A = 16 * 20, I_B = 16 * 8, I_C = 16 * 4; constexpr int NITEMS = I_A + I_B + 3 * I_C;
      for (int it = F.blk; it < NITEMS; it += F.G) { int r = it;
          if (r < I_A) { transpose_block_item(F.a->in[I_WIN], 5120, 64 * (r / 20), 256 * (r % 20), W1T, 1024, 0, RmAdd{0}, F.lds, F.tid); continue; } r -= I_A;
          if (r < I_B) { transpose_block_item(F.a->in[I_WGATE], 2048, 64 * (r / 8), 256 * (r % 8), W1T, 1024, 0, RmAdd{5120}, F.lds, F.tid); continue; } r -= I_B;
          if (r < I_C) { transpose_block_item(F.a->in[I_WUPA], 1024, 64 * (r / 4), 256 * (r % 4), WUPT, 1024, 0, RmAdd{0}, F.lds, F.tid); continue; } r -= I_C;
          if (r < I_C) { transpose_block_item(F.a->in[I_WUPB], 1024, 64 * (r / 4), 256 * (r % 4), WUPT, 1024, 0, RmAdd{1024}, F.lds, F.tid); continue; } r -= I_C;
          transpose_block_item(F.a->in[I_WOUT], 1024, 64 * (r / 4), 256 * (r % 4), WOUTT, 1024, 0, RmAdd{0}, F.lds, F.tid); } }
    { bf16_t* WST = (bf16_t*)(F.ws + WS_WST); const float* ws_ = F.a->in[I_WS];
      for (int i = F.blk * NTHREADS + F.tid; i < 8 * 128 * 128 / 2; i += F.G * NTHREADS) { const int e = 2 * i, s = e & 127, t = (e >> 7) & 127;
          const float a = (s <= t) ? ws_[e] : 0.f, b = (s + 1 <= t) ? ws_[e + 1] : 0.f; *(unsigned*)(WST + e) = cvtpk(a, b); } }
    { float* WRT = (float*)(F.ws + WS_ROUTE + RT_WRT); const float* g2 = F.a->in[I_N2G]; const float* wrg = F.a->in[I_WRG]; const float* wre = F.a->in[I_WRE];
      for (int i = F.blk * NTHREADS + F.tid; i < 48 * 1024; i += F.G * NTHREADS) { const int j = i >> 10, k = i & 1023;
          const float w = j < 4 ? wrg[k * 4 + j] : (j < 36 ? wre[k * 32 + (j - 4)] : 0.f); WRT[i] = g2[k] * w; } }
    if (F.blk == 0) { LAS int* hist = (LAS int*)(F.lds + 136 * 1024); LAS int* gt = hist + 160;
        for (int i = F.tid; i < 320; i += NTHREADS) hist[i] = 0;
        __syncthreads();
        const float dmin1 = attn_dmin_unit(F.a->in[I_QNG], F.a->in[I_KNG]);
        int w[2], jl[2];
#pragma unroll
        for (int q = 0; q < 2; ++q) { const int u = F.tid + q * NTHREADS, qb = u >> 4; jl[q] = attn_jlo(dmin1, u & 7, qb); w[q] = 2 * qb + 2 - jl[q]; atomicAdd((int*)(hist + w[q]), 1); }
        __syncthreads();
        if (F.tid < 64) { int h0 = 0, h1 = 0, h2 = 0; const int i0 = 3 * F.tid;
            if (i0 < 160) h0 = hist[i0]; if (i0 + 1 < 160) h1 = hist[i0 + 1]; if (i0 + 2 < 160) h2 = hist[i0 + 2];
            const int tot = h0 + h1 + h2; int suf = tot;
#pragma unroll
            for (int o = 1; o < 64; o <<= 1) { const int vv = __shfl_down(suf, o); if (F.tid + o < 64) suf += vv; }
            const int above = suf - tot;
            if (i0 + 2 < 160) gt[i0 + 2] = above; if (i0 + 1 < 160) gt[i0 + 1] = above + h2; if (i0 < 160) gt[i0] = above + h2 + h1; }
        __syncthreads();
#pragma unroll
        for (int q = 0; q < 2; ++q) { const int u = F.tid + q * NTHREADS; const int rank = atomicAdd((int*)(gt + w[q]), 1);
            ((int*)(F.ws + WS_ROUTE + RT_ALIST))[rank] = u | (jl[q] << 16); }
        __syncthreads(); }
    { bf16_t* XN = (bf16_t*)(F.ws + WS_XN); const float* x = F.a->in[I_X]; const f32x4* g4 = (const f32x4*)F.a->in[I_N1G] + F.lane;
      for (int m0 = F.gw * 4; m0 < M; m0 += F.NGW * 4) { f32x4 v[4][4];
#pragma unroll
          for (int q = 0; q < 4; ++q) { const f32x4* xr = (const f32x4*)(x + (size_t)(m0 + q) * DM) + F.lane;
#pragma unroll
              for (int j = 0; j < 4; ++j) v[q][j] = __builtin_nontemporal_load(xr + 64 * j); }
#pragma unroll
          for (int q = 0; q < 4; ++q) { float s = 0.f;
#pragma unroll
              for (int j = 0; j < 4; ++j) s += (v[q][j][0] * v[q][j][0] + v[q][j][1] * v[q][j][1]) + (v[q][j][2] * v[q][j][2] + v[q][j][3] * v[q][j][3]);
              const float r = rsqrtf(wave_sum(s) * (1.f / DM) + EPS);
#pragma unroll
              for (int j = 0; j < 4; ++j) { const f32x4 g = g4[64 * j]; st4(XN + (size_t)(m0 + q) * DM + 4 * F.lane + 256 * j, (v[q][j] * r) * g); } } } }
}

__device__ __forceinline__ void p1_proj(Frame& F) {
    pg8::Gemm g{(const bf16_t*)(F.ws + WS_XN), (const bf16_t*)(F.ws + WS_W1T), DM, nullptr};
    pg8::StaticOrder S; S.init(M, N1, F.G, F.blk);
    static_assert(WS_VA == WS_U + 32 * MiB && WS_Q == WS_U + 64 * MiB && WS_K == WS_U + 96 * MiB && WS_VB == WS_U + 128 * MiB, "EpiProj layout");
    EpiProj E{F.ws, (bf16_t*)F.out, F.a->in[I_QNG], F.a->in[I_KNG], F.a->in[I_BGATE]};
    pg8::gemm_phase<EpiProj, pg8::StaticOrder, PG8_ALIGN, PG8_SP2, true>(F.lds, g, S, E);
}

__device__ __forceinline__ void p2_mixer_a(Frame& F) {
    const bf16_t* VA = (const bf16_t*)(F.ws + WS_VA); const bf16_t* U = (const bf16_t*)(F.ws + WS_U); bf16_t* YA = (bf16_t*)(F.ws + WS_YA); const bf16_t* WST = (const bf16_t*)(F.ws + WS_WST);
    const float* gv = F.a->in[I_VNG]; const float* bs = F.a->in[I_BS];
    bf16_t* vT = (bf16_t*)F.ldsg;
    bf16_t* wS = (bf16_t*)(F.ldsg + 128 * 136 * 2);
    const int fr = F.lane & 15, fq = F.lane >> 4, wm = F.wid >> 1, wn = F.wid & 1;
    const int s_ = F.tid >> 2, ds = (F.tid & 3) * 32;
    int gstaged = -1;
    bf16x8 v[4];
    if (F.blk < 1024) { const int c = F.blk >> 3, g = F.blk & 7; const bf16_t* src = VA + (size_t)(c * 128 + s_) * DM + g * 128 + ds;
#pragma unroll
        for (int i = 0; i < 4; ++i) v[i] = *(const bf16x8*)(src + 8 * i); }
    for (int L = F.blk; L < 1024; L += F.G) {
        const int c = L >> 3, g = L & 7;
        if (g != gstaged) { __syncthreads();
#pragma unroll
            for (int i = 0; i < 4; ++i) { const int q = F.tid + 512 * i, t = q >> 4, ch = q & 15; *(bf16x8*)(wS + t * 136 + 8 * ch) = *(const bf16x8*)(WST + g * 16384 + t * 128 + 8 * ch); }
            gstaged = g; }
        { float ss = 0.f;
#pragma unroll
          for (int i = 0; i < 4; ++i)
#pragma unroll
              for (int j = 0; j < 8; ++j) { const float x = bf2f(v[i][j]); ss += x * x; }
          ss += __shfl_xor(ss, 1); ss += __shfl_xor(ss, 2);
          const float r = rsqrtf(ss * (1.f / 128.f) + EPS);
#pragma unroll
          for (int i = 0; i < 4; ++i)
#pragma unroll
              for (int j = 0; j < 8; ++j) { const int d = ds + 8 * i + j; const float x = (bf2f(v[i][j]) * r) * gv[g * 128 + d]; vT[d * 136 + s_] = (bf16_t)(cvtpk(x, 0.f) & 0xffffu); } }
        __syncthreads();
        const int Ln = L + F.G;
        if (Ln < 1024) { const bf16_t* src = VA + (size_t)((Ln >> 3) * 128 + s_) * DM + (Ln & 7) * 128 + ds;
#pragma unroll
            for (int i = 0; i < 4; ++i) v[i] = *(const bf16x8*)(src + 8 * i); }
        f32x4 uu[2][4]; float bb[2];
#pragma unroll
        for (int m = 0; m < 2; ++m) { const int t = 32 * wm + 16 * m + fr; bb[m] = bs[g * 128 + t]; const bf16_t* up = U + (size_t)(c * 128 + t) * DM + g * 128 + 64 * wn + 4 * fq;
#pragma unroll
            for (int n = 0; n < 4; ++n) uu[m][n] = ld4(up + 16 * n); }
        const bf16_t* ap = wS + (32 * wm + fr) * 136 + 8 * fq; const bf16_t* bp = vT + (64 * wn + fr) * 136 + 8 * fq;
        f32x4 acc[2][4]; acc_zero(acc);
        wave_gemm(acc, ap, ap + 16 * 136, bp, bp + 16 * 136, bp + 32 * 136, bp + 48 * 136, 32 * (wm + 1));
#pragma unroll
        for (int m = 0; m < 2; ++m) { const int t = 32 * wm + 16 * m + fr; bf16_t* yp = YA + (size_t)(c * 128 + t) * DM + g * 128 + 64 * wn + 4 * fq;
#pragma unroll
            for (int n = 0; n < 4; ++n) st4(yp + 16 * n, uu[m][n] * (acc[m][n] + bb[m])); }
        __syncthreads();
    }
}

namespace att {
constexpr int QBLK = 32, KVBLK = 64, QB = 128, PITCH = 1024;
constexpr int SHM_V = KVBLK * 128 * 2, SHM_K = 2 * KVBLK * 64 * 2;
constexpr int SLOT = SHM_K + SHM_V, NSLOT = 3;
constexpr int LDS_WSF = NSLOT * SLOT, LDS_XCH = LDS_WSF + NWAVES * 64 * 4, LDS_BYTES = LDS_XCH + 4 * 16 * 2 * 64 * 4;
constexpr float THR2 = 8.f * LOG2E;
#define KSWZ64(row, colB) ((row) * 128 + ((colB) ^ ((((row) >> 1) & 7) << 4)))
__device__ __forceinline__ int v_st(int k, int c) { const int kk = (k & ~0xC) | ((k & 4) << 1) | ((k & 8) >> 1); return ((kk >> 3) * 4 + (c >> 5)) * 512 + ((kk & 7) * 32 + (c & 31)) * 2; }
__device__ __forceinline__ int v_rd_base(int lane) { return ((lane & 3) << 3) | (((lane >> 2) & 3) << 6) | (((lane >> 4) & 1) << 5) | (((lane >> 5) & 1) << 8); }
constexpr int v_rd_off(int d0, int ks, int half) { return d0 * 512 + ks * 4096 + half * 2048; }
__device__ __forceinline__ int crow(int r, int hi) { return (r & 3) + 8 * (r >> 2) + 4 * hi; }

__device__ __forceinline__ void mask_tile(f32x16& p0, f32x16& p1, int dq) {
    const float NEG = -__builtin_inff();
#pragma unroll
    for (int r = 0; r < 16; ++r) { const int c = (r & 3) + 8 * (r >> 2);
        if (dq - c < 0) p0[r] = NEG;
        if (dq - c - 32 < 0) p1[r] = NEG; }
}
__device__ __forceinline__ void partialSM(f32x16& p0, f32x16& p1, float& m_reg, float& alpha) {
    float pmax = __builtin_fmaxf(__builtin_fmaxf(p0[0], p0[1]), p0[2]);
#pragma unroll
    for (int r = 3; r < 15; r += 2) pmax = __builtin_fmaxf(__builtin_fmaxf(pmax, p0[r]), p0[r + 1]);
    pmax = __builtin_fmaxf(__builtin_fmaxf(pmax, p0[15]), p1[0]);
#pragma unroll
    for (int r = 1; r < 15; r += 2) pmax = __builtin_fmaxf(__builtin_fmaxf(pmax, p1[r]), p1[r + 1]);
    pmax = __builtin_fmaxf(pmax, p1[15]);
    { auto rr = __builtin_amdgcn_permlane32_swap(__float_as_uint(pmax), __float_as_uint(pmax), false, false);
      pmax = fmaxf(__uint_as_float(rr[0]), __uint_as_float(rr[1])); }
    alpha = 1.f;
    if (__builtin_expect(!__all(pmax <= THR2), 0)) { asm volatile("" ::: "memory");
        const float d = fmaxf(pmax, 0.f); m_reg += d; alpha = __builtin_amdgcn_exp2f(-d);
#pragma unroll
        for (int r = 0; r < 16; ++r) { p0[r] -= d; p1[r] -= d; } }
#pragma unroll
    for (int r = 0; r < 16; ++r) p0[r] = __builtin_amdgcn_exp2f(p0[r]);
}
__device__ __forceinline__ void finishSM(f32x16& p0, f32x16& p1, float alpha, float& l_reg, bf16x8& pa0, bf16x8& pa1, bf16x8& pa2, bf16x8& pa3) {
#pragma unroll
    for (int r = 0; r < 16; ++r) p1[r] = __builtin_amdgcn_exp2f(p1[r]);
    float ps = 0;
#pragma unroll
    for (int r = 0; r < 16; ++r) ps += p0[r];
#pragma unroll
    for (int r = 0; r < 16; ++r) ps += p1[r];
    { auto rr = __builtin_amdgcn_permlane32_swap(__float_as_uint(ps), __float_as_uint(ps), false, false);
      ps = __uint_as_float(rr[0]) + __uint_as_float(rr[1]); }
    l_reg = l_reg * alpha + ps;
#define PK4(P, B_, OUT) do { unsigned a0 = cvtpk(P[B_+0], P[B_+1]), a1 = cvtpk(P[B_+2], P[B_+3]);                          \
        unsigned b0 = cvtpk(P[B_+4], P[B_+5]), b1 = cvtpk(P[B_+6], P[B_+7]);                                             \
        auto r0 = __builtin_amdgcn_permlane32_swap(a0, b0, false, false); auto r1 = __builtin_amdgcn_permlane32_swap(a1, b1, false, false); \
        u32x4 w = {r0[0], r1[0], r0[1], r1[1]}; OUT = __builtin_bit_cast(bf16x8, w); } while (0)
    PK4(p0, 0, pa0); PK4(p0, 8, pa1); PK4(p1, 0, pa2); PK4(p1, 8, pa3);
#undef PK4
}
__device__ __forceinline__ void qkt(f32x16& p0, f32x16& p1, const char* Kmap_lds, int r32, int hi, const bf16x8* qr, bf16x8 kx0, unsigned kc1, bf16x8 qx) {
    p0 = __builtin_amdgcn_mfma_f32_32x32x16_bf16(kx0, qx, f32x16{}, 0, 0, 0);
    { u32x4 k1 = __builtin_bit_cast(u32x4, kx0); k1.x = kc1; p1 = __builtin_amdgcn_mfma_f32_32x32x16_bf16(__builtin_bit_cast(bf16x8, k1), qx, f32x16{}, 0, 0, 0); }
#pragma unroll
    for (int d0 = 0; d0 < 4; ++d0) { const char* a = Kmap_lds + KSWZ64(r32, (d0 * 16 + hi * 8) * 2);
        const bf16x8 b0 = *reinterpret_cast<const bf16x8*>(a);
        const bf16x8 b1 = *reinterpret_cast<const bf16x8*>(a + 32 * 128);
        p0 = __builtin_amdgcn_mfma_f32_32x32x16_bf16(b0, qr[d0], p0, 0, 0, 0);
        p1 = __builtin_amdgcn_mfma_f32_32x32x16_bf16(b1, qr[d0], p1, 0, 0, 0); }
}
__device__ __forceinline__ void pv_tile(f32x16* o, int vb0, bf16x8 pa0, bf16x8 pa1, bf16x8 pa2, bf16x8 pa3) {
#define TRRD(dst, off) asm volatile("ds_read_b64_tr_b16 %0, %1 offset:%2" : "=&v"(dst) : "v"(vb0), "i"(off) : "memory")
#define PV_D0(d0) do { s16x4 l0, l1, l2, l3, h0, h1, h2, h3; constexpr int b_ = v_rd_off(d0, 0, 0); \
        TRRD(l0, b_); TRRD(h0, b_ + 2048); TRRD(l1, b_ + 4096); TRRD(h1, b_ + 6144); TRRD(l2, b_ + 8192); TRRD(h2, b_ + 10240); TRRD(l3, b_ + 12288); TRRD(h3, b_ + 14336); \
        asm volatile("s_waitcnt lgkmcnt(0)" ::: "memory"); SBAR();   \
        o[d0] = __builtin_amdgcn_mfma_f32_32x32x16_bf16(pa0, (bf16x8){l0[0], l0[1], l0[2], l0[3], h0[0], h0[1], h0[2], h0[3]}, o[d0], 0, 0, 0);   \
        o[d0] = __builtin_amdgcn_mfma_f32_32x32x16_bf16(pa1, (bf16x8){l1[0], l1[1], l1[2], l1[3], h1[0], h1[1], h1[2], h1[3]}, o[d0], 0, 0, 0);   \
        o[d0] = __builtin_amdgcn_mfma_f32_32x32x16_bf16(pa2, (bf16x8){l2[0], l2[1], l2[2], l2[3], h2[0], h2[1], h2[2], h2[3]}, o[d0], 0, 0, 0);   \
        o[d0] = __builtin_amdgcn_mfma_f32_32x32x16_bf16(pa3, (bf16x8){l3[0], l3[1], l3[2], l3[3], h3[0], h3[1], h3[2], h3[3]}, o[d0], 0, 0, 0); } while (0)
    PV_D0(0); PV_D0(1); PV_D0(2); PV_D0(3);
#undef PV_D0
#undef TRRD
}

__device__ __forceinline__ void pv_fused(f32x16* o, int vb0, bf16x8 pa0, bf16x8 pa1, bf16x8 pa2, bf16x8 pa3, f32x16& x0, const f32x16& x1, float& pmax) {
#define TRRD(dst, off) asm volatile("ds_read_b64_tr_b16 %0, %1 offset:%2" : "=&v"(dst) : "v"(vb0), "i"(off) : "memory")
#define VFR(L, H, k) (bf16x8){L[k][0], L[k][1], L[k][2], L[k][3], H[k][0], H[k][1], H[k][2], H[k][3]}
#define LGKM0() asm volatile("s_waitcnt lgkmcnt(0)" ::: "memory")
#define VBASE(d0) (v_rd_off(d0, 0, 0))
    s16x4 la[4], ha[4];
    float m = -__builtin_inff();
#pragma unroll
    for (int k = 0; k < 4; ++k) { TRRD(la[k], VBASE(0) + k * 4096); TRRD(ha[k], VBASE(0) + k * 4096 + 2048); }
    LGKM0(); SBAR();
#define PA(k) ((k) == 0 ? pa0 : (k) == 1 ? pa1 : (k) == 2 ? pa2 : pa3)
#define GAP(s, L, H)  do { constexpr int d0_ = (s) >> 2, k_ = (s) & 3;                                                           \
        o[d0_] = __builtin_amdgcn_mfma_f32_32x32x16_bf16(PA(k_), VFR(L, H, k_), o[d0_], 0, 0, 0);                                          \
        if (d0_ < 3) { TRRD(L[k_], VBASE(d0_ + 1) + k_ * 4096); TRRD(H[k_], VBASE(d0_ + 1) + k_ * 4096 + 2048); }                        \
        if ((s) < 4) { m = __builtin_fmaxf(__builtin_fmaxf(m, x0[4 * (s)]), x0[4 * (s) + 1]); m = __builtin_fmaxf(__builtin_fmaxf(m, x0[4 * (s) + 2]), x0[4 * (s) + 3]); }            \
        else if ((s) < 8) { m = __builtin_fmaxf(__builtin_fmaxf(m, x1[4 * ((s) - 4)]), x1[4 * ((s) - 4) + 1]); m = __builtin_fmaxf(__builtin_fmaxf(m, x1[4 * ((s) - 4) + 2]), x1[4 * ((s) - 4) + 3]); } \
        if ((s) >= 4 && (s) < 12) { x0[(s) - 4] = __builtin_amdgcn_exp2f(x0[(s) - 4]); }                                                   \
        else if ((s) >= 12) { x0[8 + 2 * ((s) - 12)] = __builtin_amdgcn_exp2f(x0[8 + 2 * ((s) - 12)]); x0[9 + 2 * ((s) - 12)] = __builtin_amdgcn_exp2f(x0[9 + 2 * ((s) - 12)]); } \
        if (k_ == 3 && d0_ < 3) LGKM0();                                                                                                   \
        SBAR(); } while (0)
    GAP(0, la, ha); GAP(1, la, ha); GAP(2, la, ha); GAP(3, la, ha);
    GAP(4, la, ha); GAP(5, la, ha); GAP(6, la, ha); GAP(7, la, ha);
    GAP(8, la, ha); GAP(9, la, ha); GAP(10, la, ha); GAP(11, la, ha);
    GAP(12, la, ha); GAP(13, la, ha); GAP(14, la, ha); GAP(15, la, ha);
    pmax = m;
#undef GAP
#undef PA
#undef VBASE
#undef LGKM0
#undef VFR
#undef TRRD
}
__device__ __forceinline__ bf16x8 qx_of(unsigned sdw, float x) {
    const unsigned h_ = cvtpk(x, 0.f) & 0xffffu; const float r1 = x - __uint_as_float(h_ << 16);
    const unsigned m_ = cvtpk(r1, 0.f) & 0xffffu; const float r2 = r1 - __uint_as_float(m_ << 16);
    return __builtin_bit_cast(bf16x8, (u32x4){sdw, h_ | (m_ << 16), cvtpk(r2, 0.f) & 0xffffu, 0u});
}
struct BlockRef { int base; int P0; int jlo; float slope2; };
#define BR_Q(br) ((const bf16_t*)(wsb + WS_Q) + (br).base)
#define BR_K(br) ((const bf16_t*)(wsb + WS_K) + (br).base)
#define BR_V(br) ((const bf16_t*)(wsb + WS_VB) + (br).base)
#define BR_O(br) ((bf16_t*)(wsb + WS_XN) + (br).base)
struct Seam { bf16x8 qr[4]; };
__device__ __forceinline__ void glds16s(unsigned voff, const void* sbase, unsigned lds_dst) { unsigned keep;
    asm volatile("s_mov_b32 %0, m0\n\ts_mov_b32 m0, %3\n\ts_nop 0\n\tglobal_load_lds_dwordx4 %1, %2\n\ts_mov_b32 m0, %0" : "=&s"(keep) : "v"(voff), "s"(sbase), "s"(lds_dst) : "memory"); }
#define WAIT_BAR(N) asm volatile("s_waitcnt vmcnt(" #N ") lgkmcnt(0)\n\ts_barrier" ::: "memory")
#define LBAR() asm volatile("s_waitcnt lgkmcnt(0)\n\ts_barrier" ::: "memory")
struct DmaOff { unsigned k0, k1, v0, v1; };
__device__ __forceinline__ DmaOff dma_offsets(int wid, int lane) {
    DmaOff d; unsigned ko[2], vo[2];
#pragma unroll
    for (int i = 0; i < 2; ++i) { const int G = (2 * wid + i) * 64 + lane;
        { const int map = G >> 9, row = (G >> 3) & 63, slot = G & 7, chunk = slot ^ ((row >> 1) & 7); ko[i] = (unsigned)(row * PITCH + map * 64 + chunk * 8) * 2u; }
        { const int sub = G >> 5, kk = (sub >> 2) * 8 + ((G >> 2) & 7), k = (kk & ~0xC) | ((kk & 4) << 1) | ((kk & 8) >> 1), c = (sub & 3) * 32 + (G & 3) * 8; vo[i] = (unsigned)(k * PITCH + c) * 2u; } }
    d.k0 = ko[0]; d.k1 = ko[1]; d.v0 = vo[0]; d.v1 = vo[1]; return d;
}
#define TILE_PTR(T_, br, t) ((const char*)(wsb + (T_)) + ((size_t)(br).base + (size_t)((br).jlo + (t)) * (KVBLK * PITCH)) * 2)
#define DMA_K(br, t, so) do { const char* sb_ = TILE_PTR(WS_K, br, t); const unsigned ld_ = (unsigned)__builtin_amdgcn_readfirstlane((int)(lds0 + (so) + wid * 2048)); glds16s(D.k0, sb_, ld_); glds16s(D.k1, sb_, ld_ + 1024u); } while (0)
#define DMA_V(br, t, so) do { const char* sb_ = TILE_PTR(WS_VB, br, t); const unsigned ld_ = (unsigned)__builtin_amdgcn_readfirstlane((int)(lds0 + (so) + SHM_K + wid * 2048)); glds16s(D.v0, sb_, ld_); glds16s(D.v1, sb_, ld_ + 1024u); } while (0)
__device__ __forceinline__ void attn_issue_first(const unsigned char* wsb, const BlockRef& br, char* lds, Seam& S, const DmaOff& D, int wid, int r32, int hi) {
    const unsigned lds0 = (unsigned)(uintptr_t)lds; const int map = wid >> 2, rw = wid & 3;
#pragma unroll
    for (int d0 = 0; d0 < 4; ++d0) S.qr[d0] = *(const bf16x8*)(BR_Q(br) + (size_t)(br.P0 + rw * QBLK + r32) * PITCH + map * 64 + d0 * 16 + hi * 8);
    DMA_K(br, 0, 0); DMA_V(br, 0, 0); DMA_K(br, 1, SLOT);
}
__device__ __forceinline__ void attn_block(unsigned char* wsb, const BlockRef& cur, const BlockRef& nxt, char* lds, Seam& S, float lam, const float* subg) {
    const int tid = threadIdx.x, wid = __builtin_amdgcn_readfirstlane(tid >> 6), lane = tid & 63, r32 = lane & 31, hi = lane >> 5;
    const int map = wid >> 2, rw = wid & 3;
    const int j_lo = cur.jlo, NT = cur.P0 / KVBLK + 2 - j_lo;
    const int qlo = cur.P0 + rw * QBLK, qm = qlo + r32 - 4 * hi;
    const float slope2 = cur.slope2; const int qpos = qlo + r32;
    unsigned sdw; { const unsigned h_ = cvtpk(slope2, 0.f) & 0xffffu; const float lo_ = slope2 - __uint_as_float(h_ << 16); sdw = h_ | (cvtpk(lo_, 0.f) << 16); }
    bf16x8 kx0; unsigned kx1; { const unsigned c0 = cvtpk((float)r32, (float)r32), c1 = cvtpk((float)(r32 + 32), (float)(r32 + 32)), one = hi ? 0u : 0x3f803f80u;
        kx0 = __builtin_bit_cast(bf16x8, (u32x4){hi ? 0u : c0, one, one & 0xffffu, 0u}); kx1 = hi ? 0u : c1; }
    const unsigned lds0 = (unsigned)(uintptr_t)lds; const char* Kmap = lds + map * 8192;
    float* ws = (float*)(lds + LDS_WSF) + wid * 64; float* li_l = ws, * al_l = ws + 32;
    float m_reg = 0.f, l_reg = 0; f32x16 o[4] = {};
    const int vb0 = (int)lds0 + SHM_K + v_rd_base(lane);
    const DmaOff D = dma_offsets(wid, lane);
#define RESC(a) do { if (__any((a) < 1.f)) { if (hi == 0) al_l[r32] = (a); asm volatile("s_waitcnt lgkmcnt(0)" ::: "memory");              \
                     _Pragma("unroll") for (int d_ = 0; d_ < 4; ++d_) _Pragma("unroll") for (int r = 0; r < 16; ++r) o[d_][r] *= al_l[crow(r, hi)]; } } while (0)
#define KBASE(t) ((j_lo + (t)) * KVBLK)
#define MASKT(P0_, P1_, t) do { const int kb_ = KBASE(t); if (kb_ + KVBLK - 1 > qlo) { asm volatile("" ::: "memory"); mask_tile(P0_, P1_, qm - kb_); } } while (0)
#define QX(t) qx_of(sdw, slope2 * (float)(KBASE(t) - qpos) - m_reg)
#define ROT() do { const int p_ = sl_prev; sl_prev = sl_cur; sl_cur = sl_next; sl_next = p_; } while (0)
    f32x16 pA0, pA1, pB0, pB1; float alA, alB; bf16x8 pa0, pa1, pa2, pa3;
    int sl_prev = 2 * SLOT, sl_cur = 0, sl_next = SLOT;
    WAIT_BAR(0);
    asm volatile("" : "+v"(S.qr[0]), "+v"(S.qr[1]), "+v"(S.qr[2]), "+v"(S.qr[3]));
    if (NT > 2) { DMA_V(cur, 1, SLOT); DMA_K(cur, 2, 2 * SLOT); } else { DMA_V(cur, 1, SLOT); }
    SBAR(); qkt(pA0, pA1, Kmap, r32, hi, S.qr, kx0, kx1, QX(0));
    MASKT(pA0, pA1, 0); partialSM(pA0, pA1, m_reg, alA);
    if (NT > 2) { WAIT_BAR(4); } else { WAIT_BAR(2); }
    ROT();
#define STEP(PX0, PX1, alX, PY0, PY1, alY, t) do {                                                                           \
        const bool k2_ = (t) + 2 < NT, v1_ = (t) + 1 < NT;                                                                   \
        if (k2_) DMA_K(cur, (t) + 2, sl_prev); if (v1_) DMA_V(cur, (t) + 1, sl_next);                                        \
        SBAR(); qkt(PX0, PX1, Kmap + sl_cur, r32, hi, S.qr, kx0, kx1, QX(t));                                                \
        finishSM(PY0, PY1, alY, l_reg, pa0, pa1, pa2, pa3); SBAR();                                                          \
        MASKT(PX0, PX1, (t)); SBAR();                                                                                        \
        { float pm_; pv_fused(o, vb0 + sl_prev, pa0, pa1, pa2, pa3, PX0, PX1, pm_);                                          \
          { auto rr_ = __builtin_amdgcn_permlane32_swap(__float_as_uint(pm_), __float_as_uint(pm_), false, false); pm_ = fmaxf(__uint_as_float(rr_[0]), __uint_as_float(rr_[1])); } \
          alX = 1.f;                                                                                                           \
          if (__builtin_expect(!__all(pm_ <= THR2), 0)) { asm volatile("" ::: "memory");        \
              const float d_ = fmaxf(pm_, 0.f); m_reg += d_; alX = __builtin_amdgcn_exp2f(-d_);                                \
              _Pragma("unroll") for (int r = 0; r < 16; ++r) { PX0[r] *= alX; PX1[r] -= d_; } } }                              \
        RESC(alX);                                                                                                           \
        if (k2_) { WAIT_BAR(4); } else if (v1_) { WAIT_BAR(2); } else { WAIT_BAR(0); }                                       \
        ROT(); } while (0)
    int t = 1;
    for (; t + 1 < NT; t += 2) {
        STEP(pB0, pB1, alB, pA0, pA1, alA, t);
        STEP(pA0, pA1, alA, pB0, pB1, alB, t + 1);
    }
    const bool oddtail = t < NT;
    if (oddtail) { STEP(pB0, pB1, alB, pA0, pA1, alA, t); }
    if (oddtail) { finishSM(pB0, pB1, alB, l_reg, pa0, pa1, pa2, pa3); } else { finishSM(pA0, pA1, alA, l_reg, pa0, pa1, pa2, pa3); }
    SBAR(); pv_tile(o, vb0 + sl_prev, pa0, pa1, pa2, pa3);
    LBAR();
    attn_issue_first(wsb, nxt, lds, S, D, wid, r32, hi);
    if (hi == 0) li_l[r32] = l_reg; asm volatile("s_waitcnt lgkmcnt(0)" ::: "memory");
    float rli[16];
#pragma unroll
    for (int r = 0; r < 16; ++r) rli[r] = __builtin_amdgcn_rcpf(li_l[crow(r, hi)]);
    float* xch = (float*)(lds + LDS_XCH) + (size_t)rw * (16 * 2 * 64) + lane;
#pragma unroll
    for (int half = 0; half < 2; ++half) {
        if (map == 1) {
#pragma unroll
            for (int r = 0; r < 16; ++r)
#pragma unroll
                for (int dd = 0; dd < 2; ++dd) xch[(r * 2 + dd) * 64] = o[2 * half + dd][r] * rli[r]; }
        LBAR();
        if (map == 0) {
#pragma unroll
            for (int r = 0; r < 16; ++r)
#pragma unroll
                for (int dd = 0; dd < 2; ++dd) o[2 * half + dd][r] = o[2 * half + dd][r] * rli[r] - lam * xch[(r * 2 + dd) * 64]; }
        LBAR();
    }
    if (map == 0) {
        float gsub[4];
#pragma unroll
        for (int d0 = 0; d0 < 4; ++d0) gsub[d0] = subg[d0 * 32 + r32] * (1.f - LAM_INIT);
        int obase = (cur.P0 + rw * QBLK + 4 * hi) * PITCH + r32; asm volatile("" : "+v"(obase));
        bf16_t* Ow = BR_O(cur) + obase;
#pragma unroll
        for (int r = 0; r < 16; ++r) { float ss = 0.f;
#pragma unroll
            for (int d0 = 0; d0 < 4; ++d0) ss += o[d0][r] * o[d0][r];
            ss += __shfl_xor(ss, 1); ss += __shfl_xor(ss, 2); ss += __shfl_xor(ss, 4); ss += __shfl_xor(ss, 8); ss += __shfl_xor(ss, 16);
            const float rs = rsqrtf(ss * (1.f / 128.f) + EPS); const int orow = (r & 3) + 8 * (r >> 2);
#pragma unroll
            for (int d0 = 0; d0 < 4; ++d0) { const float v = (o[d0][r] * rs) * gsub[d0]; const float vn = __shfl_xor(v, 1);
                if ((r32 & 1) == 0) *(unsigned*)(Ow + orow * PITCH + d0 * 32) = cvtpk(v, vn); } }
    }
#undef RESC
#undef KBASE
#undef MASKT
#undef QX
#undef ROT
#undef STEP
}
#undef WAIT_BAR
#undef LBAR
#undef TILE_PTR
#undef DMA_K
#undef DMA_V
#undef BR_Q
#undef BR_K
#undef BR_V
#undef BR_O
}


__device__ __forceinline__ att::BlockRef attn_ref(Frame& F, int L) {
    const int ent = ((const int*)(F.ws + WS_ROUTE + RT_ALIST))[L]; const int u = ent & 0xffff, qb = u >> 4, bh = u & 15, b = bh >> 3, h = bh & 7;
    att::BlockRef r; r.base = __builtin_amdgcn_readfirstlane(b * SEQ * 1024 + h * 128);
    r.P0 = __builtin_amdgcn_readfirstlane(qb * 128); r.jlo = __builtin_amdgcn_readfirstlane(ent >> 16); r.slope2 = exp2f(-(float)(__builtin_amdgcn_readfirstlane(h) + 1)) * LOG2E;
    return r;
}
__device__ __forceinline__ void p2_attention(Frame& F) {
    const float s1 = wave_sum(F.a->in[I_LQ1][F.lane] * F.a->in[I_LK1][F.lane]), s2 = wave_sum(F.a->in[I_LQ2][F.lane] * F.a->in[I_LK2][F.lane]);
    const float lam = expf(s1) - expf(s2) + LAM_INIT;
    constexpr int NUNITS = 1024;
    volatile LAS int* qs = (volatile LAS int*)(F.lds + 143 * 1024);
    __syncthreads();
    const int v = (F.G % 8 == 0) ? (F.blk % 8) * (F.G / 8) + F.blk / 8 : F.blk;
    int L = v, Ln = 2 * F.G - 1 - v;
    if (L >= NUNITS) return;
    att::BlockRef cur = attn_ref(F, L); att::Seam S;
    { const att::DmaOff D0 = att::dma_offsets(F.wid, F.lane); att::attn_issue_first(F.ws, cur, F.ldsg, S, D0, F.wid, F.lane & 31, F.lane >> 5); }
    for (;;) {
        const bool last = Ln >= NUNITS;
        int nn = 0; if (F.tid == 0 && !last) nn = 2 * F.G + (int)atomicAdd(F.ctl + CW_AQ, 1u);
        const att::BlockRef nxt = last ? cur : attn_ref(F, Ln);
        att::attn_block(F.ws, cur, nxt, F.ldsg, S, lam, F.a->in[I_SUBG]);
        if (last) { asm volatile("s_waitcnt vmcnt(0)" ::: "memory"); __syncthreads(); break; }
        if (F.tid == 0) qs[0] = nn;
        __syncthreads();
        cur = nxt; Ln = qs[0];
        __syncthreads();
    }
}

__device__ __forceinline__ void p3_merged(Frame& F) {
    pg8::StaticOrder S; S.init(M, DM, F.G, F.blk);
    { pg8::Gemm g{(const bf16_t*)(F.ws + WS_YA), (const bf16_t*)(F.ws + WS_WUPT), DM, nullptr}; EpiGateT E{(const bf16_t*)F.out, (bf16_t*)(F.ws + WS_T)};
      pg8::gemm_phase<EpiGateT, pg8::StaticOrder, PG8_ALIGN, PG8_SP2, false>(F.lds, g, S, E); }
    { pg8::Gemm g{(const bf16_t*)(F.ws + WS_XN), (const bf16_t*)(F.ws + WS_WUPT) + 1024 * 1024, DM, nullptr}; EpiMerged E{(const bf16_t*)F.out, (const bf16_t*)(F.ws + WS_T), (bf16_t*)(F.ws + WS_Q)};
      pg8::gemm_phase<EpiMerged, pg8::StaticOrder, PG8_ALIGN, PG8_SP2, false>(F.lds, g, S, E); }
}
__device__ __forceinline__ void p4_out(Frame& F) {
    pg8::StaticOrder S; S.init(M, DM, F.G, F.blk);
    pg8::Gemm g{(const bf16_t*)(F.ws + WS_Q), (const bf16_t*)(F.ws + WS_WOUTT), DM, nullptr}; EpiOut E{F.a->in[I_X], F.out, F.a->in[I_N2G], (bf16_t*)(F.ws + WS_H2)};
    pg8::gemm_phase<EpiOut, pg8::StaticOrder, PG8_ALIGN, PG8_SP2, false>(F.lds, g, S, E);
}
__device__ __forceinline__ void h2_row(Frame& F, int t, f32x4 (&h)[4]) {
    const f32x4* xr = (const f32x4*)(F.out + (size_t)t * DM) + F.lane; const f32x4* g4 = (const f32x4*)F.a->in[I_N2G] + F.lane;
    float s = 0.f;
#pragma unroll
    for (int j = 0; j < 4; ++j) { h[j] = xr[64 * j]; s += (h[j][0] * h[j][0] + h[j][1] * h[j][1]) + (h[j][2] * h[j][2] + h[j][3] * h[j][3]); }
    const float r = rsqrtf(wave_sum(s) * (1.f / DM) + EPS);
#pragma unroll
    for (int j = 0; j < 4; ++j) h[j] = (h[j] * r) * g4[64 * j];
}
__device__ __forceinline__ void p5_router(Frame& F) {
    const float* WRT = (const float*)(F.ws + WS_ROUTE + RT_WRT); const float* brg = F.a->in[I_BRG]; const float* bre = F.a->in[I_BRE];
    int* tokpos = (int*)(F.ws + WS_ROUTE + RT_TOKPOS); float* roww = (float*)(F.ws + WS_ROUTE + RT_ROWW); float* rowrr = (float*)(F.ws + WS_ROUTE + RT_ROWRR); int* rowtok = (int*)(F.ws + WS_ROUTE + RT_ROWTOK);
    LAS float* lg = (LAS float*)(F.lds + 128 * 1024 + (F.wid & 3) * 3072);
    const int i16 = F.lane & 15, kq = F.lane >> 4;
    if (F.wid < 4)
    for (int task = F.blk * 4 + F.wid; task < M / 16; task += F.G * 4) { const int t0 = task * 16;
        const float* xp = F.out + (size_t)(t0 + i16) * DM + 4 * kq; const float* wp = WRT + (size_t)i16 * DM + 4 * kq;
        f32x4 acc0 = {0.f, 0.f, 0.f, 0.f}, acc1 = acc0, acc2 = acc0; float ss = 0.f;
#pragma unroll 4
        for (int s = 0; s < 64; ++s) { const f32x4 xa = *(const f32x4*)(xp + 16 * s);
            const f32x4 w0 = *(const f32x4*)(wp + 16 * s), w1 = *(const f32x4*)(wp + 16 * DM + 16 * s), w2 = *(const f32x4*)(wp + 32 * DM + 16 * s);
            ss += (xa[0] * xa[0] + xa[1] * xa[1]) + (xa[2] * xa[2] + xa[3] * xa[3]);
#pragma unroll
            for (int e = 0; e < 4; ++e) { acc0 = __builtin_amdgcn_mfma_f32_16x16x4f32(xa[e], w0[e], acc0, 0, 0, 0); acc1 = __builtin_amdgcn_mfma_f32_16x16x4f32(xa[e], w1[e], acc1, 0, 0, 0);
                acc2 = __builtin_amdgcn_mfma_f32_16x16x4f32(xa[e], w2[e], acc2, 0, 0, 0); } }
        ss += __shfl_xor(ss, 16); ss += __shfl_xor(ss, 32);
        const float rr = rsqrtf(ss * (1.f / DM) + EPS);
#pragma unroll
        for (int reg = 0; reg < 4; ++reg) { LAS float* p = lg + (4 * kq + reg) * 48 + i16; p[0] = acc0[reg]; p[16] = acc1[reg]; p[32] = acc2[reg]; }
        LDS_WAIT(); asm volatile("" ::: "memory");
        if (F.lane < 16) { const LAS float* p = lg + F.lane * 48;
            float gl[4];
#pragma unroll
            for (int i = 0; i < 4; ++i) gl[i] = p[i] * rr + brg[i];
            int g = 0; float gm = gl[0];
#pragma unroll
            for (int i = 1; i < 4; ++i) if (gl[i] > gm) { gm = gl[i]; g = i; }
            float gs = 0.f;
#pragma unroll
            for (int i = 0; i < 4; ++i) gs += expf(gl[i] - gm);
            const float ggate = 1.f / gs;
            float el[8];
#pragma unroll
            for (int i = 0; i < 8; ++i) el[i] = p[4 + g * 8 + i] * rr + bre[g * 8 + i];
            int i1 = 0; float v1 = el[0];
#pragma unroll
            for (int i = 1; i < 8; ++i) if (el[i] > v1) { v1 = el[i]; i1 = i; }
            int i2 = -1; float v2 = -__builtin_inff();
#pragma unroll
            for (int i = 0; i < 8; ++i) if (i != i1 && el[i] > v2) { v2 = el[i]; i2 = i; }
            const float a = expf(v2 - v1), w1 = 1.f / (1.f + a), w2 = a / (1.f + a);
            const int t = t0 + F.lane, e1 = g * 8 + i1, e2 = g * 8 + i2;
            const int r1 = (int)atomicAdd(F.ctl + CW_CNT + e1 * CW_CNT_STRIDE, 1u), r2 = (int)atomicAdd(F.ctl + CW_CNT + e2 * CW_CNT_STRIDE, 1u);
            rowtok[e1 * ECAP + r1] = t; roww[e1 * ECAP + r1] = ggate * w1; rowrr[e1 * ECAP + r1] = rr; rowtok[e2 * ECAP + r2] = t; roww[e2 * ECAP + r2] = ggate * w2; rowrr[e2 * ECAP + r2] = rr;
            tokpos[2 * t] = (e1 << ECAP_LOG) | r1; tokpos[2 * t + 1] = (e2 << ECAP_LOG) | r2; }
        LDS_WAIT(); asm volatile("" ::: "memory");
    }
    if (F.wid >= 4) {
      LAS float* scr = (LAS float*)(F.lds + (F.wid - 4) * 32768);
      bf16_t* W13T = (bf16_t*)(F.ws + WS_W13T); bf16_t* W2T = (bf16_t*)(F.ws + WS_W2T);
#define XW_SRC(it_) (((it_) % 384) < 128 ? F.a->in[I_W1] + (size_t)((it_) / 384) * 1024 * 256 : ((it_) % 384) < 256 ? F.a->in[I_W3] + (size_t)((it_) / 384) * 1024 * 256 : F.a->in[I_W2] + (size_t)((it_) / 384) * 256 * 1024)
#define XW_STORE(v_, it_, scr_) do { const int e_ = (it_) / 384, r_ = (it_) % 384; \
          if (r_ < 128) tr_store(v_, 256, W13T, 1024, 0, RmW13{e_ * 512}, scr_, r_, F.lane); \
          else if (r_ < 256) tr_store(v_, 256, W13T, 1024, 0, RmW13{e_ * 512 + 128}, scr_, r_ - 128, F.lane); \
          else tr_store(v_, 1024, W2T, 256, 0, RmAdd{e_ * 1024}, scr_, r_ - 256, F.lane); } while (0)
      const int stride = F.G * 4;
      for (int it = F.blk * 4 + (F.wid - 4); it < NE * 384; it += 2 * stride) { const int it2 = it + stride; const bool two = it2 < NE * 384;
          float va[32], vb[32];
          { const int r = it % 384; tr_load(XW_SRC(it), r < 256 ? 256 : 1024, r < 128 ? r : r < 256 ? r - 128 : r - 256, F.lane, va); }
          if (two) { const int r = it2 % 384; tr_load(XW_SRC(it2), r < 256 ? 256 : 1024, r < 128 ? r : r < 256 ? r - 128 : r - 256, F.lane, vb); }
          XW_STORE(va, it, scr);
          if (two) XW_STORE(vb, it2, scr + 64 * 33); }
#undef XW_SRC
#undef XW_STORE
    }
}
__device__ __forceinline__ void moe_offsets(Frame& F, LAS int* offs) {
    __syncthreads();
    if (F.tid < 64) { const int c = F.tid < NE ? (int)__hip_atomic_load(F.ctl + CW_CNT + F.tid * CW_CNT_STRIDE, __ATOMIC_RELAXED, __HIP_MEMORY_SCOPE_AGENT) : 0; const int p = (c + 255) & ~255; int incl = p;
#pragma unroll
        for (int o = 1; o < 32; o <<= 1) { const int v = __shfl_up(incl, o); if ((F.tid & 63) >= o) incl += v; }
        if (F.tid < NE) { offs[F.tid] = incl - p; offs[40 + F.tid] = c; for (int t = (incl - p) >> 8; t < (incl >> 8); ++t) offs[80 + t] = F.tid; } if (F.tid == NE - 1) offs[NE] = incl; }
    __syncthreads();
}
__device__ __forceinline__ int expert_of_row(LAS int* offs, int row) { return offs[80 + (row >> 8)]; }
__device__ __forceinline__ void moe_gemm1(Frame& F, LAS int* offs, int G, int c, int lo, int hi) {
    MoeOrder S{offs, 2, G, c, lo, hi};
    pg8::Gemm g{(const bf16_t*)(F.ws + WS_H2), (const bf16_t*)(F.ws + WS_W13T), DM, (const int*)(F.ws + WS_ROUTE + RT_ROWTOK)}; EpiSwiglu E{(const float*)(F.ws + WS_ROUTE + RT_ROWW), (const float*)(F.ws + WS_ROUTE + RT_ROWRR), (bf16_t*)(F.ws + WS_HID)};
    pg8::gemm_phase<EpiSwiglu, MoeOrder, PG8_ALIGN, PG8_SP2, false, true>(F.lds, g, S, E);
}
__device__ __forceinline__ void moe_gemm2(Frame& F, LAS int* offs, int G, int c, int lo, int hi) {
    MoeOrder S{offs, 4, G, c, lo, hi};
    int kde = DE; asm volatile("" : "+s"(kde));
    pg8::Gemm g{(const bf16_t*)(F.ws + WS_HID), (const bf16_t*)(F.ws + WS_W2T), kde, nullptr}; EpiY E{(bf16_t*)(F.ws + WS_YBUF)};
    pg8::gemm_phase<EpiY, MoeOrder, PG8_ALIGN, PG8_SP2, false>(F.lds, g, S, E);
}
__device__ __forceinline__ int moe_vblk(Frame& F) { return (F.G % 8 == 0) ? (F.blk % 8) * (F.G / 8) + F.blk / 8 : F.blk; }
__device__ __forceinline__ void p7_moe_a(Frame& F) {
    LAS int* offs = (LAS int*)(F.lds + 140 * 1024); moe_offsets(F, offs);
    const int n1 = (offs[NE] / 256) * 2;
    moe_gemm1(F, offs, F.G, moe_vblk(F), 0, n1 < F.G ? n1 : F.G);
}
__device__ __forceinline__ void p7_moe_b(Frame& F) {
    LAS int* offs = (LAS int*)(F.lds + 140 * 1024); moe_offsets(F, offs);
    const int T = offs[NE] / 256, n1 = T * 2; int nrem = n1 - F.G; if (nrem < 0) nrem = 0; if (nrem > F.G / 2) nrem = F.G / 2;
    const int t2 = (T < F.G / 2 ? T : F.G / 2) * 4;
    const int vb = moe_vblk(F);
    if (vb < nrem) moe_gemm1(F, offs, nrem, vb, F.G, n1);
    else moe_gemm2(F, offs, F.G - nrem, vb - nrem, 0, t2);
}
__device__ __forceinline__ void p8_moe_c(Frame& F) {
    LAS int* offs = (LAS int*)(F.lds + 140 * 1024); moe_offsets(F, offs);
    const int T = offs[NE] / 256;
    moe_gemm2(F, offs, F.G, moe_vblk(F), (T < F.G / 2 ? T : F.G / 2) * 4, T * 4);
}
__device__ __forceinline__ void p9_combine(Frame& F) {
    LAS int* offs = (LAS int*)(F.lds + 140 * 1024);
    moe_offsets(F, offs);
    const bf16_t* YB = (const bf16_t*)(F.ws + WS_YBUF); const int* tokpos = (const int*)(F.ws + WS_ROUTE + RT_TOKPOS);
    for (int t0 = F.gw * 4; t0 < M; t0 += F.NGW * 4) { int p[4][2];
#pragma unroll
        for (int q = 0; q < 4; ++q) { const int a0 = tokpos[2 * (t0 + q)], a1 = tokpos[2 * (t0 + q) + 1]; p[q][0] = offs[a0 >> ECAP_LOG] + (a0 & (ECAP - 1)); p[q][1] = offs[a1 >> ECAP_LOG] + (a1 & (ECAP - 1)); }
        f32x4 xv[4][4];
#pragma unroll
        for (int q = 0; q < 4; ++q)
#pragma unroll
            for (int j = 0; j < 4; ++j) xv[q][j] = __builtin_nontemporal_load((const f32x4*)(F.out + (size_t)(t0 + q) * DM) + F.lane + 64 * j);
#pragma unroll
        for (int q = 0; q < 4; ++q) {
            f32x4 a[4], b[4];
#pragma unroll
            for (int j = 0; j < 4; ++j) { a[j] = ld4(YB + (size_t)p[q][0] * DM + 4 * F.lane + 256 * j); b[j] = ld4(YB + (size_t)p[q][1] * DM + 4 * F.lane + 256 * j); }
#pragma unroll
            for (int j = 0; j < 4; ++j) __builtin_nontemporal_store(xv[q][j] + (a[j] + b[j]), (f32x4*)(F.out + (size_t)(t0 + q) * DM) + F.lane + 64 * j); } }
}

#define XB_TMO      128
#define XB_XCNT(j)  (256  + 64 * (j))
#define XB_XSUB(j)  (1280 + 64 * (j))
#define XB_XGEN(j)  (2304 + 64 * (j))
#define XB_TOP      3328
#define XB_TOPGEN   3392
#define XCD_BAR_WORDS 3456
#define XB_SPIN_CAP (1u << 22)

__device__ __forceinline__ unsigned xb_ld(unsigned* p)              { return __hip_atomic_load(p, __ATOMIC_RELAXED, __HIP_MEMORY_SCOPE_AGENT); }
__device__ __forceinline__ unsigned xb_add(unsigned* p, unsigned v) { return __hip_atomic_fetch_add(p, v, __ATOMIC_RELAXED, __HIP_MEMORY_SCOPE_AGENT); }
__device__ __forceinline__ unsigned xb_xcc_id() { return (unsigned)__builtin_amdgcn_s_getreg((3 << 11) | 20) & 0xFu; }
#define XB_SPIN(cond, bar) do { unsigned _sp = 0; while (cond) { __builtin_amdgcn_s_sleep(1); \
    if ((++_sp & 255u) == 0u) { if (xb_ld(&(bar)[XB_TMO])) break; if (_sp > XB_SPIN_CAP) { atomicAdd(&(bar)[XB_TMO], 1u); break; } } } } while (0)

struct XcdBarrier {
    unsigned* bar; unsigned x;
    volatile LAS unsigned* st;
};

__device__ __forceinline__ XcdBarrier xcd_barrier_post(unsigned* bar, volatile LAS unsigned* st) {
    XcdBarrier b; b.bar = bar; b.x = xb_xcc_id(); b.st = st;
    if (threadIdx.x == 0) (void)xb_add(&bar[XB_XCNT(b.x)], 1u);
    return b;
}
__device__ __forceinline__ void xcd_barrier_complete(unsigned* bar, unsigned x, unsigned& nloc, unsigned& nx) {
    const unsigned G = gridDim.x * gridDim.y * gridDim.z;
    unsigned sum, cnt, mine, sp = 0u;
    for (;;) {
        sum = 0u; cnt = 0u; mine = 0u;
#pragma unroll
        for (unsigned j = 0; j < 16; ++j) { const unsigned c = xb_ld(&bar[XB_XCNT(j)]); sum += c; cnt += (c > 0u) ? 1u : 0u; mine = (j == x) ? c : mine; }
        if (sum == G) break;
        __builtin_amdgcn_s_sleep(1);
        if ((++sp & 255u) == 0u) { if (xb_ld(&bar[XB_TMO])) break; if (sp > XB_SPIN_CAP) { atomicAdd(&bar[XB_TMO], 1u); break; } }
    }
    nloc = mine > 0u ? mine : 1u; nx = cnt > 0u ? cnt : 1u;
}

__device__ __forceinline__ void xcd_barrier(const XcdBarrier& b) {
    asm volatile("s_waitcnt vmcnt(0)" ::: "memory");
    __syncthreads();
    if (threadIdx.x == 0) {
        unsigned* bar = b.bar;
        __builtin_amdgcn_s_waitcnt(0);
        unsigned nloc = b.st[0], nx = b.st[1];
        if (nloc == 0u) { xcd_barrier_complete(bar, b.x, nloc, nx); b.st[0] = nloc; b.st[1] = nx; }
        const unsigned old = xb_add(&bar[XB_XSUB(b.x)], 1u);
        const unsigned gen = old / nloc;
        if (old + 1u == (gen + 1u) * nloc) {
            __builtin_amdgcn_fence(__ATOMIC_RELEASE, "agent");
            asm volatile("s_waitcnt vmcnt(0)" ::: "memory");
            const unsigned og = xb_add(&bar[XB_TOP], 1u);
            const unsigned tg = og / nx;
            if (og + 1u == (tg + 1u) * nx) xb_add(&bar[XB_TOPGEN], 1u);
            else XB_SPIN(xb_ld(&bar[XB_TOPGEN]) == tg, bar);
            __builtin_amdgcn_fence(__ATOMIC_ACQUIRE, "agent");
            xb_add(&bar[XB_XGEN(b.x)], 1u);
            asm volatile("s_waitcnt vmcnt(0)" ::: "memory");
        } else {
            XB_SPIN(xb_ld(&bar[XB_XGEN(b.x)]) == gen, bar);
            __builtin_amdgcn_fence(__ATOMIC_ACQUIRE, "agent");
            asm volatile("s_waitcnt vmcnt(0)" ::: "memory");
        }
    }
    __syncthreads();
}
constexpr int LDS_BYTES = 147456;
__global__ void __launch_bounds__(NTHREADS, 2) fwd_kernel(Args args) {
    extern __shared__ __attribute__((aligned(16))) unsigned char lds[];
    Frame F;
    F.lds = (LAS unsigned char*)lds; F.ldsg = (char*)lds;
    F.tid = threadIdx.x; F.lane = F.tid & 63; F.wid = __builtin_amdgcn_readfirstlane(F.tid >> 6);
    F.blk = blockIdx.x; F.G = gridDim.x; F.gw = F.blk * NWAVES + F.wid; F.NGW = F.G * NWAVES;
    F.a = &args;
    F.out = args.out; F.ws = args.ws; F.ctl = (unsigned*)(args.ws + WS_CTL);
    const int lo = args.ph_lo, hi = args.ph_hi;
#if MK_ONE_LAUNCH
    cg::grid_group grid = cg::this_grid();
    volatile LAS unsigned* bst = (volatile LAS unsigned*)(F.lds + 144 * 1024 - 16);
    if (F.tid < 2) bst[F.tid] = 0u;
    __syncthreads();
    const XcdBarrier bar = xcd_barrier_post(F.ctl + CW_BAR, bst);
#define SEAM(k) do { if (lo <= (k) && (k) + 1 < hi) { xcd_barrier(bar); } asm volatile("" : "+v"(F.tid), "+v"(F.lane)); } while (0)
    if (hi > NPHASE) grid.sync();
#else
#define SEAM(k) do { } while (0)
#endif
#define IN(k) (lo <= (k) && (k) < hi)
    if (IN(0)) { p0_prologue(F); } SEAM(0);
    if (IN(1)) { p1_proj(F); } SEAM(1);
    if (IN(2)) { p2_mixer_a(F); p2_attention(F); } SEAM(2);
    if (IN(3)) { p3_merged(F); } SEAM(3);
    if (IN(4)) { p4_out(F); } SEAM(4);
    if (IN(5)) { p5_router(F); } SEAM(5);
    if (IN(6)) { p7_moe_a(F); } SEAM(6);
    if (IN(7)) { p7_moe_b(F); } SEAM(7);
    if (IN(8)) { p8_moe_c(F); } SEAM(8);
    if (IN(9)) { p9_combine(F); }
#undef IN
#undef SEAM
}

extern "C" void kernel_launch(void* const* d_in, const int* in_sizes, int n_in, void* d_out, int out_size, void* d_ws, size_t ws_size, hipStream_t stream) {
    static int grid = 0;
    if (grid == 0) {
        if (n_in != 26 || out_size != M * DM || ws_size < WS_END) { fprintf(stderr, "kernel_launch: unexpected shapes (n_in %d out %d ws %zu)\n", n_in, out_size, ws_size); grid = -1; return; }
        int dev = 0, cus = 0, per_cu = 0;
        (void)hipGetDevice(&dev); (void)hipDeviceGetAttribute(&cus, hipDeviceAttributeMultiprocessorCount, dev);
        if (hipFuncSetAttribute((const void*)fwd_kernel, hipFuncAttributeMaxDynamicSharedMemorySize, LDS_BYTES) != hipSuccess) { fprintf(stderr, "kernel_launch: hipFuncSetAttribute failed\n"); grid = -1; return; }
        if (hipOccupancyMaxActiveBlocksPerMultiprocessor(&per_cu, (const void*)fwd_kernel, NTHREADS, LDS_BYTES) != hipSuccess || per_cu < 1) { fprintf(stderr, "kernel_launch: occupancy query says %d\n", per_cu); per_cu = 1; }
        (void)hipGetLastError();
        grid = cus;
    }
    if (grid < 0) return;
    (void)hipMemsetAsync((char*)d_ws + WS_CTL, 0, CTL_ZERO_BYTES, stream);
    Args a{};
    for (int i = 0; i < 26; ++i) a.in[i] = (const float*)d_in[i];
    a.out = (float*)d_out; a.ws = (unsigned char*)d_ws;
#if MK_ONE_LAUNCH
    a.ph_lo = 0; a.ph_hi = NPHASE;
    void* kargs[] = {&a};
    hipError_t e = hipLaunchCooperativeKernel((const void*)fwd_kernel, dim3(grid), dim3(NTHREADS), kargs, LDS_BYTES, stream);
    if (e != hipSuccess) fprintf(stderr, "cooperative launch failed: %s (grid %d)\n", hipGetErrorString(e), grid);
#else
    for (int p = 0; p < NPHASE; ++p) { a.ph_lo = p; a.ph_hi = p + 1; hipLaunchKernelGGL(fwd_kernel, dim3(grid), dim3(NTHREADS), LDS_BYTES, stream, a); }
#endif
}
```

```cpp
#include <hip/hip_runtime.h>
#include <hip/hip_cooperative_groups.h>
#include <cstdio>
#include <cstdint>
namespace cg = cooperative_groups;

#ifndef MK_ONE_LAUNCH
#define MK_ONE_LAUNCH 1
#endif

#define LAS __attribute__((address_space(3)))
typedef unsigned short bf16_t;
typedef short bf16x8 __attribute__((ext_vector_type(8)));
typedef short s16x4 __attribute__((ext_vector_type(4)));
typedef float f32x4 __attribute__((ext_vector_type(4)));
typedef float f32x16 __attribute__((ext_vector_type(16)));
typedef float f32x2 __attribute__((ext_vector_type(2)));
typedef unsigned u32x4 __attribute__((ext_vector_type(4)));
typedef unsigned u32x2 __attribute__((ext_vector_type(2)));
typedef __bf16 bf16x2_t __attribute__((ext_vector_type(2)));

constexpr int NB = 2, SEQ = 8192, DM = 1024, M = NB * SEQ;
constexpr int NH = 8;
constexpr int N1 = 7168;
constexpr int NE = 32, DE = 256;
constexpr float EPS = 1e-6f;
constexpr float LOG2E = 1.4426950408889634f;
constexpr float C2 = 0.125f * LOG2E;
constexpr float LAM_INIT = 0.2f;
constexpr int NWAVES = 8, NTHREADS = 512;
constexpr int NPHASE = 10;
constexpr int ECAP = 16384, ECAP_LOG = 14;

constexpr size_t MiB = 1u << 20;
constexpr size_t WS_CTL = 0;
constexpr size_t CTL_ZERO_BYTES = 65536;
constexpr size_t WS_W1T = 1 * MiB;
constexpr size_t WS_WUPT = 15 * MiB;
constexpr size_t WS_WOUTT = 19 * MiB;
constexpr size_t WS_WST = 21 * MiB;
constexpr size_t WS_ROUTE = 22 * MiB;
constexpr size_t WS_XN = 32 * MiB;
constexpr size_t WS_U = 64 * MiB;
constexpr size_t WS_VA = 96 * MiB;
constexpr size_t WS_Q = 128 * MiB;
constexpr size_t WS_K = 160 * MiB;
constexpr size_t WS_VB = 192 * MiB;
constexpr size_t WS_W13T = 160 * MiB;
constexpr size_t WS_W2T = 192 * MiB;
constexpr size_t WS_HID = 208 * MiB;
constexpr size_t WS_H2 = 32 * MiB;
constexpr size_t WS_YBUF = 64 * MiB;
constexpr size_t WS_YA = 224 * MiB;
constexpr size_t WS_T = 64 * MiB;
constexpr size_t WS_END = 256 * MiB;
constexpr size_t RT_TOKE = 0, RT_TOKW = 256 * 1024, RT_TOKPOS = 512 * 1024, RT_WRT = 1024 * 1024, RT_ALIST = 1536 * 1024, RT_ROWTOK = 2048 * 1024, RT_ROWW = 4096 * 1024, RT_ROWRR = 6144 * 1024;
constexpr int CW_CNT = 8192, CW_CNT_STRIDE = 64, CW_AQ = 512, CW_BAR = 1024;

#define LDS_WAIT() asm volatile("s_waitcnt lgkmcnt(0)" ::: "memory")
#define SBAR() __builtin_amdgcn_sched_barrier(0)
__device__ __forceinline__ unsigned cvtpk(float lo, float hi) { f32x2 v = {lo, hi}; bf16x2_t b = __builtin_convertvector(v, bf16x2_t); return __builtin_bit_cast(unsigned, b); }
__device__ __forceinline__ float bf2f(short b) { return __uint_as_float(((unsigned)(unsigned short)b) << 16); }
__device__ __forceinline__ float wave_sum(float v) {
#pragma unroll
    for (int o = 1; o < 64; o <<= 1) v += __shfl_xor(v, o);
    return v;
}
__device__ __forceinline__ void st4(bf16_t* p, f32x4 v) { u32x2 w; w.x = cvtpk(v[0], v[1]); w.y = cvtpk(v[2], v[3]); *(u32x2*)p = w; }
__device__ __forceinline__ f32x4 ld4(const bf16_t* p) { const u32x2 w = *(const u32x2*)p; f32x4 r; r[0] = __uint_as_float(w.x << 16); r[1] = __uint_as_float(w.x & 0xffff0000u); r[2] = __uint_as_float(w.y << 16); r[3] = __uint_as_float(w.y & 0xffff0000u); return r; }

struct Args { const float* in[26]; float* out; unsigned char* ws; int ph_lo, ph_hi; };

struct Frame {
    LAS unsigned char* lds; char* ldsg;
    int tid, lane, wid, blk, G, gw, NGW;
    const Args* a; float* out; unsigned char* ws; unsigned* ctl;
};
enum { I_X = 0, I_N1G, I_WIN, I_VNG, I_WS, I_BS, I_QNG, I_KNG, I_LQ1, I_LK1, I_LQ2, I_LK2, I_SUBG, I_WUPA, I_WUPB, I_WGATE, I_BGATE, I_WOUT, I_N2G, I_WRG, I_BRG, I_WRE, I_BRE, I_W1, I_W3, I_W2 };

__device__ __forceinline__ void wave_gemm(f32x4 (&acc)[2][4], const bf16_t* ap0, const bf16_t* ap1, const bf16_t* bp0, const bf16_t* bp1, const bf16_t* bp2, const bf16_t* bp3, int K) {
#pragma unroll 2
    for (int k0 = 0; k0 < K; k0 += 32) {
        const bf16x8 a0 = *(const bf16x8*)(ap0 + k0), a1 = *(const bf16x8*)(ap1 + k0);
        const bf16x8 b0 = *(const bf16x8*)(bp0 + k0), b1 = *(const bf16x8*)(bp1 + k0), b2 = *(const bf16x8*)(bp2 + k0), b3 = *(const bf16x8*)(bp3 + k0);
        acc[0][0] = __builtin_amdgcn_mfma_f32_16x16x32_bf16(b0, a0, acc[0][0], 0, 0, 0);
        acc[0][1] = __builtin_amdgcn_mfma_f32_16x16x32_bf16(b1, a0, acc[0][1], 0, 0, 0);
        acc[0][2] = __builtin_amdgcn_mfma_f32_16x16x32_bf16(b2, a0, acc[0][2], 0, 0, 0);
        acc[0][3] = __builtin_amdgcn_mfma_f32_16x16x32_bf16(b3, a0, acc[0][3], 0, 0, 0);
        acc[1][0] = __builtin_amdgcn_mfma_f32_16x16x32_bf16(b0, a1, acc[1][0], 0, 0, 0);
        acc[1][1] = __builtin_amdgcn_mfma_f32_16x16x32_bf16(b1, a1, acc[1][1], 0, 0, 0);
        acc[1][2] = __builtin_amdgcn_mfma_f32_16x16x32_bf16(b2, a1, acc[1][2], 0, 0, 0);
        acc[1][3] = __builtin_amdgcn_mfma_f32_16x16x32_bf16(b3, a1, acc[1][3], 0, 0, 0);
    }
}
__device__ __forceinline__ void acc_zero(f32x4 (&acc)[2][4]) {
#pragma unroll
    for (int m = 0; m < 2; ++m)
#pragma unroll
        for (int n = 0; n < 4; ++n) acc[m][n] = (f32x4){0.f, 0.f, 0.f, 0.f};
}

namespace pg8 {
#define PG8_LAS __attribute__((address_space(3)))
constexpr int BM = 256, BK = 64, HALF = 128, HTB = HALF * BK * 2  , STAGE_BYTES = 8 * HTB, NXCD = 8, WGM = 4;

__host__ __device__ __forceinline__ int lds_byte(int r, int c) { const int st = (r >> 4) * 2 + (c >> 5), rr = r & 15, cc = c & 31, ob = rr * 64 + cc * 2; return st * 1024 + (ob ^ (((ob >> 9) & 1) << 5)); }
__host__ __device__ __forceinline__ void stage_rc(int b, int& R, int& C) { const int st = b / 1024, sb = b % 1024, swz = sb ^ (((sb >> 9) & 1) << 5); R = (st >> 1) * 16 + swz / 64; C = (st & 1) * 32 + (swz % 64) / 2; }
__host__ __device__ __forceinline__ int perm32(int rho) { const int n = rho >> 4, i = rho & 15; return 8 * (i >> 2) + 4 * n + (i & 3); }

struct Unit { int pm, pn, pb, rbase, nvalid; };
struct Gemm { const bf16_t* A; const bf16_t* Bt; int K; const int* rowtok; };

struct StaticOrder {
    int nM, nN, nwg, G, c;
    __host__ __device__ void init(int M, int N, int G_, int c_) { nM = M / BM; nN = N / BM; nwg = nM * nN; G = G_; c = c_; }
    __host__ __device__ bool next(int i, Unit& u) const {
        const long L = (long)i * G + c; if (L >= nwg) return false;
        int wgid = (int)L; { const int q = nwg / NXCD, r = nwg % NXCD, xcd = wgid % NXCD, off = wgid / NXCD; wgid = (xcd < r ? xcd * (q + 1) : r * (q + 1) + (xcd - r) * q) + off; }
        const int nig = WGM * nN, gid = wgid / nig, fm = gid * WGM, gsz = (nM - fm) < WGM ? (nM - fm) : WGM;
        u.pm = fm + ((wgid % nig) % gsz); u.pn = (wgid % nig) / gsz; u.pb = u.pn; u.rbase = 0; u.nvalid = 0; return true;
    }
    __device__ __forceinline__ void a_ready(const Unit&) const {}
    __device__ __forceinline__ void done(const Unit&) const {}
};
template <class Epi, class Sched, bool ALIGN_EPI = false, bool SP2 = false, bool BP64 = false, bool GATHER = false>
__device__ __forceinline__ void gemm_phase(PG8_LAS unsigned char* lds, const Gemm g, const Sched& S, const Epi& E) {
    const int tid = threadIdx.x, wid = __builtin_amdgcn_readfirstlane(tid >> 6), lane = tid & 63, wr = wid >> 2, wc = wid & 3, fr = lane & 15, fq = lane >> 4;
    const int K = g.K, nt = K / BK;
    unsigned voffA[2], voffB[2];
#pragma unroll
    for (int i = 0; i < 2; ++i) { int R, C; stage_rc(tid * 16 + i * 8192, R, C); const int Rp = Epi::PERM ? ((R & ~31) + perm32(R & 31)) : R; const int Rb = BP64 ? (64 * (Rp >> 5) + (Rp & 31)) : Rp;
        voffA[i] = (unsigned)(R * K + C) * 2u; voffB[i] = (unsigned)(Rb * K + C) * 2u; }
    const size_t kstep = (size_t)(BK * 2);
    const size_t hstep = (size_t)HALF * K * 2;
    const size_t tstep = 2 * hstep;
    const size_t bhs = BP64 ? (size_t)32 * K * 2 : hstep;
    const unsigned ldsw = (unsigned)wid * 1024u;
    const int aoff = lds_byte(wr * 64 + fr, fq * 8), boff = lds_byte(wc * 32 + fr, fq * 8);
#define PG8_SA(b, h) (((b) * 2 + (h)) * HTB)
#define PG8_SB(b, h) ((4 + (b) * 2 + (h)) * HTB)
#define PG8_STAGE(bufoff, gbase, voff) do { _Pragma("unroll") for (int _i = 0; _i < 2; ++_i) \
        __builtin_amdgcn_global_load_lds((const unsigned*)((const char*)(gbase) + (voff)[_i]), (PG8_LAS unsigned*)(lds + (bufoff) + ldsw + _i * 8192), 16, 0, 0); } while (0)
#define PG8_LDA(dst, b, h) do { _Pragma("unroll") for (int m = 0; m < 4; ++m) _Pragma("unroll") for (int k = 0; k < 2; ++k) dst[m][k] = *(const PG8_LAS bf16x8*)(lds + PG8_SA(b, h) + aoff + m * 2048 + k * 1024); } while (0)
#define PG8_LDB(dst, b, h) do { _Pragma("unroll") for (int n = 0; n < 2; ++n) _Pragma("unroll") for (int k = 0; k < 2; ++k) dst[n][k] = *(const PG8_LAS bf16x8*)(lds + PG8_SB(b, h) + boff + n * 2048 + k * 1024); } while (0)
#define PG8_MMA(ai, bj, At, Bt) do { __builtin_amdgcn_s_setprio(1); _Pragma("unroll") for (int m = 0; m < 4; ++m) _Pragma("unroll") for (int n = 0; n < 2; ++n) _Pragma("unroll") for (int k = 0; k < 2; ++k) \
        acc[ai][bj][m][n] = __builtin_amdgcn_mfma_f32_16x16x32_bf16(Bt[n][k], At[m][k], acc[ai][bj][m][n], 0, 0, 0); __builtin_amdgcn_s_setprio(0); } while (0)
#define PG8_WAIT_V(n) asm volatile("s_waitcnt vmcnt(" #n ")" ::: "memory")
#define PG8_WAIT_L(n) asm volatile("s_waitcnt lgkmcnt(" #n ")" ::: "memory")
#define PG8_BAR __builtin_amdgcn_s_barrier()
#define PG8_SCHED __builtin_amdgcn_sched_barrier(0)
    Unit cur, nxt; int ui = 0;
    if (!S.next(0, cur)) return;
    static_assert(!GATHER || SP2, "GATHER is written for the SP2 loop");
    unsigned vA0[2] = {0u, 0u}, vA1[2] = {0u, 0u}, nvA0[2] = {0u, 0u}, nvA1[2] = {0u, 0u};
#define PG8_GLOAD(u_, d0_, d1_) do { _Pragma("unroll") for (int _i = 0; _i < 2; ++_i) { int R_, C_; stage_rc(tid * 16 + _i * 8192, R_, C_); \
        const int t0_ = R_ < (u_).nvalid ? g.rowtok[(u_).rbase + R_] : 0, t1_ = HALF + R_ < (u_).nvalid ? g.rowtok[(u_).rbase + HALF + R_] : 0; d0_[_i] = (unsigned)(t0_ * K + C_) * 2u; d1_[_i] = (unsigned)(t1_ * K + C_) * 2u; } } while (0)
#define PG8_STAGE_A(bufoff, ptr, half, vcur0, vcur1) do { if constexpr (GATHER) { PG8_STAGE(bufoff, ptr, (half) ? vcur1 : vcur0); } else { PG8_STAGE(bufoff, (ptr) + ((half) ? hstep : (size_t)0), voffA); } } while (0)
    if constexpr (GATHER) PG8_GLOAD(cur, vA0, vA1);
    f32x4 acc[2][2][4][2];
#pragma unroll
    for (int a = 0; a < 2; ++a)
#pragma unroll
        for (int b = 0; b < 2; ++b)
#pragma unroll
            for (int m = 0; m < 4; ++m)
#pragma unroll
                for (int n = 0; n < 2; ++n) acc[a][b][m][n] = (f32x4){0.f, 0.f, 0.f, 0.f};
    bf16x8 At[4][2], B0[2][2], B1[2][2];
    const char* cA = (const char*)g.A + (GATHER ? (size_t)0 : (size_t)cur.pm * tstep); const char* cB = (const char*)g.Bt + (size_t)cur.pb * tstep;
    S.a_ready(cur);
    if constexpr (SP2) {
        PG8_STAGE(PG8_SB(0, 0), cB, voffB); PG8_STAGE(PG8_SB(0, 1), cB + bhs, voffB); PG8_STAGE_A(PG8_SA(0, 0), cA, 0, vA0, vA1); PG8_STAGE_A(PG8_SA(0, 1), cA, 1, vA0, vA1);
        if (wr == 1) PG8_BAR;
        PG8_WAIT_V(2); PG8_BAR;
        PG8_STAGE(PG8_SB(1, 0), cB + kstep, voffB); PG8_STAGE_A(PG8_SA(1, 0), cA + kstep, 0, vA0, vA1); PG8_STAGE(PG8_SB(1, 1), cB + bhs + kstep, voffB);
        PG8_WAIT_V(6); PG8_BAR;
    } else {
        PG8_STAGE(PG8_SB(0, 0), cB, voffB); PG8_STAGE(PG8_SA(0, 0), cA, voffA); PG8_STAGE(PG8_SB(0, 1), cB + bhs, voffB); PG8_STAGE(PG8_SA(0, 1), cA + hstep, voffA);
        if (wr == 1) PG8_BAR;
        PG8_WAIT_V(4); PG8_BAR;
        PG8_STAGE(PG8_SB(1, 0), cB + kstep, voffB); PG8_STAGE(PG8_SA(1, 0), cA + kstep, voffA); PG8_STAGE(PG8_SB(1, 1), cB + bhs + kstep, voffB);
        PG8_WAIT_V(6); PG8_BAR;
    }
    for (;;) {
        const bool has_next = S.next(ui + 1, nxt);
        const char* nA = (has_next && !GATHER) ? (const char*)g.A + (size_t)nxt.pm * tstep : cA; const char* nB = has_next ? (const char*)g.Bt + (size_t)nxt.pb * tstep : cB;
        if constexpr (GATHER) { if (has_next) { PG8_GLOAD(nxt, nvA0, nvA1); } else { nvA0[0] = vA0[0]; nvA0[1] = vA0[1]; nvA1[0] = vA1[0]; nvA1[1] = vA1[1]; } }
        for (int t = 0; t < nt; t += 2) {
            const bool last = (t == nt - 2);
            const char* a1 = cA + (size_t)(t + 1) * kstep;
            const char* a2 = last ? nA : cA + (size_t)(t + 2) * kstep; const char* b2 = last ? nB : cB + (size_t)(t + 2) * kstep;
            const char* a3 = a2 + kstep; const char* b3 = b2 + kstep;
            if (last && has_next) S.a_ready(nxt);
            unsigned xA0[2], xA1[2];
            if constexpr (GATHER) { xA0[0] = last ? nvA0[0] : vA0[0]; xA0[1] = last ? nvA0[1] : vA0[1]; xA1[0] = last ? nvA1[0] : vA1[0]; xA1[1] = last ? nvA1[1] : vA1[1]; }
            if constexpr (SP2) {
            PG8_LDB(B0, 0, 0); PG8_LDB(B1, 0, 1); PG8_SCHED; PG8_LDA(At, 0, 0); PG8_STAGE_A(PG8_SA(1, 1), a1, 1, vA0, vA1);
            PG8_WAIT_V(8); PG8_WAIT_L(0); PG8_BAR; PG8_MMA(0, 0, At, B0); PG8_MMA(0, 1, At, B1); PG8_BAR; PG8_SCHED;
            PG8_LDA(At, 0, 1); PG8_STAGE(PG8_SB(0, 0), b2, voffB); PG8_STAGE(PG8_SB(0, 1), b2 + bhs, voffB); PG8_STAGE_A(PG8_SA(0, 0), a2, 0, xA0, xA1);
            PG8_WAIT_V(8); PG8_WAIT_L(0); PG8_BAR; PG8_MMA(1, 0, At, B0); PG8_MMA(1, 1, At, B1); PG8_BAR; PG8_SCHED;
            PG8_LDB(B0, 1, 0); PG8_LDB(B1, 1, 1); PG8_SCHED; PG8_LDA(At, 1, 0); PG8_STAGE_A(PG8_SA(0, 1), a2, 1, xA0, xA1);
            PG8_WAIT_V(8); PG8_WAIT_L(0); PG8_BAR; PG8_MMA(0, 0, At, B0); PG8_MMA(0, 1, At, B1); PG8_BAR; PG8_SCHED;
            PG8_LDA(At, 1, 1); PG8_STAGE(PG8_SB(1, 0), b3, voffB); PG8_STAGE(PG8_SB(1, 1), b3 + bhs, voffB); PG8_STAGE_A(PG8_SA(1, 0), a3, 0, xA0, xA1);
            PG8_WAIT_V(8); PG8_WAIT_L(0); PG8_BAR; PG8_MMA(1, 0, At, B0); PG8_MMA(1, 1, At, B1); PG8_BAR; PG8_SCHED;
            } else {
            PG8_LDB(B0, 0, 0); PG8_SCHED; PG8_LDA(At, 0, 0); PG8_STAGE(PG8_SA(1, 1), a1 + hstep, voffA);
            PG8_WAIT_L(8); PG8_BAR; PG8_WAIT_L(0); PG8_MMA(0, 0, At, B0); PG8_BAR; PG8_SCHED;
            PG8_LDB(B1, 0, 1); PG8_STAGE(PG8_SB(0, 0), b2, voffB);
            PG8_BAR; PG8_WAIT_L(0); PG8_MMA(0, 1, At, B1); PG8_BAR;
            PG8_LDA(At, 0, 1); PG8_STAGE(PG8_SA(0, 0), a2, voffA);
            PG8_BAR; PG8_WAIT_L(0); PG8_MMA(1, 0, At, B0); PG8_BAR; PG8_SCHED;
            PG8_STAGE(PG8_SB(0, 1), b2 + bhs, voffB);
            PG8_WAIT_V(6); PG8_BAR; PG8_MMA(1, 1, At, B1); PG8_BAR;
            PG8_LDB(B0, 1, 0); PG8_SCHED; PG8_LDA(At, 1, 0); PG8_STAGE(PG8_SA(0, 1), a2 + hstep, voffA);
            PG8_WAIT_L(8); PG8_BAR; PG8_WAIT_L(0); PG8_MMA(0, 0, At, B0); PG8_BAR; PG8_SCHED;
            PG8_LDB(B1, 1, 1); PG8_STAGE(PG8_SB(1, 0), b3, voffB);
            PG8_BAR; PG8_WAIT_L(0); PG8_MMA(0, 1, At, B1); PG8_BAR;
            PG8_LDA(At, 1, 1); PG8_STAGE(PG8_SA(1, 0), a3, voffA);
            PG8_BAR; PG8_WAIT_L(0); PG8_MMA(1, 0, At, B0); PG8_BAR; PG8_SCHED;
            PG8_STAGE(PG8_SB(1, 1), b3 + bhs, voffB);
            PG8_WAIT_V(6); PG8_BAR; PG8_MMA(1, 1, At, B1); PG8_BAR;
            }
        }
        if constexpr (ALIGN_EPI) { if (wr == 0) PG8_BAR; }
        if constexpr (!Epi::AFTER_DRAIN) { E(acc, cur, wr, wc, fr, fq); S.done(cur); }
        if (!has_next) break;
#pragma unroll
        for (int a = 0; a < 2; ++a)
#pragma unroll
            for (int b = 0; b < 2; ++b)
#pragma unroll
                for (int m = 0; m < 4; ++m)
#pragma unroll
                    for (int n = 0; n < 2; ++n) acc[a][b][m][n] = (f32x4){0.f, 0.f, 0.f, 0.f};
        cur = nxt; cA = nA; cB = nB; ++ui;
        if constexpr (GATHER) { vA0[0] = nvA0[0]; vA0[1] = nvA0[1]; vA1[0] = nvA1[0]; vA1[1] = nvA1[1]; }
        if constexpr (ALIGN_EPI) { if (wr == 1) PG8_BAR; }
    }
    PG8_WAIT_V(0);
    if constexpr (!ALIGN_EPI) { if (wr == 0) PG8_BAR; }
    PG8_BAR;
    if constexpr (Epi::AFTER_DRAIN) { E.fused(acc, cur, wr, wc, fr, fq, lds, wid, lane); S.done(cur); }
#undef PG8_GLOAD
#undef PG8_STAGE_A
#undef PG8_SA
#undef PG8_SB
#undef PG8_STAGE
#undef PG8_LDA
#undef PG8_LDB
#undef PG8_MMA
#undef PG8_WAIT_V
#undef PG8_WAIT_L
#undef PG8_BAR
#undef PG8_SCHED
}
}

#define PG8_SP2 true
#define PG8_ALIGN true
__device__ __forceinline__ void st8nt(bf16_t* p, f32x4 a, f32x4 b) { u32x4 w; w.x = cvtpk(a[0], a[1]); w.y = cvtpk(a[2], a[3]); w.z = cvtpk(b[0], b[1]); w.w = cvtpk(b[2], b[3]); __builtin_nontemporal_store(w, (u32x4*)p); }
__device__ __forceinline__ void st8(bf16_t* p, f32x4 a, f32x4 b) { u32x4 w; w.x = cvtpk(a[0], a[1]); w.y = cvtpk(a[2], a[3]); w.z = cvtpk(b[0], b[1]); w.w = cvtpk(b[2], b[3]); *(u32x4*)p = w; }
__device__ __forceinline__ void ld8(const bf16_t* p, f32x4& a, f32x4& b) { const u32x4 w = *(const u32x4*)p;
    a[0] = __uint_as_float(w.x << 16); a[1] = __uint_as_float(w.x & 0xffff0000u); a[2] = __uint_as_float(w.y << 16); a[3] = __uint_as_float(w.y & 0xffff0000u);
    b[0] = __uint_as_float(w.z << 16); b[1] = __uint_as_float(w.z & 0xffff0000u); b[2] = __uint_as_float(w.w << 16); b[3] = __uint_as_float(w.w & 0xffff0000u); }
struct EpiProj {
    static constexpr bool PERM = true, AFTER_DRAIN = false;
    unsigned char* ws; bf16_t* GATE; const float *qg, *kg, *bgate;
    __device__ __forceinline__ void operator()(const f32x4 (&acc)[2][2][4][2], const pg8::Unit& u, int wr, int wc, int fr, int fq) const {
        asm volatile("" : "+v"(fr), "+v"(fq));
        const int seg = u.pn >> 2;
        const int row0 = u.pm * 256 + wr * 64 + fr;
        const int cw = (u.pn & 3) * 256 + wc * 64 + 8 * fq;
        if (seg <= 1 || seg == 4) { bf16_t* dst = (bf16_t*)(ws + WS_U + (size_t)seg * (32 * MiB)) + cw;
#pragma unroll
            for (int ai = 0; ai < 2; ++ai)
#pragma unroll
                for (int m = 0; m < 4; ++m) { bf16_t* rp = dst + (size_t)(row0 + ai * 128 + m * 16) * DM;
#pragma unroll
                    for (int bj = 0; bj < 2; ++bj) st8nt(rp + 32 * bj, acc[ai][bj][m][0], acc[ai][bj][m][1]); }
        } else if (seg == 2 || seg == 3) { const float* g = (seg == 2 ? qg : kg) + 8 * fq; bf16_t* dst = (bf16_t*)(ws + WS_U + (size_t)seg * (32 * MiB)) + cw; const float sc = seg == 2 ? C2 : 1.f;
            f32x4 gv[2][2];
#pragma unroll
            for (int bj = 0; bj < 2; ++bj)
#pragma unroll
                for (int n = 0; n < 2; ++n) gv[bj][n] = *(const f32x4*)(g + 32 * bj + 4 * n) * sc;
#pragma unroll
            for (int ai = 0; ai < 2; ++ai)
#pragma unroll
                for (int m = 0; m < 4; ++m) { float ss = 0.f;
#pragma unroll
                    for (int bj = 0; bj < 2; ++bj)
#pragma unroll
                        for (int n = 0; n < 2; ++n) { const f32x4 a = acc[ai][bj][m][n]; ss += (a[0] * a[0] + a[1] * a[1]) + (a[2] * a[2] + a[3] * a[3]); }
                    ss += __shfl_xor(ss, 16); ss += __shfl_xor(ss, 32);
                    const float r = rsqrtf(ss * (1.f / 64.f) + EPS); bf16_t* rp = dst + (size_t)(row0 + ai * 128 + m * 16) * DM;
#pragma unroll
                    for (int bj = 0; bj < 2; ++bj) st8nt(rp + 32 * bj, (acc[ai][bj][m][0] * r) * gv[bj][0], (acc[ai][bj][m][1] * r) * gv[bj][1]); }
        } else { const int c = (u.pn - 20) * 256 + wc * 64 + 8 * fq; const float* bg = bgate + c;
#pragma unroll
            for (int bj = 0; bj < 2; ++bj) { const f32x4 b0 = *(const f32x4*)(bg + 32 * bj), b1 = *(const f32x4*)(bg + 32 * bj + 4);
#pragma unroll
                for (int ai = 0; ai < 2; ++ai)
#pragma unroll
                    for (int m = 0; m < 4; ++m) { f32x4 v0 = acc[ai][bj][m][0] + b0, v1 = acc[ai][bj][m][1] + b1;
#pragma unroll
                        for (int j = 0; j < 4; ++j) { v0[j] = __builtin_amdgcn_rcpf(1.f + __builtin_amdgcn_exp2f(-LOG2E * v0[j])); v1[j] = __builtin_amdgcn_rcpf(1.f + __builtin_amdgcn_exp2f(-LOG2E * v1[j])); }
                        st8nt(GATE + (size_t)(row0 + ai * 128 + m * 16) * 2048 + c + 32 * bj, v0, v1); } }
        }
    }
};

#define EPI_LOOP(...) _Pragma("unroll") for (int ai = 0; ai < 2; ++ai) _Pragma("unroll") for (int m = 0; m < 4; ++m) { const size_t row = (size_t)(u.pm * 256 + wr * 64 + fr + ai * 128 + m * 16); \
        _Pragma("unroll") for (int bj = 0; bj < 2; ++bj) { const int col = u.pn * 256 + bj * 128 + wc * 32 + 8 * fq; const f32x4 a0 = acc[ai][bj][m][0], a1 = acc[ai][bj][m][1]; __VA_ARGS__ } if (m & 1) asm volatile("" ::: "memory"); }
struct EpiGateT {
    static constexpr bool PERM = true, AFTER_DRAIN = false;
    const bf16_t* GATE; bf16_t* T;
    __device__ __forceinline__ void operator()(const f32x4 (&acc)[2][2][4][2], const pg8::Unit& u, int wr, int wc, int fr, int fq) const {
        asm volatile("" : "+v"(fr), "+v"(fq));
        EPI_LOOP( f32x4 g0, g1; ld8(GATE + row * 2048 + col, g0, g1); st8(T + row * DM + col, g0 * a0, g1 * a1); )
    }
};
struct EpiMerged {
    static constexpr bool PERM = true, AFTER_DRAIN = false;
    const bf16_t* GATE; const bf16_t* T; bf16_t* MG;
    __device__ __forceinline__ void operator()(const f32x4 (&acc)[2][2][4][2], const pg8::Unit& u, int wr, int wc, int fr, int fq) const {
        asm volatile("" : "+v"(fr), "+v"(fq));
        EPI_LOOP( f32x4 g0, g1, t0, t1; ld8(GATE + row * 2048 + 1024 + col, g0, g1); ld8(T + row * DM + col, t0, t1); st8(MG + row * DM + col, t0 + g0 * a0, t1 + g1 * a1); )
    }
};
struct EpiOut {
    static constexpr bool PERM = true, AFTER_DRAIN = false;
    const float* x; float* out; const float* g2; bf16_t* H2;
    __device__ __forceinline__ void operator()(const f32x4 (&acc)[2][2][4][2], const pg8::Unit& u, int wr, int wc, int fr, int fq) const {
        asm volatile("" : "+v"(fr), "+v"(fq));
        EPI_LOOP( const float* xp = x + row * DM + col; float* op = out + row * DM + col; const f32x4 x0 = __builtin_nontemporal_load((const f32x4*)xp) + a0, x1 = __builtin_nontemporal_load((const f32x4*)(xp + 4)) + a1; *(f32x4*)op = x0; *(f32x4*)(op + 4) = x1;
                  st8(H2 + row * DM + col, x0 * *(const f32x4*)(g2 + col), x1 * *(const f32x4*)(g2 + col + 4)); )
    }
};
struct EpiY {
    static constexpr bool PERM = true, AFTER_DRAIN = false;
    bf16_t* Y;
    __device__ __forceinline__ void operator()(const f32x4 (&acc)[2][2][4][2], const pg8::Unit& u, int wr, int wc, int fr, int fq) const {
        asm volatile("" : "+v"(fr), "+v"(fq));
        EPI_LOOP( st8(Y + row * DM + col, a0, a1); )
    }
};
struct EpiSwiglu {
    static constexpr bool PERM = true, AFTER_DRAIN = false;
    const float* roww; const float* rowrr; bf16_t* HID;
    __device__ __forceinline__ void operator()(const f32x4 (&acc)[2][2][4][2], const pg8::Unit& u, int wr, int wc, int fr, int fq) const {
        asm volatile("" : "+v"(fr), "+v"(fq));
#pragma unroll
        for (int ai = 0; ai < 2; ++ai)
#pragma unroll
            for (int m = 0; m < 4; ++m) { const int rl = wr * 64 + fr + ai * 128 + m * 16; const size_t row = (size_t)(u.pm * 256 + rl); const float w = rl < u.nvalid ? roww[u.rbase + rl] : 0.f, rr = rl < u.nvalid ? rowrr[u.rbase + rl] : 0.f;
                f32x4 hv[2];
#pragma unroll
                for (int n = 0; n < 2; ++n) { const f32x4 a1 = acc[ai][0][m][n] * rr, a3 = acc[ai][1][m][n] * rr;
#pragma unroll
                    for (int j = 0; j < 4; ++j) hv[n][j] = ((a1[j] * __builtin_amdgcn_rcpf(1.f + __builtin_amdgcn_exp2f(-LOG2E * a1[j]))) * a3[j]) * w; }
                st8(HID + row * DE + u.pn * 128 + wc * 32 + 8 * fq, hv[0], hv[1]); }
    }
};
__device__ __forceinline__ int expert_of_row(LAS int* offs, int row);
struct MoeOrder {
    LAS int* offs; int npn, G, c, lo, hi;
    __device__ __forceinline__ bool next(int i, pg8::Unit& u) const { const int L = lo + i * G + c; if (L >= hi || c < 0) return false;
        const int tile = L / npn, pn = L - tile * npn, e = expert_of_row(offs, tile * 256), lr0 = tile * 256 - offs[e], nv = offs[40 + e] - lr0;
        u.pm = tile; u.pn = pn; u.pb = e * npn + pn; u.rbase = e * ECAP + lr0; u.nvalid = nv < 256 ? nv : 256; return true; }
    __device__ __forceinline__ void a_ready(const pg8::Unit&) const {}
    __device__ __forceinline__ void done(const pg8::Unit&) const {}
};

__device__ __forceinline__ float attn_dmin_unit(const float* qg, const float* kg) {
    const int ln = threadIdx.x & 63; float a = fabsf(qg[ln]), b = fabsf(kg[ln]);
#pragma unroll
    for (int o = 1; o < 64; o <<= 1) { a = fmaxf(a, __shfl_xor(a, o)); b = fmaxf(b, __shfl_xor(b, o)); }
    return 2.02f * (8.f * a * b) + 106.f;
}
__device__ __forceinline__ int attn_jlo(float dmin1, int h, int qb) {
    const float dmin = dmin1 * exp2f((float)(h + 1)); const float lowk = (float)(qb * 128) - dmin;
    return lowk > 0.f ? ((int)lowk) >> 6 : 0;
}
__device__ __forceinline__ void tr_load(const float* W, int N, int item, int lane, float (&v)[32]) {
    const int nblk = N / 32, kb = item / nblk, nb = item % nblk, k0 = 64 * kb, n0 = 32 * nb;
    const float* wp = W + (size_t)(k0 + (lane >> 5)) * N + n0 + (lane & 31);
#pragma unroll
    for (int i = 0; i < 32; ++i) v[i] = __builtin_nontemporal_load(wp + (size_t)(2 * i) * N);
}
template <class RM>
__device__ __forceinline__ void tr_store(const float (&v)[32], int N, bf16_t* WT, int ldt, int koff, RM rm, LAS float* scr, int item, int lane) {
    const int nblk = N / 32, kb = item / nblk, nb = item % nblk, k0 = 64 * kb, n0 = 32 * nb;
    { LAS float* sp = scr + (lane >> 5) * 33 + (lane & 31);
#pragma unroll
      for (int i = 0; i < 32; ++i) sp[2 * i * 33] = v[i]; }
    LDS_WAIT(); asm volatile("" ::: "memory");
    const int c = lane & 7;
#pragma unroll
    for (int j = 0; j < 4; ++j) { const int n = (lane >> 3) + 8 * j; const LAS float* s = scr + (8 * c) * 33 + n;
        u32x4 o; o.x = cvtpk(s[0 * 33], s[1 * 33]); o.y = cvtpk(s[2 * 33], s[3 * 33]); o.z = cvtpk(s[4 * 33], s[5 * 33]); o.w = cvtpk(s[6 * 33], s[7 * 33]);
        *(u32x4*)(WT + (size_t)rm(n0 + n) * ldt + koff + k0 + 8 * c) = o; }
    LDS_WAIT(); asm volatile("" ::: "memory");
}
template <class RM>
__device__ __forceinline__ void transpose_item(const float* W, int N, bf16_t* WT, int ldt, int koff, RM rm, LAS float* scr, int item, int lane) {
    float v[32]; tr_load(W, N, item, lane, v); tr_store(v, N, WT, ldt, koff, rm, scr, item, lane);
}
template <class RM>
__device__ __forceinline__ void transpose_block_item(const float* W, int N, int k0, int n0, bf16_t* WT, int ldt, int koff, RM rm, LAS unsigned char* lds, int tid) {
    const int w = tid >> 6, lane = tid & 63;
    f32x4 v[8];
#pragma unroll
    for (int r = 0; r < 8; ++r) v[r] = __builtin_nontemporal_load((const f32x4*)(W + (size_t)(k0 + 8 * w + r) * N + n0 + 4 * lane));
#pragma unroll
    for (int c = 0; c < 4; ++c) { u32x4 o; o.x = cvtpk(v[0][c], v[1][c]); o.y = cvtpk(v[2][c], v[3][c]); o.z = cvtpk(v[4][c], v[5][c]); o.w = cvtpk(v[6][c], v[7][c]);
        *(LAS u32x4*)(lds + (4 * lane + c) * 144 + 16 * w) = o; }
    __syncthreads();
#pragma unroll
    for (int i = 0; i < 4; ++i) { const int q = tid + 512 * i, row = q >> 3, ch = q & 7;
        *(u32x4*)(WT + (size_t)rm(n0 + row) * ldt + koff + k0 + 8 * ch) = *(const LAS u32x4*)(lds + row * 144 + 16 * ch); }
    __syncthreads();
}
struct RmAdd { int off; __device__ __forceinline__ int operator()(int n) const { return off + n; } };
struct RmW13 { int off; __device__ __forceinline__ int operator()(int n) const { return off + (n >> 7) * 256 + (n & 127); } };

__device__ __forceinline__ void p0_prologue(Frame& F) {
    bf16_t* W1T = (bf16_t*)(F.ws + WS_W1T); bf16_t* WUPT = (bf16_t*)(F.ws + WS_WUPT); bf16_t* WOUTT = (bf16_t*)(F.ws + WS_WOUTT);
    { constexpr int I_A = 16 * 20, I_B = 16 * 8, I_C = 16 * 4; constexpr int NITEMS = I_A + I_B + 3 * I_C;
      for (int it = F.blk; it < NITEMS; it += F.G) { int r = it;
          if (r < I_A) { transpose_block_item(F.a->in[I_WIN], 5120, 64 * (r / 20), 256 * (r % 20), W1T, 1024, 0, RmAdd{0}, F.lds, F.tid); continue; } r -= I_A;
          if (r < I_B) { transpose_block_item(F.a->in[I_WGATE], 2048, 64 * (r / 8), 256 * (r % 8), W1T, 1024, 0, RmAdd{5120}, F.lds, F.tid); continue; } r -= I_B;
          if (r < I_C) { transpose_block_item(F.a->in[I_WUPA], 1024, 64 * (r / 4), 256 * (r % 4), WUPT, 1024, 0, RmAdd{0}, F.lds, F.tid); continue; } r -= I_C;
          if (r < I_C) { transpose_block_item(F.a->in[I_WUPB], 1024, 64 * (r / 4), 256 * (r % 4), WUPT, 1024, 0, RmAdd{1024}, F.lds, F.tid); continue; } r -= I_C;
          transpose_block_item(F.a->in[I_WOUT], 1024, 64 * (r / 4), 256 * (r % 4), WOUTT, 1024, 0, RmAdd{0}, F.lds, F.tid); } }
    { bf16_t* WST = (bf16_t*)(F.ws + WS_WST); const float* ws_ = F.a->in[I_WS];
      for (int i = F.blk * NTHREADS + F.tid; i < 8 * 128 * 128 / 2; i += F.G * NTHREADS) { const int e = 2 * i, s = e & 127, t = (e >> 7) & 127;
          const float a = (s <= t) ? ws_[e] : 0.f, b = (s + 1 <= t) ? ws_[e + 1] : 0.f; *(unsigned*)(WST + e) = cvtpk(a, b); } }
    { float* WRT = (float*)(F.ws + WS_ROUTE + RT_WRT); const float* g2 = F.a->in[I_N2G]; const float* wrg = F.a->in[I_WRG]; const float* wre = F.a->in[I_WRE];
      for (int i = F.blk * NTHREADS + F.tid; i < 48 * 1024; i += F.G * NTHREADS) { const int j = i >> 10, k = i & 1023;
          const float w = j < 4 ? wrg[k * 4 + j] : (j < 36 ? wre[k * 32 + (j - 4)] : 0.f); WRT[i] = g2[k] * w; } }
    if (F.blk == 0) { LAS int* hist = (LAS int*)(F.lds + 136 * 1024); LAS int* gt = hist + 160;
        for (int i = F.tid; i < 320; i += NTHREADS) hist[i] = 0;
        __syncthreads();
        const float dmin1 = attn_dmin_unit(F.a->in[I_QNG], F.a->in[I_KNG]);
        int w[2], jl[2];
#pragma unroll
        for (int q = 0; q < 2; ++q) { const int u = F.tid + q * NTHREADS, qb = u >> 4; jl[q] = attn_jlo(dmin1, u & 7, qb); w[q] = 2 * qb + 2 - jl[q]; atomicAdd((int*)(hist + w[q]), 1); }
        __syncthreads();
        if (F.tid < 64) { int h0 = 0, h1 = 0, h2 = 0; const int i0 = 3 * F.tid;
            if (i0 < 160) h0 = hist[i0]; if (i0 + 1 < 160) h1 = hist[i0 + 1]; if (i0 + 2 < 160) h2 = hist[i0 + 2];
            const int tot = h0 + h1 + h2; int suf = tot;
#pragma unroll
            for (int o = 1; o < 64; o <<= 1) { const int vv = __shfl_down(suf, o); if (F.tid + o < 64) suf += vv; }
            const int above = suf - tot;
            if (i0 + 2 < 160) gt[i0 + 2] = above; if (i0 + 1 < 160) gt[i0 + 1] = above + h2; if (i0 < 160) gt[i0] = above + h2 + h1; }
        __syncthreads();
#pragma unroll
        for (int q = 0; q < 2; ++q) { const int u = F.tid + q * NTHREADS; const int rank = atomicAdd((int*)(gt + w[q]), 1);
            ((int*)(F.ws + WS_ROUTE + RT_ALIST))[rank] = u | (jl[q] << 16); }
        __syncthreads(); }
    { bf16_t* XN = (bf16_t*)(F.ws + WS_XN); const float* x = F.a->in[I_X]; const f32x4* g4 = (const f32x4*)F.a->in[I_N1G] + F.lane;
      for (int m0 = F.gw * 4; m0 < M; m0 += F.NGW * 4) { f32x4 v[4][4];
#pragma unroll
          for (int q = 0; q < 4; ++q) { const f32x4* xr = (const f32x4*)(x + (size_t)(m0 + q) * DM) + F.lane;
#pragma unroll
              for (int j = 0; j < 4; ++j) v[q][j] = __builtin_nontemporal_load(xr + 64 * j); }
#pragma unroll
          for (int q = 0; q < 4; ++q) { float s = 0.f;
#pragma unroll
              for (int j = 0; j < 4; ++j) s += (v[q][j][0] * v[q][j][0] + v[q][j][1] * v[q][j][1]) + (v[q][j][2] * v[q][j][2] + v[q][j][3] * v[q][j][3]);
              const float r = rsqrtf(wave_sum(s) * (1.f / DM) + EPS);
#pragma unroll
              for (int j = 0; j < 4; ++j) { const f32x4 g = g4[64 * j]; st4(XN + (size_t)(m0 + q) * DM + 4 * F.lane + 256 * j, (v[q][j] * r) * g); } } } }
}

__device__ __forceinline__ void p1_proj(Frame& F) {
    pg8::Gemm g{(const bf16_t*)(F.ws + WS_XN), (const bf16_t*)(F.ws + WS_W1T), DM, nullptr};
    pg8::StaticOrder S; S.init(M, N1, F.G, F.blk);
    static_assert(WS_VA == WS_U + 32 * MiB && WS_Q == WS_U + 64 * MiB && WS_K == WS_U + 96 * MiB && WS_VB == WS_U + 128 * MiB, "EpiProj layout");
    EpiProj E{F.ws, (bf16_t*)F.out, F.a->in[I_QNG], F.a->in[I_KNG], F.a->in[I_BGATE]};
    pg8::gemm_phase<EpiProj, pg8::StaticOrder, PG8_ALIGN, PG8_SP2, true>(F.lds, g, S, E);
}

__device__ __forceinline__ void p2_mixer_a(Frame& F) {
    const bf16_t* VA = (const bf16_t*)(F.ws + WS_VA); const bf16_t* U = (const bf16_t*)(F.ws + WS_U); bf16_t* YA = (bf16_t*)(F.ws + WS_YA); const bf16_t* WST = (const bf16_t*)(F.ws + WS_WST);
    const float* gv = F.a->in[I_VNG]; const float* bs = F.a->in[I_BS];
    bf16_t* vT = (bf16_t*)F.ldsg;
    bf16_t* wS = (bf16_t*)(F.ldsg + 128 * 136 * 2);
    const int fr = F.lane & 15, fq = F.lane >> 4, wm = F.wid >> 1, wn = F.wid & 1;
    const int s_ = F.tid >> 2, ds = (F.tid & 3) * 32;
    int gstaged = -1;
    bf16x8 v[4];
    if (F.blk < 1024) { const int c = F.blk >> 3, g = F.blk & 7; const bf16_t* src = VA + (size_t)(c * 128 + s_) * DM + g * 128 + ds;
#pragma unroll
        for (int i = 0; i < 4; ++i) v[i] = *(const bf16x8*)(src + 8 * i); }
    for (int L = F.blk; L < 1024; L += F.G) {
        const int c = L >> 3, g = L & 7;
        if (g != gstaged) { __syncthreads();
#pragma unroll
            for (int i = 0; i < 4; ++i) { const int q = F.tid + 512 * i, t = q >> 4, ch = q & 15; *(bf16x8*)(wS + t * 136 + 8 * ch) = *(const bf16x8*)(WST + g * 16384 + t * 128 + 8 * ch); }
            gstaged = g; }
        { float ss = 0.f;
#pragma unroll
          for (int i = 0; i < 4; ++i)
#pragma unroll
              for (int j = 0; j < 8; ++j) { const float x = bf2f(v[i][j]); ss += x * x; }
          ss += __shfl_xor(ss, 1); ss += __shfl_xor(ss, 2);
          const float r = rsqrtf(ss * (1.f / 128.f) + EPS);
#pragma unroll
          for (int i = 0; i < 4; ++i)
#pragma unroll
              for (int j = 0; j < 8; ++j) { const int d = ds + 8 * i + j; const float x = (bf2f(v[i][j]) * r) * gv[g * 128 + d]; vT[d * 136 + s_] = (bf16_t)(cvtpk(x, 0.f) & 0xffffu); } }
        __syncthreads();
        const int Ln = L + F.G;
        if (Ln < 1024) { const bf16_t* src = VA + (size_t)((Ln >> 3) * 128 + s_) * DM + (Ln & 7) * 128 + ds;
#pragma unroll
            for (int i = 0; i < 4; ++i) v[i] = *(const bf16x8*)(src + 8 * i); }
        f32x4 uu[2][4]; float bb[2];
#pragma unroll
        for (int m = 0; m < 2; ++m) { const int t = 32 * wm + 16 * m + fr; bb[m] = bs[g * 128 + t]; const bf16_t* up = U + (size_t)(c * 128 + t) * DM + g * 128 + 64 * wn + 4 * fq;
#pragma unroll
            for (int n = 0; n < 4; ++n) uu[m][n] = ld4(up + 16 * n); }
        const bf16_t* ap = wS + (32 * wm + fr) * 136 + 8 * fq; const bf16_t* bp = vT + (64 * wn + fr) * 136 + 8 * fq;
        f32x4 acc[2][4]; acc_zero(acc);
        wave_gemm(acc, ap, ap + 16 * 136, bp, bp + 16 * 136, bp + 32 * 136, bp + 48 * 136, 32 * (wm + 1));
#pragma unroll
        for (int m = 0; m < 2; ++m) { const int t = 32 * wm + 16 * m + fr; bf16_t* yp = YA + (size_t)(c * 128 + t) * DM + g * 128 + 64 * wn + 4 * fq;
#pragma unroll
            for (int n = 0; n < 4; ++n) st4(yp + 16 * n, uu[m][n] * (acc[m][n] + bb[m])); }
        __syncthreads();
    }
}

namespace att {
constexpr int QBLK = 32, KVBLK = 64, QB = 128, PITCH = 1024;
constexpr int SHM_V = KVBLK * 128 * 2, SHM_K = 2 * KVBLK * 64 * 2;
constexpr int SLOT = SHM_K + SHM_V, NSLOT = 3;
constexpr int LDS_WSF = NSLOT * SLOT, LDS_XCH = LDS_WSF + NWAVES * 64 * 4, LDS_BYTES = LDS_XCH + 4 * 16 * 2 * 64 * 4;
constexpr float THR2 = 8.f * LOG2E;
#define KSWZ64(row, colB) ((row) * 128 + ((colB) ^ ((((row) >> 1) & 7) << 4)))
__device__ __forceinline__ int v_st(int k, int c) { const int kk = (k & ~0xC) | ((k & 4) << 1) | ((k & 8) >> 1); return ((kk >> 3) * 4 + (c >> 5)) * 512 + ((kk & 7) * 32 + (c & 31)) * 2; }
__device__ __forceinline__ int v_rd_base(int lane) { return ((lane & 3) << 3) | (((lane >> 2) & 3) << 6) | (((lane >> 4) & 1) << 5) | (((lane >> 5) & 1) << 8); }
constexpr int v_rd_off(int d0, int ks, int half) { return d0 * 512 + ks * 4096 + half * 2048; }
__device__ __forceinline__ int crow(int r, int hi) { return (r & 3) + 8 * (r >> 2) + 4 * hi; }

__device__ __forceinline__ void mask_tile(f32x16& p0, f32x16& p1, int dq) {
    const float NEG = -__builtin_inff();
#pragma unroll
    for (int r = 0; r < 16; ++r) { const int c = (r & 3) + 8 * (r >> 2);
        if (dq - c < 0) p0[r] = NEG;
        if (dq - c - 32 < 0) p1[r] = NEG; }
}
__device__ __forceinline__ void partialSM(f32x16& p0, f32x16& p1, float& m_reg, float& alpha) {
    float pmax = __builtin_fmaxf(__builtin_fmaxf(p0[0], p0[1]), p0[2]);
#pragma unroll
    for (int r = 3; r < 15; r += 2) pmax = __builtin_fmaxf(__builtin_fmaxf(pmax, p0[r]), p0[r + 1]);
    pmax = __builtin_fmaxf(__builtin_fmaxf(pmax, p0[15]), p1[0]);
#pragma unroll
    for (int r = 1; r < 15; r += 2) pmax = __builtin_fmaxf(__builtin_fmaxf(pmax, p1[r]), p1[r + 1]);
    pmax = __builtin_fmaxf(pmax, p1[15]);
    { auto rr = __builtin_amdgcn_permlane32_swap(__float_as_uint(pmax), __float_as_uint(pmax), false, false);
      pmax = fmaxf(__uint_as_float(rr[0]), __uint_as_float(rr[1])); }
    alpha = 1.f;
    if (__builtin_expect(!__all(pmax <= THR2), 0)) { asm volatile("" ::: "memory");
        const float d = fmaxf(pmax, 0.f); m_reg += d; alpha = __builtin_amdgcn_exp2f(-d);
#pragma unroll
        for (int r = 0; r < 16; ++r) { p0[r] -= d; p1[r] -= d; } }
#pragma unroll
    for (int r = 0; r < 16; ++r) p0[r] = __builtin_amdgcn_exp2f(p0[r]);
}
__device__ __forceinline__ void finishSM_h(f32x16& p0, f32x16& p1, float alpha, float& l_reg, float ps0, bf16x8& pa0, bf16x8& pa1, bf16x8& pa2, bf16x8& pa3) {
#pragma unroll
    for (int r = 0; r < 16; ++r) p1[r] = __builtin_amdgcn_exp2f(p1[r]);
    float ps = ps0;
#pragma unroll
    for (int r = 0; r < 16; ++r) ps += p1[r];
    { auto rr = __builtin_amdgcn_permlane32_swap(__float_as_uint(ps), __float_as_uint(ps), false, false);
      ps = __uint_as_float(rr[0]) + __uint_as_float(rr[1]); }
    l_reg = l_reg * alpha + ps;
#define PK4(P, B_, OUT) do { unsigned a0 = cvtpk(P[B_+0], P[B_+1]), a1 = cvtpk(P[B_+2], P[B_+3]);                          \
        unsigned b0 = cvtpk(P[B_+4], P[B_+5]), b1 = cvtpk(P[B_+6], P[B_+7]);                                             \
        auto r0 = __builtin_amdgcn_permlane32_swap(a0, b0, false, false); auto r1 = __builtin_amdgcn_permlane32_swap(a1, b1, false, false); \
        u32x4 w = {r0[0], r1[0], r0[1], r1[1]}; OUT = __builtin_bit_cast(bf16x8, w); } while (0)
    PK4(p0, 0, pa0); PK4(p0, 8, pa1); PK4(p1, 0, pa2); PK4(p1, 8, pa3);
#undef PK4
}
__device__ __forceinline__ void finishSM(f32x16& p0, f32x16& p1, float alpha, float& l_reg, bf16x8& pa0, bf16x8& pa1, bf16x8& pa2, bf16x8& pa3) {
#pragma unroll
    for (int r = 0; r < 16; ++r) p1[r] = __builtin_amdgcn_exp2f(p1[r]);
    float ps = 0;
#pragma unroll
    for (int r = 0; r < 16; ++r) ps += p0[r];
#pragma unroll
    for (int r = 0; r < 16; ++r) ps += p1[r];
    { auto rr = __builtin_amdgcn_permlane32_swap(__float_as_uint(ps), __float_as_uint(ps), false, false);
      ps = __uint_as_float(rr[0]) + __uint_as_float(rr[1]); }
    l_reg = l_reg * alpha + ps;
#define PK4(P, B_, OUT) do { unsigned a0 = cvtpk(P[B_+0], P[B_+1]), a1 = cvtpk(P[B_+2], P[B_+3]);                          \
        unsigned b0 = cvtpk(P[B_+4], P[B_+5]), b1 = cvtpk(P[B_+6], P[B_+7]);                                             \
        auto r0 = __builtin_amdgcn_permlane32_swap(a0, b0, false, false); auto r1 = __builtin_amdgcn_permlane32_swap(a1, b1, false, false); \
        u32x4 w = {r0[0], r1[0], r0[1], r1[1]}; OUT = __builtin_bit_cast(bf16x8, w); } while (0)
    PK4(p0, 0, pa0); PK4(p0, 8, pa1); PK4(p1, 0, pa2); PK4(p1, 8, pa3);
#undef PK4
}
__device__ __forceinline__ void qkt(f32x16& p0, f32x16& p1, const char* Kmap_lds, int r32, int hi, const bf16x8* qr, bf16x8 kx0, unsigned kc1, bf16x8 qx) {
    p0 = __builtin_amdgcn_mfma_f32_32x32x16_bf16(kx0, qx, f32x16{}, 0, 0, 0);
    { u32x4 k1 = __builtin_bit_cast(u32x4, kx0); k1.x = kc1; p1 = __builtin_amdgcn_mfma_f32_32x32x16_bf16(__builtin_bit_cast(bf16x8, k1), qx, f32x16{}, 0, 0, 0); }
#pragma unroll
    for (int d0 = 0; d0 < 4; ++d0) { const char* a = Kmap_lds + KSWZ64(r32, (d0 * 16 + hi * 8) * 2);
        const bf16x8 b0 = *reinterpret_cast<const bf16x8*>(a);
        const bf16x8 b1 = *reinterpret_cast<const bf16x8*>(a + 32 * 128);
        p0 = __builtin_amdgcn_mfma_f32_32x32x16_bf16(b0, qr[d0], p0, 0, 0, 0);
        p1 = __builtin_amdgcn_mfma_f32_32x32x16_bf16(b1, qr[d0], p1, 0, 0, 0); }
}
__device__ __forceinline__ void pv_tile(f32x16* o, int vb0, bf16x8 pa0, bf16x8 pa1, bf16x8 pa2, bf16x8 pa3) {
#define TRRD(dst, off) asm volatile("ds_read_b64_tr_b16 %0, %1 offset:%2" : "=&v"(dst) : "v"(vb0), "i"(off) : "memory")
#define PV_D0(d0) do { s16x4 l0, l1, l2, l3, h0, h1, h2, h3; constexpr int b_ = v_rd_off(d0, 0, 0); \
        TRRD(l0, b_); TRRD(h0, b_ + 2048); TRRD(l1, b_ + 4096); TRRD(h1, b_ + 6144); TRRD(l2, b_ + 8192); TRRD(h2, b_ + 10240); TRRD(l3, b_ + 12288); TRRD(h3, b_ + 14336); \
        asm volatile("s_waitcnt lgkmcnt(0)" ::: "memory"); SBAR();   \
        o[d0] = __builtin_amdgcn_mfma_f32_32x32x16_bf16(pa0, (bf16x8){l0[0], l0[1], l0[2], l0[3], h0[0], h0[1], h0[2], h0[3]}, o[d0], 0, 0, 0);   \
        o[d0] = __builtin_amdgcn_mfma_f32_32x32x16_bf16(pa1, (bf16x8){l1[0], l1[1], l1[2], l1[3], h1[0], h1[1], h1[2], h1[3]}, o[d0], 0, 0, 0);   \
        o[d0] = __builtin_amdgcn_mfma_f32_32x32x16_bf16(pa2, (bf16x8){l2[0], l2[1], l2[2], l2[3], h2[0], h2[1], h2[2], h2[3]}, o[d0], 0, 0, 0);   \
        o[d0] = __builtin_amdgcn_mfma_f32_32x32x16_bf16(pa3, (bf16x8){l3[0], l3[1], l3[2], l3[3], h3[0], h3[1], h3[2], h3[3]}, o[d0], 0, 0, 0); } while (0)
    PV_D0(0); PV_D0(1); PV_D0(2); PV_D0(3);
#undef PV_D0
#undef TRRD
}

__device__ __forceinline__ void pv_fused(f32x16* o, int vb0, bf16x8 pa0, bf16x8 pa1, bf16x8 pa2, bf16x8 pa3, f32x16& x0, const f32x16& x1, float& pmax, float& ps0) {
#define TRRD(dst, off) asm volatile("ds_read_b64_tr_b16 %0, %1 offset:%2" : "=&v"(dst) : "v"(vb0), "i"(off) : "memory")
#define VFR(L, H, k) (bf16x8){L[k][0], L[k][1], L[k][2], L[k][3], H[k][0], H[k][1], H[k][2], H[k][3]}
#define LGKM0() asm volatile("s_waitcnt lgkmcnt(0)" ::: "memory")
#define VBASE(d0) (v_rd_off(d0, 0, 0))
    s16x4 la[4], ha[4];
    float m = -__builtin_inff(), sx = 0.f;
#pragma unroll
    for (int k = 0; k < 4; ++k) { TRRD(la[k], VBASE(0) + k * 4096); TRRD(ha[k], VBASE(0) + k * 4096 + 2048); }
    LGKM0(); SBAR();
#define PA(k) ((k) == 0 ? pa0 : (k) == 1 ? pa1 : (k) == 2 ? pa2 : pa3)
#define GAP(s, L, H)  do { constexpr int d0_ = (s) >> 2, k_ = (s) & 3;                                                           \
        o[d0_] = __builtin_amdgcn_mfma_f32_32x32x16_bf16(PA(k_), VFR(L, H, k_), o[d0_], 0, 0, 0);                                          \
        if (d0_ < 3) { TRRD(L[k_], VBASE(d0_ + 1) + k_ * 4096); TRRD(H[k_], VBASE(d0_ + 1) + k_ * 4096 + 2048); }                        \
        if ((s) < 4) { m = __builtin_fmaxf(__builtin_fmaxf(m, x0[4 * (s)]), x0[4 * (s) + 1]); m = __builtin_fmaxf(__builtin_fmaxf(m, x0[4 * (s) + 2]), x0[4 * (s) + 3]); }            \
        else if ((s) < 8) { m = __builtin_fmaxf(__builtin_fmaxf(m, x1[4 * ((s) - 4)]), x1[4 * ((s) - 4) + 1]); m = __builtin_fmaxf(__builtin_fmaxf(m, x1[4 * ((s) - 4) + 2]), x1[4 * ((s) - 4) + 3]); } \
        if ((s) >= 4 && (s) < 12) { x0[(s) - 4] = __builtin_amdgcn_exp2f(x0[(s) - 4]); if ((s) >= 5) sx += x0[(s) - 5]; }                  \
        else if ((s) >= 12) { x0[8 + 2 * ((s) - 12)] = __builtin_amdgcn_exp2f(x0[8 + 2 * ((s) - 12)]); x0[9 + 2 * ((s) - 12)] = __builtin_amdgcn_exp2f(x0[9 + 2 * ((s) - 12)]); \
                              sx += x0[7 + 2 * ((s) - 12)]; sx += x0[8 + 2 * ((s) - 12)]; }                                                  \
        if (k_ == 3 && d0_ < 3) LGKM0();                                                                                                   \
        SBAR(); } while (0)
    GAP(0, la, ha); GAP(1, la, ha); GAP(2, la, ha); GAP(3, la, ha);
    GAP(4, la, ha); GAP(5, la, ha); GAP(6, la, ha); GAP(7, la, ha);
    GAP(8, la, ha); GAP(9, la, ha); GAP(10, la, ha); GAP(11, la, ha);
    GAP(12, la, ha); GAP(13, la, ha); GAP(14, la, ha); GAP(15, la, ha);
    ps0 = sx + x0[15]; pmax = m;
#undef GAP
#undef PA
#undef VBASE
#undef LGKM0
#undef VFR
#undef TRRD
}
__device__ __forceinline__ bf16x8 qx_of(unsigned sdw, float x) {
    const unsigned h_ = cvtpk(x, 0.f) & 0xffffu; const float r1 = x - __uint_as_float(h_ << 16);
    const unsigned m_ = cvtpk(r1, 0.f) & 0xffffu; const float r2 = r1 - __uint_as_float(m_ << 16);
    return __builtin_bit_cast(bf16x8, (u32x4){sdw, h_ | (m_ << 16), cvtpk(r2, 0.f) & 0xffffu, 0u});
}
struct BlockRef { int base; int P0; int jlo; float slope2; };
#define BR_Q(br) ((const bf16_t*)(wsb + WS_Q) + (br).base)
#define BR_K(br) ((const bf16_t*)(wsb + WS_K) + (br).base)
#define BR_V(br) ((const bf16_t*)(wsb + WS_VB) + (br).base)
#define BR_O(br) ((bf16_t*)(wsb + WS_XN) + (br).base)
struct Seam { bf16x8 qr[4]; };
__device__ __forceinline__ void glds16s(unsigned voff, const void* sbase, unsigned lds_dst) { unsigned keep;
    asm volatile("s_mov_b32 %0, m0\n\ts_mov_b32 m0, %3\n\ts_nop 0\n\tglobal_load_lds_dwordx4 %1, %2\n\ts_mov_b32 m0, %0" : "=&s"(keep) : "v"(voff), "s"(sbase), "s"(lds_dst) : "memory"); }
#define WAIT_BAR(N) asm volatile("s_waitcnt vmcnt(" #N ") lgkmcnt(0)\n\ts_barrier" ::: "memory")
#define LBAR() asm volatile("s_waitcnt lgkmcnt(0)\n\ts_barrier" ::: "memory")
struct DmaOff { unsigned k0, k1, v0, v1; };
__device__ __forceinline__ DmaOff dma_offsets(int wid, int lane) {
    DmaOff d; unsigned ko[2], vo[2];
#pragma unroll
    for (int i = 0; i < 2; ++i) { const int G = (2 * wid + i) * 64 + lane;
        { const int map = G >> 9, row = (G >> 3) & 63, slot = G & 7, chunk = slot ^ ((row >> 1) & 7); ko[i] = (unsigned)(row * PITCH + map * 64 + chunk * 8) * 2u; }
        { const int sub = G >> 5, kk = (sub >> 2) * 8 + ((G >> 2) & 7), k = (kk & ~0xC) | ((kk & 4) << 1) | ((kk & 8) >> 1), c = (sub & 3) * 32 + (G & 3) * 8; vo[i] = (unsigned)(k * PITCH + c) * 2u; } }
    d.k0 = ko[0]; d.k1 = ko[1]; d.v0 = vo[0]; d.v1 = vo[1]; return d;
}
#define TILE_PTR(T_, br, t) ((const char*)(wsb + (T_)) + ((size_t)(br).base + (size_t)((br).jlo + (t)) * (KVBLK * PITCH)) * 2)
#define DMA_K(br, t, so) do { const char* sb_ = TILE_PTR(WS_K, br, t); const unsigned ld_ = (unsigned)__builtin_amdgcn_readfirstlane((int)(lds0 + (so) + wid * 2048)); glds16s(D.k0, sb_, ld_); glds16s(D.k1, sb_, ld_ + 1024u); } while (0)
#define DMA_V(br, t, so) do { const char* sb_ = TILE_PTR(WS_VB, br, t); const unsigned ld_ = (unsigned)__builtin_amdgcn_readfirstlane((int)(lds0 + (so) + SHM_K + wid * 2048)); glds16s(D.v0, sb_, ld_); glds16s(D.v1, sb_, ld_ + 1024u); } while (0)
__device__ __forceinline__ void attn_issue_first(const unsigned char* wsb, const BlockRef& br, char* lds, Seam& S, const DmaOff& D, int wid, int r32, int hi) {
    const unsigned lds0 = (unsigned)(uintptr_t)lds; const int map = wid >> 2, rw = wid & 3;
#pragma unroll
    for (int d0 = 0; d0 < 4; ++d0) S.qr[d0] = *(const bf16x8*)(BR_Q(br) + (size_t)(br.P0 + rw * QBLK + r32) * PITCH + map * 64 + d0 * 16 + hi * 8);
    DMA_K(br, 0, 0); DMA_V(br, 0, 0); DMA_K(br, 1, SLOT);
}
__device__ __forceinline__ void attn_block(unsigned char* wsb, const BlockRef& cur, const BlockRef& nxt, char* lds, Seam& S, float lam, const float* subg) {
    const int tid = threadIdx.x, wid = __builtin_amdgcn_readfirstlane(tid >> 6), lane = tid & 63, r32 = lane & 31, hi = lane >> 5;
    const int map = wid >> 2, rw = wid & 3;
    const int j_lo = cur.jlo, NT = cur.P0 / KVBLK + 2 - j_lo;
    const int qlo = cur.P0 + rw * QBLK, qm = qlo + r32 - 4 * hi;
    const float slope2 = cur.slope2; const int qpos = qlo + r32;
    unsigned sdw; { const unsigned h_ = cvtpk(slope2, 0.f) & 0xffffu; const float lo_ = slope2 - __uint_as_float(h_ << 16); sdw = h_ | (cvtpk(lo_, 0.f) << 16); }
    bf16x8 kx0; unsigned kx1; { const unsigned c0 = cvtpk((float)r32, (float)r32), c1 = cvtpk((float)(r32 + 32), (float)(r32 + 32)), one = hi ? 0u : 0x3f803f80u;
        kx0 = __builtin_bit_cast(bf16x8, (u32x4){hi ? 0u : c0, one, one & 0xffffu, 0u}); kx1 = hi ? 0u : c1; }
    const unsigned lds0 = (unsigned)(uintptr_t)lds; const char* Kmap = lds + map * 8192;
    float* ws = (float*)(lds + LDS_WSF) + wid * 64; float* li_l = ws, * al_l = ws + 32;
    float m_reg = 0.f, l_reg = 0; f32x16 o[4] = {};
    const int vb0 = (int)lds0 + SHM_K + v_rd_base(lane);
    const DmaOff D = dma_offsets(wid, lane);
#define RESC(a) do { if (__any((a) < 1.f)) { if (hi == 0) al_l[r32] = (a); asm volatile("s_waitcnt lgkmcnt(0)" ::: "memory");              \
                     _Pragma("unroll") for (int d_ = 0; d_ < 4; ++d_) _Pragma("unroll") for (int r = 0; r < 16; ++r) o[d_][r] *= al_l[crow(r, hi)]; } } while (0)
#define KBASE(t) ((j_lo + (t)) * KVBLK)
#define MASKT(P0_, P1_, t) do { const int kb_ = KBASE(t); if (kb_ + KVBLK - 1 > qlo) { asm volatile("" ::: "memory"); mask_tile(P0_, P1_, qm - kb_); } } while (0)
#define QX(t) qx_of(sdw, slope2 * (float)(KBASE(t) - qpos) - m_reg)
#define ROT() do { const int p_ = sl_prev; sl_prev = sl_cur; sl_cur = sl_next; sl_next = p_; } while (0)
    f32x16 pA0, pA1, pB0, pB1; float alA, alB; bf16x8 pa0, pa1, pa2, pa3;
    int sl_prev = 2 * SLOT, sl_cur = 0, sl_next = SLOT;
    WAIT_BAR(0);
    asm volatile("" : "+v"(S.qr[0]), "+v"(S.qr[1]), "+v"(S.qr[2]), "+v"(S.qr[3]));
    if (NT > 2) { DMA_V(cur, 1, SLOT); DMA_K(cur, 2, 2 * SLOT); } else { DMA_V(cur, 1, SLOT); }
    SBAR(); qkt(pA0, pA1, Kmap, r32, hi, S.qr, kx0, kx1, QX(0));
    MASKT(pA0, pA1, 0); partialSM(pA0, pA1, m_reg, alA);
    float psA = 0.f, psB = 0.f;
#pragma unroll
    for (int r = 0; r < 16; ++r) psA += pA0[r];
    if (NT > 2) { WAIT_BAR(4); } else { WAIT_BAR(2); }
    ROT();
#define STEP(PX0, PX1, alX, psX, PY0, PY1, alY, psY, t) do {                                                                           \
        const bool k2_ = (t) + 2 < NT, v1_ = (t) + 1 < NT;                                                                   \
        if (k2_) DMA_K(cur, (t) + 2, sl_prev); if (v1_) DMA_V(cur, (t) + 1, sl_next);                                        \
        SBAR(); qkt(PX0, PX1, Kmap + sl_cur, r32, hi, S.qr, kx0, kx1, QX(t));                                                \
        finishSM_h(PY0, PY1, alY, l_reg, psY, pa0, pa1, pa2, pa3); SBAR();                                                   \
        MASKT(PX0, PX1, (t)); SBAR();                                                                                        \
        { float pm_; pv_fused(o, vb0 + sl_prev, pa0, pa1, pa2, pa3, PX0, PX1, pm_, psX);                                     \
          { auto rr_ = __builtin_amdgcn_permlane32_swap(__float_as_uint(pm_), __float_as_uint(pm_), false, false); pm_ = fmaxf(__uint_as_float(rr_[0]), __uint_as_float(rr_[1])); } \
          alX = 1.f;                                                                                                           \
          if (__builtin_expect(!__all(pm_ <= THR2), 0)) { asm volatile("" ::: "memory");        \
              const float d_ = fmaxf(pm_, 0.f); m_reg += d_; alX = __builtin_amdgcn_exp2f(-d_);                                \
              psX *= alX; _Pragma("unroll") for (int r = 0; r < 16; ++r) { PX0[r] *= alX; PX1[r] -= d_; } } }                              \
        RESC(alX);                                                                                                           \
        if (k2_) { WAIT_BAR(4); } else if (v1_) { WAIT_BAR(2); } else { WAIT_BAR(0); }                                       \
        ROT(); } while (0)
    int t = 1;
    for (; t + 1 < NT; t += 2) {
        STEP(pB0, pB1, alB, psB, pA0, pA1, alA, psA, t);
        STEP(pA0, pA1, alA, psA, pB0, pB1, alB, psB, t + 1);
    }
    const bool oddtail = t < NT;
    if (oddtail) { STEP(pB0, pB1, alB, psB, pA0, pA1, alA, psA, t); }
    if (oddtail) { finishSM_h(pB0, pB1, alB, l_reg, psB, pa0, pa1, pa2, pa3); } else { finishSM_h(pA0, pA1, alA, l_reg, psA, pa0, pa1, pa2, pa3); }
    SBAR(); pv_tile(o, vb0 + sl_prev, pa0, pa1, pa2, pa3);
    LBAR();
    attn_issue_first(wsb, nxt, lds, S, D, wid, r32, hi);
    if (hi == 0) li_l[r32] = l_reg; asm volatile("s_waitcnt lgkmcnt(0)" ::: "memory");
    float rli[16];
#pragma unroll
    for (int r = 0; r < 16; ++r) rli[r] = __builtin_amdgcn_rcpf(li_l[crow(r, hi)]);
    float* xch = (float*)(lds + LDS_XCH) + (size_t)rw * (16 * 2 * 64) + lane;
#pragma unroll
    for (int half = 0; half < 2; ++half) {
        if (map == 1) {
#pragma unroll
            for (int r = 0; r < 16; ++r)
#pragma unroll
                for (int dd = 0; dd < 2; ++dd) xch[(r * 2 + dd) * 64] = o[2 * half + dd][r] * rli[r]; }
        LBAR();
        if (map == 0) {
#pragma unroll
            for (int r = 0; r < 16; ++r)
#pragma unroll
                for (int dd = 0; dd < 2; ++dd) o[2 * half + dd][r] = o[2 * half + dd][r] * rli[r] - lam * xch[(r * 2 + dd) * 64]; }
        LBAR();
    }
    if (map == 0) {
        float gsub[4];
#pragma unroll
        for (int d0 = 0; d0 < 4; ++d0) gsub[d0] = subg[d0 * 32 + r32] * (1.f - LAM_INIT);
        int obase = (cur.P0 + rw * QBLK + 4 * hi) * PITCH + r32; asm volatile("" : "+v"(obase));
        bf16_t* Ow = BR_O(cur) + obase;
#pragma unroll
        for (int r = 0; r < 16; ++r) { float ss = 0.f;
#pragma unroll
            for (int d0 = 0; d0 < 4; ++d0) ss += o[d0][r] * o[d0][r];
            ss += __shfl_xor(ss, 1); ss += __shfl_xor(ss, 2); ss += __shfl_xor(ss, 4); ss += __shfl_xor(ss, 8); ss += __shfl_xor(ss, 16);
            const float rs = rsqrtf(ss * (1.f / 128.f) + EPS); const int orow = (r & 3) + 8 * (r >> 2);
#pragma unroll
            for (int d0 = 0; d0 < 4; ++d0) { const float v = (o[d0][r] * rs) * gsub[d0]; const float vn = __shfl_xor(v, 1);
                if ((r32 & 1) == 0) *(unsigned*)(Ow + orow * PITCH + d0 * 32) = cvtpk(v, vn); } }
    }
#undef RESC
#undef KBASE
#undef MASKT
#undef QX
#undef ROT
#undef STEP
}
#undef WAIT_BAR
#undef LBAR
#undef TILE_PTR
#undef DMA_K
#undef DMA_V
#undef BR_Q
#undef BR_K
#undef BR_V
#undef BR_O
}


__device__ __forceinline__ att::BlockRef attn_ref(Frame& F, int L) {
    const int ent = ((const int*)(F.ws + WS_ROUTE + RT_ALIST))[L]; const int u = ent & 0xffff, qb = u >> 4, bh = u & 15, b = bh >> 3, h = bh & 7;
    att::BlockRef r; r.base = __builtin_amdgcn_readfirstlane(b * SEQ * 1024 + h * 128);
    r.P0 = __builtin_amdgcn_readfirstlane(qb * 128); r.jlo = __builtin_amdgcn_readfirstlane(ent >> 16); r.slope2 = exp2f(-(float)(__builtin_amdgcn_readfirstlane(h) + 1)) * LOG2E;
    return r;
}
__device__ __forceinline__ void p2_attention(Frame& F) {
    const float s1 = wave_sum(F.a->in[I_LQ1][F.lane] * F.a->in[I_LK1][F.lane]), s2 = wave_sum(F.a->in[I_LQ2][F.lane] * F.a->in[I_LK2][F.lane]);
    const float lam = expf(s1) - expf(s2) + LAM_INIT;
    constexpr int NUNITS = 1024;
    volatile LAS int* qs = (volatile LAS int*)(F.lds + 143 * 1024);
    __syncthreads();
    const int v = (F.G % 8 == 0) ? (F.blk % 8) * (F.G / 8) + F.blk / 8 : F.blk;
    int L = v, Ln = 2 * F.G - 1 - v;
    if (L >= NUNITS) return;
    att::BlockRef cur = attn_ref(F, L); att::Seam S;
    { const att::DmaOff D0 = att::dma_offsets(F.wid, F.lane); att::attn_issue_first(F.ws, cur, F.ldsg, S, D0, F.wid, F.lane & 31, F.lane >> 5); }
    for (;;) {
        const bool last = Ln >= NUNITS;
        int nn = 0; if (F.tid == 0 && !last) nn = 2 * F.G + (int)atomicAdd(F.ctl + CW_AQ, 1u);
        const att::BlockRef nxt = last ? cur : attn_ref(F, Ln);
        att::attn_block(F.ws, cur, nxt, F.ldsg, S, lam, F.a->in[I_SUBG]);
        if (last) { asm volatile("s_waitcnt vmcnt(0)" ::: "memory"); __syncthreads(); break; }
        if (F.tid == 0) qs[0] = nn;
        __syncthreads();
        cur = nxt; Ln = qs[0];
        __syncthreads();
    }
}

__device__ __forceinline__ void p3_merged(Frame& F) {
    pg8::StaticOrder S; S.init(M, DM, F.G, F.blk);
    { pg8::Gemm g{(const bf16_t*)(F.ws + WS_YA), (const bf16_t*)(F.ws + WS_WUPT), DM, nullptr}; EpiGateT E{(const bf16_t*)F.out, (bf16_t*)(F.ws + WS_T)};
      pg8::gemm_phase<EpiGateT, pg8::StaticOrder, PG8_ALIGN, PG8_SP2, false>(F.lds, g, S, E); }
    { pg8::Gemm g{(const bf16_t*)(F.ws + WS_XN), (const bf16_t*)(F.ws + WS_WUPT) + 1024 * 1024, DM, nullptr}; EpiMerged E{(const bf16_t*)F.out, (const bf16_t*)(F.ws + WS_T), (bf16_t*)(F.ws + WS_Q)};
      pg8::gemm_phase<EpiMerged, pg8::StaticOrder, PG8_ALIGN, PG8_SP2, false>(F.lds, g, S, E); }
}
__device__ __forceinline__ void p4_out(Frame& F) {
    pg8::StaticOrder S; S.init(M, DM, F.G, F.blk);
    pg8::Gemm g{(const bf16_t*)(F.ws + WS_Q), (const bf16_t*)(F.ws + WS_WOUTT), DM, nullptr}; EpiOut E{F.a->in[I_X], F.out, F.a->in[I_N2G], (bf16_t*)(F.ws + WS_H2)};
    pg8::gemm_phase<EpiOut, pg8::StaticOrder, PG8_ALIGN, PG8_SP2, false>(F.lds, g, S, E);
}
__device__ __forceinline__ void h2_row(Frame& F, int t, f32x4 (&h)[4]) {
    const f32x4* xr = (const f32x4*)(F.out + (size_t)t * DM) + F.lane; const f32x4* g4 = (const f32x4*)F.a->in[I_N2G] + F.lane;
    float s = 0.f;
#pragma unroll
    for (int j = 0; j < 4; ++j) { h[j] = xr[64 * j]; s += (h[j][0] * h[j][0] + h[j][1] * h[j][1]) + (h[j][2] * h[j][2] + h[j][3] * h[j][3]); }
    const float r = rsqrtf(wave_sum(s) * (1.f / DM) + EPS);
#pragma unroll
    for (int j = 0; j < 4; ++j) h[j] = (h[j] * r) * g4[64 * j];
}
__device__ __forceinline__ void p5_router(Frame& F) {
    const float* WRT = (const float*)(F.ws + WS_ROUTE + RT_WRT); const float* brg = F.a->in[I_BRG]; const float* bre = F.a->in[I_BRE];
    int* tokpos = (int*)(F.ws + WS_ROUTE + RT_TOKPOS); float* roww = (float*)(F.ws + WS_ROUTE + RT_ROWW); float* rowrr = (float*)(F.ws + WS_ROUTE + RT_ROWRR); int* rowtok = (int*)(F.ws + WS_ROUTE + RT_ROWTOK);
    LAS float* lg = (LAS float*)(F.lds + 128 * 1024 + (F.wid & 3) * 3072);
    const int i16 = F.lane & 15, kq = F.lane >> 4;
    if (F.wid < 4)
    for (int task = F.blk * 4 + F.wid; task < M / 16; task += F.G * 4) { const int t0 = task * 16;
        const float* xp = F.out + (size_t)(t0 + i16) * DM + 4 * kq; const float* wp = WRT + (size_t)i16 * DM + 4 * kq;
        f32x4 acc0 = {0.f, 0.f, 0.f, 0.f}, acc1 = acc0, acc2 = acc0; float ss = 0.f;
#pragma unroll 4
        for (int s = 0; s < 64; ++s) { const f32x4 xa = *(const f32x4*)(xp + 16 * s);
            const f32x4 w0 = *(const f32x4*)(wp + 16 * s), w1 = *(const f32x4*)(wp + 16 * DM + 16 * s), w2 = *(const f32x4*)(wp + 32 * DM + 16 * s);
            ss += (xa[0] * xa[0] + xa[1] * xa[1]) + (xa[2] * xa[2] + xa[3] * xa[3]);
#pragma unroll
            for (int e = 0; e < 4; ++e) { acc0 = __builtin_amdgcn_mfma_f32_16x16x4f32(xa[e], w0[e], acc0, 0, 0, 0); acc1 = __builtin_amdgcn_mfma_f32_16x16x4f32(xa[e], w1[e], acc1, 0, 0, 0);
                acc2 = __builtin_amdgcn_mfma_f32_16x16x4f32(xa[e], w2[e], acc2, 0, 0, 0); } }
        ss += __shfl_xor(ss, 16); ss += __shfl_xor(ss, 32);
        const float rr = rsqrtf(ss * (1.f / DM) + EPS);
#pragma unroll
        for (int reg = 0; reg < 4; ++reg) { LAS float* p = lg + (4 * kq + reg) * 48 + i16; p[0] = acc0[reg]; p[16] = acc1[reg]; p[32] = acc2[reg]; }
        LDS_WAIT(); asm volatile("" ::: "memory");
        if (F.lane < 16) { const LAS float* p = lg + F.lane * 48;
            float gl[4];
#pragma unroll
            for (int i = 0; i < 4; ++i) gl[i] = p[i] * rr + brg[i];
            int g = 0; float gm = gl[0];
#pragma unroll
            for (int i = 1; i < 4; ++i) if (gl[i] > gm) { gm = gl[i]; g = i; }
            float gs = 0.f;
#pragma unroll
            for (int i = 0; i < 4; ++i) gs += expf(gl[i] - gm);
            const float ggate = 1.f / gs;
            float el[8];
#pragma unroll
            for (int i = 0; i < 8; ++i) el[i] = p[4 + g * 8 + i] * rr + bre[g * 8 + i];
            int i1 = 0; float v1 = el[0];
#pragma unroll
            for (int i = 1; i < 8; ++i) if (el[i] > v1) { v1 = el[i]; i1 = i; }
            int i2 = -1; float v2 = -__builtin_inff();
#pragma unroll
            for (int i = 0; i < 8; ++i) if (i != i1 && el[i] > v2) { v2 = el[i]; i2 = i; }
            const float a = expf(v2 - v1), w1 = 1.f / (1.f + a), w2 = a / (1.f + a);
            const int t = t0 + F.lane, e1 = g * 8 + i1, e2 = g * 8 + i2;
            const int r1 = (int)atomicAdd(F.ctl + CW_CNT + e1 * CW_CNT_STRIDE, 1u), r2 = (int)atomicAdd(F.ctl + CW_CNT + e2 * CW_CNT_STRIDE, 1u);
            rowtok[e1 * ECAP + r1] = t; roww[e1 * ECAP + r1] = ggate * w1; rowrr[e1 * ECAP + r1] = rr; rowtok[e2 * ECAP + r2] = t; roww[e2 * ECAP + r2] = ggate * w2; rowrr[e2 * ECAP + r2] = rr;
            tokpos[2 * t] = (e1 << ECAP_LOG) | r1; tokpos[2 * t + 1] = (e2 << ECAP_LOG) | r2; }
        LDS_WAIT(); asm volatile("" ::: "memory");
    }
    if (F.wid >= 4) {
      LAS float* scr = (LAS float*)(F.lds + (F.wid - 4) * 32768);
      bf16_t* W13T = (bf16_t*)(F.ws + WS_W13T); bf16_t* W2T = (bf16_t*)(F.ws + WS_W2T);
#define XW_SRC(it_) (((it_) % 384) < 128 ? F.a->in[I_W1] + (size_t)((it_) / 384) * 1024 * 256 : ((it_) % 384) < 256 ? F.a->in[I_W3] + (size_t)((it_) / 384) * 1024 * 256 : F.a->in[I_W2] + (size_t)((it_) / 384) * 256 * 1024)
#define XW_STORE(v_, it_, scr_) do { const int e_ = (it_) / 384, r_ = (it_) % 384; \
          if (r_ < 128) tr_store(v_, 256, W13T, 1024, 0, RmW13{e_ * 512}, scr_, r_, F.lane); \
          else if (r_ < 256) tr_store(v_, 256, W13T, 1024, 0, RmW13{e_ * 512 + 128}, scr_, r_ - 128, F.lane); \
          else tr_store(v_, 1024, W2T, 256, 0, RmAdd{e_ * 1024}, scr_, r_ - 256, F.lane); } while (0)
      const int stride = F.G * 4;
      for (int it = F.blk * 4 + (F.wid - 4); it < NE * 384; it += 2 * stride) { const int it2 = it + stride; const bool two = it2 < NE * 384;
          float va[32], vb[32];
          { const int r = it % 384; tr_load(XW_SRC(it), r < 256 ? 256 : 1024, r < 128 ? r : r < 256 ? r - 128 : r - 256, F.lane, va); }
          if (two) { const int r = it2 % 384; tr_load(XW_SRC(it2), r < 256 ? 256 : 1024, r < 128 ? r : r < 256 ? r - 128 : r - 256, F.lane, vb); }
          XW_STORE(va, it, scr);
          if (two) XW_STORE(vb, it2, scr + 64 * 33); }
#undef XW_SRC
#undef XW_STORE
    }
}
__device__ __forceinline__ void moe_offsets(Frame& F, LAS int* offs) {
    __syncthreads();
    if (F.tid < 64) { const int c = F.tid < NE ? (int)__hip_atomic_load(F.ctl + CW_CNT + F.tid * CW_CNT_STRIDE, __ATOMIC_RELAXED, __HIP_MEMORY_SCOPE_AGENT) : 0; const int p = (c + 255) & ~255; int incl = p;
#pragma unroll
        for (int o = 1; o < 32; o <<= 1) { const int v = __shfl_up(incl, o); if ((F.tid & 63) >= o) incl += v; }
        if (F.tid < NE) { offs[F.tid] = incl - p; offs[40 + F.tid] = c; for (int t = (incl - p) >> 8; t < (incl >> 8); ++t) offs[80 + t] = F.tid; } if (F.tid == NE - 1) offs[NE] = incl; }
    __syncthreads();
}
__device__ __forceinline__ int expert_of_row(LAS int* offs, int row) { return offs[80 + (row >> 8)]; }
__device__ __forceinline__ void moe_gemm1(Frame& F, LAS int* offs, int G, int c, int lo, int hi) {
    MoeOrder S{offs, 2, G, c, lo, hi};
    pg8::Gemm g{(const bf16_t*)(F.ws + WS_H2), (const bf16_t*)(F.ws + WS_W13T), DM, (const int*)(F.ws + WS_ROUTE + RT_ROWTOK)}; EpiSwiglu E{(const float*)(F.ws + WS_ROUTE + RT_ROWW), (const float*)(F.ws + WS_ROUTE + RT_ROWRR), (bf16_t*)(F.ws + WS_HID)};
    pg8::gemm_phase<EpiSwiglu, MoeOrder, PG8_ALIGN, PG8_SP2, false, true>(F.lds, g, S, E);
}
__device__ __forceinline__ void moe_gemm2(Frame& F, LAS int* offs, int G, int c, int lo, int hi) {
    MoeOrder S{offs, 4, G, c, lo, hi};
    int kde = DE; asm volatile("" : "+s"(kde));
    pg8::Gemm g{(const bf16_t*)(F.ws + WS_HID), (const bf16_t*)(F.ws + WS_W2T), kde, nullptr}; EpiY E{(bf16_t*)(F.ws + WS_YBUF)};
    pg8::gemm_phase<EpiY, MoeOrder, PG8_ALIGN, PG8_SP2, false>(F.lds, g, S, E);
}
__device__ __forceinline__ int moe_vblk(Frame& F) { return (F.G % 8 == 0) ? (F.blk % 8) * (F.G / 8) + F.blk / 8 : F.blk; }
__device__ __forceinline__ void p7_moe_a(Frame& F) {
    LAS int* offs = (LAS int*)(F.lds + 140 * 1024); moe_offsets(F, offs);
    const int n1 = (offs[NE] / 256) * 2;
    moe_gemm1(F, offs, F.G, moe_vblk(F), 0, n1 < F.G ? n1 : F.G);
}
__device__ __forceinline__ void p7_moe_b(Frame& F) {
    LAS int* offs = (LAS int*)(F.lds + 140 * 1024); moe_offsets(F, offs);
    const int T = offs[NE] / 256, n1 = T * 2; int nrem = n1 - F.G; if (nrem < 0) nrem = 0; if (nrem > F.G / 2) nrem = F.G / 2;
    const int t2 = (T < F.G / 2 ? T : F.G / 2) * 4;
    const int vb = moe_vblk(F);
    if (vb < nrem) moe_gemm1(F, offs, nrem, vb, F.G, n1);
    else moe_gemm2(F, offs, F.G - nrem, vb - nrem, 0, t2);
}
__device__ __forceinline__ void p8_moe_c(Frame& F) {
    LAS int* offs = (LAS int*)(F.lds + 140 * 1024); moe_offsets(F, offs);
    const int T = offs[NE] / 256;
    moe_gemm2(F, offs, F.G, moe_vblk(F), (T < F.G / 2 ? T : F.G / 2) * 4, T * 4);
}
__device__ __forceinline__ void p9_combine(Frame& F) {
    LAS int* offs = (LAS int*)(F.lds + 140 * 1024);
    moe_offsets(F, offs);
    const bf16_t* YB = (const bf16_t*)(F.ws + WS_YBUF); const int* tokpos = (const int*)(F.ws + WS_ROUTE + RT_TOKPOS);
    for (int t0 = F.gw * 4; t0 < M; t0 += F.NGW * 4) { int p[4][2];
#pragma unroll
        for (int q = 0; q < 4; ++q) { const int a0 = tokpos[2 * (t0 + q)], a1 = tokpos[2 * (t0 + q) + 1]; p[q][0] = offs[a0 >> ECAP_LOG] + (a0 & (ECAP - 1)); p[q][1] = offs[a1 >> ECAP_LOG] + (a1 & (ECAP - 1)); }
        f32x4 xv[4][4];
#pragma unroll
        for (int q = 0; q < 4; ++q)
#pragma unroll
            for (int j = 0; j < 4; ++j) xv[q][j] = __builtin_nontemporal_load((const f32x4*)(F.out + (size_t)(t0 + q) * DM) + F.lane + 64 * j);
#pragma unroll
        for (int q = 0; q < 4; ++q) {
            f32x4 a[4], b[4];
#pragma unroll
            for (int j = 0; j < 4; ++j) { a[j] = ld4(YB + (size_t)p[q][0] * DM + 4 * F.lane + 256 * j); b[j] = ld4(YB + (size_t)p[q][1] * DM + 4 * F.lane + 256 * j); }
#pragma unroll
            for (int j = 0; j < 4; ++j) __builtin_nontemporal_store(xv[q][j] + (a[j] + b[j]), (f32x4*)(F.out + (size_t)(t0 + q) * DM) + F.lane + 64 * j); } }
}

#define XB_TMO      128
#define XB_XCNT(j)  (256  + 64 * (j))
#define XB_XSUB(j)  (1280 + 64 * (j))
#define XB_XGEN(j)  (2304 + 64 * (j))
#define XB_TOP      3328
#define XB_TOPGEN   3392
#define XCD_BAR_WORDS 3456
#define XB_SPIN_CAP (1u << 22)

__device__ __forceinline__ unsigned xb_ld(unsigned* p)              { return __hip_atomic_load(p, __ATOMIC_RELAXED, __HIP_MEMORY_SCOPE_AGENT); }
__device__ __forceinline__ unsigned xb_add(unsigned* p, unsigned v) { return __hip_atomic_fetch_add(p, v, __ATOMIC_RELAXED, __HIP_MEMORY_SCOPE_AGENT); }
__device__ __forceinline__ unsigned xb_xcc_id() { return (unsigned)__builtin_amdgcn_s_getreg((3 << 11) | 20) & 0xFu; }
#define XB_SPIN(cond, bar) do { unsigned _sp = 0; while (cond) { __builtin_amdgcn_s_sleep(1); \
    if ((++_sp & 255u) == 0u) { if (xb_ld(&(bar)[XB_TMO])) break; if (_sp > XB_SPIN_CAP) { atomicAdd(&(bar)[XB_TMO], 1u); break; } } } } while (0)

struct XcdBarrier {
    unsigned* bar; unsigned x;
    volatile LAS unsigned* st;
};

__device__ __forceinline__ XcdBarrier xcd_barrier_post(unsigned* bar, volatile LAS unsigned* st) {
    XcdBarrier b; b.bar = bar; b.x = xb_xcc_id(); b.st = st;
    if (threadIdx.x == 0) (void)xb_add(&bar[XB_XCNT(b.x)], 1u);
    return b;
}
__device__ __forceinline__ void xcd_barrier_complete(unsigned* bar, unsigned x, unsigned& nloc, unsigned& nx) {
    const unsigned G = gridDim.x * gridDim.y * gridDim.z;
    unsigned sum, cnt, mine, sp = 0u;
    for (;;) {
        sum = 0u; cnt = 0u; mine = 0u;
#pragma unroll
        for (unsigned j = 0; j < 16; ++j) { const unsigned c = xb_ld(&bar[XB_XCNT(j)]); sum += c; cnt += (c > 0u) ? 1u : 0u; mine = (j == x) ? c : mine; }
        if (sum == G) break;
        __builtin_amdgcn_s_sleep(1);
        if ((++sp & 255u) == 0u) { if (xb_ld(&bar[XB_TMO])) break; if (sp > XB_SPIN_CAP) { atomicAdd(&bar[XB_TMO], 1u); break; } }
    }
    nloc = mine > 0u ? mine : 1u; nx = cnt > 0u ? cnt : 1u;
}

__device__ __forceinline__ void xcd_barrier(const XcdBarrier& b) {
    asm volatile("s_waitcnt vmcnt(0)" ::: "memory");
    __syncthreads();
    if (threadIdx.x == 0) {
        unsigned* bar = b.bar;
        __builtin_amdgcn_s_waitcnt(0);
        unsigned nloc = b.st[0], nx = b.st[1];
        if (nloc == 0u) { xcd_barrier_complete(bar, b.x, nloc, nx); b.st[0] = nloc; b.st[1] = nx; }
        const unsigned old = xb_add(&bar[XB_XSUB(b.x)], 1u);
        const unsigned gen = old / nloc;
        if (old + 1u == (gen + 1u) * nloc) {
            __builtin_amdgcn_fence(__ATOMIC_RELEASE, "agent");
            asm volatile("s_waitcnt vmcnt(0)" ::: "memory");
            const unsigned og = xb_add(&bar[XB_TOP], 1u);
            const unsigned tg = og / nx;
            if (og + 1u == (tg + 1u) * nx) xb_add(&bar[XB_TOPGEN], 1u);
            else XB_SPIN(xb_ld(&bar[XB_TOPGEN]) == tg, bar);
            __builtin_amdgcn_fence(__ATOMIC_ACQUIRE, "agent");
            xb_add(&bar[XB_XGEN(b.x)], 1u);
            asm volatile("s_waitcnt vmcnt(0)" ::: "memory");
        } else {
            XB_SPIN(xb_ld(&bar[XB_XGEN(b.x)]) == gen, bar);
            __builtin_amdgcn_fence(__ATOMIC_ACQUIRE, "agent");
            asm volatile("s_waitcnt vmcnt(0)" ::: "memory");
        }
    }
    __syncthreads();
}
constexpr int LDS_BYTES = 147456;
__global__ void __launch_bounds__(NTHREADS, 2) fwd_kernel(Args args) {
    extern __shared__ __attribute__((aligned(16))) unsigned char lds[];
    Frame F;
    F.lds = (LAS unsigned char*)lds; F.ldsg = (char*)lds;
    F.tid = threadIdx.x; F.lane = F.tid & 63; F.wid = __builtin_amdgcn_readfirstlane(F.tid >> 6);
    F.blk = blockIdx.x; F.G = gridDim.x; F.gw = F.blk * NWAVES + F.wid; F.NGW = F.G * NWAVES;
    F.a = &args;
    F.out = args.out; F.ws = args.ws; F.ctl = (unsigned*)(args.ws + WS_CTL);
    const int lo = args.ph_lo, hi = args.ph_hi;
#if MK_ONE_LAUNCH
    cg::grid_group grid = cg::this_grid();
    volatile LAS unsigned* bst = (volatile LAS unsigned*)(F.lds + 144 * 1024 - 16);
    if (F.tid < 2) bst[F.tid] = 0u;
    __syncthreads();
    const XcdBarrier bar = xcd_barrier_post(F.ctl + CW_BAR, bst);
#define SEAM(k) do { if (lo <= (k) && (k) + 1 < hi) { xcd_barrier(bar); } asm volatile("" : "+v"(F.tid), "+v"(F.lane)); } while (0)
    if (hi > NPHASE) grid.sync();
#else
#define SEAM(k) do { } while (0)
#endif
#define IN(k) (lo <= (k) && (k) < hi)
    if (IN(0)) { p0_prologue(F); } SEAM(0);
    if (IN(1)) { p1_proj(F); } SEAM(1);
    if (IN(2)) { p2_mixer_a(F); p2_attention(F); } SEAM(2);
    if (IN(3)) { p3_merged(F); } SEAM(3);
    if (IN(4)) { p4_out(F); } SEAM(4);
    if (IN(5)) { p5_router(F); } SEAM(5);
    if (IN(6)) { p7_moe_a(F); } SEAM(6);
    if (IN(7)) { p7_moe_b(F); } SEAM(7);
    if (IN(8)) { p8_moe_c(F); } SEAM(8);
    if (IN(9)) { p9_combine(F); }
#undef IN
#undef SEAM
}

extern "C" void kernel_launch(void* const* d_in, const int* in_sizes, int n_in, void* d_out, int out_size, void* d_ws, size_t ws_size, hipStream_t stream) {
    static int grid = 0;
    if (grid == 0) {
        if (n_in != 26 || out_size != M * DM || ws_size < WS_END) { fprintf(stderr, "kernel_launch: unexpected shapes (n_in %d out %d ws %zu)\n", n_in, out_size, ws_size); grid = -1; return; }
        int dev = 0, cus = 0, per_cu = 0;
        (void)hipGetDevice(&dev); (void)hipDeviceGetAttribute(&cus, hipDeviceAttributeMultiprocessorCount, dev);
        if (hipFuncSetAttribute((const void*)fwd_kernel, hipFuncAttributeMaxDynamicSharedMemorySize, LDS_BYTES) != hipSuccess) { fprintf(stderr, "kernel_launch: hipFuncSetAttribute failed\n"); grid = -1; return; }
        if (hipOccupancyMaxActiveBlocksPerMultiprocessor(&per_cu, (const void*)fwd_kernel, NTHREADS, LDS_BYTES) != hipSuccess || per_cu < 1) { fprintf(stderr, "kernel_launch: occupancy query says %d\n", per_cu); per_cu = 1; }
        (void)hipGetLastError();
        grid = cus;
    }
    if (grid < 0) return;
    (void)hipMemsetAsync((char*)d_ws + WS_CTL, 0, CTL_ZERO_BYTES, stream);
    Args a{};
    for (int i = 0; i < 26; ++i) a.in[i] = (const float*)d_in[i];
    a.out = (float*)d_out; a.ws = (unsigned char*)d_ws;
#if MK_ONE_LAUNCH
    a.ph_lo = 0; a.ph_hi = NPHASE;
    void* kargs[] = {&a};
    hipError_t e = hipLaunchCooperativeKernel((const void*)fwd_kernel, dim3(grid), dim3(NTHREADS), kargs, LDS_BYTES, stream);
    if (e != hipSuccess) fprintf(stderr, "cooperative launch failed: %s (grid %d)\n", hipGetErrorString(e), grid);
#else
    for (int p = 0; p < NPHASE; ++p) { a.ph_lo = p; a.ph_hi = p + 1; hipLaunchKernelGGL(fwd_kernel, dim3(grid), dim3(NTHREADS), LDS_BYTES, stream, a); }
#endif
}
```

```cpp
#include <hip/hip_runtime.h>
#include <hip/hip_cooperative_groups.h>
#include <cstdio>
#include <cstdint>
namespace cg = cooperative_groups;

#ifndef MK_ONE_LAUNCH
#define MK_ONE_LAUNCH 1
#endif

#define LAS __attribute__((address_space(3)))
typedef unsigned short bf16_t;
typedef short bf16x8 __attribute__((ext_vector_type(8)));
typedef short s16x4 __attribute__((ext_vector_type(4)));
typedef float f32x4 __attribute__((ext_vector_type(4)));
typedef float f32x16 __attribute__((ext_vector_type(16)));
typedef float f32x2 __attribute__((ext_vector_type(2)));
typedef unsigned u32x4 __attribute__((ext_vector_type(4)));
typedef unsigned u32x2 __attribute__((ext_vector_type(2)));
typedef __bf16 bf16x2_t __attribute__((ext_vector_type(2)));

constexpr int NB = 2, SEQ = 8192, DM = 1024, M = NB * SEQ;
constexpr int NH = 8;
constexpr int N1 = 7168;
constexpr int NE = 32, DE = 256;
constexpr float EPS = 1e-6f;
constexpr float LOG2E = 1.4426950408889634f;
constexpr float C2 = 0.125f * LOG2E;
constexpr float LAM_INIT = 0.2f;
constexpr int NWAVES = 8, NTHREADS = 512;
constexpr int NPHASE = 10;
constexpr int ECAP = 16384, ECAP_LOG = 14;

constexpr size_t MiB = 1u << 20;
constexpr size_t WS_CTL = 0;
constexpr size_t CTL_ZERO_BYTES = 65536;
constexpr size_t WS_W1T = 1 * MiB;
constexpr size_t WS_WUPT = 15 * MiB;
constexpr size_t WS_WOUTT = 19 * MiB;
constexpr size_t WS_WST = 21 * MiB;
constexpr size_t WS_ROUTE = 22 * MiB;
constexpr size_t WS_XN = 32 * MiB;
constexpr size_t WS_U = 64 * MiB;
constexpr size_t WS_VA = 96 * MiB;
constexpr size_t WS_Q = 128 * MiB;
constexpr size_t WS_K = 160 * MiB;
constexpr size_t WS_VB = 192 * MiB;
constexpr size_t WS_W13T = 160 * MiB;
constexpr size_t WS_W2T = 192 * MiB;
constexpr size_t WS_HID = 208 * MiB;
constexpr size_t WS_H2 = 32 * MiB;
constexpr size_t WS_YBUF = 64 * MiB;
constexpr size_t WS_YA = 224 * MiB;
constexpr size_t WS_T = 64 * MiB;
constexpr size_t WS_END = 256 * MiB;
constexpr size_t RT_TOKE = 0, RT_TOKW = 256 * 1024, RT_TOKPOS = 512 * 1024, RT_WRT = 1024 * 1024, RT_ALIST = 1536 * 1024, RT_ROWTOK = 2048 * 1024, RT_ROWW = 4096 * 1024, RT_ROWRR = 6144 * 1024;
constexpr int CW_CNT = 8192, CW_CNT_STRIDE = 64, CW_AQ = 512, CW_BAR = 1024;

#define LDS_WAIT() asm volatile("s_waitcnt lgkmcnt(0)" ::: "memory")
#define SBAR() __builtin_amdgcn_sched_barrier(0)
__device__ __forceinline__ unsigned cvtpk(float lo, float hi) { f32x2 v = {lo, hi}; bf16x2_t b = __builtin_convertvector(v, bf16x2_t); return __builtin_bit_cast(unsigned, b); }
__device__ __forceinline__ float bf2f(short b) { return __uint_as_float(((unsigned)(unsigned short)b) << 16); }
__device__ __forceinline__ float wave_sum(float v) {
#pragma unroll
    for (int o = 1; o < 64; o <<= 1) v += __shfl_xor(v, o);
    return v;
}
__device__ __forceinline__ void st4(bf16_t* p, f32x4 v) { u32x2 w; w.x = cvtpk(v[0], v[1]); w.y = cvtpk(v[2], v[3]); *(u32x2*)p = w; }
__device__ __forceinline__ f32x4 ld4(const bf16_t* p) { const u32x2 w = *(const u32x2*)p; f32x4 r; r[0] = __uint_as_float(w.x << 16); r[1] = __uint_as_float(w.x & 0xffff0000u); r[2] = __uint_as_float(w.y << 16); r[3] = __uint_as_float(w.y & 0xffff0000u); return r; }

struct Args { const float* in[26]; float* out; unsigned char* ws; int ph_lo, ph_hi; };

struct Frame {
    LAS unsigned char* lds; char* ldsg;
    int tid, lane, wid, blk, G, gw, NGW;
    const Args* a; float* out; unsigned char* ws; unsigned* ctl;
};
enum { I_X = 0, I_N1G, I_WIN, I_VNG, I_WS, I_BS, I_QNG, I_KNG, I_LQ1, I_LK1, I_LQ2, I_LK2, I_SUBG, I_WUPA, I_WUPB, I_WGATE, I_BGATE, I_WOUT, I_N2G, I_WRG, I_BRG, I_WRE, I_BRE, I_W1, I_W3, I_W2 };

__device__ __forceinline__ void wave_gemm(f32x4 (&acc)[2][4], const bf16_t* ap0, const bf16_t* ap1, const bf16_t* bp0, const bf16_t* bp1, const bf16_t* bp2, const bf16_t* bp3, int K) {
#pragma unroll 2
    for (int k0 = 0; k0 < K; k0 += 32) {
        const bf16x8 a0 = *(const bf16x8*)(ap0 + k0), a1 = *(const bf16x8*)(ap1 + k0);
        const bf16x8 b0 = *(const bf16x8*)(bp0 + k0), b1 = *(const bf16x8*)(bp1 + k0), b2 = *(const bf16x8*)(bp2 + k0), b3 = *(const bf16x8*)(bp3 + k0);
        acc[0][0] = __builtin_amdgcn_mfma_f32_16x16x32_bf16(b0, a0, acc[0][0], 0, 0, 0);
        acc[0][1] = __builtin_amdgcn_mfma_f32_16x16x32_bf16(b1, a0, acc[0][1], 0, 0, 0);
        acc[0][2] = __builtin_amdgcn_mfma_f32_16x16x32_bf16(b2, a0, acc[0][2], 0, 0, 0);
        acc[0][3] = __builtin_amdgcn_mfma_f32_16x16x32_bf16(b3, a0, acc[0][3], 0, 0, 0);
        acc[1][0] = __builtin_amdgcn_mfma_f32_16x16x32_bf16(b0, a1, acc[1][0], 0, 0, 0);
        acc[1][1] = __builtin_amdgcn_mfma_f32_16x16x32_bf16(b1, a1, acc[1][1], 0, 0, 0);
        acc[1][2] = __builtin_amdgcn_mfma_f32_16x16x32_bf16(b2, a1, acc[1][2], 0, 0, 0);
        acc[1][3] = __builtin_amdgcn_mfma_f32_16x16x32_bf16(b3, a1, acc[1][3], 0, 0, 0);
    }
}
__device__ __forceinline__ void acc_zero(f32x4 (&acc)[2][4]) {
#pragma unroll
    for (int m = 0; m < 2; ++m)
#pragma unroll
        for (int n = 0; n < 4; ++n) acc[m][n] = (f32x4){0.f, 0.f, 0.f, 0.f};
}

namespace pg8 {
#define PG8_LAS __attribute__((address_space(3)))
constexpr int BM = 256, BK = 64, HALF = 128, HTB = HALF * BK * 2  , STAGE_BYTES = 8 * HTB, NXCD = 8, WGM = 4;

__host__ __device__ __forceinline__ int lds_byte(int r, int c) { const int st = (r >> 4) * 2 + (c >> 5), rr = r & 15, cc = c & 31, ob = rr * 64 + cc * 2; return st * 1024 + (ob ^ (((ob >> 9) & 1) << 5)); }
__host__ __device__ __forceinline__ void stage_rc(int b, int& R, int& C) { const int st = b / 1024, sb = b % 1024, swz = sb ^ (((sb >> 9) & 1) << 5); R = (st >> 1) * 16 + swz / 64; C = (st & 1) * 32 + (swz % 64) / 2; }
__host__ __device__ __forceinline__ int perm32(int rho) { const int n = rho >> 4, i = rho & 15; return 8 * (i >> 2) + 4 * n + (i & 3); }

struct Unit { int pm, pn, pb, rbase, nvalid; };
struct Gemm { const bf16_t* A; const bf16_t* Bt; int K; const int* rowtok; };

struct StaticOrder {
    int nM, nN, nwg, G, c;
    __host__ __device__ void init(int M, int N, int G_, int c_) { nM = M / BM; nN = N / BM; nwg = nM * nN; G = G_; c = c_; }
    __host__ __device__ bool next(int i, Unit& u) const {
        const long L = (long)i * G + c; if (L >= nwg) return false;
        int wgid = (int)L; { const int q = nwg / NXCD, r = nwg % NXCD, xcd = wgid % NXCD, off = wgid / NXCD; wgid = (xcd < r ? xcd * (q + 1) : r * (q + 1) + (xcd - r) * q) + off; }
        const int nig = WGM * nN, gid = wgid / nig, fm = gid * WGM, gsz = (nM - fm) < WGM ? (nM - fm) : WGM;
        u.pm = fm + ((wgid % nig) % gsz); u.pn = (wgid % nig) / gsz; u.pb = u.pn; u.rbase = 0; u.nvalid = 0; return true;
    }
    __device__ __forceinline__ void a_ready(const Unit&) const {}
    __device__ __forceinline__ void done(const Unit&) const {}
};
template <class Epi, class Sched, bool ALIGN_EPI = false, bool SP2 = false, bool BP64 = false, bool GATHER = false>
__device__ __forceinline__ void gemm_phase(PG8_LAS unsigned char* lds, const Gemm g, const Sched& S, const Epi& E) {
    const int tid = threadIdx.x, wid = __builtin_amdgcn_readfirstlane(tid >> 6), lane = tid & 63, wr = wid >> 2, wc = wid & 3, fr = lane & 15, fq = lane >> 4;
    const int K = g.K, nt = K / BK;
    unsigned voffA[2], voffB[2];
#pragma unroll
    for (int i = 0; i < 2; ++i) { int R, C; stage_rc(tid * 16 + i * 8192, R, C); const int Rp = Epi::PERM ? ((R & ~31) + perm32(R & 31)) : R; const int Rb = BP64 ? (64 * (Rp >> 5) + (Rp & 31)) : Rp;
        voffA[i] = (unsigned)(R * K + C) * 2u; voffB[i] = (unsigned)(Rb * K + C) * 2u; }
    const size_t kstep = (size_t)(BK * 2);
    const size_t hstep = (size_t)HALF * K * 2;
    const size_t tstep = 2 * hstep;
    const size_t bhs = BP64 ? (size_t)32 * K * 2 : hstep;
    const unsigned ldsw = (unsigned)wid * 1024u;
    const int aoff = lds_byte(wr * 64 + fr, fq * 8), boff = lds_byte(wc * 32 + fr, fq * 8);
#define PG8_SA(b, h) (((b) * 2 + (h)) * HTB)
#define PG8_SB(b, h) ((4 + (b) * 2 + (h)) * HTB)
#define PG8_STAGE(bufoff, gbase, voff) do { _Pragma("unroll") for (int _i = 0; _i < 2; ++_i) \
        __builtin_amdgcn_global_load_lds((const unsigned*)((const char*)(gbase) + (voff)[_i]), (PG8_LAS unsigned*)(lds + (bufoff) + ldsw + _i * 8192), 16, 0, 0); } while (0)
#define PG8_LDA(dst, b, h) do { _Pragma("unroll") for (int m = 0; m < 4; ++m) _Pragma("unroll") for (int k = 0; k < 2; ++k) dst[m][k] = *(const PG8_LAS bf16x8*)(lds + PG8_SA(b, h) + aoff + m * 2048 + k * 1024); } while (0)
#define PG8_LDB(dst, b, h) do { _Pragma("unroll") for (int n = 0; n < 2; ++n) _Pragma("unroll") for (int k = 0; k < 2; ++k) dst[n][k] = *(const PG8_LAS bf16x8*)(lds + PG8_SB(b, h) + boff + n * 2048 + k * 1024); } while (0)
#define PG8_MMA(ai, bj, At, Bt) do { __builtin_amdgcn_s_setprio(1); _Pragma("unroll") for (int m = 0; m < 4; ++m) _Pragma("unroll") for (int n = 0; n < 2; ++n) _Pragma("unroll") for (int k = 0; k < 2; ++k) \
        acc[ai][bj][m][n] = __builtin_amdgcn_mfma_f32_16x16x32_bf16(Bt[n][k], At[m][k], acc[ai][bj][m][n], 0, 0, 0); __builtin_amdgcn_s_setprio(0); } while (0)
#define PG8_WAIT_V(n) asm volatile("s_waitcnt vmcnt(" #n ")" ::: "memory")
#define PG8_WAIT_L(n) asm volatile("s_waitcnt lgkmcnt(" #n ")" ::: "memory")
#define PG8_BAR __builtin_amdgcn_s_barrier()
#define PG8_SCHED __builtin_amdgcn_sched_barrier(0)
    Unit cur, nxt; int ui = 0;
    if (!S.next(0, cur)) return;
    static_assert(!GATHER || SP2, "GATHER is written for the SP2 loop");
    unsigned vA0[2] = {0u, 0u}, vA1[2] = {0u, 0u}, nvA0[2] = {0u, 0u}, nvA1[2] = {0u, 0u};
#define PG8_GLOAD(u_, d0_, d1_) do { _Pragma("unroll") for (int _i = 0; _i < 2; ++_i) { int R_, C_; stage_rc(tid * 16 + _i * 8192, R_, C_); \
        const int t0_ = R_ < (u_).nvalid ? g.rowtok[(u_).rbase + R_] : 0, t1_ = HALF + R_ < (u_).nvalid ? g.rowtok[(u_).rbase + HALF + R_] : 0; d0_[_i] = (unsigned)(t0_ * K + C_) * 2u; d1_[_i] = (unsigned)(t1_ * K + C_) * 2u; } } while (0)
#define PG8_STAGE_A(bufoff, ptr, half, vcur0, vcur1) do { if constexpr (GATHER) { PG8_STAGE(bufoff, ptr, (half) ? vcur1 : vcur0); } else { PG8_STAGE(bufoff, (ptr) + ((half) ? hstep : (size_t)0), voffA); } } while (0)
    if constexpr (GATHER) PG8_GLOAD(cur, vA0, vA1);
    f32x4 acc[2][2][4][2];
#pragma unroll
    for (int a = 0; a < 2; ++a)
#pragma unroll
        for (int b = 0; b < 2; ++b)
#pragma unroll
            for (int m = 0; m < 4; ++m)
#pragma unroll
                for (int n = 0; n < 2; ++n) acc[a][b][m][n] = (f32x4){0.f, 0.f, 0.f, 0.f};
    bf16x8 At[4][2], B0[2][2], B1[2][2];
    const char* cA = (const char*)g.A + (GATHER ? (size_t)0 : (size_t)cur.pm * tstep); const char* cB = (const char*)g.Bt + (size_t)cur.pb * tstep;
    S.a_ready(cur);
    if constexpr (SP2) {
        PG8_STAGE(PG8_SB(0, 0), cB, voffB); PG8_STAGE(PG8_SB(0, 1), cB + bhs, voffB); PG8_STAGE_A(PG8_SA(0, 0), cA, 0, vA0, vA1); PG8_STAGE_A(PG8_SA(0, 1), cA, 1, vA0, vA1);
        if (wr == 1) PG8_BAR;
        PG8_WAIT_V(2); PG8_BAR;
        PG8_STAGE(PG8_SB(1, 0), cB + kstep, voffB); PG8_STAGE_A(PG8_SA(1, 0), cA + kstep, 0, vA0, vA1); PG8_STAGE(PG8_SB(1, 1), cB + bhs + kstep, voffB);
        PG8_WAIT_V(6); PG8_BAR;
    } else {
        PG8_STAGE(PG8_SB(0, 0), cB, voffB); PG8_STAGE(PG8_SA(0, 0), cA, voffA); PG8_STAGE(PG8_SB(0, 1), cB + bhs, voffB); PG8_STAGE(PG8_SA(0, 1), cA + hstep, voffA);
        if (wr == 1) PG8_BAR;
        PG8_WAIT_V(4); PG8_BAR;
        PG8_STAGE(PG8_SB(1, 0), cB + kstep, voffB); PG8_STAGE(PG8_SA(1, 0), cA + kstep, voffA); PG8_STAGE(PG8_SB(1, 1), cB + bhs + kstep, voffB);
        PG8_WAIT_V(6); PG8_BAR;
    }
    for (;;) {
        const bool has_next = S.next(ui + 1, nxt);
        const char* nA = (has_next && !GATHER) ? (const char*)g.A + (size_t)nxt.pm * tstep : cA; const char* nB = has_next ? (const char*)g.Bt + (size_t)nxt.pb * tstep : cB;
        if constexpr (GATHER) { if (has_next) { PG8_GLOAD(nxt, nvA0, nvA1); } else { nvA0[0] = vA0[0]; nvA0[1] = vA0[1]; nvA1[0] = vA1[0]; nvA1[1] = vA1[1]; } }
        for (int t = 0; t < nt; t += 2) {
            const bool last = (t == nt - 2);
            const char* a1 = cA + (size_t)(t + 1) * kstep;
            const char* a2 = last ? nA : cA + (size_t)(t + 2) * kstep; const char* b2 = last ? nB : cB + (size_t)(t + 2) * kstep;
            const char* a3 = a2 + kstep; const char* b3 = b2 + kstep;
            if (last && has_next) S.a_ready(nxt);
            unsigned xA0[2], xA1[2];
            if constexpr (GATHER) { xA0[0] = last ? nvA0[0] : vA0[0]; xA0[1] = last ? nvA0[1] : vA0[1]; xA1[0] = last ? nvA1[0] : vA1[0]; xA1[1] = last ? nvA1[1] : vA1[1]; }
            if constexpr (SP2) {
            PG8_LDB(B0, 0, 0); PG8_LDB(B1, 0, 1); PG8_SCHED; PG8_LDA(At, 0, 0); PG8_STAGE_A(PG8_SA(1, 1), a1, 1, vA0, vA1);
            PG8_WAIT_V(8); PG8_WAIT_L(0); PG8_BAR; PG8_MMA(0, 0, At, B0); PG8_MMA(0, 1, At, B1); PG8_BAR; PG8_SCHED;
            PG8_LDA(At, 0, 1); PG8_STAGE(PG8_SB(0, 0), b2, voffB); PG8_STAGE(PG8_SB(0, 1), b2 + bhs, voffB); PG8_STAGE_A(PG8_SA(0, 0), a2, 0, xA0, xA1);
            PG8_WAIT_V(8); PG8_WAIT_L(0); PG8_BAR; PG8_MMA(1, 0, At, B0); PG8_MMA(1, 1, At, B1); PG8_BAR; PG8_SCHED;
            PG8_LDB(B0, 1, 0); PG8_LDB(B1, 1, 1); PG8_SCHED; PG8_LDA(At, 1, 0); PG8_STAGE_A(PG8_SA(0, 1), a2, 1, xA0, xA1);
            PG8_WAIT_V(8); PG8_WAIT_L(0); PG8_BAR; PG8_MMA(0, 0, At, B0); PG8_MMA(0, 1, At, B1); PG8_BAR; PG8_SCHED;
            PG8_LDA(At, 1, 1); PG8_STAGE(PG8_SB(1, 0), b3, voffB); PG8_STAGE(PG8_SB(1, 1), b3 + bhs, voffB); PG8_STAGE_A(PG8_SA(1, 0), a3, 0, xA0, xA1);
            PG8_WAIT_V(8); PG8_WAIT_L(0); PG8_BAR; PG8_MMA(1, 0, At, B0); PG8_MMA(1, 1, At, B1); PG8_BAR; PG8_SCHED;
            } else {
            PG8_LDB(B0, 0, 0); PG8_SCHED; PG8_LDA(At, 0, 0); PG8_STAGE(PG8_SA(1, 1), a1 + hstep, voffA);
            PG8_WAIT_L(8); PG8_BAR; PG8_WAIT_L(0); PG8_MMA(0, 0, At, B0); PG8_BAR; PG8_SCHED;
            PG8_LDB(B1, 0, 1); PG8_STAGE(PG8_SB(0, 0), b2, voffB);
            PG8_BAR; PG8_WAIT_L(0); PG8_MMA(0, 1, At, B1); PG8_BAR;
            PG8_LDA(At, 0, 1); PG8_STAGE(PG8_SA(0, 0), a2, voffA);
            PG8_BAR; PG8_WAIT_L(0); PG8_MMA(1, 0, At, B0); PG8_BAR; PG8_SCHED;
            PG8_STAGE(PG8_SB(0, 1), b2 + bhs, voffB);
            PG8_WAIT_V(6); PG8_BAR; PG8_MMA(1, 1, At, B1); PG8_BAR;
            PG8_LDB(B0, 1, 0); PG8_SCHED; PG8_LDA(At, 1, 0); PG8_STAGE(PG8_SA(0, 1), a2 + hstep, voffA);
            PG8_WAIT_L(8); PG8_BAR; PG8_WAIT_L(0); PG8_MMA(0, 0, At, B0); PG8_BAR; PG8_SCHED;
            PG8_LDB(B1, 1, 1); PG8_STAGE(PG8_SB(1, 0), b3, voffB);
            PG8_BAR; PG8_WAIT_L(0); PG8_MMA(0, 1, At, B1); PG8_BAR;
            PG8_LDA(At, 1, 1); PG8_STAGE(PG8_SA(1, 0), a3, voffA);
            PG8_BAR; PG8_WAIT_L(0); PG8_MMA(1, 0, At, B0); PG8_BAR; PG8_SCHED;
            PG8_STAGE(PG8_SB(1, 1), b3 + bhs, voffB);
            PG8_WAIT_V(6); PG8_BAR; PG8_MMA(1, 1, At, B1); PG8_BAR;
            }
        }
        if constexpr (ALIGN_EPI) { if (wr == 0) PG8_BAR; }
        if constexpr (!Epi::AFTER_DRAIN) { E(acc, cur, wr, wc, fr, fq); S.done(cur); }
        if (!has_next) break;
#pragma unroll
        for (int a = 0; a < 2; ++a)
#pragma unroll
            for (int b = 0; b < 2; ++b)
#pragma unroll
                for (int m = 0; m < 4; ++m)
#pragma unroll
                    for (int n = 0; n < 2; ++n) acc[a][b][m][n] = (f32x4){0.f, 0.f, 0.f, 0.f};
        cur = nxt; cA = nA; cB = nB; ++ui;
        if constexpr (GATHER) { vA0[0] = nvA0[0]; vA0[1] = nvA0[1]; vA1[0] = nvA1[0]; vA1[1] = nvA1[1]; }
        if constexpr (ALIGN_EPI) { if (wr == 1) PG8_BAR; }
    }
    PG8_WAIT_V(0);
    if constexpr (!ALIGN_EPI) { if (wr == 0) PG8_BAR; }
    PG8_BAR;
    if constexpr (Epi::AFTER_DRAIN) { E.fused(acc, cur, wr, wc, fr, fq, lds, wid, lane); S.done(cur); }
#undef PG8_GLOAD
#undef PG8_STAGE_A
#undef PG8_SA
#undef PG8_SB
#undef PG8_STAGE
#undef PG8_LDA
#undef PG8_LDB
#undef PG8_MMA
#undef PG8_WAIT_V
#undef PG8_WAIT_L
#undef PG8_BAR
#undef PG8_SCHED
}
}

#define PG8_SP2 true
#define PG8_ALIGN true
__device__ __forceinline__ void st8nt(bf16_t* p, f32x4 a, f32x4 b) { u32x4 w; w.x = cvtpk(a[0], a[1]); w.y = cvtpk(a[2], a[3]); w.z = cvtpk(b[0], b[1]); w.w = cvtpk(b[2], b[3]); __builtin_nontemporal_store(w, (u32x4*)p); }
__device__ __forceinline__ void st8(bf16_t* p, f32x4 a, f32x4 b) { u32x4 w; w.x = cvtpk(a[0], a[1]); w.y = cvtpk(a[2], a[3]); w.z = cvtpk(b[0], b[1]); w.w = cvtpk(b[2], b[3]); *(u32x4*)p = w; }
__device__ __forceinline__ void ld8(const bf16_t* p, f32x4& a, f32x4& b) { const u32x4 w = *(const u32x4*)p;
    a[0] = __uint_as_float(w.x << 16); a[1] = __uint_as_float(w.x & 0xffff0000u); a[2] = __uint_as_float(w.y << 16); a[3] = __uint_as_float(w.y & 0xffff0000u);
    b[0] = __uint_as_float(w.z << 16); b[1] = __uint_as_float(w.z & 0xffff0000u); b[2] = __uint_as_float(w.w << 16); b[3] = __uint_as_float(w.w & 0xffff0000u); }
struct EpiProj {
    static constexpr bool PERM = true, AFTER_DRAIN = false;
    unsigned char* ws; bf16_t* GATE; const float *qg, *kg, *bgate;
    __device__ __forceinline__ void operator()(const f32x4 (&acc)[2][2][4][2], const pg8::Unit& u, int wr, int wc, int fr, int fq) const {
        asm volatile("" : "+v"(fr), "+v"(fq));
        const int seg = u.pn >> 2;
        const int row0 = u.pm * 256 + wr * 64 + fr;
        const int cw = (u.pn & 3) * 256 + wc * 64 + 8 * fq;
        if (seg <= 1 || seg == 4) { bf16_t* dst = (bf16_t*)(ws + WS_U + (size_t)seg * (32 * MiB)) + cw;
#pragma unroll
            for (int ai = 0; ai < 2; ++ai)
#pragma unroll
                for (int m = 0; m < 4; ++m) { bf16_t* rp = dst + (size_t)(row0 + ai * 128 + m * 16) * DM;
#pragma unroll
                    for (int bj = 0; bj < 2; ++bj) st8nt(rp + 32 * bj, acc[ai][bj][m][0], acc[ai][bj][m][1]); }
        } else if (seg == 2 || seg == 3) { const float* g = (seg == 2 ? qg : kg) + 8 * fq; bf16_t* dst = (bf16_t*)(ws + WS_U + (size_t)seg * (32 * MiB)) + cw; const float sc = seg == 2 ? C2 : 1.f;
            f32x4 gv[2][2];
#pragma unroll
            for (int bj = 0; bj < 2; ++bj)
#pragma unroll
                for (int n = 0; n < 2; ++n) gv[bj][n] = *(const f32x4*)(g + 32 * bj + 4 * n) * sc;
#pragma unroll
            for (int ai = 0; ai < 2; ++ai)
#pragma unroll
                for (int m = 0; m < 4; ++m) { float ss = 0.f;
#pragma unroll
                    for (int bj = 0; bj < 2; ++bj)
#pragma unroll
                        for (int n = 0; n < 2; ++n) { const f32x4 a = acc[ai][bj][m][n]; ss += (a[0] * a[0] + a[1] * a[1]) + (a[2] * a[2] + a[3] * a[3]); }
                    ss += __shfl_xor(ss, 16); ss += __shfl_xor(ss, 32);
                    const float r = rsqrtf(ss * (1.f / 64.f) + EPS); bf16_t* rp = dst + (size_t)(row0 + ai * 128 + m * 16) * DM;
#pragma unroll
                    for (int bj = 0; bj < 2; ++bj) st8nt(rp + 32 * bj, (acc[ai][bj][m][0] * r) * gv[bj][0], (acc[ai][bj][m][1] * r) * gv[bj][1]); }
        } else { const int c = (u.pn - 20) * 256 + wc * 64 + 8 * fq; const float* bg = bgate + c;
#pragma unroll
            for (int bj = 0; bj < 2; ++bj) { const f32x4 b0 = *(const f32x4*)(bg + 32 * bj), b1 = *(const f32x4*)(bg + 32 * bj + 4);
#pragma unroll
                for (int ai = 0; ai < 2; ++ai)
#pragma unroll
                    for (int m = 0; m < 4; ++m) { f32x4 v0 = acc[ai][bj][m][0] + b0, v1 = acc[ai][bj][m][1] + b1;
#pragma unroll
                        for (int j = 0; j < 4; ++j) { v0[j] = __builtin_amdgcn_rcpf(1.f + __builtin_amdgcn_exp2f(-LOG2E * v0[j])); v1[j] = __builtin_amdgcn_rcpf(1.f + __builtin_amdgcn_exp2f(-LOG2E * v1[j])); }
                        st8nt(GATE + (size_t)(row0 + ai * 128 + m * 16) * 2048 + c + 32 * bj, v0, v1); } }
        }
    }
};

#define EPI_LOOP(...) _Pragma("unroll") for (int ai = 0; ai < 2; ++ai) _Pragma("unroll") for (int m = 0; m < 4; ++m) { const size_t row = (size_t)(u.pm * 256 + wr * 64 + fr + ai * 128 + m * 16); \
        _Pragma("unroll") for (int bj = 0; bj < 2; ++bj) { const int col = u.pn * 256 + bj * 128 + wc * 32 + 8 * fq; const f32x4 a0 = acc[ai][bj][m][0], a1 = acc[ai][bj][m][1]; __VA_ARGS__ } if (m & 1) asm volatile("" ::: "memory"); }
struct EpiGateT {
    static constexpr bool PERM = true, AFTER_DRAIN = false;
    const bf16_t* GATE; bf16_t* T;
    __device__ __forceinline__ void operator()(const f32x4 (&acc)[2][2][4][2], const pg8::Unit& u, int wr, int wc, int fr, int fq) const {
        asm volatile("" : "+v"(fr), "+v"(fq));
        EPI_LOOP( f32x4 g0, g1; ld8(GATE + row * 2048 + col, g0, g1); st8(T + row * DM + col, g0 * a0, g1 * a1); )
    }
};
struct EpiMerged {
    static constexpr bool PERM = true, AFTER_DRAIN = false;
    const bf16_t* GATE; const bf16_t* T; bf16_t* MG;
    __device__ __forceinline__ void operator()(const f32x4 (&acc)[2][2][4][2], const pg8::Unit& u, int wr, int wc, int fr, int fq) const {
        asm volatile("" : "+v"(fr), "+v"(fq));
        EPI_LOOP( f32x4 g0, g1, t0, t1; ld8(GATE + row * 2048 + 1024 + col, g0, g1); ld8(T + row * DM + col, t0, t1); st8(MG + row * DM + col, t0 + g0 * a0, t1 + g1 * a1); )
    }
};
struct EpiOut {
    static constexpr bool PERM = true, AFTER_DRAIN = false;
    const float* x; float* out; const float* g2; bf16_t* H2;
    __device__ __forceinline__ void operator()(const f32x4 (&acc)[2][2][4][2], const pg8::Unit& u, int wr, int wc, int fr, int fq) const {
        asm volatile("" : "+v"(fr), "+v"(fq));
        EPI_LOOP( const float* xp = x + row * DM + col; float* op = out + row * DM + col; const f32x4 x0 = __builtin_nontemporal_load((const f32x4*)xp) + a0, x1 = __builtin_nontemporal_load((const f32x4*)(xp + 4)) + a1; *(f32x4*)op = x0; *(f32x4*)(op + 4) = x1;
                  st8(H2 + row * DM + col, x0 * *(const f32x4*)(g2 + col), x1 * *(const f32x4*)(g2 + col + 4)); )
    }
};
struct EpiY {
    static constexpr bool PERM = true, AFTER_DRAIN = false;
    bf16_t* Y;
    __device__ __forceinline__ void operator()(const f32x4 (&acc)[2][2][4][2], const pg8::Unit& u, int wr, int wc, int fr, int fq) const {
        asm volatile("" : "+v"(fr), "+v"(fq));
        EPI_LOOP( st8(Y + row * DM + col, a0, a1); )
    }
};
struct EpiSwiglu {
    static constexpr bool PERM = true, AFTER_DRAIN = false;
    const float* roww; const float* rowrr; bf16_t* HID;
    __device__ __forceinline__ void operator()(const f32x4 (&acc)[2][2][4][2], const pg8::Unit& u, int wr, int wc, int fr, int fq) const {
        asm volatile("" : "+v"(fr), "+v"(fq));
#pragma unroll
        for (int ai = 0; ai < 2; ++ai)
#pragma unroll
            for (int m = 0; m < 4; ++m) { const int rl = wr * 64 + fr + ai * 128 + m * 16; const size_t row = (size_t)(u.pm * 256 + rl); const float w = rl < u.nvalid ? roww[u.rbase + rl] : 0.f, rr = rl < u.nvalid ? rowrr[u.rbase + rl] : 0.f;
                f32x4 hv[2];
#pragma unroll
                for (int n = 0; n < 2; ++n) { const f32x4 a1 = acc[ai][0][m][n] * rr, a3 = acc[ai][1][m][n] * rr;
#pragma unroll
                    for (int j = 0; j < 4; ++j) hv[n][j] = ((a1[j] * __builtin_amdgcn_rcpf(1.f + __builtin_amdgcn_exp2f(-LOG2E * a1[j]))) * a3[j]) * w; }
                st8(HID + row * DE + u.pn * 128 + wc * 32 + 8 * fq, hv[0], hv[1]); }
    }
};
__device__ __forceinline__ int expert_of_row(LAS int* offs, int row);
struct MoeOrder {
    LAS int* offs; int npn, G, c, lo, hi;
    __device__ __forceinline__ bool next(int i, pg8::Unit& u) const { const int L = lo + i * G + c; if (L >= hi || c < 0) return false;
        const int tile = L / npn, pn = L - tile * npn, e = expert_of_row(offs, tile * 256), lr0 = tile * 256 - offs[e], nv = offs[40 + e] - lr0;
        u.pm = tile; u.pn = pn; u.pb = e * npn + pn; u.rbase = e * ECAP + lr0; u.nvalid = nv < 256 ? nv : 256; return true; }
    __device__ __forceinline__ void a_ready(const pg8::Unit&) const {}
    __device__ __forceinline__ void done(const pg8::Unit&) const {}
};

__device__ __forceinline__ float attn_dmin_unit(const float* qg, const float* kg) {
    const int ln = threadIdx.x & 63; float a = fabsf(qg[ln]), b = fabsf(kg[ln]);
#pragma unroll
    for (int o = 1; o < 64; o <<= 1) { a = fmaxf(a, __shfl_xor(a, o)); b = fmaxf(b, __shfl_xor(b, o)); }
    return 2.02f * (8.f * a * b) + 106.f;
}
__device__ __forceinline__ int attn_jlo(float dmin1, int h, int qb) {
    const float dmin = dmin1 * exp2f((float)(h + 1)); const float lowk = (float)(qb * 128) - dmin;
    return lowk > 0.f ? ((int)lowk) >> 6 : 0;
}
__device__ __forceinline__ void tr_load(const float* W, int N, int item, int lane, float (&v)[32]) {
    const int nblk = N / 32, kb = item / nblk, nb = item % nblk, k0 = 64 * kb, n0 = 32 * nb;
    const float* wp = W + (size_t)(k0 + (lane >> 5)) * N + n0 + (lane & 31);
#pragma unroll
    for (int i = 0; i < 32; ++i) v[i] = __builtin_nontemporal_load(wp + (size_t)(2 * i) * N);
}
template <class RM>
__device__ __forceinline__ void tr_store(const float (&v)[32], int N, bf16_t* WT, int ldt, int koff, RM rm, LAS float* scr, int item, int lane) {
    const int nblk = N / 32, kb = item / nblk, nb = item % nblk, k0 = 64 * kb, n0 = 32 * nb;
    { LAS float* sp = scr + (lane >> 5) * 33 + (lane & 31);
#pragma unroll
      for (int i = 0; i < 32; ++i) sp[2 * i * 33] = v[i]; }
    LDS_WAIT(); asm volatile("" ::: "memory");
    const int c = lane & 7;
#pragma unroll
    for (int j = 0; j < 4; ++j) { const int n = (lane >> 3) + 8 * j; const LAS float* s = scr + (8 * c) * 33 + n;
        u32x4 o; o.x = cvtpk(s[0 * 33], s[1 * 33]); o.y = cvtpk(s[2 * 33], s[3 * 33]); o.z = cvtpk(s[4 * 33], s[5 * 33]); o.w = cvtpk(s[6 * 33], s[7 * 33]);
        *(u32x4*)(WT + (size_t)rm(n0 + n) * ldt + koff + k0 + 8 * c) = o; }
    LDS_WAIT(); asm volatile("" ::: "memory");
}
template <class RM>
__device__ __forceinline__ void transpose_item(const float* W, int N, bf16_t* WT, int ldt, int koff, RM rm, LAS float* scr, int item, int lane) {
    float v[32]; tr_load(W, N, item, lane, v); tr_store(v, N, WT, ldt, koff, rm, scr, item, lane);
}
template <class RM>
__device__ __forceinline__ void transpose_block_item(const float* W, int N, int k0, int n0, bf16_t* WT, int ldt, int koff, RM rm, LAS unsigned char* lds, int tid) {
    const int w = tid >> 6, lane = tid & 63;
    f32x4 v[8];
#pragma unroll
    for (int r = 0; r < 8; ++r) v[r] = __builtin_nontemporal_load((const f32x4*)(W + (size_t)(k0 + 8 * w + r) * N + n0 + 4 * lane));
#pragma unroll
    for (int c = 0; c < 4; ++c) { u32x4 o; o.x = cvtpk(v[0][c], v[1][c]); o.y = cvtpk(v[2][c], v[3][c]); o.z = cvtpk(v[4][c], v[5][c]); o.w = cvtpk(v[6][c], v[7][c]);
        *(LAS u32x4*)(lds + (4 * lane + c) * 144 + 16 * w) = o; }
    __syncthreads();
#pragma unroll
    for (int i = 0; i < 4; ++i) { const int q = tid + 512 * i, row = q >> 3, ch = q & 7;
        *(u32x4*)(WT + (size_t)rm(n0 + row) * ldt + koff + k0 + 8 * ch) = *(const LAS u32x4*)(lds + row * 144 + 16 * ch); }
    __syncthreads();
}
struct RmAdd { int off; __device__ __forceinline__ int operator()(int n) const { return off + n; } };
struct RmW13 { int off; __device__ __forceinline__ int operator()(int n) const { return off + (n >> 7) * 256 + (n & 127); } };

__device__ __forceinline__ void p0_prologue(Frame& F) {
    bf16_t* W1T = (bf16_t*)(F.ws + WS_W1T); bf16_t* WUPT = (bf16_t*)(F.ws + WS_WUPT); bf16_t* WOUTT = (bf16_t*)(F.ws + WS_WOUTT);
    { constexpr int I_A = 16 * 20, I_B = 16 * 8, I_C = 16 * 4; constexpr int NITEMS = I_A + I_B + 3 * I_C;
      for (int it = F.blk; it < NITEMS; it += F.G) { int r = it;
          if (r < I_A) { transpose_block_item(F.a->in[I_WIN], 5120, 64 * (r / 20), 256 * (r % 20), W1T, 1024, 0, RmAdd{0}, F.lds, F.tid); continue; } r -= I_A;
          if (r < I_B) { transpose_block_item(F.a->in[I_WGATE], 2048, 64 * (r / 8), 256 * (r % 8), W1T, 1024, 0, RmAdd{5120}, F.lds, F.tid); continue; } r -= I_B;
          if (r < I_C) { transpose_block_item(F.a->in[I_WUPA], 1024, 64 * (r / 4), 256 * (r % 4), WUPT, 1024, 0, RmAdd{0}, F.lds, F.tid); continue; } r -= I_C;
          if (r < I_C) { transpose_block_item(F.a->in[I_WUPB], 1024, 64 * (r / 4), 256 * (r % 4), WUPT, 1024, 0, RmAdd{1024}, F.lds, F.tid); continue; } r -= I_C;
          transpose_block_item(F.a->in[I_WOUT], 1024, 64 * (r / 4), 256 * (r % 4), WOUTT, 1024, 0, RmAdd{0}, F.lds, F.tid); } }
    { bf16_t* WST = (bf16_t*)(F.ws + WS_WST); const float* ws_ = F.a->in[I_WS];
      for (int i = F.blk * NTHREADS + F.tid; i < 8 * 128 * 128 / 2; i += F.G * NTHREADS) { const int e = 2 * i, s = e & 127, t = (e >> 7) & 127;
          const float a = (s <= t) ? ws_[e] : 0.f, b = (s + 1 <= t) ? ws_[e + 1] : 0.f; *(unsigned*)(WST + e) = cvtpk(a, b); } }
    { float* WRT = (float*)(F.ws + WS_ROUTE + RT_WRT); const float* g2 = F.a->in[I_N2G]; const float* wrg = F.a->in[I_WRG]; const float* wre = F.a->in[I_WRE];
      for (int i = F.blk * NTHREADS + F.tid; i < 48 * 1024; i += F.G * NTHREADS) { const int j = i >> 10, k = i & 1023;
          const float w = j < 4 ? wrg[k * 4 + j] : (j < 36 ? wre[k * 32 + (j - 4)] : 0.f); WRT[i] = g2[k] * w; } }
    if (F.blk == 0) { LAS int* hist = (LAS int*)(F.lds + 136 * 1024); LAS int* gt = hist + 160;
        for (int i = F.tid; i < 320; i += NTHREADS) hist[i] = 0;
        __syncthreads();
        const float dmin1 = attn_dmin_unit(F.a->in[I_QNG], F.a->in[I_KNG]);
        int w[2], jl[2];
#pragma unroll
        for (int q = 0; q < 2; ++q) { const int u = F.tid + q * NTHREADS, qb = u >> 4; jl[q] = attn_jlo(dmin1, u & 7, qb); w[q] = 2 * qb + 2 - jl[q]; atomicAdd((int*)(hist + w[q]), 1); }
        __syncthreads();
        if (F.tid < 64) { int h0 = 0, h1 = 0, h2 = 0; const int i0 = 3 * F.tid;
            if (i0 < 160) h0 = hist[i0]; if (i0 + 1 < 160) h1 = hist[i0 + 1]; if (i0 + 2 < 160) h2 = hist[i0 + 2];
            const int tot = h0 + h1 + h2; int suf = tot;
#pragma unroll
            for (int o = 1; o < 64; o <<= 1) { const int vv = __shfl_down(suf, o); if (F.tid + o < 64) suf += vv; }
            const int above = suf - tot;
            if (i0 + 2 < 160) gt[i0 + 2] = above; if (i0 + 1 < 160) gt[i0 + 1] = above + h2; if (i0 < 160) gt[i0] = above + h2 + h1; }
        __syncthreads();
#pragma unroll
        for (int q = 0; q < 2; ++q) { const int u = F.tid + q * NTHREADS; const int rank = atomicAdd((int*)(gt + w[q]), 1);
            ((int*)(F.ws + WS_ROUTE + RT_ALIST))[rank] = u | (jl[q] << 16); }
        __syncthreads(); }
    { bf16_t* XN = (bf16_t*)(F.ws + WS_XN); const float* x = F.a->in[I_X]; const f32x4* g4 = (const f32x4*)F.a->in[I_N1G] + F.lane;
      for (int m0 = F.gw * 4; m0 < M; m0 += F.NGW * 4) { f32x4 v[4][4];
#pragma unroll
          for (int q = 0; q < 4; ++q) { const f32x4* xr = (const f32x4*)(x + (size_t)(m0 + q) * DM) + F.lane;
#pragma unroll
              for (int j = 0; j < 4; ++j) v[q][j] = __builtin_nontemporal_load(xr + 64 * j); }
#pragma unroll
          for (int q = 0; q < 4; ++q) { float s = 0.f;
#pragma unroll
              for (int j = 0; j < 4; ++j) s += (v[q][j][0] * v[q][j][0] + v[q][j][1] * v[q][j][1]) + (v[q][j][2] * v[q][j][2] + v[q][j][3] * v[q][j][3]);
              const float r = rsqrtf(wave_sum(s) * (1.f / DM) + EPS);
#pragma unroll
              for (int j = 0; j < 4; ++j) { const f32x4 g = g4[64 * j]; st4(XN + (size_t)(m0 + q) * DM + 4 * F.lane + 256 * j, (v[q][j] * r) * g); } } } }
}

__device__ __forceinline__ void p1_proj(Frame& F) {
    pg8::Gemm g{(const bf16_t*)(F.ws + WS_XN), (const bf16_t*)(F.ws + WS_W1T), DM, nullptr};
    pg8::StaticOrder S; S.init(M, N1, F.G, F.blk);
    static_assert(WS_VA == WS_U + 32 * MiB && WS_Q == WS_U + 64 * MiB && WS_K == WS_U + 96 * MiB && WS_VB == WS_U + 128 * MiB, "EpiProj layout");
    EpiProj E{F.ws, (bf16_t*)F.out, F.a->in[I_QNG], F.a->in[I_KNG], F.a->in[I_BGATE]};
    pg8::gemm_phase<EpiProj, pg8::StaticOrder, PG8_ALIGN, PG8_SP2, true>(F.lds, g, S, E);
}

__device__ __forceinline__ void p2_mixer_a(Frame& F) {
    const bf16_t* VA = (const bf16_t*)(F.ws + WS_VA); const bf16_t* U = (const bf16_t*)(F.ws + WS_U); bf16_t* YA = (bf16_t*)(F.ws + WS_YA); const bf16_t* WST = (const bf16_t*)(F.ws + WS_WST);
    const float* gv = F.a->in[I_VNG]; const float* bs = F.a->in[I_BS];
    bf16_t* vT = (bf16_t*)F.ldsg;
    bf16_t* wS = (bf16_t*)(F.ldsg + 128 * 136 * 2);
    const int fr = F.lane & 15, fq = F.lane >> 4, wm = F.wid >> 1, wn = F.wid & 1;
    const int s_ = F.tid >> 2, ds = (F.tid & 3) * 32;
    int gstaged = -1;
    bf16x8 v[4];
    if (F.blk < 1024) { const int c = F.blk >> 3, g = F.blk & 7; const bf16_t* src = VA + (size_t)(c * 128 + s_) * DM + g * 128 + ds;
#pragma unroll
        for (int i = 0; i < 4; ++i) v[i] = *(const bf16x8*)(src + 8 * i); }
    for (int L = F.blk; L < 1024; L += F.G) {
        const int c = L >> 3, g = L & 7;
        if (g != gstaged) { __syncthreads();
#pragma unroll
            for (int i = 0; i < 4; ++i) { const int q = F.tid + 512 * i, t = q >> 4, ch = q & 15; *(bf16x8*)(wS + t * 136 + 8 * ch) = *(const bf16x8*)(WST + g * 16384 + t * 128 + 8 * ch); }
            gstaged = g; }
        { float ss = 0.f;
#pragma unroll
          for (int i = 0; i < 4; ++i)
#pragma unroll
              for (int j = 0; j < 8; ++j) { const float x = bf2f(v[i][j]); ss += x * x; }
          ss += __shfl_xor(ss, 1); ss += __shfl_xor(ss, 2);
          const float r = rsqrtf(ss * (1.f / 128.f) + EPS);
#pragma unroll
          for (int i = 0; i < 4; ++i)
#pragma unroll
              for (int j = 0; j < 8; ++j) { const int d = ds + 8 * i + j; const float x = (bf2f(v[i][j]) * r) * gv[g * 128 + d]; vT[d * 136 + s_] = (bf16_t)(cvtpk(x, 0.f) & 0xffffu); } }
        __syncthreads();
        const int Ln = L + F.G;
        if (Ln < 1024) { const bf16_t* src = VA + (size_t)((Ln >> 3) * 128 + s_) * DM + (Ln & 7) * 128 + ds;
#pragma unroll
            for (int i = 0; i < 4; ++i) v[i] = *(const bf16x8*)(src + 8 * i); }
        f32x4 uu[2][4]; float bb[2];
#pragma unroll
        for (int m = 0; m < 2; ++m) { const int t = 32 * wm + 16 * m + fr; bb[m] = bs[g * 128 + t]; const bf16_t* up = U + (size_t)(c * 128 + t) * DM + g * 128 + 64 * wn + 4 * fq;
#pragma unroll
            for (int n = 0; n < 4; ++n) uu[m][n] = ld4(up + 16 * n); }
        const bf16_t* ap = wS + (32 * wm + fr) * 136 + 8 * fq; const bf16_t* bp = vT + (64 * wn + fr) * 136 + 8 * fq;
        f32x4 acc[2][4]; acc_zero(acc);
        wave_gemm(acc, ap, ap + 16 * 136, bp, bp + 16 * 136, bp + 32 * 136, bp + 48 * 136, 32 * (wm + 1));
#pragma unroll
        for (int m = 0; m < 2; ++m) { const int t = 32 * wm + 16 * m + fr; bf16_t* yp = YA + (size_t)(c * 128 + t) * DM + g * 128 + 64 * wn + 4 * fq;
#pragma unroll
            for (int n = 0; n < 4; ++n) st4(yp + 16 * n, uu[m][n] * (acc[m][n] + bb[m])); }
        __syncthreads();
    }
}

namespace att {
constexpr int QBLK = 32, KVBLK = 64, QB = 128, PITCH = 1024;
constexpr int SHM_V = KVBLK * 128 * 2, SHM_K = 2 * KVBLK * 64 * 2;
constexpr int SLOT = SHM_K + SHM_V, NSLOT = 3;
constexpr int LDS_WSF = NSLOT * SLOT, LDS_XCH = LDS_WSF + NWAVES * 64 * 4, LDS_BYTES = LDS_XCH + 4 * 16 * 2 * 64 * 4;
constexpr float THR2 = 8.f * LOG2E;
#define KSWZ64(row, colB) ((row) * 128 + ((colB) ^ ((((row) >> 1) & 7) << 4)))
__device__ __forceinline__ int v_st(int k, int c) { const int kk = (k & ~0xC) | ((k & 4) << 1) | ((k & 8) >> 1); return ((kk >> 3) * 4 + (c >> 5)) * 512 + ((kk & 7) * 32 + (c & 31)) * 2; }
__device__ __forceinline__ int v_rd_base(int lane) { return ((lane & 3) << 3) | (((lane >> 2) & 3) << 6) | (((lane >> 4) & 1) << 5) | (((lane >> 5) & 1) << 8); }
constexpr int v_rd_off(int d0, int ks, int half) { return d0 * 512 + ks * 4096 + half * 2048; }
__device__ __forceinline__ int crow(int r, int hi) { return (r & 3) + 8 * (r >> 2) + 4 * hi; }

__device__ __forceinline__ void mask_tile(f32x16& p0, f32x16& p1, int dq) {
    const float NEG = -__builtin_inff();
#pragma unroll
    for (int r = 0; r < 16; ++r) { const int c = (r & 3) + 8 * (r >> 2);
        if (dq - c < 0) p0[r] = NEG;
        if (dq - c - 32 < 0) p1[r] = NEG; }
}
__device__ __forceinline__ void partialSM(f32x16& p0, f32x16& p1, float& m_reg, float& alpha) {
    float pmax = __builtin_fmaxf(__builtin_fmaxf(p0[0], p0[1]), p0[2]);
#pragma unroll
    for (int r = 3; r < 15; r += 2) pmax = __builtin_fmaxf(__builtin_fmaxf(pmax, p0[r]), p0[r + 1]);
    pmax = __builtin_fmaxf(__builtin_fmaxf(pmax, p0[15]), p1[0]);
#pragma unroll
    for (int r = 1; r < 15; r += 2) pmax = __builtin_fmaxf(__builtin_fmaxf(pmax, p1[r]), p1[r + 1]);
    pmax = __builtin_fmaxf(pmax, p1[15]);
    { auto rr = __builtin_amdgcn_permlane32_swap(__float_as_uint(pmax), __float_as_uint(pmax), false, false);
      pmax = fmaxf(__uint_as_float(rr[0]), __uint_as_float(rr[1])); }
    alpha = 1.f;
    if (__builtin_expect(!__all(pmax <= THR2), 0)) { asm volatile("" ::: "memory");
        const float d = fmaxf(pmax, 0.f); m_reg += d; alpha = __builtin_amdgcn_exp2f(-d);
#pragma unroll
        for (int r = 0; r < 16; ++r) { p0[r] -= d; p1[r] -= d; } }
#pragma unroll
    for (int r = 0; r < 16; ++r) p0[r] = __builtin_amdgcn_exp2f(p0[r]);
}
__device__ __forceinline__ void finishSM_h(f32x16& p0, f32x16& p1, float alpha, float& l_reg, float ps0, bf16x8& pa0, bf16x8& pa1, bf16x8& pa2, bf16x8& pa3) {
#pragma unroll
    for (int r = 0; r < 16; ++r) p1[r] = __builtin_amdgcn_exp2f(p1[r]);
    float ps = ps0;
#pragma unroll
    for (int r = 0; r < 16; ++r) ps += p1[r];
    { auto rr = __builtin_amdgcn_permlane32_swap(__float_as_uint(ps), __float_as_uint(ps), false, false);
      ps = __uint_as_float(rr[0]) + __uint_as_float(rr[1]); }
    l_reg = l_reg * alpha + ps;
#define PK8(P, B_, OUT) do { u32x4 w = {cvtpk(P[B_+0], P[B_+1]), cvtpk(P[B_+2], P[B_+3]), cvtpk(P[B_+4], P[B_+5]), cvtpk(P[B_+6], P[B_+7])}; OUT = __builtin_bit_cast(bf16x8, w); } while (0)
    PK8(p0, 0, pa0); PK8(p0, 8, pa1); PK8(p1, 0, pa2); PK8(p1, 8, pa3);
#undef PK8
}
__device__ __forceinline__ void finishSM(f32x16& p0, f32x16& p1, float alpha, float& l_reg, bf16x8& pa0, bf16x8& pa1, bf16x8& pa2, bf16x8& pa3) {
#pragma unroll
    for (int r = 0; r < 16; ++r) p1[r] = __builtin_amdgcn_exp2f(p1[r]);
    float ps = 0;
#pragma unroll
    for (int r = 0; r < 16; ++r) ps += p0[r];
#pragma unroll
    for (int r = 0; r < 16; ++r) ps += p1[r];
    { auto rr = __builtin_amdgcn_permlane32_swap(__float_as_uint(ps), __float_as_uint(ps), false, false);
      ps = __uint_as_float(rr[0]) + __uint_as_float(rr[1]); }
    l_reg = l_reg * alpha + ps;
#define PK4(P, B_, OUT) do { unsigned a0 = cvtpk(P[B_+0], P[B_+1]), a1 = cvtpk(P[B_+2], P[B_+3]);                          \
        unsigned b0 = cvtpk(P[B_+4], P[B_+5]), b1 = cvtpk(P[B_+6], P[B_+7]);                                             \
        auto r0 = __builtin_amdgcn_permlane32_swap(a0, b0, false, false); auto r1 = __builtin_amdgcn_permlane32_swap(a1, b1, false, false); \
        u32x4 w = {r0[0], r1[0], r0[1], r1[1]}; OUT = __builtin_bit_cast(bf16x8, w); } while (0)
    PK4(p0, 0, pa0); PK4(p0, 8, pa1); PK4(p1, 0, pa2); PK4(p1, 8, pa3);
#undef PK4
}
__device__ __forceinline__ void qkt(f32x16& p0, f32x16& p1, const char* Kmap_lds, int r32, int hi, const bf16x8* qr, bf16x8 kx0, unsigned kc1, bf16x8 qx) {
    p0 = __builtin_amdgcn_mfma_f32_32x32x16_bf16(kx0, qx, f32x16{}, 0, 0, 0);
    { u32x4 k1 = __builtin_bit_cast(u32x4, kx0); k1.x = kc1; p1 = __builtin_amdgcn_mfma_f32_32x32x16_bf16(__builtin_bit_cast(bf16x8, k1), qx, f32x16{}, 0, 0, 0); }
#pragma unroll
    for (int d0 = 0; d0 < 4; ++d0) { const char* a = Kmap_lds + KSWZ64(r32, (d0 * 16 + hi * 8) * 2);
        const bf16x8 b0 = *reinterpret_cast<const bf16x8*>(a);
        const bf16x8 b1 = *reinterpret_cast<const bf16x8*>(a + 32 * 128);
        p0 = __builtin_amdgcn_mfma_f32_32x32x16_bf16(b0, qr[d0], p0, 0, 0, 0);
        p1 = __builtin_amdgcn_mfma_f32_32x32x16_bf16(b1, qr[d0], p1, 0, 0, 0); }
}
__device__ __forceinline__ void pv_tile(f32x16* o, int vb0, bf16x8 pa0, bf16x8 pa1, bf16x8 pa2, bf16x8 pa3) {
#define TRRD(dst, off) asm volatile("ds_read_b64_tr_b16 %0, %1 offset:%2" : "=&v"(dst) : "v"(vb0), "i"(off) : "memory")
#define PV_D0(d0) do { s16x4 l0, l1, l2, l3, h0, h1, h2, h3; constexpr int b_ = v_rd_off(d0, 0, 0); \
        TRRD(l0, b_); TRRD(h0, b_ + 2048); TRRD(l1, b_ + 4096); TRRD(h1, b_ + 6144); TRRD(l2, b_ + 8192); TRRD(h2, b_ + 10240); TRRD(l3, b_ + 12288); TRRD(h3, b_ + 14336); \
        asm volatile("s_waitcnt lgkmcnt(0)" ::: "memory"); SBAR();   \
        o[d0] = __builtin_amdgcn_mfma_f32_32x32x16_bf16((bf16x8){l0[0], l0[1], l0[2], l0[3], h0[0], h0[1], h0[2], h0[3]}, pa0, o[d0], 0, 0, 0);   \
        o[d0] = __builtin_amdgcn_mfma_f32_32x32x16_bf16((bf16x8){l1[0], l1[1], l1[2], l1[3], h1[0], h1[1], h1[2], h1[3]}, pa1, o[d0], 0, 0, 0);   \
        o[d0] = __builtin_amdgcn_mfma_f32_32x32x16_bf16((bf16x8){l2[0], l2[1], l2[2], l2[3], h2[0], h2[1], h2[2], h2[3]}, pa2, o[d0], 0, 0, 0);   \
        o[d0] = __builtin_amdgcn_mfma_f32_32x32x16_bf16((bf16x8){l3[0], l3[1], l3[2], l3[3], h3[0], h3[1], h3[2], h3[3]}, pa3, o[d0], 0, 0, 0); } while (0)
    PV_D0(0); PV_D0(1); PV_D0(2); PV_D0(3);
#undef PV_D0
#undef TRRD
}

__device__ __forceinline__ void pv_fused(f32x16* o, int vb0, bf16x8 pa0, bf16x8 pa1, bf16x8 pa2, bf16x8 pa3, f32x16& x0, const f32x16& x1, float& pmax, float& ps0) {
#define TRRD(dst, off) asm volatile("ds_read_b64_tr_b16 %0, %1 offset:%2" : "=&v"(dst) : "v"(vb0), "i"(off) : "memory")
#define VFR(L, H, k) (bf16x8){L[k][0], L[k][1], L[k][2], L[k][3], H[k][0], H[k][1], H[k][2], H[k][3]}
#define LGKM0() asm volatile("s_waitcnt lgkmcnt(0)" ::: "memory")
#define VBASE(d0) (v_rd_off(d0, 0, 0))
    s16x4 la[4], ha[4];
    float m = -__builtin_inff(), sx = 0.f;
#pragma unroll
    for (int k = 0; k < 4; ++k) { TRRD(la[k], VBASE(0) + k * 4096); TRRD(ha[k], VBASE(0) + k * 4096 + 2048); }
    LGKM0(); SBAR();
#define PA(k) ((k) == 0 ? pa0 : (k) == 1 ? pa1 : (k) == 2 ? pa2 : pa3)
#define GAP(s, L, H)  do { constexpr int d0_ = (s) >> 2, k_ = (s) & 3;                                                           \
        o[d0_] = __builtin_amdgcn_mfma_f32_32x32x16_bf16(VFR(L, H, k_), PA(k_), o[d0_], 0, 0, 0);                                          \
        if (d0_ < 3) { TRRD(L[k_], VBASE(d0_ + 1) + k_ * 4096); TRRD(H[k_], VBASE(d0_ + 1) + k_ * 4096 + 2048); }                        \
        if ((s) < 4) { m = __builtin_fmaxf(__builtin_fmaxf(m, x0[4 * (s)]), x0[4 * (s) + 1]); m = __builtin_fmaxf(__builtin_fmaxf(m, x0[4 * (s) + 2]), x0[4 * (s) + 3]); }            \
        else if ((s) < 8) { m = __builtin_fmaxf(__builtin_fmaxf(m, x1[4 * ((s) - 4)]), x1[4 * ((s) - 4) + 1]); m = __builtin_fmaxf(__builtin_fmaxf(m, x1[4 * ((s) - 4) + 2]), x1[4 * ((s) - 4) + 3]); } \
        if ((s) >= 4 && (s) < 12) { x0[(s) - 4] = __builtin_amdgcn_exp2f(x0[(s) - 4]); if ((s) >= 5) sx += x0[(s) - 5]; }                  \
        else if ((s) >= 12) { x0[8 + 2 * ((s) - 12)] = __builtin_amdgcn_exp2f(x0[8 + 2 * ((s) - 12)]); x0[9 + 2 * ((s) - 12)] = __builtin_amdgcn_exp2f(x0[9 + 2 * ((s) - 12)]); \
                              sx += x0[7 + 2 * ((s) - 12)]; sx += x0[8 + 2 * ((s) - 12)]; }                                                  \
        if (k_ == 3 && d0_ < 3) LGKM0();                                                                                                   \
        SBAR(); } while (0)
    GAP(0, la, ha); GAP(1, la, ha); GAP(2, la, ha); GAP(3, la, ha);
    GAP(4, la, ha); GAP(5, la, ha); GAP(6, la, ha); GAP(7, la, ha);
    GAP(8, la, ha); GAP(9, la, ha); GAP(10, la, ha); GAP(11, la, ha);
    GAP(12, la, ha); GAP(13, la, ha); GAP(14, la, ha); GAP(15, la, ha);
    ps0 = sx + x0[15]; pmax = m;
#undef GAP
#undef PA
#undef VBASE
#undef LGKM0
#undef VFR
#undef TRRD
}
__device__ __forceinline__ bf16x8 qx_of(unsigned sdw, float x) {
    const unsigned h_ = cvtpk(x, 0.f) & 0xffffu; const float r1 = x - __uint_as_float(h_ << 16);
    const unsigned m_ = cvtpk(r1, 0.f) & 0xffffu; const float r2 = r1 - __uint_as_float(m_ << 16);
    return __builtin_bit_cast(bf16x8, (u32x4){sdw, h_ | (m_ << 16), cvtpk(r2, 0.f) & 0xffffu, 0u});
}
struct BlockRef { int base; int P0; int jlo; float slope2; };
#define BR_Q(br) ((const bf16_t*)(wsb + WS_Q) + (br).base)
#define BR_K(br) ((const bf16_t*)(wsb + WS_K) + (br).base)
#define BR_V(br) ((const bf16_t*)(wsb + WS_VB) + (br).base)
#define BR_O(br) ((bf16_t*)(wsb + WS_XN) + (br).base)
struct Seam { bf16x8 qr[4]; };
__device__ __forceinline__ void glds16s(unsigned voff, const void* sbase, unsigned lds_dst) { unsigned keep;
    asm volatile("s_mov_b32 %0, m0\n\ts_mov_b32 m0, %3\n\ts_nop 0\n\tglobal_load_lds_dwordx4 %1, %2\n\ts_mov_b32 m0, %0" : "=&s"(keep) : "v"(voff), "s"(sbase), "s"(lds_dst) : "memory"); }
#define WAIT_BAR(N) asm volatile("s_waitcnt vmcnt(" #N ") lgkmcnt(0)\n\ts_barrier" ::: "memory")
#define LBAR() asm volatile("s_waitcnt lgkmcnt(0)\n\ts_barrier" ::: "memory")
struct DmaOff { unsigned k0, k1, v0, v1; };
__device__ __forceinline__ DmaOff dma_offsets(int wid, int lane) {
    DmaOff d; unsigned ko[2], vo[2];
#pragma unroll
    for (int i = 0; i < 2; ++i) { const int G = (2 * wid + i) * 64 + lane;
        { const int map = G >> 9, row = (G >> 3) & 63, slot = G & 7, chunk = slot ^ ((row >> 1) & 7); ko[i] = (unsigned)(row * PITCH + map * 64 + chunk * 8) * 2u; }
        { const int sub = G >> 5, kk = (sub >> 2) * 8 + ((G >> 2) & 7), c = (sub & 3) * 32 + (G & 3) * 8; vo[i] = (unsigned)(kk * PITCH + c) * 2u; } }
    d.k0 = ko[0]; d.k1 = ko[1]; d.v0 = vo[0]; d.v1 = vo[1]; return d;
}
#define TILE_PTR(T_, br, t) ((const char*)(wsb + (T_)) + ((size_t)(br).base + (size_t)((br).jlo + (t)) * (KVBLK * PITCH)) * 2)
#define DMA_K(br, t, so) do { const char* sb_ = TILE_PTR(WS_K, br, t); const unsigned ld_ = (unsigned)__builtin_amdgcn_readfirstlane((int)(lds0 + (so) + wid * 2048)); glds16s(D.k0, sb_, ld_); glds16s(D.k1, sb_, ld_ + 1024u); } while (0)
#define DMA_V(br, t, so) do { const char* sb_ = TILE_PTR(WS_VB, br, t); const unsigned ld_ = (unsigned)__builtin_amdgcn_readfirstlane((int)(lds0 + (so) + SHM_K + wid * 2048)); glds16s(D.v0, sb_, ld_); glds16s(D.v1, sb_, ld_ + 1024u); } while (0)
__device__ __forceinline__ void attn_issue_first(const unsigned char* wsb, const BlockRef& br, char* lds, Seam& S, const DmaOff& D, int wid, int r32, int hi) {
    const unsigned lds0 = (unsigned)(uintptr_t)lds; const int map = wid >> 2, rw = wid & 3;
#pragma unroll
    for (int d0 = 0; d0 < 4; ++d0) S.qr[d0] = *(const bf16x8*)(BR_Q(br) + (size_t)(br.P0 + rw * QBLK + r32) * PITCH + map * 64 + d0 * 16 + hi * 8);
    DMA_K(br, 0, 0); DMA_V(br, 0, 0); DMA_K(br, 1, SLOT);
}
__device__ __forceinline__ void attn_block(unsigned char* wsb, const BlockRef& cur, const BlockRef& nxt, char* lds, Seam& S, float lam, const float* subg) {
    const int tid = threadIdx.x, wid = __builtin_amdgcn_readfirstlane(tid >> 6), lane = tid & 63, r32 = lane & 31, hi = lane >> 5;
    const int map = wid >> 2, rw = wid & 3;
    const int j_lo = cur.jlo, NT = cur.P0 / KVBLK + 2 - j_lo;
    const int qlo = cur.P0 + rw * QBLK, qm = qlo + r32 - 4 * hi;
    const float slope2 = cur.slope2; const int qpos = qlo + r32;
    unsigned sdw; { const unsigned h_ = cvtpk(slope2, 0.f) & 0xffffu; const float lo_ = slope2 - __uint_as_float(h_ << 16); sdw = h_ | (cvtpk(lo_, 0.f) << 16); }
    bf16x8 kx0; unsigned kx1; { const unsigned c0 = cvtpk((float)r32, (float)r32), c1 = cvtpk((float)(r32 + 32), (float)(r32 + 32)), one = hi ? 0u : 0x3f803f80u;
        kx0 = __builtin_bit_cast(bf16x8, (u32x4){hi ? 0u : c0, one, one & 0xffffu, 0u}); kx1 = hi ? 0u : c1; }
    const unsigned lds0 = (unsigned)(uintptr_t)lds; const char* Kmap = lds + map * 8192;
    float m_reg = 0.f, l_reg = 0; f32x16 o[4] = {};
    const int vb0 = (int)lds0 + SHM_K + v_rd_base(lane);
    const DmaOff D = dma_offsets(wid, lane);
#define RESC(a) do { if (__any((a) < 1.f)) { _Pragma("unroll") for (int d_ = 0; d_ < 4; ++d_) _Pragma("unroll") for (int r = 0; r < 16; ++r) o[d_][r] *= (a); } } while (0)
#define KBASE(t) ((j_lo + (t)) * KVBLK)
#define MASKT(P0_, P1_, t) do { const int kb_ = KBASE(t); if (kb_ + KVBLK - 1 > qlo) { asm volatile("" ::: "memory"); mask_tile(P0_, P1_, qm - kb_); } } while (0)
#define QX(t) qx_of(sdw, slope2 * (float)(KBASE(t) - qpos) - m_reg)
#define ROT() do { const int p_ = sl_prev; sl_prev = sl_cur; sl_cur = sl_next; sl_next = p_; } while (0)
    f32x16 pA0, pA1, pB0, pB1; float alA, alB; bf16x8 pa0, pa1, pa2, pa3;
    int sl_prev = 2 * SLOT, sl_cur = 0, sl_next = SLOT;
    WAIT_BAR(0);
    asm volatile("" : "+v"(S.qr[0]), "+v"(S.qr[1]), "+v"(S.qr[2]), "+v"(S.qr[3]));
    if (NT > 2) { DMA_V(cur, 1, SLOT); DMA_K(cur, 2, 2 * SLOT); } else { DMA_V(cur, 1, SLOT); }
    SBAR(); qkt(pA0, pA1, Kmap, r32, hi, S.qr, kx0, kx1, QX(0));
    MASKT(pA0, pA1, 0); partialSM(pA0, pA1, m_reg, alA);
    float psA = 0.f, psB = 0.f;
#pragma unroll
    for (int r = 0; r < 16; ++r) psA += pA0[r];
    if (NT > 2) { WAIT_BAR(4); } else { WAIT_BAR(2); }
    ROT();
#define STEP(PX0, PX1, alX, psX, PY0, PY1, alY, psY, t) do {                                                                           \
        const bool k2_ = (t) + 2 < NT, v1_ = (t) + 1 < NT;                                                                   \
        if (k2_) DMA_K(cur, (t) + 2, sl_prev); if (v1_) DMA_V(cur, (t) + 1, sl_next);                                        \
        SBAR(); qkt(PX0, PX1, Kmap + sl_cur, r32, hi, S.qr, kx0, kx1, QX(t));                                                \
        finishSM_h(PY0, PY1, alY, l_reg, psY, pa0, pa1, pa2, pa3); SBAR();                                                   \
        MASKT(PX0, PX1, (t)); SBAR();                                                                                        \
        { float pm_; pv_fused(o, vb0 + sl_prev, pa0, pa1, pa2, pa3, PX0, PX1, pm_, psX);                                     \
          { auto rr_ = __builtin_amdgcn_permlane32_swap(__float_as_uint(pm_), __float_as_uint(pm_), false, false); pm_ = fmaxf(__uint_as_float(rr_[0]), __uint_as_float(rr_[1])); } \
          alX = 1.f;                                                                                                           \
          if (__builtin_expect(!__all(pm_ <= THR2), 0)) { asm volatile("" ::: "memory");        \
              const float d_ = fmaxf(pm_, 0.f); m_reg += d_; alX = __builtin_amdgcn_exp2f(-d_);                                \
              psX *= alX; _Pragma("unroll") for (int r = 0; r < 16; ++r) { PX0[r] *= alX; PX1[r] -= d_; } } }                              \
        RESC(alX);                                                                                                           \
        if (k2_) { WAIT_BAR(4); } else if (v1_) { WAIT_BAR(2); } else { WAIT_BAR(0); }                                       \
        ROT(); } while (0)
    int t = 1;
    for (; t + 1 < NT; t += 2) {
        STEP(pB0, pB1, alB, psB, pA0, pA1, alA, psA, t);
        STEP(pA0, pA1, alA, psA, pB0, pB1, alB, psB, t + 1);
    }
    const bool oddtail = t < NT;
    if (oddtail) { STEP(pB0, pB1, alB, psB, pA0, pA1, alA, psA, t); }
    if (oddtail) { finishSM_h(pB0, pB1, alB, l_reg, psB, pa0, pa1, pa2, pa3); } else { finishSM_h(pA0, pA1, alA, l_reg, psA, pa0, pa1, pa2, pa3); }
    SBAR(); pv_tile(o, vb0 + sl_prev, pa0, pa1, pa2, pa3);
    LBAR();
    attn_issue_first(wsb, nxt, lds, S, D, wid, r32, hi);
    const float rl = __builtin_amdgcn_rcpf(l_reg);
    float* xch = (float*)(lds + LDS_XCH) + (size_t)rw * (16 * 2 * 64) + lane;
#pragma unroll
    for (int half = 0; half < 2; ++half) {
        if (map == 1) {
#pragma unroll
            for (int r = 0; r < 16; ++r)
#pragma unroll
                for (int dd = 0; dd < 2; ++dd) xch[(r * 2 + dd) * 64] = o[2 * half + dd][r] * rl; }
        LBAR();
        if (map == 0) {
#pragma unroll
            for (int r = 0; r < 16; ++r)
#pragma unroll
                for (int dd = 0; dd < 2; ++dd) o[2 * half + dd][r] = o[2 * half + dd][r] * rl - lam * xch[(r * 2 + dd) * 64]; }
        LBAR();
    }
    if (map == 0) {
        float ss = 0.f;
#pragma unroll
        for (int d0 = 0; d0 < 4; ++d0)
#pragma unroll
            for (int r = 0; r < 16; ++r) ss += o[d0][r] * o[d0][r];
        ss += __shfl_xor(ss, 32);
        const float rs = rsqrtf(ss * (1.f / 128.f) + EPS) * (1.f - LAM_INIT);
        int obase = (cur.P0 + rw * QBLK + r32) * PITCH + 4 * hi; asm volatile("" : "+v"(obase));
        bf16_t* Ow = BR_O(cur) + obase; const float* gp = subg + 4 * hi;
#pragma unroll
        for (int d0 = 0; d0 < 4; ++d0)
#pragma unroll
            for (int g4 = 0; g4 < 4; ++g4) { const f32x4 gg = *(const f32x4*)(gp + 32 * d0 + 8 * g4);
                f32x4 v; v[0] = o[d0][4 * g4] * rs; v[1] = o[d0][4 * g4 + 1] * rs; v[2] = o[d0][4 * g4 + 2] * rs; v[3] = o[d0][4 * g4 + 3] * rs;
                st4(Ow + 32 * d0 + 8 * g4, v * gg); }
    }
#undef RESC
#undef KBASE
#undef MASKT
#undef QX
#undef ROT
#undef STEP
}
#undef WAIT_BAR
#undef LBAR
#undef TILE_PTR
#undef DMA_K
#undef DMA_V
#undef BR_Q
#undef BR_K
#undef BR_V
#undef BR_O
}


__device__ __forceinline__ att::BlockRef attn_ref(Frame& F, int L) {
    const int ent = ((const int*)(F.ws + WS_ROUTE + RT_ALIST))[L]; const int u = ent & 0xffff, qb = u >> 4, bh = u & 15, b = bh >> 3, h = bh & 7;
    att::BlockRef r; r.base = __builtin_amdgcn_readfirstlane(b * SEQ * 1024 + h * 128);
    r.P0 = __builtin_amdgcn_readfirstlane(qb * 128); r.jlo = __builtin_amdgcn_readfirstlane(ent >> 16); r.slope2 = exp2f(-(float)(__builtin_amdgcn_readfirstlane(h) + 1)) * LOG2E;
    return r;
}
__device__ __forceinline__ void p2_attention(Frame& F) {
    const float s1 = wave_sum(F.a->in[I_LQ1][F.lane] * F.a->in[I_LK1][F.lane]), s2 = wave_sum(F.a->in[I_LQ2][F.lane] * F.a->in[I_LK2][F.lane]);
    const float lam = expf(s1) - expf(s2) + LAM_INIT;
    constexpr int NUNITS = 1024;
    volatile LAS int* qs = (volatile LAS int*)(F.lds + 143 * 1024);
    __syncthreads();
    const int v = (F.G % 8 == 0) ? (F.blk % 8) * (F.G / 8) + F.blk / 8 : F.blk;
    int L = v, Ln = 2 * F.G - 1 - v;
    if (L >= NUNITS) return;
    att::BlockRef cur = attn_ref(F, L); att::Seam S;
    { const att::DmaOff D0 = att::dma_offsets(F.wid, F.lane); att::attn_issue_first(F.ws, cur, F.ldsg, S, D0, F.wid, F.lane & 31, F.lane >> 5); }
    for (;;) {
        const bool last = Ln >= NUNITS;
        int nn = 0; if (F.tid == 0 && !last) nn = 2 * F.G + (int)atomicAdd(F.ctl + CW_AQ, 1u);
        const att::BlockRef nxt = last ? cur : attn_ref(F, Ln);
        att::attn_block(F.ws, cur, nxt, F.ldsg, S, lam, F.a->in[I_SUBG]);
        if (last) { asm volatile("s_waitcnt vmcnt(0)" ::: "memory"); __syncthreads(); break; }
        if (F.tid == 0) qs[0] = nn;
        __syncthreads();
        cur = nxt; Ln = qs[0];
        __syncthreads();
    }
}

__device__ __forceinline__ void p3_merged(Frame& F) {
    pg8::StaticOrder S; S.init(M, DM, F.G, F.blk);
    { pg8::Gemm g{(const bf16_t*)(F.ws + WS_YA), (const bf16_t*)(F.ws + WS_WUPT), DM, nullptr}; EpiGateT E{(const bf16_t*)F.out, (bf16_t*)(F.ws + WS_T)};
      pg8::gemm_phase<EpiGateT, pg8::StaticOrder, PG8_ALIGN, PG8_SP2, false>(F.lds, g, S, E); }
    { pg8::Gemm g{(const bf16_t*)(F.ws + WS_XN), (const bf16_t*)(F.ws + WS_WUPT) + 1024 * 1024, DM, nullptr}; EpiMerged E{(const bf16_t*)F.out, (const bf16_t*)(F.ws + WS_T), (bf16_t*)(F.ws + WS_Q)};
      pg8::gemm_phase<EpiMerged, pg8::StaticOrder, PG8_ALIGN, PG8_SP2, false>(F.lds, g, S, E); }
}
__device__ __forceinline__ void p4_out(Frame& F) {
    pg8::StaticOrder S; S.init(M, DM, F.G, F.blk);
    pg8::Gemm g{(const bf16_t*)(F.ws + WS_Q), (const bf16_t*)(F.ws + WS_WOUTT), DM, nullptr}; EpiOut E{F.a->in[I_X], F.out, F.a->in[I_N2G], (bf16_t*)(F.ws + WS_H2)};
    pg8::gemm_phase<EpiOut, pg8::StaticOrder, PG8_ALIGN, PG8_SP2, false>(F.lds, g, S, E);
}
__device__ __forceinline__ void h2_row(Frame& F, int t, f32x4 (&h)[4]) {
    const f32x4* xr = (const f32x4*)(F.out + (size_t)t * DM) + F.lane; const f32x4* g4 = (const f32x4*)F.a->in[I_N2G] + F.lane;
    float s = 0.f;
#pragma unroll
    for (int j = 0; j < 4; ++j) { h[j] = xr[64 * j]; s += (h[j][0] * h[j][0] + h[j][1] * h[j][1]) + (h[j][2] * h[j][2] + h[j][3] * h[j][3]); }
    const float r = rsqrtf(wave_sum(s) * (1.f / DM) + EPS);
#pragma unroll
    for (int j = 0; j < 4; ++j) h[j] = (h[j] * r) * g4[64 * j];
}
__device__ __forceinline__ void p5_router(Frame& F) {
    const float* WRT = (const float*)(F.ws + WS_ROUTE + RT_WRT); const float* brg = F.a->in[I_BRG]; const float* bre = F.a->in[I_BRE];
    int* tokpos = (int*)(F.ws + WS_ROUTE + RT_TOKPOS); float* roww = (float*)(F.ws + WS_ROUTE + RT_ROWW); float* rowrr = (float*)(F.ws + WS_ROUTE + RT_ROWRR); int* rowtok = (int*)(F.ws + WS_ROUTE + RT_ROWTOK);
    LAS float* lg = (LAS float*)(F.lds + 128 * 1024 + (F.wid & 3) * 3072);
    const int i16 = F.lane & 15, kq = F.lane >> 4;
    if (F.wid < 4)
    for (int task = F.blk * 4 + F.wid; task < M / 16; task += F.G * 4) { const int t0 = task * 16;
        const float* xp = F.out + (size_t)(t0 + i16) * DM + 4 * kq; const float* wp = WRT + (size_t)i16 * DM + 4 * kq;
        f32x4 acc0 = {0.f, 0.f, 0.f, 0.f}, acc1 = acc0, acc2 = acc0; float ss = 0.f;
#pragma unroll 4
        for (int s = 0; s < 64; ++s) { const f32x4 xa = *(const f32x4*)(xp + 16 * s);
            const f32x4 w0 = *(const f32x4*)(wp + 16 * s), w1 = *(const f32x4*)(wp + 16 * DM + 16 * s), w2 = *(const f32x4*)(wp + 32 * DM + 16 * s);
            ss += (xa[0] * xa[0] + xa[1] * xa[1]) + (xa[2] * xa[2] + xa[3] * xa[3]);
#pragma unroll
            for (int e = 0; e < 4; ++e) { acc0 = __builtin_amdgcn_mfma_f32_16x16x4f32(xa[e], w0[e], acc0, 0, 0, 0); acc1 = __builtin_amdgcn_mfma_f32_16x16x4f32(xa[e], w1[e], acc1, 0, 0, 0);
                acc2 = __builtin_amdgcn_mfma_f32_16x16x4f32(xa[e], w2[e], acc2, 0, 0, 0); } }
        ss += __shfl_xor(ss, 16); ss += __shfl_xor(ss, 32);
        const float rr = rsqrtf(ss * (1.f / DM) + EPS);
#pragma unroll
        for (int reg = 0; reg < 4; ++reg) { LAS float* p = lg + (4 * kq + reg) * 48 + i16; p[0] = acc0[reg]; p[16] = acc1[reg]; p[32] = acc2[reg]; }
        LDS_WAIT(); asm volatile("" ::: "memory");
        if (F.lane < 16) { const LAS float* p = lg + F.lane * 48;
            float gl[4];
#pragma unroll
            for (int i = 0; i < 4; ++i) gl[i] = p[i] * rr + brg[i];
            int g = 0; float gm = gl[0];
#pragma unroll
            for (int i = 1; i < 4; ++i) if (gl[i] > gm) { gm = gl[i]; g = i; }
            float gs = 0.f;
#pragma unroll
            for (int i = 0; i < 4; ++i) gs += expf(gl[i] - gm);
            const float ggate = 1.f / gs;
            float el[8];
#pragma unroll
            for (int i = 0; i < 8; ++i) el[i] = p[4 + g * 8 + i] * rr + bre[g * 8 + i];
            int i1 = 0; float v1 = el[0];
#pragma unroll
            for (int i = 1; i < 8; ++i) if (el[i] > v1) { v1 = el[i]; i1 = i; }
            int i2 = -1; float v2 = -__builtin_inff();
#pragma unroll
            for (int i = 0; i < 8; ++i) if (i != i1 && el[i] > v2) { v2 = el[i]; i2 = i; }
            const float a = expf(v2 - v1), w1 = 1.f / (1.f + a), w2 = a / (1.f + a);
            const int t = t0 + F.lane, e1 = g * 8 + i1, e2 = g * 8 + i2;
            const int r1 = (int)atomicAdd(F.ctl + CW_CNT + e1 * CW_CNT_STRIDE, 1u), r2 = (int)atomicAdd(F.ctl + CW_CNT + e2 * CW_CNT_STRIDE, 1u);
            rowtok[e1 * ECAP + r1] = t; roww[e1 * ECAP + r1] = ggate * w1; rowrr[e1 * ECAP + r1] = rr; rowtok[e2 * ECAP + r2] = t; roww[e2 * ECAP + r2] = ggate * w2; rowrr[e2 * ECAP + r2] = rr;
            tokpos[2 * t] = (e1 << ECAP_LOG) | r1; tokpos[2 * t + 1] = (e2 << ECAP_LOG) | r2; }
        LDS_WAIT(); asm volatile("" ::: "memory");
    }
    if (F.wid >= 4) {
      LAS float* scr = (LAS float*)(F.lds + (F.wid - 4) * 32768);
      bf16_t* W13T = (bf16_t*)(F.ws + WS_W13T); bf16_t* W2T = (bf16_t*)(F.ws + WS_W2T);
#define XW_SRC(it_) (((it_) % 384) < 128 ? F.a->in[I_W1] + (size_t)((it_) / 384) * 1024 * 256 : ((it_) % 384) < 256 ? F.a->in[I_W3] + (size_t)((it_) / 384) * 1024 * 256 : F.a->in[I_W2] + (size_t)((it_) / 384) * 256 * 1024)
#define XW_STORE(v_, it_, scr_) do { const int e_ = (it_) / 384, r_ = (it_) % 384; \
          if (r_ < 128) tr_store(v_, 256, W13T, 1024, 0, RmW13{e_ * 512}, scr_, r_, F.lane); \
          else if (r_ < 256) tr_store(v_, 256, W13T, 1024, 0, RmW13{e_ * 512 + 128}, scr_, r_ - 128, F.lane); \
          else tr_store(v_, 1024, W2T, 256, 0, RmAdd{e_ * 1024}, scr_, r_ - 256, F.lane); } while (0)
      const int stride = F.G * 4;
      for (int it = F.blk * 4 + (F.wid - 4); it < NE * 384; it += 2 * stride) { const int it2 = it + stride; const bool two = it2 < NE * 384;
          float va[32], vb[32];
          { const int r = it % 384; tr_load(XW_SRC(it), r < 256 ? 256 : 1024, r < 128 ? r : r < 256 ? r - 128 : r - 256, F.lane, va); }
          if (two) { const int r = it2 % 384; tr_load(XW_SRC(it2), r < 256 ? 256 : 1024, r < 128 ? r : r < 256 ? r - 128 : r - 256, F.lane, vb); }
          XW_STORE(va, it, scr);
          if (two) XW_STORE(vb, it2, scr + 64 * 33); }
#undef XW_SRC
#undef XW_STORE
    }
}
__device__ __forceinline__ void moe_offsets(Frame& F, LAS int* offs) {
    __syncthreads();
    if (F.tid < 64) { const int c = F.tid < NE ? (int)__hip_atomic_load(F.ctl + CW_CNT + F.tid * CW_CNT_STRIDE, __ATOMIC_RELAXED, __HIP_MEMORY_SCOPE_AGENT) : 0; const int p = (c + 255) & ~255; int incl = p;
#pragma unroll
        for (int o = 1; o < 32; o <<= 1) { const int v = __shfl_up(incl, o); if ((F.tid & 63) >= o) incl += v; }
        if (F.tid < NE) { offs[F.tid] = incl - p; offs[40 + F.tid] = c; for (int t = (incl - p) >> 8; t < (incl >> 8); ++t) offs[80 + t] = F.tid; } if (F.tid == NE - 1) offs[NE] = incl; }
    __syncthreads();
}
__device__ __forceinline__ int expert_of_row(LAS int* offs, int row) { return offs[80 + (row >> 8)]; }
__device__ __forceinline__ void moe_gemm1(Frame& F, LAS int* offs, int G, int c, int lo, int hi) {
    MoeOrder S{offs, 2, G, c, lo, hi};
    pg8::Gemm g{(const bf16_t*)(F.ws + WS_H2), (const bf16_t*)(F.ws + WS_W13T), DM, (const int*)(F.ws + WS_ROUTE + RT_ROWTOK)}; EpiSwiglu E{(const float*)(F.ws + WS_ROUTE + RT_ROWW), (const float*)(F.ws + WS_ROUTE + RT_ROWRR), (bf16_t*)(F.ws + WS_HID)};
    pg8::gemm_phase<EpiSwiglu, MoeOrder, PG8_ALIGN, PG8_SP2, false, true>(F.lds, g, S, E);
}
__device__ __forceinline__ void moe_gemm2(Frame& F, LAS int* offs, int G, int c, int lo, int hi) {
    MoeOrder S{offs, 4, G, c, lo, hi};
    int kde = DE; asm volatile("" : "+s"(kde));
    pg8::Gemm g{(const bf16_t*)(F.ws + WS_HID), (const bf16_t*)(F.ws + WS_W2T), kde, nullptr}; EpiY E{(bf16_t*)(F.ws + WS_YBUF)};
    pg8::gemm_phase<EpiY, MoeOrder, PG8_ALIGN, PG8_SP2, false>(F.lds, g, S, E);
}
__device__ __forceinline__ int moe_vblk(Frame& F) { return (F.G % 8 == 0) ? (F.blk % 8) * (F.G / 8) + F.blk / 8 : F.blk; }
__device__ __forceinline__ void p7_moe_a(Frame& F) {
    LAS int* offs = (LAS int*)(F.lds + 140 * 1024); moe_offsets(F, offs);
    const int n1 = (offs[NE] / 256) * 2;
    moe_gemm1(F, offs, F.G, moe_vblk(F), 0, n1 < F.G ? n1 : F.G);
}
__device__ __forceinline__ void p7_moe_b(Frame& F) {
    LAS int* offs = (LAS int*)(F.lds + 140 * 1024); moe_offsets(F, offs);
    const int T = offs[NE] / 256, n1 = T * 2; int nrem = n1 - F.G; if (nrem < 0) nrem = 0; if (nrem > F.G / 2) nrem = F.G / 2;
    const int t2 = (T < F.G / 2 ? T : F.G / 2) * 4;
    const int vb = moe_vblk(F);
    if (vb < nrem) moe_gemm1(F, offs, nrem, vb, F.G, n1);
    else moe_gemm2(F, offs, F.G - nrem, vb - nrem, 0, t2);
}
__device__ __forceinline__ void p8_moe_c(Frame& F) {
    LAS int* offs = (LAS int*)(F.lds + 140 * 1024); moe_offsets(F, offs);
    const int T = offs[NE] / 256;
    moe_gemm2(F, offs, F.G, moe_vblk(F), (T < F.G / 2 ? T : F.G / 2) * 4, T * 4);
}
__device__ __forceinline__ void p9_combine(Frame& F) {
    LAS int* offs = (LAS int*)(F.lds + 140 * 1024);
    moe_offsets(F, offs);
    const bf16_t* YB = (const bf16_t*)(F.ws + WS_YBUF); const int* tokpos = (const int*)(F.ws + WS_ROUTE + RT_TOKPOS);
    for (int t0 = F.gw * 4; t0 < M; t0 += F.NGW * 4) { int p[4][2];
#pragma unroll
        for (int q = 0; q < 4; ++q) { const int a0 = tokpos[2 * (t0 + q)], a1 = tokpos[2 * (t0 + q) + 1]; p[q][0] = offs[a0 >> ECAP_LOG] + (a0 & (ECAP - 1)); p[q][1] = offs[a1 >> ECAP_LOG] + (a1 & (ECAP - 1)); }
        f32x4 xv[4][4];
#pragma unroll
        for (int q = 0; q < 4; ++q)
#pragma unroll
            for (int j = 0; j < 4; ++j) xv[q][j] = __builtin_nontemporal_load((const f32x4*)(F.out + (size_t)(t0 + q) * DM) + F.lane + 64 * j);
#pragma unroll
        for (int q = 0; q < 4; ++q) {
            f32x4 a[4], b[4];
#pragma unroll
            for (int j = 0; j < 4; ++j) { a[j] = ld4(YB + (size_t)p[q][0] * DM + 4 * F.lane + 256 * j); b[j] = ld4(YB + (size_t)p[q][1] * DM + 4 * F.lane + 256 * j); }
#pragma unroll
            for (int j = 0; j < 4; ++j) __builtin_nontemporal_store(xv[q][j] + (a[j] + b[j]), (f32x4*)(F.out + (size_t)(t0 + q) * DM) + F.lane + 64 * j); } }
}

#define XB_TMO      128
#define XB_XCNT(j)  (256  + 64 * (j))
#define XB_XSUB(j)  (1280 + 64 * (j))
#define XB_XGEN(j)  (2304 + 64 * (j))
#define XB_TOP      3328
#define XB_TOPGEN   3392
#define XCD_BAR_WORDS 3456
#define XB_SPIN_CAP (1u << 22)

__device__ __forceinline__ unsigned xb_ld(unsigned* p)              { return __hip_atomic_load(p, __ATOMIC_RELAXED, __HIP_MEMORY_SCOPE_AGENT); }
__device__ __forceinline__ unsigned xb_add(unsigned* p, unsigned v) { return __hip_atomic_fetch_add(p, v, __ATOMIC_RELAXED, __HIP_MEMORY_SCOPE_AGENT); }
__device__ __forceinline__ unsigned xb_xcc_id() { return (unsigned)__builtin_amdgcn_s_getreg((3 << 11) | 20) & 0xFu; }
#define XB_SPIN(cond, bar) do { unsigned _sp = 0; while (cond) { __builtin_amdgcn_s_sleep(1); \
    if ((++_sp & 255u) == 0u) { if (xb_ld(&(bar)[XB_TMO])) break; if (_sp > XB_SPIN_CAP) { atomicAdd(&(bar)[XB_TMO], 1u); break; } } } } while (0)

struct XcdBarrier {
    unsigned* bar; unsigned x;
    volatile LAS unsigned* st;
};

__device__ __forceinline__ XcdBarrier xcd_barrier_post(unsigned* bar, volatile LAS unsigned* st) {
    XcdBarrier b; b.bar = bar; b.x = xb_xcc_id(); b.st = st;
    if (threadIdx.x == 0) (void)xb_add(&bar[XB_XCNT(b.x)], 1u);
    return b;
}
__device__ __forceinline__ void xcd_barrier_complete(unsigned* bar, unsigned x, unsigned& nloc, unsigned& nx) {
    const unsigned G = gridDim.x * gridDim.y * gridDim.z;
    unsigned sum, cnt, mine, sp = 0u;
    for (;;) {
        sum = 0u; cnt = 0u; mine = 0u;
#pragma unroll
        for (unsigned j = 0; j < 16; ++j) { const unsigned c = xb_ld(&bar[XB_XCNT(j)]); sum += c; cnt += (c > 0u) ? 1u : 0u; mine = (j == x) ? c : mine; }
        if (sum == G) break;
        __builtin_amdgcn_s_sleep(1);
        if ((++sp & 255u) == 0u) { if (xb_ld(&bar[XB_TMO])) break; if (sp > XB_SPIN_CAP) { atomicAdd(&bar[XB_TMO], 1u); break; } }
    }
    nloc = mine > 0u ? mine : 1u; nx = cnt > 0u ? cnt : 1u;
}

__device__ __forceinline__ void xcd_barrier(const XcdBarrier& b) {
    asm volatile("s_waitcnt vmcnt(0)" ::: "memory");
    __syncthreads();
    if (threadIdx.x == 0) {
        unsigned* bar = b.bar;
        __builtin_amdgcn_s_waitcnt(0);
        unsigned nloc = b.st[0], nx = b.st[1];
        if (nloc == 0u) { xcd_barrier_complete(bar, b.x, nloc, nx); b.st[0] = nloc; b.st[1] = nx; }
        const unsigned old = xb_add(&bar[XB_XSUB(b.x)], 1u);
        const unsigned gen = old / nloc;
        if (old + 1u == (gen + 1u) * nloc) {
            __builtin_amdgcn_fence(__ATOMIC_RELEASE, "agent");
            asm volatile("s_waitcnt vmcnt(0)" ::: "memory");
            const unsigned og = xb_add(&bar[XB_TOP], 1u);
            const unsigned tg = og / nx;
            if (og + 1u == (tg + 1u) * nx) xb_add(&bar[XB_TOPGEN], 1u);
            else XB_SPIN(xb_ld(&bar[XB_TOPGEN]) == tg, bar);
            __builtin_amdgcn_fence(__ATOMIC_ACQUIRE, "agent");
            xb_add(&bar[XB_XGEN(b.x)], 1u);
            asm volatile("s_waitcnt vmcnt(0)" ::: "memory");
        } else {
            XB_SPIN(xb_ld(&bar[XB_XGEN(b.x)]) == gen, bar);
            __builtin_amdgcn_fence(__ATOMIC_ACQUIRE, "agent");
            asm volatile("s_waitcnt vmcnt(0)" ::: "memory");
        }
    }
    __syncthreads();
}
constexpr int LDS_BYTES = 147456;
__global__ void __launch_bounds__(NTHREADS, 2) fwd_kernel(Args args) {
    extern __shared__ __attribute__((aligned(16))) unsigned char lds[];
    Frame F;
    F.lds = (LAS unsigned char*)lds; F.ldsg = (char*)lds;
    F.tid = threadIdx.x; F.lane = F.tid & 63; F.wid = __builtin_amdgcn_readfirstlane(F.tid >> 6);
    F.blk = blockIdx.x; F.G = gridDim.x; F.gw = F.blk * NWAVES + F.wid; F.NGW = F.G * NWAVES;
    F.a = &args;
    F.out = args.out; F.ws = args.ws; F.ctl = (unsigned*)(args.ws + WS_CTL);
    const int lo = args.ph_lo, hi = args.ph_hi;
#if MK_ONE_LAUNCH
    cg::grid_group grid = cg::this_grid();
    volatile LAS unsigned* bst = (volatile LAS unsigned*)(F.lds + 144 * 1024 - 16);
    if (F.tid < 2) bst[F.tid] = 0u;
    __syncthreads();
    const XcdBarrier bar = xcd_barrier_post(F.ctl + CW_BAR, bst);
#define SEAM(k) do { if (lo <= (k) && (k) + 1 < hi) { xcd_barrier(bar); } asm volatile("" : "+v"(F.tid), "+v"(F.lane)); } while (0)
    if (hi > NPHASE) grid.sync();
#else
#define SEAM(k) do { } while (0)
#endif
#define IN(k) (lo <= (k) && (k) < hi)
    if (IN(0)) { p0_prologue(F); } SEAM(0);
    if (IN(1)) { p1_proj(F); } SEAM(1);
    if (IN(2)) { p2_mixer_a(F); p2_attention(F); } SEAM(2);
    if (IN(3)) { p3_merged(F); } SEAM(3);
    if (IN(4)) { p4_out(F); } SEAM(4);
    if (IN(5)) { p5_router(F); } SEAM(5);
    if (IN(6)) { p7_moe_a(F); } SEAM(6);
    if (IN(7)) { p7_moe_b(F); } SEAM(7);
    if (IN(8)) { p8_moe_c(F); } SEAM(8);
    if (IN(9)) { p9_combine(F); }
#undef IN
#undef SEAM
}

extern "C" void kernel_launch(void* const* d_in, const int* in_sizes, int n_in, void* d_out, int out_size, void* d_ws, size_t ws_size, hipStream_t stream) {
    static int grid = 0;
    if (grid == 0) {
        if (n_in != 26 || out_size != M * DM || ws_size < WS_END) { fprintf(stderr, "kernel_launch: unexpected shapes (n_in %d out %d ws %zu)\n", n_in, out_size, ws_size); grid = -1; return; }
        int dev = 0, cus = 0, per_cu = 0;
        (void)hipGetDevice(&dev); (void)hipDeviceGetAttribute(&cus, hipDeviceAttributeMultiprocessorCount, dev);
        if (hipFuncSetAttribute((const void*)fwd_kernel, hipFuncAttributeMaxDynamicSharedMemorySize, LDS_BYTES) != hipSuccess) { fprintf(stderr, "kernel_launch: hipFuncSetAttribute failed\n"); grid = -1; return; }
        if (hipOccupancyMaxActiveBlocksPerMultiprocessor(&per_cu, (const void*)fwd_kernel, NTHREADS, LDS_BYTES) != hipSuccess || per_cu < 1) { fprintf(stderr, "kernel_launch: occupancy query says %d\n", per_cu); per_cu = 1; }
        (void)hipGetLastError();
        grid = cus;
    }
    if (grid < 0) return;
    (void)hipMemsetAsync((char*)d_ws + WS_CTL, 0, CTL_ZERO_BYTES, stream);
    Args a{};
    for (int i = 0; i < 26; ++i) a.in[i] = (const float*)d_in[i];
    a.out = (float*)d_out; a.ws = (unsigned char*)d_ws;
#if MK_ONE_LAUNCH
    a.ph_lo = 0; a.ph_hi = NPHASE;
    void* kargs[] = {&a};
    hipError_t e = hipLaunchCooperativeKernel((const void*)fwd_kernel, dim3(grid), dim3(NTHREADS), kargs, LDS_BYTES, stream);
    if (e != hipSuccess) fprintf(stderr, "cooperative launch failed: %s (grid %d)\n", hipGetErrorString(e), grid);
#else
    for (int p = 0; p < NPHASE; ++p) { a.ph_lo = p; a.ph_hi = p + 1; hipLaunchKernelGGL(fwd_kernel, dim3(grid), dim3(NTHREADS), LDS_BYTES, stream, a); }
#endif
}
```

```cpp
#include <hip/hip_runtime.h>
#include <hip/hip_cooperative_groups.h>
#include <cstdio>
#include <cstdint>
namespace cg = cooperative_groups;

#ifndef MK_ONE_LAUNCH
#define MK_ONE_LAUNCH 1
#endif

#define LAS __attribute__((address_space(3)))
typedef unsigned short bf16_t;
typedef short bf16x8 __attribute__((ext_vector_type(8)));
typedef short s16x4 __attribute__((ext_vector_type(4)));
typedef float f32x4 __attribute__((ext_vector_type(4)));
typedef float f32x16 __attribute__((ext_vector_type(16)));
typedef float f32x2 __attribute__((ext_vector_type(2)));
typedef unsigned u32x4 __attribute__((ext_vector_type(4)));
typedef unsigned u32x2 __attribute__((ext_vector_type(2)));
typedef __bf16 bf16x2_t __attribute__((ext_vector_type(2)));

constexpr int NB = 2, SEQ = 8192, DM = 1024, M = NB * SEQ;
constexpr int NH = 8;
constexpr int N1 = 7168;
constexpr int NE = 32, DE = 256;
constexpr float EPS = 1e-6f;
constexpr float LOG2E = 1.4426950408889634f;
constexpr float C2 = 0.125f * LOG2E;
constexpr float LAM_INIT = 0.2f;
constexpr int NWAVES = 8, NTHREADS = 512;
constexpr int NPHASE = 10;
constexpr int ECAP = 16384, ECAP_LOG = 14;

constexpr size_t MiB = 1u << 20;
constexpr size_t WS_CTL = 0;
constexpr size_t CTL_ZERO_BYTES = 65536;
constexpr int CW_DONE = 16000;
__device__ unsigned g_ctl[CTL_ZERO_BYTES / 4];
constexpr size_t WS_W1T = 1 * MiB;
constexpr size_t WS_WUPT = 15 * MiB;
constexpr size_t WS_WOUTT = 19 * MiB;
constexpr size_t WS_WST = 21 * MiB;
constexpr size_t WS_ROUTE = 22 * MiB;
constexpr size_t WS_XN = 32 * MiB;
constexpr size_t WS_U = 64 * MiB;
constexpr size_t WS_VA = 96 * MiB;
constexpr size_t WS_Q = 128 * MiB;
constexpr size_t WS_K = 160 * MiB;
constexpr size_t WS_VB = 192 * MiB;
constexpr size_t WS_W13T = 160 * MiB;
constexpr size_t WS_W2T = 192 * MiB;
constexpr size_t WS_HID = 208 * MiB;
constexpr size_t WS_H2 = 32 * MiB;
constexpr size_t WS_YBUF = 64 * MiB;
constexpr size_t WS_YA = 224 * MiB;
constexpr size_t WS_T = 64 * MiB;
constexpr size_t WS_END = 256 * MiB;
constexpr size_t RT_TOKE = 0, RT_TOKW = 256 * 1024, RT_TOKPOS = 512 * 1024, RT_WRT = 1024 * 1024, RT_ALIST = 1536 * 1024, RT_ROWTOK = 2048 * 1024, RT_ROWW = 4096 * 1024, RT_ROWRR = 6144 * 1024;
constexpr int CW_CNT = 8192, CW_CNT_STRIDE = 64, CW_AQ = 512, CW_BAR = 1024;

#define LDS_WAIT() asm volatile("s_waitcnt lgkmcnt(0)" ::: "memory")
#define SBAR() __builtin_amdgcn_sched_barrier(0)
__device__ __forceinline__ unsigned cvtpk(float lo, float hi) { f32x2 v = {lo, hi}; bf16x2_t b = __builtin_convertvector(v, bf16x2_t); return __builtin_bit_cast(unsigned, b); }
__device__ __forceinline__ float bf2f(short b) { return __uint_as_float(((unsigned)(unsigned short)b) << 16); }
__device__ __forceinline__ float wave_sum(float v) {
#pragma unroll
    for (int o = 1; o < 64; o <<= 1) v += __shfl_xor(v, o);
    return v;
}
__device__ __forceinline__ void st4(bf16_t* p, f32x4 v) { u32x2 w; w.x = cvtpk(v[0], v[1]); w.y = cvtpk(v[2], v[3]); *(u32x2*)p = w; }
__device__ __forceinline__ f32x4 ld4(const bf16_t* p) { const u32x2 w = *(const u32x2*)p; f32x4 r; r[0] = __uint_as_float(w.x << 16); r[1] = __uint_as_float(w.x & 0xffff0000u); r[2] = __uint_as_float(w.y << 16); r[3] = __uint_as_float(w.y & 0xffff0000u); return r; }

struct Args { const float* in[26]; float* out; unsigned char* ws; int ph_lo, ph_hi; };

struct Frame {
    LAS unsigned char* lds; char* ldsg;
    int tid, lane, wid, blk, G, gw, NGW;
    const Args* a; float* out; unsigned char* ws; unsigned* ctl;
};
enum { I_X = 0, I_N1G, I_WIN, I_VNG, I_WS, I_BS, I_QNG, I_KNG, I_LQ1, I_LK1, I_LQ2, I_LK2, I_SUBG, I_WUPA, I_WUPB, I_WGATE, I_BGATE, I_WOUT, I_N2G, I_WRG, I_BRG, I_WRE, I_BRE, I_W1, I_W3, I_W2 };

__device__ __forceinline__ void wave_gemm(f32x4 (&acc)[2][4], const bf16_t* ap0, const bf16_t* ap1, const bf16_t* bp0, const bf16_t* bp1, const bf16_t* bp2, const bf16_t* bp3, int K) {
#pragma unroll 2
    for (int k0 = 0; k0 < K; k0 += 32) {
        const bf16x8 a0 = *(const bf16x8*)(ap0 + k0), a1 = *(const bf16x8*)(ap1 + k0);
        const bf16x8 b0 = *(const bf16x8*)(bp0 + k0), b1 = *(const bf16x8*)(bp1 + k0), b2 = *(const bf16x8*)(bp2 + k0), b3 = *(const bf16x8*)(bp3 + k0);
        acc[0][0] = __builtin_amdgcn_mfma_f32_16x16x32_bf16(b0, a0, acc[0][0], 0, 0, 0);
        acc[0][1] = __builtin_amdgcn_mfma_f32_16x16x32_bf16(b1, a0, acc[0][1], 0, 0, 0);
        acc[0][2] = __builtin_amdgcn_mfma_f32_16x16x32_bf16(b2, a0, acc[0][2], 0, 0, 0);
        acc[0][3] = __builtin_amdgcn_mfma_f32_16x16x32_bf16(b3, a0, acc[0][3], 0, 0, 0);
        acc[1][0] = __builtin_amdgcn_mfma_f32_16x16x32_bf16(b0, a1, acc[1][0], 0, 0, 0);
        acc[1][1] = __builtin_amdgcn_mfma_f32_16x16x32_bf16(b1, a1, acc[1][1], 0, 0, 0);
        acc[1][2] = __builtin_amdgcn_mfma_f32_16x16x32_bf16(b2, a1, acc[1][2], 0, 0, 0);
        acc[1][3] = __builtin_amdgcn_mfma_f32_16x16x32_bf16(b3, a1, acc[1][3], 0, 0, 0);
    }
}
__device__ __forceinline__ void acc_zero(f32x4 (&acc)[2][4]) {
#pragma unroll
    for (int m = 0; m < 2; ++m)
#pragma unroll
        for (int n = 0; n < 4; ++n) acc[m][n] = (f32x4){0.f, 0.f, 0.f, 0.f};
}

namespace pg8 {
#define PG8_LAS __attribute__((address_space(3)))
constexpr int BM = 256, BK = 64, HALF = 128, HTB = HALF * BK * 2  , STAGE_BYTES = 8 * HTB, NXCD = 8, WGM = 4;

__host__ __device__ __forceinline__ int lds_byte(int r, int c) { const int st = (r >> 4) * 2 + (c >> 5), rr = r & 15, cc = c & 31, ob = rr * 64 + cc * 2; return st * 1024 + (ob ^ (((ob >> 9) & 1) << 5)); }
__host__ __device__ __forceinline__ void stage_rc(int b, int& R, int& C) { const int st = b / 1024, sb = b % 1024, swz = sb ^ (((sb >> 9) & 1) << 5); R = (st >> 1) * 16 + swz / 64; C = (st & 1) * 32 + (swz % 64) / 2; }
__host__ __device__ __forceinline__ int perm32(int rho) { const int n = rho >> 4, i = rho & 15; return 8 * (i >> 2) + 4 * n + (i & 3); }

struct Unit { int pm, pn, pb, rbase, nvalid; };
struct Gemm { const bf16_t* A; const bf16_t* Bt; int K; const int* rowtok; };

struct StaticOrder {
    int nM, nN, nwg, G, c;
    __host__ __device__ void init(int M, int N, int G_, int c_) { nM = M / BM; nN = N / BM; nwg = nM * nN; G = G_; c = c_; }
    __host__ __device__ bool next(int i, Unit& u) const {
        const long L = (long)i * G + c; if (L >= nwg) return false;
        int wgid = (int)L; { const int q = nwg / NXCD, r = nwg % NXCD, xcd = wgid % NXCD, off = wgid / NXCD; wgid = (xcd < r ? xcd * (q + 1) : r * (q + 1) + (xcd - r) * q) + off; }
        const int nig = WGM * nN, gid = wgid / nig, fm = gid * WGM, gsz = (nM - fm) < WGM ? (nM - fm) : WGM;
        u.pm = fm + ((wgid % nig) % gsz); u.pn = (wgid % nig) / gsz; u.pb = u.pn; u.rbase = 0; u.nvalid = 0; return true;
    }
    __device__ __forceinline__ void a_ready(const Unit&) const {}
    __device__ __forceinline__ void done(const Unit&) const {}
};
template <class Epi, class Sched, bool ALIGN_EPI = false, bool SP2 = false, bool BP64 = false, bool GATHER = false>
__device__ __forceinline__ void gemm_phase(PG8_LAS unsigned char* lds, const Gemm g, const Sched& S, const Epi& E) {
    const int tid = threadIdx.x, wid = __builtin_amdgcn_readfirstlane(tid >> 6), lane = tid & 63, wr = wid >> 2, wc = wid & 3, fr = lane & 15, fq = lane >> 4;
    const int K = g.K, nt = K / BK;
    unsigned voffA[2], voffB[2];
#pragma unroll
    for (int i = 0; i < 2; ++i) { int R, C; stage_rc(tid * 16 + i * 8192, R, C); const int Rp = Epi::PERM ? ((R & ~31) + perm32(R & 31)) : R; const int Rb = BP64 ? (64 * (Rp >> 5) + (Rp & 31)) : Rp;
        voffA[i] = (unsigned)(R * K + C) * 2u; voffB[i] = (unsigned)(Rb * K + C) * 2u; }
    const size_t kstep = (size_t)(BK * 2);
    const size_t hstep = (size_t)HALF * K * 2;
    const size_t tstep = 2 * hstep;
    const size_t bhs = BP64 ? (size_t)32 * K * 2 : hstep;
    const unsigned ldsw = (unsigned)wid * 1024u;
    const int aoff = lds_byte(wr * 64 + fr, fq * 8), boff = lds_byte(wc * 32 + fr, fq * 8);
#define PG8_SA(b, h) (((b) * 2 + (h)) * HTB)
#define PG8_SB(b, h) ((4 + (b) * 2 + (h)) * HTB)
#define PG8_STAGE(bufoff, gbase, voff) do { _Pragma("unroll") for (int _i = 0; _i < 2; ++_i) \
        __builtin_amdgcn_global_load_lds((const unsigned*)((const char*)(gbase) + (voff)[_i]), (PG8_LAS unsigned*)(lds + (bufoff) + ldsw + _i * 8192), 16, 0, 0); } while (0)
#define PG8_LDA(dst, b, h) do { _Pragma("unroll") for (int m = 0; m < 4; ++m) _Pragma("unroll") for (int k = 0; k < 2; ++k) dst[m][k] = *(const PG8_LAS bf16x8*)(lds + PG8_SA(b, h) + aoff + m * 2048 + k * 1024); } while (0)
#define PG8_LDB(dst, b, h) do { _Pragma("unroll") for (int n = 0; n < 2; ++n) _Pragma("unroll") for (int k = 0; k < 2; ++k) dst[n][k] = *(const PG8_LAS bf16x8*)(lds + PG8_SB(b, h) + boff + n * 2048 + k * 1024); } while (0)
#define PG8_MMA(ai, bj, At, Bt) do { __builtin_amdgcn_s_setprio(1); _Pragma("unroll") for (int m = 0; m < 4; ++m) _Pragma("unroll") for (int n = 0; n < 2; ++n) _Pragma("unroll") for (int k = 0; k < 2; ++k) \
        acc[ai][bj][m][n] = __builtin_amdgcn_mfma_f32_16x16x32_bf16(Bt[n][k], At[m][k], acc[ai][bj][m][n], 0, 0, 0); __builtin_amdgcn_s_setprio(0); } while (0)
#define PG8_WAIT_V(n) asm volatile("s_waitcnt vmcnt(" #n ")" ::: "memory")
#define PG8_WAIT_L(n) asm volatile("s_waitcnt lgkmcnt(" #n ")" ::: "memory")
#define PG8_BAR __builtin_amdgcn_s_barrier()
#define PG8_SCHED __builtin_amdgcn_sched_barrier(0)
    Unit cur, nxt; int ui = 0;
    if (!S.next(0, cur)) return;
    static_assert(!GATHER || SP2, "GATHER is written for the SP2 loop");
    unsigned vA0[2] = {0u, 0u}, vA1[2] = {0u, 0u}, nvA0[2] = {0u, 0u}, nvA1[2] = {0u, 0u};
#define PG8_GLOAD(u_, d0_, d1_) do { _Pragma("unroll") for (int _i = 0; _i < 2; ++_i) { int R_, C_; stage_rc(tid * 16 + _i * 8192, R_, C_); \
        const int t0_ = R_ < (u_).nvalid ? g.rowtok[(u_).rbase + R_] : 0, t1_ = HALF + R_ < (u_).nvalid ? g.rowtok[(u_).rbase + HALF + R_] : 0; d0_[_i] = (unsigned)(t0_ * K + C_) * 2u; d1_[_i] = (unsigned)(t1_ * K + C_) * 2u; } } while (0)
#define PG8_STAGE_A(bufoff, ptr, half, vcur0, vcur1) do { if constexpr (GATHER) { PG8_STAGE(bufoff, ptr, (half) ? vcur1 : vcur0); } else { PG8_STAGE(bufoff, (ptr) + ((half) ? hstep : (size_t)0), voffA); } } while (0)
    if constexpr (GATHER) PG8_GLOAD(cur, vA0, vA1);
    f32x4 acc[2][2][4][2];
#pragma unroll
    for (int a = 0; a < 2; ++a)
#pragma unroll
        for (int b = 0; b < 2; ++b)
#pragma unroll
            for (int m = 0; m < 4; ++m)
#pragma unroll
                for (int n = 0; n < 2; ++n) acc[a][b][m][n] = (f32x4){0.f, 0.f, 0.f, 0.f};
    bf16x8 At[4][2], B0[2][2], B1[2][2];
    const char* cA = (const char*)g.A + (GATHER ? (size_t)0 : (size_t)cur.pm * tstep); const char* cB = (const char*)g.Bt + (size_t)cur.pb * tstep;
    S.a_ready(cur);
    if constexpr (SP2) {
        PG8_STAGE(PG8_SB(0, 0), cB, voffB); PG8_STAGE(PG8_SB(0, 1), cB + bhs, voffB); PG8_STAGE_A(PG8_SA(0, 0), cA, 0, vA0, vA1); PG8_STAGE_A(PG8_SA(0, 1), cA, 1, vA0, vA1);
        if (wr == 1) PG8_BAR;
        PG8_WAIT_V(2); PG8_BAR;
        PG8_STAGE(PG8_SB(1, 0), cB + kstep, voffB); PG8_STAGE_A(PG8_SA(1, 0), cA + kstep, 0, vA0, vA1); PG8_STAGE(PG8_SB(1, 1), cB + bhs + kstep, voffB);
        PG8_WAIT_V(6); PG8_BAR;
    } else {
        PG8_STAGE(PG8_SB(0, 0), cB, voffB); PG8_STAGE(PG8_SA(0, 0), cA, voffA); PG8_STAGE(PG8_SB(0, 1), cB + bhs, voffB); PG8_STAGE(PG8_SA(0, 1), cA + hstep, voffA);
        if (wr == 1) PG8_BAR;
        PG8_WAIT_V(4); PG8_BAR;
        PG8_STAGE(PG8_SB(1, 0), cB + kstep, voffB); PG8_STAGE(PG8_SA(1, 0), cA + kstep, voffA); PG8_STAGE(PG8_SB(1, 1), cB + bhs + kstep, voffB);
        PG8_WAIT_V(6); PG8_BAR;
    }
    for (;;) {
        const bool has_next = S.next(ui + 1, nxt);
        const char* nA = (has_next && !GATHER) ? (const char*)g.A + (size_t)nxt.pm * tstep : cA; const char* nB = has_next ? (const char*)g.Bt + (size_t)nxt.pb * tstep : cB;
        if constexpr (GATHER) { if (has_next) { PG8_GLOAD(nxt, nvA0, nvA1); } else { nvA0[0] = vA0[0]; nvA0[1] = vA0[1]; nvA1[0] = vA1[0]; nvA1[1] = vA1[1]; } }
        for (int t = 0; t < nt; t += 2) {
            const bool last = (t == nt - 2);
            const char* a1 = cA + (size_t)(t + 1) * kstep;
            const char* a2 = last ? nA : cA + (size_t)(t + 2) * kstep; const char* b2 = last ? nB : cB + (size_t)(t + 2) * kstep;
            const char* a3 = a2 + kstep; const char* b3 = b2 + kstep;
            if (last && has_next) S.a_ready(nxt);
            unsigned xA0[2], xA1[2];
            if constexpr (GATHER) { xA0[0] = last ? nvA0[0] : vA0[0]; xA0[1] = last ? nvA0[1] : vA0[1]; xA1[0] = last ? nvA1[0] : vA1[0]; xA1[1] = last ? nvA1[1] : vA1[1]; }
            if constexpr (SP2) {
            PG8_LDB(B0, 0, 0); PG8_LDB(B1, 0, 1); PG8_SCHED; PG8_LDA(At, 0, 0); PG8_STAGE_A(PG8_SA(1, 1), a1, 1, vA0, vA1);
            PG8_WAIT_V(8); PG8_WAIT_L(0); PG8_BAR; PG8_MMA(0, 0, At, B0); PG8_MMA(0, 1, At, B1); PG8_BAR; PG8_SCHED;
            PG8_LDA(At, 0, 1); PG8_STAGE(PG8_SB(0, 0), b2, voffB); PG8_STAGE(PG8_SB(0, 1), b2 + bhs, voffB); PG8_STAGE_A(PG8_SA(0, 0), a2, 0, xA0, xA1);
            PG8_WAIT_V(8); PG8_WAIT_L(0); PG8_BAR; PG8_MMA(1, 0, At, B0); PG8_MMA(1, 1, At, B1); PG8_BAR; PG8_SCHED;
            PG8_LDB(B0, 1, 0); PG8_LDB(B1, 1, 1); PG8_SCHED; PG8_LDA(At, 1, 0); PG8_STAGE_A(PG8_SA(0, 1), a2, 1, xA0, xA1);
            PG8_WAIT_V(8); PG8_WAIT_L(0); PG8_BAR; PG8_MMA(0, 0, At, B0); PG8_MMA(0, 1, At, B1); PG8_BAR; PG8_SCHED;
            PG8_LDA(At, 1, 1); PG8_STAGE(PG8_SB(1, 0), b3, voffB); PG8_STAGE(PG8_SB(1, 1), b3 + bhs, voffB); PG8_STAGE_A(PG8_SA(1, 0), a3, 0, xA0, xA1);
            PG8_WAIT_V(8); PG8_WAIT_L(0); PG8_BAR; PG8_MMA(1, 0, At, B0); PG8_MMA(1, 1, At, B1); PG8_BAR; PG8_SCHED;
            } else {
            PG8_LDB(B0, 0, 0); PG8_SCHED; PG8_LDA(At, 0, 0); PG8_STAGE(PG8_SA(1, 1), a1 + hstep, voffA);
            PG8_WAIT_L(8); PG8_BAR; PG8_WAIT_L(0); PG8_MMA(0, 0, At, B0); PG8_BAR; PG8_SCHED;
            PG8_LDB(B1, 0, 1); PG8_STAGE(PG8_SB(0, 0), b2, voffB);
            PG8_BAR; PG8_WAIT_L(0); PG8_MMA(0, 1, At, B1); PG8_BAR;
            PG8_LDA(At, 0, 1); PG8_STAGE(PG8_SA(0, 0), a2, voffA);
            PG8_BAR; PG8_WAIT_L(0); PG8_MMA(1, 0, At, B0); PG8_BAR; PG8_SCHED;
            PG8_STAGE(PG8_SB(0, 1), b2 + bhs, voffB);
            PG8_WAIT_V(6); PG8_BAR; PG8_MMA(1, 1, At, B1); PG8_BAR;
            PG8_LDB(B0, 1, 0); PG8_SCHED; PG8_LDA(At, 1, 0); PG8_STAGE(PG8_SA(0, 1), a2 + hstep, voffA);
            PG8_WAIT_L(8); PG8_BAR; PG8_WAIT_L(0); PG8_MMA(0, 0, At, B0); PG8_BAR; PG8_SCHED;
            PG8_LDB(B1, 1, 1); PG8_STAGE(PG8_SB(1, 0), b3, voffB);
            PG8_BAR; PG8_WAIT_L(0); PG8_MMA(0, 1, At, B1); PG8_BAR;
            PG8_LDA(At, 1, 1); PG8_STAGE(PG8_SA(1, 0), a3, voffA);
            PG8_BAR; PG8_WAIT_L(0); PG8_MMA(1, 0, At, B0); PG8_BAR; PG8_SCHED;
            PG8_STAGE(PG8_SB(1, 1), b3 + bhs, voffB);
            PG8_WAIT_V(6); PG8_BAR; PG8_MMA(1, 1, At, B1); PG8_BAR;
            }
        }
        if constexpr (ALIGN_EPI) { if (wr == 0) PG8_BAR; }
        if constexpr (!Epi::AFTER_DRAIN) { E(acc, cur, wr, wc, fr, fq); S.done(cur); }
        if (!has_next) break;
#pragma unroll
        for (int a = 0; a < 2; ++a)
#pragma unroll
            for (int b = 0; b < 2; ++b)
#pragma unroll
                for (int m = 0; m < 4; ++m)
#pragma unroll
                    for (int n = 0; n < 2; ++n) acc[a][b][m][n] = (f32x4){0.f, 0.f, 0.f, 0.f};
        cur = nxt; cA = nA; cB = nB; ++ui;
        if constexpr (GATHER) { vA0[0] = nvA0[0]; vA0[1] = nvA0[1]; vA1[0] = nvA1[0]; vA1[1] = nvA1[1]; }
        if constexpr (ALIGN_EPI) { if (wr == 1) PG8_BAR; }
    }
    PG8_WAIT_V(0);
    if constexpr (!ALIGN_EPI) { if (wr == 0) PG8_BAR; }
    PG8_BAR;
    if constexpr (Epi::AFTER_DRAIN) { E.fused(acc, cur, wr, wc, fr, fq, lds, wid, lane); S.done(cur); }
#undef PG8_GLOAD
#undef PG8_STAGE_A
#undef PG8_SA
#undef PG8_SB
#undef PG8_STAGE
#undef PG8_LDA
#undef PG8_LDB
#undef PG8_MMA
#undef PG8_WAIT_V
#undef PG8_WAIT_L
#undef PG8_BAR
#undef PG8_SCHED
}
}

#define PG8_SP2 true
#define PG8_ALIGN true
__device__ __forceinline__ void st8nt(bf16_t* p, f32x4 a, f32x4 b) { u32x4 w; w.x = cvtpk(a[0], a[1]); w.y = cvtpk(a[2], a[3]); w.z = cvtpk(b[0], b[1]); w.w = cvtpk(b[2], b[3]); __builtin_nontemporal_store(w, (u32x4*)p); }
__device__ __forceinline__ void st8(bf16_t* p, f32x4 a, f32x4 b) { u32x4 w; w.x = cvtpk(a[0], a[1]); w.y = cvtpk(a[2], a[3]); w.z = cvtpk(b[0], b[1]); w.w = cvtpk(b[2], b[3]); *(u32x4*)p = w; }
__device__ __forceinline__ void ld8(const bf16_t* p, f32x4& a, f32x4& b) { const u32x4 w = *(const u32x4*)p;
    a[0] = __uint_as_float(w.x << 16); a[1] = __uint_as_float(w.x & 0xffff0000u); a[2] = __uint_as_float(w.y << 16); a[3] = __uint_as_float(w.y & 0xffff0000u);
    b[0] = __uint_as_float(w.z << 16); b[1] = __uint_as_float(w.z & 0xffff0000u); b[2] = __uint_as_float(w.w << 16); b[3] = __uint_as_float(w.w & 0xffff0000u); }
struct EpiProj {
    static constexpr bool PERM = true, AFTER_DRAIN = false;
    unsigned char* ws; bf16_t* GATE; const float *qg, *kg, *bgate;
    __device__ __forceinline__ void operator()(const f32x4 (&acc)[2][2][4][2], const pg8::Unit& u, int wr, int wc, int fr, int fq) const {
        asm volatile("" : "+v"(fr), "+v"(fq));
        const int seg = u.pn >> 2;
        const int row0 = u.pm * 256 + wr * 64 + fr;
        const int cw = (u.pn & 3) * 256 + wc * 64 + 8 * fq;
        if (seg <= 1 || seg == 4) { bf16_t* dst = (bf16_t*)(ws + WS_U + (size_t)seg * (32 * MiB)) + cw;
#pragma unroll
            for (int ai = 0; ai < 2; ++ai)
#pragma unroll
                for (int m = 0; m < 4; ++m) { bf16_t* rp = dst + (size_t)(row0 + ai * 128 + m * 16) * DM;
#pragma unroll
                    for (int bj = 0; bj < 2; ++bj) st8nt(rp + 32 * bj, acc[ai][bj][m][0], acc[ai][bj][m][1]); }
        } else if (seg == 2 || seg == 3) { const float* g = (seg == 2 ? qg : kg) + 8 * fq; bf16_t* dst = (bf16_t*)(ws + WS_U + (size_t)seg * (32 * MiB)) + cw; const float sc = seg == 2 ? C2 : 1.f;
            f32x4 gv[2][2];
#pragma unroll
            for (int bj = 0; bj < 2; ++bj)
#pragma unroll
                for (int n = 0; n < 2; ++n) gv[bj][n] = *(const f32x4*)(g + 32 * bj + 4 * n) * sc;
#pragma unroll
            for (int ai = 0; ai < 2; ++ai)
#pragma unroll
                for (int m = 0; m < 4; ++m) { float ss = 0.f;
#pragma unroll
                    for (int bj = 0; bj < 2; ++bj)
#pragma unroll
                        for (int n = 0; n < 2; ++n) { const f32x4 a = acc[ai][bj][m][n]; ss += (a[0] * a[0] + a[1] * a[1]) + (a[2] * a[2] + a[3] * a[3]); }
                    ss += __shfl_xor(ss, 16); ss += __shfl_xor(ss, 32);
                    const float r = rsqrtf(ss * (1.f / 64.f) + EPS); bf16_t* rp = dst + (size_t)(row0 + ai * 128 + m * 16) * DM;
#pragma unroll
                    for (int bj = 0; bj < 2; ++bj) st8nt(rp + 32 * bj, (acc[ai][bj][m][0] * r) * gv[bj][0], (acc[ai][bj][m][1] * r) * gv[bj][1]); }
        } else { const int c = (u.pn - 20) * 256 + wc * 64 + 8 * fq; const float* bg = bgate + c;
#pragma unroll
            for (int bj = 0; bj < 2; ++bj) { const f32x4 b0 = *(const f32x4*)(bg + 32 * bj), b1 = *(const f32x4*)(bg + 32 * bj + 4);
#pragma unroll
                for (int ai = 0; ai < 2; ++ai)
#pragma unroll
                    for (int m = 0; m < 4; ++m) { f32x4 v0 = acc[ai][bj][m][0] + b0, v1 = acc[ai][bj][m][1] + b1;
#pragma unroll
                        for (int j = 0; j < 4; ++j) { v0[j] = __builtin_amdgcn_rcpf(1.f + __builtin_amdgcn_exp2f(-LOG2E * v0[j])); v1[j] = __builtin_amdgcn_rcpf(1.f + __builtin_amdgcn_exp2f(-LOG2E * v1[j])); }
                        st8nt(GATE + (size_t)(row0 + ai * 128 + m * 16) * 2048 + c + 32 * bj, v0, v1); } }
        }
    }
};

#define EPI_LOOP(...) _Pragma("unroll") for (int ai = 0; ai < 2; ++ai) _Pragma("unroll") for (int m = 0; m < 4; ++m) { const size_t row = (size_t)(u.pm * 256 + wr * 64 + fr + ai * 128 + m * 16); \
        _Pragma("unroll") for (int bj = 0; bj < 2; ++bj) { const int col = u.pn * 256 + bj * 128 + wc * 32 + 8 * fq; const f32x4 a0 = acc[ai][bj][m][0], a1 = acc[ai][bj][m][1]; __VA_ARGS__ } if (m & 1) asm volatile("" ::: "memory"); }
struct EpiGateT {
    static constexpr bool PERM = true, AFTER_DRAIN = false;
    const bf16_t* GATE; bf16_t* T;
    __device__ __forceinline__ void operator()(const f32x4 (&acc)[2][2][4][2], const pg8::Unit& u, int wr, int wc, int fr, int fq) const {
        asm volatile("" : "+v"(fr), "+v"(fq));
        EPI_LOOP( f32x4 g0, g1; ld8(GATE + row * 2048 + col, g0, g1); st8(T + row * DM + col, g0 * a0, g1 * a1); )
    }
};
struct EpiMerged {
    static constexpr bool PERM = true, AFTER_DRAIN = false;
    const bf16_t* GATE; const bf16_t* T; bf16_t* MG;
    __device__ __forceinline__ void operator()(const f32x4 (&acc)[2][2][4][2], const pg8::Unit& u, int wr, int wc, int fr, int fq) const {
        asm volatile("" : "+v"(fr), "+v"(fq));
        EPI_LOOP( f32x4 g0, g1, t0, t1; ld8(GATE + row * 2048 + 1024 + col, g0, g1); ld8(T + row * DM + col, t0, t1); st8(MG + row * DM + col, t0 + g0 * a0, t1 + g1 * a1); )
    }
};
struct EpiOut {
    static constexpr bool PERM = true, AFTER_DRAIN = false;
    const float* x; float* out; const float* g2; bf16_t* H2;
    __device__ __forceinline__ void operator()(const f32x4 (&acc)[2][2][4][2], const pg8::Unit& u, int wr, int wc, int fr, int fq) const {
        asm volatile("" : "+v"(fr), "+v"(fq));
        EPI_LOOP( const float* xp = x + row * DM + col; float* op = out + row * DM + col; const f32x4 x0 = __builtin_nontemporal_load((const f32x4*)xp) + a0, x1 = __builtin_nontemporal_load((const f32x4*)(xp + 4)) + a1; *(f32x4*)op = x0; *(f32x4*)(op + 4) = x1;
                  st8(H2 + row * DM + col, x0 * *(const f32x4*)(g2 + col), x1 * *(const f32x4*)(g2 + col + 4)); )
    }
};
struct EpiY {
    static constexpr bool PERM = true, AFTER_DRAIN = false;
    bf16_t* Y;
    __device__ __forceinline__ void operator()(const f32x4 (&acc)[2][2][4][2], const pg8::Unit& u, int wr, int wc, int fr, int fq) const {
        asm volatile("" : "+v"(fr), "+v"(fq));
        EPI_LOOP( st8(Y + row * DM + col, a0, a1); )
    }
};
struct EpiSwiglu {
    static constexpr bool PERM = true, AFTER_DRAIN = false;
    const float* roww; const float* rowrr; bf16_t* HID;
    __device__ __forceinline__ void operator()(const f32x4 (&acc)[2][2][4][2], const pg8::Unit& u, int wr, int wc, int fr, int fq) const {
        asm volatile("" : "+v"(fr), "+v"(fq));
#pragma unroll
        for (int ai = 0; ai < 2; ++ai)
#pragma unroll
            for (int m = 0; m < 4; ++m) { const int rl = wr * 64 + fr + ai * 128 + m * 16; const size_t row = (size_t)(u.pm * 256 + rl); const float w = rl < u.nvalid ? roww[u.rbase + rl] : 0.f, rr = rl < u.nvalid ? rowrr[u.rbase + rl] : 0.f;
                f32x4 hv[2];
#pragma unroll
                for (int n = 0; n < 2; ++n) { const f32x4 a1 = acc[ai][0][m][n] * rr, a3 = acc[ai][1][m][n] * rr;
#pragma unroll
                    for (int j = 0; j < 4; ++j) hv[n][j] = ((a1[j] * __builtin_amdgcn_rcpf(1.f + __builtin_amdgcn_exp2f(-LOG2E * a1[j]))) * a3[j]) * w; }
                st8(HID + row * DE + u.pn * 128 + wc * 32 + 8 * fq, hv[0], hv[1]); }
    }
};
__device__ __forceinline__ int expert_of_row(LAS int* offs, int row);
struct MoeOrder {
    LAS int* offs; int npn, G, c, lo, hi;
    __device__ __forceinline__ bool next(int i, pg8::Unit& u) const { const int L = lo + i * G + c; if (L >= hi || c < 0) return false;
        const int tile = L / npn, pn = L - tile * npn, e = expert_of_row(offs, tile * 256), lr0 = tile * 256 - offs[e], nv = offs[40 + e] - lr0;
        u.pm = tile; u.pn = pn; u.pb = e * npn + pn; u.rbase = e * ECAP + lr0; u.nvalid = nv < 256 ? nv : 256; return true; }
    __device__ __forceinline__ void a_ready(const pg8::Unit&) const {}
    __device__ __forceinline__ void done(const pg8::Unit&) const {}
};

__device__ __forceinline__ float attn_dmin_unit(const float* qg, const float* kg) {
    const int ln = threadIdx.x & 63; float a = fabsf(qg[ln]), b = fabsf(kg[ln]);
#pragma unroll
    for (int o = 1; o < 64; o <<= 1) { a = fmaxf(a, __shfl_xor(a, o)); b = fmaxf(b, __shfl_xor(b, o)); }
    return 2.02f * (8.f * a * b) + 106.f;
}
__device__ __forceinline__ int attn_jlo(float dmin1, int h, int qb) {
    const float dmin = dmin1 * exp2f((float)(h + 1)); const float lowk = (float)(qb * 128) - dmin;
    return lowk > 0.f ? ((int)lowk) >> 6 : 0;
}
__device__ __forceinline__ void tr_load(const float* W, int N, int item, int lane, float (&v)[32]) {
    const int nblk = N / 32, kb = item / nblk, nb = item % nblk, k0 = 64 * kb, n0 = 32 * nb;
    const float* wp = W + (size_t)(k0 + (lane >> 5)) * N + n0 + (lane & 31);
#pragma unroll
    for (int i = 0; i < 32; ++i) v[i] = __builtin_nontemporal_load(wp + (size_t)(2 * i) * N);
}
template <class RM>
__device__ __forceinline__ void tr_store(const float (&v)[32], int N, bf16_t* WT, int ldt, int koff, RM rm, LAS float* scr, int item, int lane) {
    const int nblk = N / 32, kb = item / nblk, nb = item % nblk, k0 = 64 * kb, n0 = 32 * nb;
    { LAS float* sp = scr + (lane >> 5) * 33 + (lane & 31);
#pragma unroll
      for (int i = 0; i < 32; ++i) sp[2 * i * 33] = v[i]; }
    LDS_WAIT(); asm volatile("" ::: "memory");
    const int c = lane & 7;
#pragma unroll
    for (int j = 0; j < 4; ++j) { const int n = (lane >> 3) + 8 * j; const LAS float* s = scr + (8 * c) * 33 + n;
        u32x4 o; o.x = cvtpk(s[0 * 33], s[1 * 33]); o.y = cvtpk(s[2 * 33], s[3 * 33]); o.z = cvtpk(s[4 * 33], s[5 * 33]); o.w = cvtpk(s[6 * 33], s[7 * 33]);
        *(u32x4*)(WT + (size_t)rm(n0 + n) * ldt + koff + k0 + 8 * c) = o; }
    LDS_WAIT(); asm volatile("" ::: "memory");
}
template <class RM>
__device__ __forceinline__ void transpose_item(const float* W, int N, bf16_t* WT, int ldt, int koff, RM rm, LAS float* scr, int item, int lane) {
    float v[32]; tr_load(W, N, item, lane, v); tr_store(v, N, WT, ldt, koff, rm, scr, item, lane);
}
template <class RM>
__device__ __forceinline__ void transpose_block_item(const float* W, int N, int k0, int n0, bf16_t* WT, int ldt, int koff, RM rm, LAS unsigned char* lds, int tid) {
    const int w = tid >> 6, lane = tid & 63;
    f32x4 v[8];
#pragma unroll
    for (int r = 0; r < 8; ++r) v[r] = __builtin_nontemporal_load((const f32x4*)(W + (size_t)(k0 + 8 * w + r) * N + n0 + 4 * lane));
#pragma unroll
    for (int c = 0; c < 4; ++c) { u32x4 o; o.x = cvtpk(v[0][c], v[1][c]); o.y = cvtpk(v[2][c], v[3][c]); o.z = cvtpk(v[4][c], v[5][c]); o.w = cvtpk(v[6][c], v[7][c]);
        *(LAS u32x4*)(lds + (4 * lane + c) * 144 + 16 * w) = o; }
    __syncthreads();
#pragma unroll
    for (int i = 0; i < 4; ++i) { const int q = tid + 512 * i, row = q >> 3, ch = q & 7;
        *(u32x4*)(WT + (size_t)rm(n0 + row) * ldt + koff + k0 + 8 * ch) = *(const LAS u32x4*)(lds + row * 144 + 16 * ch); }
    __syncthreads();
}
struct RmAdd { int off; __device__ __forceinline__ int operator()(int n) const { return off + n; } };
struct RmW13 { int off; __device__ __forceinline__ int operator()(int n) const { return off + (n >> 7) * 256 + (n & 127); } };

struct XwItem { const float* W; bf16_t* WT; int N, ldt, ob, is13; };
__device__ __forceinline__ XwItem xw_item(Frame& F, int id, int& k0, int& n0) {
    XwItem x;
    if (id >= NE * 48) { int r = id - NE * 48; x.ldt = 1024; x.is13 = 0; x.ob = 0;
        if (r < 320) { x.W = F.a->in[I_WIN]; x.N = 5120; k0 = 64 * (r / 20); n0 = 256 * (r % 20); x.WT = (bf16_t*)(F.ws + WS_W1T); return x; } r -= 320;
        if (r < 128) { x.W = F.a->in[I_WGATE]; x.N = 2048; k0 = 64 * (r / 8); n0 = 256 * (r % 8); x.WT = (bf16_t*)(F.ws + WS_W1T); x.ob = 5120; return x; } r -= 128;
        x.N = 1024; k0 = 64 * ((r & 63) >> 2); n0 = 256 * (r & 3);
        if (r < 64) { x.W = F.a->in[I_WUPA]; x.WT = (bf16_t*)(F.ws + WS_WUPT); } else if (r < 128) { x.W = F.a->in[I_WUPB]; x.WT = (bf16_t*)(F.ws + WS_WUPT); x.ob = 1024; } else { x.W = F.a->in[I_WOUT]; x.WT = (bf16_t*)(F.ws + WS_WOUTT); }
        return x; }
    const int e = id / 48, r = id % 48;
    if (r < 32) { x.W = (r < 16 ? F.a->in[I_W1] : F.a->in[I_W3]) + (size_t)e * 1024 * 256; x.N = 256; k0 = 64 * (r & 15); n0 = 0; x.WT = (bf16_t*)(F.ws + WS_W13T); x.ldt = 1024; x.ob = e * 512 + (r < 16 ? 0 : 128); x.is13 = 1; }
    else { x.W = F.a->in[I_W2] + (size_t)e * 256 * 1024; x.N = 1024; k0 = 64 * ((r - 32) >> 2); n0 = 256 * ((r - 32) & 3); x.WT = (bf16_t*)(F.ws + WS_W2T); x.ldt = 256; x.ob = e * 1024; x.is13 = 0; }
    return x;
}
__device__ __forceinline__ void xw_convert(Frame& F, int id0, int id1, int idstep) {
    const int w = F.wid, lane = F.lane;
#define XW_LOAD(V_, id_) do { int k0_, n0_; const XwItem x_ = xw_item(F, (id_), k0_, n0_); _Pragma("unroll") for (int r = 0; r < 8; ++r) V_[r] = __builtin_nontemporal_load((const f32x4*)(x_.W + (size_t)(k0_ + 8 * w + r) * x_.N + n0_ + 4 * lane)); } while (0)
#define XW_PUT(V_, buf_) do { LAS unsigned char* l_ = F.lds + (buf_) * 36864; _Pragma("unroll") for (int c = 0; c < 4; ++c) { u32x4 o; o.x = cvtpk(V_[0][c], V_[1][c]); o.y = cvtpk(V_[2][c], V_[3][c]); o.z = cvtpk(V_[4][c], V_[5][c]); o.w = cvtpk(V_[6][c], V_[7][c]); \
            *(LAS u32x4*)(l_ + (4 * lane + c) * 144 + 16 * w) = o; } } while (0)
#define XW_OUT(id_, buf_) do { int k0_, n0_; const XwItem x_ = xw_item(F, (id_), k0_, n0_); const LAS unsigned char* l_ = F.lds + (buf_) * 36864; _Pragma("unroll") for (int i = 0; i < 4; ++i) { const int q = F.tid + 512 * i, row = q >> 3, ch = q & 7, n = n0_ + row; \
            const int orow = x_.ob + (x_.is13 ? ((n >> 7) << 8) + (n & 127) : n); *(u32x4*)(x_.WT + (size_t)orow * x_.ldt + k0_ + 8 * ch) = *(const LAS u32x4*)(l_ + row * 144 + 16 * ch); } } while (0)
    f32x4 va[8], vb[8];
    int id = id0;
    if (id < id1) XW_LOAD(va, id);
    while (id < id1) {
        const int id2 = id + idstep, id3 = id2 + idstep;
        if (id2 < id1) XW_LOAD(vb, id2);
        XW_PUT(va, 0); __syncthreads(); XW_OUT(id, 0);
        if (id2 >= id1) break;
        if (id3 < id1) XW_LOAD(va, id3);
        XW_PUT(vb, 1); __syncthreads(); XW_OUT(id2, 1);
        id = id3;
    }
    __syncthreads();
#undef XW_LOAD
#undef XW_PUT
#undef XW_OUT
}
__device__ __forceinline__ void p0_prologue(Frame& F) {
    xw_convert(F, NE * 48 + F.blk, NE * 48 + 448, F.G);
    { bf16_t* WST = (bf16_t*)(F.ws + WS_WST); const float* ws_ = F.a->in[I_WS];
      for (int i = F.blk * NTHREADS + F.tid; i < 8 * 128 * 128 / 2; i += F.G * NTHREADS) { const int e = 2 * i, s = e & 127, t = (e >> 7) & 127;
          const float a = (s <= t) ? ws_[e] : 0.f, b = (s + 1 <= t) ? ws_[e + 1] : 0.f; *(unsigned*)(WST + e) = cvtpk(a, b); } }
    { float* WRT = (float*)(F.ws + WS_ROUTE + RT_WRT); const float* g2 = F.a->in[I_N2G]; const float* wrg = F.a->in[I_WRG]; const float* wre = F.a->in[I_WRE];
      for (int i = F.blk * NTHREADS + F.tid; i < 48 * 1024; i += F.G * NTHREADS) { const int j = i >> 10, k = i & 1023;
          const float w = j < 4 ? wrg[k * 4 + j] : (j < 36 ? wre[k * 32 + (j - 4)] : 0.f); WRT[i] = g2[k] * w; } }
    if (F.blk == 0) { LAS int* hist = (LAS int*)(F.lds + 136 * 1024); LAS int* gt = hist + 160;
        for (int i = F.tid; i < 320; i += NTHREADS) hist[i] = 0;
        __syncthreads();
        const float dmin1 = attn_dmin_unit(F.a->in[I_QNG], F.a->in[I_KNG]);
        int w[2], jl[2];
#pragma unroll
        for (int q = 0; q < 2; ++q) { const int u = F.tid + q * NTHREADS, qb = u >> 4; jl[q] = attn_jlo(dmin1, u & 7, qb); w[q] = 2 * qb + 2 - jl[q]; atomicAdd((int*)(hist + w[q]), 1); }
        __syncthreads();
        if (F.tid < 64) { int h0 = 0, h1 = 0, h2 = 0; const int i0 = 3 * F.tid;
            if (i0 < 160) h0 = hist[i0]; if (i0 + 1 < 160) h1 = hist[i0 + 1]; if (i0 + 2 < 160) h2 = hist[i0 + 2];
            const int tot = h0 + h1 + h2; int suf = tot;
#pragma unroll
            for (int o = 1; o < 64; o <<= 1) { const int vv = __shfl_down(suf, o); if (F.tid + o < 64) suf += vv; }
            const int above = suf - tot;
            if (i0 + 2 < 160) gt[i0 + 2] = above; if (i0 + 1 < 160) gt[i0 + 1] = above + h2; if (i0 < 160) gt[i0] = above + h2 + h1; }
        __syncthreads();
#pragma unroll
        for (int q = 0; q < 2; ++q) { const int u = F.tid + q * NTHREADS; const int rank = atomicAdd((int*)(gt + w[q]), 1);
            ((int*)(F.ws + WS_ROUTE + RT_ALIST))[rank] = u | (jl[q] << 16); }
        __syncthreads(); }
    { bf16_t* XN = (bf16_t*)(F.ws + WS_XN); const float* x = F.a->in[I_X]; const f32x4* g4 = (const f32x4*)F.a->in[I_N1G] + F.lane;
      for (int m0 = F.gw * 4; m0 < M; m0 += F.NGW * 4) { f32x4 v[4][4];
#pragma unroll
          for (int q = 0; q < 4; ++q) { const f32x4* xr = (const f32x4*)(x + (size_t)(m0 + q) * DM) + F.lane;
#pragma unroll
              for (int j = 0; j < 4; ++j) v[q][j] = __builtin_nontemporal_load(xr + 64 * j); }
#pragma unroll
          for (int q = 0; q < 4; ++q) { float s = 0.f;
#pragma unroll
              for (int j = 0; j < 4; ++j) s += (v[q][j][0] * v[q][j][0] + v[q][j][1] * v[q][j][1]) + (v[q][j][2] * v[q][j][2] + v[q][j][3] * v[q][j][3]);
              const float r = rsqrtf(wave_sum(s) * (1.f / DM) + EPS);
#pragma unroll
              for (int j = 0; j < 4; ++j) { const f32x4 g = g4[64 * j]; st4(XN + (size_t)(m0 + q) * DM + 4 * F.lane + 256 * j, (v[q][j] * r) * g); } } } }
}

__device__ __forceinline__ void p1_proj(Frame& F) {
    pg8::Gemm g{(const bf16_t*)(F.ws + WS_XN), (const bf16_t*)(F.ws + WS_W1T), DM, nullptr};
    pg8::StaticOrder S; S.init(M, N1, F.G, F.blk);
    static_assert(WS_VA == WS_U + 32 * MiB && WS_Q == WS_U + 64 * MiB && WS_K == WS_U + 96 * MiB && WS_VB == WS_U + 128 * MiB, "EpiProj layout");
    EpiProj E{F.ws, (bf16_t*)F.out, F.a->in[I_QNG], F.a->in[I_KNG], F.a->in[I_BGATE]};
    if ((F.blk >> 3) & 1) { const int nd = (F.G >> 4) << 3;
        xw_convert(F, NE * 48 + 448 + (((F.blk >> 4) << 3) | (F.blk & 7)), NE * 48 + 640, nd > 0 ? nd : 1); }
    pg8::gemm_phase<EpiProj, pg8::StaticOrder, PG8_ALIGN, PG8_SP2, true>(F.lds, g, S, E);
}

__device__ __forceinline__ void p2_mixer_a(Frame& F) {
    const bf16_t* VA = (const bf16_t*)(F.ws + WS_VA); const bf16_t* U = (const bf16_t*)(F.ws + WS_U); bf16_t* YA = (bf16_t*)(F.ws + WS_YA); const bf16_t* WST = (const bf16_t*)(F.ws + WS_WST);
    const float* gv = F.a->in[I_VNG]; const float* bs = F.a->in[I_BS];
    bf16_t* vT = (bf16_t*)F.ldsg;
    bf16_t* wS = (bf16_t*)(F.ldsg + 128 * 136 * 2);
    const int fr = F.lane & 15, fq = F.lane >> 4, wm = F.wid >> 1, wn = F.wid & 1;
    const int s_ = F.tid >> 2, ds = (F.tid & 3) * 8;
    const int pb = ((F.tid & 1) << 5) | (((F.tid >> 1) & 1) << 2);
    int gstaged = -1;
    bf16x8 v[4]; f32x4 gvr[8];
    u32x2 uraw[2][4]; float bb[2] = {0.f, 0.f};
#define MX_LOAD(L_) do { const int c_ = (L_) >> 3, g_ = (L_) & 7; const bf16_t* src = VA + (size_t)(c_ * 128 + s_) * DM + g_ * 128 + ds;                         \
        _Pragma("unroll") for (int i = 0; i < 4; ++i) v[i] = *(const bf16x8*)(src + 32 * i);                                                                     \
        _Pragma("unroll") for (int m = 0; m < 2; ++m) { const int t = 32 * wm + 16 * m + fr; bb[m] = bs[g_ * 128 + t]; const bf16_t* up = U + (size_t)(c_ * 128 + t) * DM + g_ * 128 + 64 * wn + 16 * fq; \
            _Pragma("unroll") for (int h = 0; h < 2; ++h) { const u32x4 w_ = *(const u32x4*)(up + 8 * h); uraw[m][2 * h] = (u32x2){w_.x, w_.y}; uraw[m][2 * h + 1] = (u32x2){w_.z, w_.w}; } } } while (0)
    int L0 = F.blk, Lstep = F.G;
    if ((F.G & 31) == 0) { const int ib = F.blk >> 3, nb = F.G >> 3, first = nb - (nb >> 2); if (ib < first) return; L0 = ((ib - first) << 3) | (F.blk & 7); Lstep = (nb >> 2) << 3; }
    if (L0 < 1024) MX_LOAD(L0);
    for (int L = L0; L < 1024; L += Lstep) {
        const int c = L >> 3, g = L & 7;
        if (g != gstaged) { __syncthreads();
#pragma unroll
            for (int i = 0; i < 8; ++i) gvr[i] = *(const f32x4*)(gv + g * 128 + ds + 32 * (i >> 1) + 4 * (i & 1));
#pragma unroll
            for (int i = 0; i < 4; ++i) { const int q = F.tid + 512 * i, t = q >> 4, ch = q & 15; *(bf16x8*)(wS + t * 136 + 8 * ch) = *(const bf16x8*)(WST + g * 16384 + t * 128 + 8 * ch); }
            gstaged = g; }
        { float ss = 0.f;
#pragma unroll
          for (int i = 0; i < 4; ++i)
#pragma unroll
              for (int j = 0; j < 8; ++j) { const float x = bf2f(v[i][j]); ss += x * x; }
          ss += __shfl_xor(ss, 1); ss += __shfl_xor(ss, 2);
          const float r = rsqrtf(ss * (1.f / 128.f) + EPS);
#pragma unroll
          for (int i = 0; i < 4; ++i)
#pragma unroll
              for (int j = 0; j < 8; j += 2) { const float x0 = (bf2f(v[i][j]) * r) * gvr[2 * i + (j >> 2)][j & 3], x1 = (bf2f(v[i][j + 1]) * r) * gvr[2 * i + (j >> 2)][(j & 3) + 1];
                  const unsigned w_ = cvtpk(x0, x1); bf16_t* q_ = vT + (pb + (((i >> 1) << 6) | ((j >> 2) << 4) | (((2 * i) & 3) << 2) | (j & 3))) * 136 + s_;
                  q_[0] = (bf16_t)(w_ & 0xffffu); q_[136] = (bf16_t)(w_ >> 16); } }
        __syncthreads();
        f32x4 uu[2][4]; float bc[2];
#pragma unroll
        for (int m = 0; m < 2; ++m) { bc[m] = bb[m];
#pragma unroll
            for (int n = 0; n < 4; ++n) { const u32x2 w = uraw[m][n]; uu[m][n][0] = __uint_as_float(w.x << 16); uu[m][n][1] = __uint_as_float(w.x & 0xffff0000u); uu[m][n][2] = __uint_as_float(w.y << 16); uu[m][n][3] = __uint_as_float(w.y & 0xffff0000u); } }
        const int Ln = L + Lstep;
        if (Ln < 1024) MX_LOAD(Ln);
        const bf16_t* ap = wS + (32 * wm + fr) * 136 + 8 * fq; const bf16_t* bp = vT + (64 * wn + fr) * 136 + 8 * fq;
        f32x4 acc[2][4]; acc_zero(acc);
        wave_gemm(acc, ap, ap + 16 * 136, bp, bp + 16 * 136, bp + 32 * 136, bp + 48 * 136, 32 * (wm + 1));
#pragma unroll
        for (int m = 0; m < 2; ++m) { const int t = 32 * wm + 16 * m + fr; bf16_t* yp = YA + (size_t)(c * 128 + t) * DM + g * 128 + 64 * wn + 16 * fq;
#pragma unroll
            for (int h = 0; h < 2; ++h) { const f32x4 y0 = uu[m][2 * h] * (acc[m][2 * h] + bc[m]), y1 = uu[m][2 * h + 1] * (acc[m][2 * h + 1] + bc[m]);
                *(u32x4*)(yp + 8 * h) = (u32x4){cvtpk(y0[0], y0[1]), cvtpk(y0[2], y0[3]), cvtpk(y1[0], y1[1]), cvtpk(y1[2], y1[3])}; } }
        __syncthreads();
    }
#undef MX_LOAD
}

namespace att {
constexpr int QBLK = 32, KVBLK = 64, QB = 128, PITCH = 1024;
constexpr int SHM_V = KVBLK * 128 * 2, SHM_K = 2 * KVBLK * 64 * 2;
constexpr int SLOT = SHM_K + SHM_V, NSLOT = 3;
constexpr int LDS_WSF = NSLOT * SLOT, LDS_XCH = LDS_WSF + NWAVES * 64 * 4, LDS_BYTES = LDS_XCH + 4 * 16 * 2 * 64 * 4;
constexpr float THR2 = 8.f * LOG2E;
#define KSWZ64(row, colB) ((row) * 128 + ((colB) ^ ((((row) >> 1) & 7) << 4)))
__device__ __forceinline__ int v_st(int k, int c) { const int kk = (k & ~0xC) | ((k & 4) << 1) | ((k & 8) >> 1); return ((kk >> 3) * 4 + (c >> 5)) * 512 + ((kk & 7) * 32 + (c & 31)) * 2; }
__device__ __forceinline__ int v_rd_base(int lane) { return ((lane & 3) << 3) | (((lane >> 2) & 3) << 6) | (((lane >> 4) & 1) << 5) | (((lane >> 5) & 1) << 8); }
constexpr int v_rd_off(int d0, int ks, int half) { return d0 * 512 + ks * 4096 + half * 2048; }
__device__ __forceinline__ int crow(int r, int hi) { return (r & 3) + 8 * (r >> 2) + 4 * hi; }

__device__ __forceinline__ void mask_tile(f32x16& p0, f32x16& p1, int dq) {
    const float NEG = -__builtin_inff();
#pragma unroll
    for (int r = 0; r < 16; ++r) { const int c = (r & 3) + 8 * (r >> 2);
        if (dq - c < 0) p0[r] = NEG;
        if (dq - c - 32 < 0) p1[r] = NEG; }
}
__device__ __forceinline__ void partialSM(f32x16& p0, f32x16& p1, float& m_reg, float& alpha) {
    float pmax = __builtin_fmaxf(__builtin_fmaxf(p0[0], p0[1]), p0[2]);
#pragma unroll
    for (int r = 3; r < 15; r += 2) pmax = __builtin_fmaxf(__builtin_fmaxf(pmax, p0[r]), p0[r + 1]);
    pmax = __builtin_fmaxf(__builtin_fmaxf(pmax, p0[15]), p1[0]);
#pragma unroll
    for (int r = 1; r < 15; r += 2) pmax = __builtin_fmaxf(__builtin_fmaxf(pmax, p1[r]), p1[r + 1]);
    pmax = __builtin_fmaxf(pmax, p1[15]);
    { auto rr = __builtin_amdgcn_permlane32_swap(__float_as_uint(pmax), __float_as_uint(pmax), false, false);
      pmax = fmaxf(__uint_as_float(rr[0]), __uint_as_float(rr[1])); }
    alpha = 1.f;
    if (__builtin_expect(!__all(pmax <= THR2), 0)) { asm volatile("" ::: "memory");
        const float d = fmaxf(pmax, 0.f); m_reg += d; alpha = __builtin_amdgcn_exp2f(-d);
#pragma unroll
        for (int r = 0; r < 16; ++r) { p0[r] -= d; p1[r] -= d; } }
#pragma unroll
    for (int r = 0; r < 16; ++r) p0[r] = __builtin_amdgcn_exp2f(p0[r]);
}
__device__ __forceinline__ void finishSM_h(f32x16& p0, f32x16& p1, float alpha, float& l_reg, float ps0, bf16x8& pa0, bf16x8& pa1, bf16x8& pa2, bf16x8& pa3) {
#pragma unroll
    for (int r = 0; r < 16; ++r) p1[r] = __builtin_amdgcn_exp2f(p1[r]);
    float ps = ps0;
#pragma unroll
    for (int r = 0; r < 16; ++r) ps += p1[r];
    { auto rr = __builtin_amdgcn_permlane32_swap(__float_as_uint(ps), __float_as_uint(ps), false, false);
      ps = __uint_as_float(rr[0]) + __uint_as_float(rr[1]); }
    l_reg = l_reg * alpha + ps;
#define PK8(P, B_, OUT) do { u32x4 w = {cvtpk(P[B_+0], P[B_+1]), cvtpk(P[B_+2], P[B_+3]), cvtpk(P[B_+4], P[B_+5]), cvtpk(P[B_+6], P[B_+7])}; OUT = __builtin_bit_cast(bf16x8, w); } while (0)
    PK8(p0, 0, pa0); PK8(p0, 8, pa1); PK8(p1, 0, pa2); PK8(p1, 8, pa3);
#undef PK8
}
__device__ __forceinline__ void finishSM(f32x16& p0, f32x16& p1, float alpha, float& l_reg, bf16x8& pa0, bf16x8& pa1, bf16x8& pa2, bf16x8& pa3) {
#pragma unroll
    for (int r = 0; r < 16; ++r) p1[r] = __builtin_amdgcn_exp2f(p1[r]);
    float ps = 0;
#pragma unroll
    for (int r = 0; r < 16; ++r) ps += p0[r];
#pragma unroll
    for (int r = 0; r < 16; ++r) ps += p1[r];
    { auto rr = __builtin_amdgcn_permlane32_swap(__float_as_uint(ps), __float_as_uint(ps), false, false);
      ps = __uint_as_float(rr[0]) + __uint_as_float(rr[1]); }
    l_reg = l_reg * alpha + ps;
#define PK4(P, B_, OUT) do { unsigned a0 = cvtpk(P[B_+0], P[B_+1]), a1 = cvtpk(P[B_+2], P[B_+3]);                          \
        unsigned b0 = cvtpk(P[B_+4], P[B_+5]), b1 = cvtpk(P[B_+6], P[B_+7]);                                             \
        auto r0 = __builtin_amdgcn_permlane32_swap(a0, b0, false, false); auto r1 = __builtin_amdgcn_permlane32_swap(a1, b1, false, false); \
        u32x4 w = {r0[0], r1[0], r0[1], r1[1]}; OUT = __builtin_bit_cast(bf16x8, w); } while (0)
    PK4(p0, 0, pa0); PK4(p0, 8, pa1); PK4(p1, 0, pa2); PK4(p1, 8, pa3);
#undef PK4
}
__device__ __forceinline__ void qkt(f32x16& p0, f32x16& p1, const char* Kmap_lds, int r32, int hi, const bf16x8* qr, bf16x8 kx0, unsigned kc1, bf16x8 qx) {
    p0 = __builtin_amdgcn_mfma_f32_32x32x16_bf16(kx0, qx, f32x16{}, 0, 0, 0);
    { u32x4 k1 = __builtin_bit_cast(u32x4, kx0); k1.x = kc1; p1 = __builtin_amdgcn_mfma_f32_32x32x16_bf16(__builtin_bit_cast(bf16x8, k1), qx, f32x16{}, 0, 0, 0); }
#pragma unroll
    for (int d0 = 0; d0 < 4; ++d0) { const char* a = Kmap_lds + KSWZ64(r32, (d0 * 16 + hi * 8) * 2);
        const bf16x8 b0 = *reinterpret_cast<const bf16x8*>(a);
        const bf16x8 b1 = *reinterpret_cast<const bf16x8*>(a + 32 * 128);
        p0 = __builtin_amdgcn_mfma_f32_32x32x16_bf16(b0, qr[d0], p0, 0, 0, 0);
        p1 = __builtin_amdgcn_mfma_f32_32x32x16_bf16(b1, qr[d0], p1, 0, 0, 0); }
}
__device__ __forceinline__ void qkt_a(f32x16& p0, f32x16& p1, const char* Kmap_lds, int r32, int hi, const bf16x8* qr, bf16x8 kx0, unsigned kc1, bf16x8 qx) {
    p0 = __builtin_amdgcn_mfma_f32_32x32x16_bf16(kx0, qx, f32x16{}, 0, 0, 0);
    { u32x4 k1 = __builtin_bit_cast(u32x4, kx0); k1.x = kc1; p1 = __builtin_amdgcn_mfma_f32_32x32x16_bf16(__builtin_bit_cast(bf16x8, k1), qx, f32x16{}, 0, 0, 0); }
#pragma unroll
    for (int d0 = 0; d0 < 2; ++d0) { const char* a = Kmap_lds + KSWZ64(r32, (d0 * 16 + hi * 8) * 2);
        const bf16x8 b0 = *reinterpret_cast<const bf16x8*>(a);
        const bf16x8 b1 = *reinterpret_cast<const bf16x8*>(a + 32 * 128);
        p0 = __builtin_amdgcn_mfma_f32_32x32x16_bf16(b0, qr[d0], p0, 0, 0, 0);
        p1 = __builtin_amdgcn_mfma_f32_32x32x16_bf16(b1, qr[d0], p1, 0, 0, 0); }
}
__device__ __forceinline__ void qkt_b(f32x16& p0, f32x16& p1, const char* Kmap_lds, int r32, int hi, const bf16x8* qr) {
#pragma unroll
    for (int d0 = 2; d0 < 4; ++d0) { const char* a = Kmap_lds + KSWZ64(r32, (d0 * 16 + hi * 8) * 2);
        const bf16x8 b0 = *reinterpret_cast<const bf16x8*>(a);
        const bf16x8 b1 = *reinterpret_cast<const bf16x8*>(a + 32 * 128);
        p0 = __builtin_amdgcn_mfma_f32_32x32x16_bf16(b0, qr[d0], p0, 0, 0, 0);
        p1 = __builtin_amdgcn_mfma_f32_32x32x16_bf16(b1, qr[d0], p1, 0, 0, 0); }
}
__device__ __forceinline__ void pv_tile(f32x16* o, int vb0, bf16x8 pa0, bf16x8 pa1, bf16x8 pa2, bf16x8 pa3) {
#define TRRD(dst, off) asm volatile("ds_read_b64_tr_b16 %0, %1 offset:%2" : "=&v"(dst) : "v"(vb0), "i"(off) : "memory")
#define PV_D0(d0) do { s16x4 l0, l1, l2, l3, h0, h1, h2, h3; constexpr int b_ = v_rd_off(d0, 0, 0); \
        TRRD(l0, b_); TRRD(h0, b_ + 2048); TRRD(l1, b_ + 4096); TRRD(h1, b_ + 6144); TRRD(l2, b_ + 8192); TRRD(h2, b_ + 10240); TRRD(l3, b_ + 12288); TRRD(h3, b_ + 14336); \
        asm volatile("s_waitcnt lgkmcnt(0)" ::: "memory"); SBAR();   \
        o[d0] = __builtin_amdgcn_mfma_f32_32x32x16_bf16((bf16x8){l0[0], l0[1], l0[2], l0[3], h0[0], h0[1], h0[2], h0[3]}, pa0, o[d0], 0, 0, 0);   \
        o[d0] = __builtin_amdgcn_mfma_f32_32x32x16_bf16((bf16x8){l1[0], l1[1], l1[2], l1[3], h1[0], h1[1], h1[2], h1[3]}, pa1, o[d0], 0, 0, 0);   \
        o[d0] = __builtin_amdgcn_mfma_f32_32x32x16_bf16((bf16x8){l2[0], l2[1], l2[2], l2[3], h2[0], h2[1], h2[2], h2[3]}, pa2, o[d0], 0, 0, 0);   \
        o[d0] = __builtin_amdgcn_mfma_f32_32x32x16_bf16((bf16x8){l3[0], l3[1], l3[2], l3[3], h3[0], h3[1], h3[2], h3[3]}, pa3, o[d0], 0, 0, 0); } while (0)
    PV_D0(0); PV_D0(1); PV_D0(2); PV_D0(3);
#undef PV_D0
#undef TRRD
}

__device__ __forceinline__ void pv_fused(f32x16* o, int vb0, bf16x8 pa0, bf16x8 pa1, bf16x8 pa2, bf16x8 pa3, f32x16& x0, const f32x16& x1, float& pmax, float& ps0) {
#define TRRD(dst, off) asm volatile("ds_read_b64_tr_b16 %0, %1 offset:%2" : "=&v"(dst) : "v"(vb0), "i"(off) : "memory")
#define VFR(L, H, k) (bf16x8){L[k][0], L[k][1], L[k][2], L[k][3], H[k][0], H[k][1], H[k][2], H[k][3]}
#define LGKM0() asm volatile("s_waitcnt lgkmcnt(0)" ::: "memory")
#define VBASE(d0) (v_rd_off(d0, 0, 0))
    s16x4 la[4], ha[4];
    float m = -__builtin_inff(), sx = 0.f;
#pragma unroll
    for (int k = 0; k < 4; ++k) { TRRD(la[k], VBASE(0) + k * 4096); TRRD(ha[k], VBASE(0) + k * 4096 + 2048); }
    LGKM0(); SBAR();
#define PA(k) ((k) == 0 ? pa0 : (k) == 1 ? pa1 : (k) == 2 ? pa2 : pa3)
#define GAP(s, L, H)  do { constexpr int d0_ = (s) >> 2, k_ = (s) & 3;                                                           \
        o[d0_] = __builtin_amdgcn_mfma_f32_32x32x16_bf16(VFR(L, H, k_), PA(k_), o[d0_], 0, 0, 0);                                          \
        if (d0_ < 3) { TRRD(L[k_], VBASE(d0_ + 1) + k_ * 4096); TRRD(H[k_], VBASE(d0_ + 1) + k_ * 4096 + 2048); }                        \
        if ((s) < 4) { m = __builtin_fmaxf(__builtin_fmaxf(m, x0[4 * (s)]), x0[4 * (s) + 1]); m = __builtin_fmaxf(__builtin_fmaxf(m, x0[4 * (s) + 2]), x0[4 * (s) + 3]); }            \
        else if ((s) < 8) { m = __builtin_fmaxf(__builtin_fmaxf(m, x1[4 * ((s) - 4)]), x1[4 * ((s) - 4) + 1]); m = __builtin_fmaxf(__builtin_fmaxf(m, x1[4 * ((s) - 4) + 2]), x1[4 * ((s) - 4) + 3]); } \
        if ((s) >= 4 && (s) < 12) { x0[(s) - 4] = __builtin_amdgcn_exp2f(x0[(s) - 4]); if ((s) >= 5) sx += x0[(s) - 5]; }                  \
        else if ((s) >= 12) { x0[8 + 2 * ((s) - 12)] = __builtin_amdgcn_exp2f(x0[8 + 2 * ((s) - 12)]); x0[9 + 2 * ((s) - 12)] = __builtin_amdgcn_exp2f(x0[9 + 2 * ((s) - 12)]); \
                              sx += x0[7 + 2 * ((s) - 12)]; sx += x0[8 + 2 * ((s) - 12)]; }                                                  \
        if (k_ == 3 && d0_ < 3) LGKM0();                                                                                                   \
        SBAR(); } while (0)
    GAP(0, la, ha); GAP(1, la, ha); GAP(2, la, ha); GAP(3, la, ha);
    GAP(4, la, ha); GAP(5, la, ha); GAP(6, la, ha); GAP(7, la, ha);
    GAP(8, la, ha); GAP(9, la, ha); GAP(10, la, ha); GAP(11, la, ha);
    GAP(12, la, ha); GAP(13, la, ha); GAP(14, la, ha); GAP(15, la, ha);
    ps0 = sx + x0[15]; pmax = m;
#undef GAP
#undef PA
#undef VBASE
#undef LGKM0
#undef VFR
#undef TRRD
}
__device__ __forceinline__ bf16x8 qx_of(unsigned sdw, float x) {
    const unsigned h_ = cvtpk(x, 0.f) & 0xffffu; const float r1 = x - __uint_as_float(h_ << 16);
    const unsigned m_ = cvtpk(r1, 0.f) & 0xffffu; const float r2 = r1 - __uint_as_float(m_ << 16);
    return __builtin_bit_cast(bf16x8, (u32x4){sdw, h_ | (m_ << 16), cvtpk(r2, 0.f) & 0xffffu, 0u});
}
struct BlockRef { int base; int P0; int jlo; float slope2; };
#define BR_Q(br) ((const bf16_t*)(wsb + WS_Q) + (br).base)
#define BR_K(br) ((const bf16_t*)(wsb + WS_K) + (br).base)
#define BR_V(br) ((const bf16_t*)(wsb + WS_VB) + (br).base)
#define BR_O(br) ((bf16_t*)(wsb + WS_XN) + (br).base)
struct Seam { bf16x8 qr[4]; };
__device__ __forceinline__ void glds16s(unsigned voff, const void* sbase, unsigned lds_dst) { unsigned keep;
    asm volatile("s_mov_b32 %0, m0\n\ts_mov_b32 m0, %3\n\ts_nop 0\n\tglobal_load_lds_dwordx4 %1, %2\n\ts_mov_b32 m0, %0" : "=&s"(keep) : "v"(voff), "s"(sbase), "s"(lds_dst) : "memory"); }
#define WAIT_BAR(N) asm volatile("s_waitcnt vmcnt(" #N ") lgkmcnt(0)\n\ts_barrier" ::: "memory")
#define LBAR() asm volatile("s_waitcnt lgkmcnt(0)\n\ts_barrier" ::: "memory")
struct DmaOff { unsigned k0, k1, v0, v1; };
__device__ __forceinline__ DmaOff dma_offsets(int wid, int lane) {
    DmaOff d; unsigned ko[2], vo[2];
#pragma unroll
    for (int i = 0; i < 2; ++i) { const int G = (2 * wid + i) * 64 + lane;
        { const int map = G >> 9, row = (G >> 3) & 63, slot = G & 7, chunk = slot ^ ((row >> 1) & 7); ko[i] = (unsigned)(row * PITCH + map * 64 + chunk * 8) * 2u; }
        { const int sub = G >> 5, kk = (sub >> 2) * 8 + ((G >> 2) & 7), c = (sub & 3) * 32 + (G & 3) * 8; vo[i] = (unsigned)(kk * PITCH + c) * 2u; } }
    d.k0 = ko[0]; d.k1 = ko[1]; d.v0 = vo[0]; d.v1 = vo[1]; return d;
}
#define TILE_PTR(T_, br, t) ((const char*)(wsb + (T_)) + ((size_t)(br).base + (size_t)((br).jlo + (t)) * (KVBLK * PITCH)) * 2)
#define DMA_K(br, t, so) do { const char* sb_ = TILE_PTR(WS_K, br, t); const unsigned ld_ = (unsigned)__builtin_amdgcn_readfirstlane((int)(lds0 + (so) + wid * 2048)); glds16s(D.k0, sb_, ld_); glds16s(D.k1, sb_, ld_ + 1024u); } while (0)
#define DMA_V(br, t, so) do { const char* sb_ = TILE_PTR(WS_VB, br, t); const unsigned ld_ = (unsigned)__builtin_amdgcn_readfirstlane((int)(lds0 + (so) + SHM_K + wid * 2048)); glds16s(D.v0, sb_, ld_); glds16s(D.v1, sb_, ld_ + 1024u); } while (0)
__device__ __forceinline__ void attn_issue_first(const unsigned char* wsb, const BlockRef& br, char* lds, Seam& S, const DmaOff& D, int wid, int r32, int hi) {
    const unsigned lds0 = (unsigned)(uintptr_t)lds; const int map = wid >> 2, rw = wid & 3;
#pragma unroll
    for (int d0 = 0; d0 < 4; ++d0) S.qr[d0] = *(const bf16x8*)(BR_Q(br) + (size_t)(br.P0 + rw * QBLK + r32) * PITCH + map * 64 + d0 * 16 + hi * 8);
    DMA_K(br, 0, 0); DMA_V(br, 0, 0); DMA_K(br, 1, SLOT);
}
struct Sched { unsigned* ctr; const int* alist; int myx, G; int qx; int pv; };
#define XQ(S_) ((S_).myx ^ ((0x76542130 >> (4 * (S_).qx)) & 7))
#define LIDX(x_, n_) ((((n_) >> 3) << 6) + ((x_) << 3) + ((n_) & 7))
#define QOFF(S_, x_) (((S_).G - (x_) + 7) >> 3)
__device__ __forceinline__ BlockRef ref_of(int ent) {
    const int u = ent & 0xffff, qb = u >> 4, bh = u & 15, b = bh >> 3, h = bh & 7;
    BlockRef r; r.base = __builtin_amdgcn_readfirstlane(b * SEQ * 1024 + h * 128);
    r.P0 = __builtin_amdgcn_readfirstlane(qb * 128); r.jlo = __builtin_amdgcn_readfirstlane(ent >> 16); r.slope2 = exp2f(-(float)(__builtin_amdgcn_readfirstlane(h) + 1)) * LOG2E;
    return r;
}
__device__ __forceinline__ void attn_block(unsigned char* wsb, const BlockRef& cur, BlockRef& nxt, bool& last, Sched& Q, char* lds, Seam& S, float lam, const float* subg) {
    volatile LAS int* qs = (volatile LAS int*)(uintptr_t)((unsigned)(uintptr_t)lds + 143 * 1024);
    int cst = 0;
    const int tid = threadIdx.x, wid = __builtin_amdgcn_readfirstlane(tid >> 6), lane = tid & 63, r32 = lane & 31, hi = lane >> 5;
    const int map = wid >> 2, rw = wid & 3;
    const int j_lo = cur.jlo, NT = cur.P0 / KVBLK + 2 - j_lo;
    const int qlo = cur.P0 + rw * QBLK, qm = qlo + r32 - 4 * hi;
    const float slope2 = cur.slope2; const int qpos = qlo + r32;
    unsigned sdw; { const unsigned h_ = cvtpk(slope2, 0.f) & 0xffffu; const float lo_ = slope2 - __uint_as_float(h_ << 16); sdw = h_ | (cvtpk(lo_, 0.f) << 16); }
    bf16x8 kx0; unsigned kx1; { const unsigned c0 = cvtpk((float)r32, (float)r32), c1 = cvtpk((float)(r32 + 32), (float)(r32 + 32)), one = hi ? 0u : 0x3f803f80u;
        kx0 = __builtin_bit_cast(bf16x8, (u32x4){hi ? 0u : c0, one, one & 0xffffu, 0u}); kx1 = hi ? 0u : c1; }
    const unsigned lds0 = (unsigned)(uintptr_t)lds; const char* Kmap = lds + map * 8192;
    float m_reg = 0.f, l_reg = 0; f32x16 o[4] = {};
    const int vb0 = (int)lds0 + SHM_K + v_rd_base(lane);
    const DmaOff D = dma_offsets(wid, lane);
#define RESC(a) do { if (__any((a) < 1.f)) { _Pragma("unroll") for (int d_ = 0; d_ < 4; ++d_) _Pragma("unroll") for (int r = 0; r < 16; ++r) o[d_][r] *= (a); } } while (0)
#define CLAIM_SUB() do { if (tid == 0) {                                                                                                          \
            if (cst == 0) { Q.pv = Q.qx < 8 ? (int)atomicAdd(Q.ctr + 64 * XQ(Q), 1u) : 1 << 20; }                                                    \
            else if (cst == 1) { const int x_ = XQ(Q), n_ = Q.qx < 8 ? QOFF(Q, x_) + Q.pv : 128; if (n_ < 128) Q.pv = ((volatile LAS int*)(uintptr_t)((unsigned)(uintptr_t)lds + 132 * 1024))[LIDX(x_, n_)]; else { if (Q.qx < 8) atomicOr(Q.ctr - 256, 1u << x_); Q.pv = -1; } qs[1] = Q.pv; }       \
            }                                                                                                                                      \
        cst += cst == 1 ? 2 : 1; } while (0)
#define CLAIM(t) do { if ((t) >= tq && cst < 3) { asm volatile("" ::: "memory"); CLAIM_SUB(); } } while (0)
    const int tq = NT > 2 ? NT - 1 : 1;
#define KBASE(t) ((j_lo + (t)) * KVBLK)
#define MASKT(P0_, P1_, t) do { const int kb_ = KBASE(t); if (kb_ + KVBLK - 1 > qlo) { asm volatile("" ::: "memory"); mask_tile(P0_, P1_, qm - kb_); } } while (0)
#define QX(t) qx_of(sdw, slope2 * (float)(KBASE(t) - qpos) - m_reg)
#define ROT() do { const int p_ = sl_prev; sl_prev = sl_cur; sl_cur = sl_next; sl_next = p_; } while (0)
    f32x16 pA0, pA1, pB0, pB1; float alA, alB; bf16x8 pa0, pa1, pa2, pa3;
    int sl_prev = 2 * SLOT, sl_cur = 0, sl_next = SLOT;
    WAIT_BAR(0);
    asm volatile("" : "+v"(S.qr[0]), "+v"(S.qr[1]), "+v"(S.qr[2]), "+v"(S.qr[3]));
    if (NT > 2) { DMA_V(cur, 1, SLOT); DMA_K(cur, 2, 2 * SLOT); } else { DMA_V(cur, 1, SLOT); }
    SBAR(); qkt(pA0, pA1, Kmap, r32, hi, S.qr, kx0, kx1, QX(0));
    MASKT(pA0, pA1, 0); partialSM(pA0, pA1, m_reg, alA);
    float psA = 0.f, psB = 0.f;
#pragma unroll
    for (int r = 0; r < 16; ++r) psA += pA0[r];
    bf16x8 qxn = QX(1);
    if (NT > 2) { WAIT_BAR(4); } else { WAIT_BAR(2); }
    ROT();
#define STEP(PX0, PX1, alX, psX, PY0, PY1, alY, psY, t) do {                                                                           \
        const bool k2_ = (t) + 2 < NT, v1_ = (t) + 1 < NT; CLAIM(t);                                                          \
        if (k2_) DMA_K(cur, (t) + 2, sl_prev); if (v1_) DMA_V(cur, (t) + 1, sl_next);                                        \
        SBAR(); qkt_a(PX0, PX1, Kmap + sl_cur, r32, hi, S.qr, kx0, kx1, qxn); SBAR();                                        \
        qkt_b(PX0, PX1, Kmap + sl_cur, r32, hi, S.qr); finishSM_h(PY0, PY1, alY, l_reg, psY, pa0, pa1, pa2, pa3); SBAR();    \
        MASKT(PX0, PX1, (t)); SBAR();                                                                                        \
        { float pm_; pv_fused(o, vb0 + sl_prev, pa0, pa1, pa2, pa3, PX0, PX1, pm_, psX);                                     \
          { auto rr_ = __builtin_amdgcn_permlane32_swap(__float_as_uint(pm_), __float_as_uint(pm_), false, false); pm_ = fmaxf(__uint_as_float(rr_[0]), __uint_as_float(rr_[1])); } \
          alX = 1.f;                                                                                                           \
          if (__builtin_expect(!__all(pm_ <= THR2), 0)) { asm volatile("" ::: "memory");        \
              const float d_ = fmaxf(pm_, 0.f); m_reg += d_; alX = __builtin_amdgcn_exp2f(-d_);                                \
              psX *= alX; _Pragma("unroll") for (int r = 0; r < 16; ++r) { PX0[r] *= alX; PX1[r] -= d_; } } }                              \
        RESC(alX); qxn = QX((t) + 1);                  \
        if (k2_) { WAIT_BAR(4); } else if (v1_) { WAIT_BAR(2); } else { WAIT_BAR(0); }                                       \
        ROT(); } while (0)
    int t = 1;
    for (; t + 1 < NT; t += 2) {
        STEP(pB0, pB1, alB, psB, pA0, pA1, alA, psA, t);
        STEP(pA0, pA1, alA, psA, pB0, pB1, alB, psB, t + 1);
    }
    const bool oddtail = t < NT;
    if (oddtail) { STEP(pB0, pB1, alB, psB, pA0, pA1, alA, psA, t); }
    if (oddtail) { finishSM_h(pB0, pB1, alB, l_reg, psB, pa0, pa1, pa2, pa3); } else { finishSM_h(pA0, pA1, alA, l_reg, psA, pa0, pa1, pa2, pa3); }
    SBAR(); pv_tile(o, vb0 + sl_prev, pa0, pa1, pa2, pa3);
    while (cst < 3) { CLAIM_SUB(); }
    LBAR();
    { int ent = qs[1];
      if (ent < 0) {
          if (tid == 0) { int e_ = -1;
              const unsigned mk_ = __hip_atomic_load(Q.ctr - 256, __ATOMIC_RELAXED, __HIP_MEMORY_SCOPE_AGENT);
              for (++Q.qx; Q.qx < 8; ++Q.qx) { const int x_ = XQ(Q); if ((mk_ >> x_) & 1u) continue; const int n_ = QOFF(Q, x_) + (int)atomicAdd(Q.ctr + 64 * x_, 1u); if (n_ < 128) { e_ = Q.alist[LIDX(x_, n_)]; break; } atomicOr(Q.ctr - 256, 1u << x_); }
              if (Q.qx > 8) Q.qx = 8;
              qs[2] = e_; }
          LBAR(); ent = qs[2]; }
      ent = __builtin_amdgcn_readfirstlane(ent); last = ent < 0;
      if (last) nxt = cur; else nxt = ref_of(ent); }
    attn_issue_first(wsb, nxt, lds, S, D, wid, r32, hi);
    const float rl = __builtin_amdgcn_rcpf(l_reg);
    float* xch = (float*)(lds + LDS_XCH) + (size_t)rw * (16 * 2 * 64) + lane;
#pragma unroll
    for (int half = 0; half < 2; ++half) {
        if (map == 1) {
#pragma unroll
            for (int r = 0; r < 16; ++r)
#pragma unroll
                for (int dd = 0; dd < 2; ++dd) xch[(r * 2 + dd) * 64] = o[2 * half + dd][r] * rl; }
        LBAR();
        if (map == 0) {
#pragma unroll
            for (int r = 0; r < 16; ++r)
#pragma unroll
                for (int dd = 0; dd < 2; ++dd) o[2 * half + dd][r] = o[2 * half + dd][r] * rl - lam * xch[(r * 2 + dd) * 64]; }
        LBAR();
    }
    if (map == 0) {
        float ss = 0.f;
#pragma unroll
        for (int d0 = 0; d0 < 4; ++d0)
#pragma unroll
            for (int r = 0; r < 16; ++r) ss += o[d0][r] * o[d0][r];
        ss += __shfl_xor(ss, 32);
        const float rs = rsqrtf(ss * (1.f / 128.f) + EPS) * (1.f - LAM_INIT);
        char* stg = lds + LDS_XCH + rw * 8192; const float* gp = subg + 4 * hi;
        int so = r32 * 256 + 8 * hi, sq = r32 & 15; asm volatile("" : "+v"(so), "+v"(sq));
#pragma unroll
        for (int d0 = 0; d0 < 4; ++d0)
#pragma unroll
            for (int g4 = 0; g4 < 4; ++g4) { const f32x4 gg = *(const f32x4*)(gp + 32 * d0 + 8 * g4);
                u32x2 w_; w_.x = cvtpk(o[d0][4 * g4] * rs * gg[0], o[d0][4 * g4 + 1] * rs * gg[1]); w_.y = cvtpk(o[d0][4 * g4 + 2] * rs * gg[2], o[d0][4 * g4 + 3] * rs * gg[3]);
                *(u32x2*)(stg + so + (((4 * d0 + g4) ^ sq) << 4)) = w_; }
        asm volatile("s_waitcnt lgkmcnt(0)" ::: "memory");
        int obase = (cur.P0 + rw * QBLK + (lane >> 4)) * PITCH + 8 * (lane & 15); asm volatile("" : "+v"(obase));
        bf16_t* Ow = BR_O(cur) + obase;
        int rq = lane >> 4, rc = lane & 15; asm volatile("" : "+v"(rq), "+v"(rc));
#pragma unroll
        for (int k = 0; k < 8; ++k) { const int R = 4 * k + rq;
            const u32x4 w_ = *(const u32x4*)(stg + R * 256 + ((rc ^ (R & 15)) << 4));
            *(u32x4*)(Ow + (size_t)(4 * k) * PITCH) = w_; if (k & 1) asm volatile("" ::: "memory"); }
    }
#undef RESC
#undef CLAIM
#undef CLAIM_SUB
#undef KBASE
#undef MASKT
#undef QX
#undef ROT
#undef STEP
}
#undef WAIT_BAR
#undef LBAR
#undef TILE_PTR
#undef DMA_K
#undef DMA_V
#undef BR_Q
#undef BR_K
#undef BR_V
#undef BR_O
}


__device__ __forceinline__ void p2_attention(Frame& F) {
    const float s1 = wave_sum(F.a->in[I_LQ1][F.lane] * F.a->in[I_LK1][F.lane]), s2 = wave_sum(F.a->in[I_LQ2][F.lane] * F.a->in[I_LK2][F.lane]);
    const float lam = expf(s1) - expf(s2) + LAM_INIT;
    __syncthreads();
    const int myx = F.blk & 7, ib = F.blk >> 3;
    if (ib >= 128) return;
    const int* alist = (const int*)(F.ws + WS_ROUTE + RT_ALIST);
    { LAS int* la = (LAS int*)(F.lds + 132 * 1024);
      for (int i = F.tid; i < 1024; i += NTHREADS) la[i] = alist[i]; }
    __syncthreads();
    att::Sched Q; Q.ctr = F.ctl + CW_AQ; Q.alist = alist; Q.myx = myx; Q.G = F.G; Q.qx = 0; Q.pv = 0;
    att::BlockRef cur = att::ref_of(alist[LIDX(myx, ib)]), nxt; att::Seam S;
    { const att::DmaOff D0 = att::dma_offsets(F.wid, F.lane); att::attn_issue_first(F.ws, cur, F.ldsg, S, D0, F.wid, F.lane & 31, F.lane >> 5); }
    for (;;) {
        bool last;
        att::attn_block(F.ws, cur, nxt, last, Q, F.ldsg, S, lam, F.a->in[I_SUBG]);
        if (last) { asm volatile("s_waitcnt vmcnt(0)" ::: "memory"); __syncthreads(); break; }
        cur = nxt;
    }
}
__device__ __forceinline__ void p3_merged(Frame& F) {
    pg8::StaticOrder S; S.init(M, DM, F.G, F.blk);
    const bool late = (F.blk >> 3) & 1;
    if (late) xw_convert(F, F.blk, NE * 48, F.G);
    { pg8::Gemm g{(const bf16_t*)(F.ws + WS_YA), (const bf16_t*)(F.ws + WS_WUPT), DM, nullptr}; EpiGateT E{(const bf16_t*)F.out, (bf16_t*)(F.ws + WS_T)};
      pg8::gemm_phase<EpiGateT, pg8::StaticOrder, PG8_ALIGN, PG8_SP2, false>(F.lds, g, S, E); }
    { pg8::Gemm g{(const bf16_t*)(F.ws + WS_XN), (const bf16_t*)(F.ws + WS_WUPT) + 1024 * 1024, DM, nullptr}; EpiMerged E{(const bf16_t*)F.out, (const bf16_t*)(F.ws + WS_T), (bf16_t*)(F.ws + WS_Q)};
      pg8::gemm_phase<EpiMerged, pg8::StaticOrder, PG8_ALIGN, PG8_SP2, false>(F.lds, g, S, E); }
    if (!late) { __syncthreads(); xw_convert(F, F.blk, NE * 48, F.G); }
}
__device__ __forceinline__ void p4_out(Frame& F) {
    pg8::StaticOrder S; S.init(M, DM, F.G, F.blk);
    pg8::Gemm g{(const bf16_t*)(F.ws + WS_Q), (const bf16_t*)(F.ws + WS_WOUTT), DM, nullptr}; EpiOut E{F.a->in[I_X], F.out, F.a->in[I_N2G], (bf16_t*)(F.ws + WS_H2)};
    pg8::gemm_phase<EpiOut, pg8::StaticOrder, PG8_ALIGN, PG8_SP2, false>(F.lds, g, S, E);
}
__device__ __forceinline__ void h2_row(Frame& F, int t, f32x4 (&h)[4]) {
    const f32x4* xr = (const f32x4*)(F.out + (size_t)t * DM) + F.lane; const f32x4* g4 = (const f32x4*)F.a->in[I_N2G] + F.lane;
    float s = 0.f;
#pragma unroll
    for (int j = 0; j < 4; ++j) { h[j] = xr[64 * j]; s += (h[j][0] * h[j][0] + h[j][1] * h[j][1]) + (h[j][2] * h[j][2] + h[j][3] * h[j][3]); }
    const float r = rsqrtf(wave_sum(s) * (1.f / DM) + EPS);
#pragma unroll
    for (int j = 0; j < 4; ++j) h[j] = (h[j] * r) * g4[64 * j];
}
__device__ __forceinline__ void p5_router(Frame& F) {
    const float* WRT = (const float*)(F.ws + WS_ROUTE + RT_WRT); const float* brg = F.a->in[I_BRG]; const float* bre = F.a->in[I_BRE];
    int* tokpos = (int*)(F.ws + WS_ROUTE + RT_TOKPOS); float* roww = (float*)(F.ws + WS_ROUTE + RT_ROWW); float* rowrr = (float*)(F.ws + WS_ROUTE + RT_ROWRR); int* rowtok = (int*)(F.ws + WS_ROUTE + RT_ROWTOK);
    const int i16 = F.lane & 15, kq = F.lane >> 4;
    volatile LAS unsigned* rcnt = (volatile LAS unsigned*)(F.lds + 130 * 1024);
    if (F.tid == 0) rcnt[0] = 0u;
    __syncthreads();
    {
      LAS float* Pw = (LAS float*)(F.lds + F.wid * 16384);
      LAS float* ssP = (LAS float*)(F.lds + 128 * 1024);
      unsigned target = 0u;
      for (int grp = F.blk; grp < M / 64; grp += F.G) { const int t0 = grp * 64;
        const int sx = __builtin_amdgcn_readfirstlane((t0 * DM + 128 * F.wid) * 4), sw = __builtin_amdgcn_readfirstlane(128 * F.wid * 4), voff = (i16 * DM + 4 * kq) * 4;
        const __amdgpu_buffer_rsrc_t rx = __builtin_amdgcn_make_buffer_rsrc((void*)F.out, 0, M * DM * 4, 0x00020000), rw = __builtin_amdgcn_make_buffer_rsrc((void*)WRT, 0, 48 * DM * 4, 0x00020000);
        f32x4 acc[4][3]; float ss[4] = {0.f, 0.f, 0.f, 0.f};
#pragma unroll
        for (int rb = 0; rb < 4; ++rb)
#pragma unroll
            for (int cb = 0; cb < 3; ++cb) acc[rb][cb] = (f32x4){0.f, 0.f, 0.f, 0.f};
        f32x4 xA[2][4], wA[2][3], xB[2][4], wB[2][3];
#define RT_LOAD(X_, W_, s0_) do { _Pragma("unroll") for (int j = 0; j < 2; ++j) { _Pragma("unroll") for (int rb = 0; rb < 4; ++rb) X_[j][rb] = __builtin_bit_cast(f32x4, __builtin_amdgcn_raw_buffer_load_b128(rx, voff, sx + rb * 16 * DM * 4 + 64 * ((s0_) + j), 0)); \
            _Pragma("unroll") for (int cb = 0; cb < 3; ++cb) W_[j][cb] = __builtin_bit_cast(f32x4, __builtin_amdgcn_raw_buffer_load_b128(rw, voff, sw + cb * 16 * DM * 4 + 64 * ((s0_) + j), 0)); } } while (0)
#define RT_MMA(X_, W_) do { _Pragma("unroll") for (int j = 0; j < 2; ++j) _Pragma("unroll") for (int rb = 0; rb < 4; ++rb) { const f32x4 xa = X_[j][rb]; ss[rb] += (xa[0] * xa[0] + xa[1] * xa[1]) + (xa[2] * xa[2] + xa[3] * xa[3]); \
            _Pragma("unroll") for (int e = 0; e < 4; ++e) _Pragma("unroll") for (int cb = 0; cb < 3; ++cb) acc[rb][cb] = __builtin_amdgcn_mfma_f32_16x16x4f32(xa[e], W_[j][cb][e], acc[rb][cb], 0, 0, 0); } } while (0)
        RT_LOAD(xA, wA, 0); RT_LOAD(xB, wB, 2); SBAR();
        RT_MMA(xA, wA); SBAR(); RT_LOAD(xA, wA, 4); SBAR();
        RT_MMA(xB, wB); SBAR(); RT_LOAD(xB, wB, 6); SBAR();
        RT_MMA(xA, wA); SBAR();
        RT_MMA(xB, wB);
#undef RT_LOAD
#undef RT_MMA
#pragma unroll
        for (int rb = 0; rb < 4; ++rb) { ss[rb] += __shfl_xor(ss[rb], 16); ss[rb] += __shfl_xor(ss[rb], 32);
#pragma unroll
            for (int cb = 0; cb < 3; ++cb)
#pragma unroll
                for (int reg = 0; reg < 4; ++reg) Pw[(16 * rb + 4 * kq + reg) * 48 + 16 * cb + i16] = acc[rb][cb][reg];
            if (kq == 0) ssP[F.wid * 64 + 16 * rb + i16] = ss[rb]; }
        LDS_WAIT(); asm volatile("" ::: "memory");
        target += 8u;
        if (F.lane == 0) atomicAdd((unsigned*)(LAS unsigned*)rcnt, 1u);
        while (rcnt[0] < target) __builtin_amdgcn_s_sleep(1);
        asm volatile("" ::: "memory");
        if (F.wid == 0) { const int tl = F.lane;
            const LAS float* q0 = (const LAS float*)(F.lds) + tl * 48;
#define PL(i_) (((q0[(i_)] + q0[4096 + (i_)]) + (q0[8192 + (i_)] + q0[12288 + (i_)])) + ((q0[16384 + (i_)] + q0[20480 + (i_)]) + (q0[24576 + (i_)] + q0[28672 + (i_)])))
            const float rr = rsqrtf((((ssP[tl] + ssP[64 + tl]) + (ssP[128 + tl] + ssP[192 + tl])) + ((ssP[256 + tl] + ssP[320 + tl]) + (ssP[384 + tl] + ssP[448 + tl]))) * (1.f / DM) + EPS);
            float gl[4];
#pragma unroll
            for (int i = 0; i < 4; ++i) gl[i] = PL(i) * rr + brg[i];
            int g = 0; float gm = gl[0];
#pragma unroll
            for (int i = 1; i < 4; ++i) if (gl[i] > gm) { gm = gl[i]; g = i; }
            float gs = 0.f;
#pragma unroll
            for (int i = 0; i < 4; ++i) gs += expf(gl[i] - gm);
            const float ggate = 1.f / gs;
            float el[8];
#pragma unroll
            for (int i = 0; i < 8; ++i) el[i] = PL(4 + g * 8 + i) * rr + bre[g * 8 + i];
#undef PL
            int i1 = 0; float v1 = el[0];
#pragma unroll
            for (int i = 1; i < 8; ++i) if (el[i] > v1) { v1 = el[i]; i1 = i; }
            int i2 = -1; float v2 = -__builtin_inff();
#pragma unroll
            for (int i = 0; i < 8; ++i) if (i != i1 && el[i] > v2) { v2 = el[i]; i2 = i; }
            const float a = expf(v2 - v1), w1 = 1.f / (1.f + a), w2 = a / (1.f + a);
            const int t = t0 + tl, e1 = g * 8 + i1, e2 = g * 8 + i2;
            const unsigned long long lt = (1ull << F.lane) - 1ull;
            int cnt = 0, l1 = 0, l2 = 0;
            for (int e = 0; e < NE; ++e) { const unsigned long long m1 = __ballot(e1 == e), m2 = __ballot(e2 == e); const int c1 = __popcll(m1);
                if (F.lane == e) cnt = c1 + __popcll(m2);
                if (e1 == e) l1 = __popcll(m1 & lt);
                if (e2 == e) l2 = c1 + __popcll(m2 & lt); }
            int base = 0; if (F.lane < NE && cnt > 0) base = (int)atomicAdd(F.ctl + CW_CNT + F.lane * CW_CNT_STRIDE, (unsigned)cnt);
            const int r1 = __shfl(base, e1) + l1, r2 = __shfl(base, e2) + l2;
            rowtok[e1 * ECAP + r1] = t; roww[e1 * ECAP + r1] = ggate * w1; rowrr[e1 * ECAP + r1] = rr; rowtok[e2 * ECAP + r2] = t; roww[e2 * ECAP + r2] = ggate * w2; rowrr[e2 * ECAP + r2] = rr;
            tokpos[2 * t] = (e1 << ECAP_LOG) | r1; tokpos[2 * t + 1] = (e2 << ECAP_LOG) | r2; }
        LDS_WAIT(); asm volatile("" ::: "memory");
        target += 8u;
        if (F.lane == 0) atomicAdd((unsigned*)(LAS unsigned*)rcnt, 1u);
        while (rcnt[0] < target) __builtin_amdgcn_s_sleep(1);
        asm volatile("" ::: "memory");
      }
    }
}
__device__ __forceinline__ void moe_offsets(Frame& F, LAS int* offs) {
    __syncthreads();
    if (F.tid < 64) { const int c = F.tid < NE ? (int)__hip_atomic_load(F.ctl + CW_CNT + F.tid * CW_CNT_STRIDE, __ATOMIC_RELAXED, __HIP_MEMORY_SCOPE_AGENT) : 0; const int p = (c + 255) & ~255; int incl = p;
#pragma unroll
        for (int o = 1; o < 32; o <<= 1) { const int v = __shfl_up(incl, o); if ((F.tid & 63) >= o) incl += v; }
        if (F.tid < NE) { offs[F.tid] = incl - p; offs[40 + F.tid] = c; for (int t = (incl - p) >> 8; t < (incl >> 8); ++t) offs[80 + t] = F.tid; } if (F.tid == NE - 1) offs[NE] = incl; }
    __syncthreads();
}
__device__ __forceinline__ int expert_of_row(LAS int* offs, int row) { return offs[80 + (row >> 8)]; }
__device__ __forceinline__ void moe_gemm1(Frame& F, LAS int* offs, int G, int c, int lo, int hi) {
    MoeOrder S{offs, 2, G, c, lo, hi};
    pg8::Gemm g{(const bf16_t*)(F.ws + WS_H2), (const bf16_t*)(F.ws + WS_W13T), DM, (const int*)(F.ws + WS_ROUTE + RT_ROWTOK)}; EpiSwiglu E{(const float*)(F.ws + WS_ROUTE + RT_ROWW), (const float*)(F.ws + WS_ROUTE + RT_ROWRR), (bf16_t*)(F.ws + WS_HID)};
    pg8::gemm_phase<EpiSwiglu, MoeOrder, PG8_ALIGN, PG8_SP2, false, true>(F.lds, g, S, E);
}
__device__ __forceinline__ void moe_gemm2(Frame& F, LAS int* offs, int G, int c, int lo, int hi) {
    MoeOrder S{offs, 4, G, c, lo, hi};
    int kde = DE; asm volatile("" : "+s"(kde));
    pg8::Gemm g{(const bf16_t*)(F.ws + WS_HID), (const bf16_t*)(F.ws + WS_W2T), kde, nullptr}; EpiY E{(bf16_t*)(F.ws + WS_YBUF)};
    pg8::gemm_phase<EpiY, MoeOrder, PG8_ALIGN, PG8_SP2, false>(F.lds, g, S, E);
}
__device__ __forceinline__ int moe_vblk(Frame& F) { return (F.G % 8 == 0) ? (F.blk % 8) * (F.G / 8) + F.blk / 8 : F.blk; }
__device__ __forceinline__ void p7_moe_a(Frame& F) {
    LAS int* offs = (LAS int*)(F.lds + 140 * 1024); moe_offsets(F, offs);
    const int n1 = (offs[NE] / 256) * 2;
    moe_gemm1(F, offs, F.G, moe_vblk(F), 0, n1 < F.G ? n1 : F.G);
}
__device__ __forceinline__ void p7_moe_b(Frame& F) {
    LAS int* offs = (LAS int*)(F.lds + 140 * 1024); if (F.a->ph_lo == 7) moe_offsets(F, offs);
    const int T = offs[NE] / 256, n1 = T * 2; int nrem = n1 - F.G; if (nrem < 0) nrem = 0; if (nrem > F.G / 2) nrem = F.G / 2;
    const int t2 = (T < F.G / 2 ? T : F.G / 2) * 4;
    const int vb = moe_vblk(F);
    if (vb < nrem) moe_gemm1(F, offs, nrem, vb, F.G, n1);
    else moe_gemm2(F, offs, F.G - nrem, vb - nrem, 0, t2);
}
__device__ __forceinline__ void p8_moe_c(Frame& F) {
    LAS int* offs = (LAS int*)(F.lds + 140 * 1024); if (F.a->ph_lo == 8) moe_offsets(F, offs);
    const int T = offs[NE] / 256;
    moe_gemm2(F, offs, F.G, moe_vblk(F), (T < F.G / 2 ? T : F.G / 2) * 4, T * 4);
}
__device__ __forceinline__ void p9_combine(Frame& F) {
    LAS int* offs = (LAS int*)(F.lds + 140 * 1024);
    if (F.a->ph_lo == 9) moe_offsets(F, offs);
    const bf16_t* YB = (const bf16_t*)(F.ws + WS_YBUF); const int* tokpos = (const int*)(F.ws + WS_ROUTE + RT_TOKPOS);
    for (int t0 = F.gw * 4; t0 < M; t0 += F.NGW * 4) { int p[4][2];
#pragma unroll
        for (int q = 0; q < 4; ++q) { const int a0 = tokpos[2 * (t0 + q)], a1 = tokpos[2 * (t0 + q) + 1]; p[q][0] = offs[a0 >> ECAP_LOG] + (a0 & (ECAP - 1)); p[q][1] = offs[a1 >> ECAP_LOG] + (a1 & (ECAP - 1)); }
        f32x4 xv[4][4];
#pragma unroll
        for (int q = 0; q < 4; ++q)
#pragma unroll
            for (int j = 0; j < 4; ++j) xv[q][j] = __builtin_nontemporal_load((const f32x4*)(F.out + (size_t)(t0 + q) * DM) + F.lane + 64 * j);
#pragma unroll
        for (int q = 0; q < 4; ++q) {
            f32x4 a[4], b[4];
#pragma unroll
            for (int j = 0; j < 4; ++j) { a[j] = ld4(YB + (size_t)p[q][0] * DM + 4 * F.lane + 256 * j); b[j] = ld4(YB + (size_t)p[q][1] * DM + 4 * F.lane + 256 * j); }
#pragma unroll
            for (int j = 0; j < 4; ++j) __builtin_nontemporal_store(xv[q][j] + (a[j] + b[j]), (f32x4*)(F.out + (size_t)(t0 + q) * DM) + F.lane + 64 * j); } }
}

#define XB_TMO      128
#define XB_XCNT(j)  (256  + 64 * (j))
#define XB_XSUB(j)  (1280 + 64 * (j))
#define XB_XGEN(j)  (2304 + 64 * (j))
#define XB_TOP      3328
#define XB_TOPGEN   3392
#define XCD_BAR_WORDS 3456
#define XB_SPIN_CAP (1u << 22)

__device__ __forceinline__ unsigned xb_ld(unsigned* p)              { return __hip_atomic_load(p, __ATOMIC_RELAXED, __HIP_MEMORY_SCOPE_AGENT); }
__device__ __forceinline__ unsigned xb_add(unsigned* p, unsigned v) { return __hip_atomic_fetch_add(p, v, __ATOMIC_RELAXED, __HIP_MEMORY_SCOPE_AGENT); }
__device__ __forceinline__ unsigned xb_xcc_id() { return (unsigned)__builtin_amdgcn_s_getreg((3 << 11) | 20) & 0xFu; }
#define XB_SPIN(cond, bar) do { unsigned _sp = 0; while (cond) { __builtin_amdgcn_s_sleep(1); \
    if ((++_sp & 255u) == 0u) { if (xb_ld(&(bar)[XB_TMO])) break; if (_sp > XB_SPIN_CAP) { atomicAdd(&(bar)[XB_TMO], 1u); break; } } } } while (0)

struct XcdBarrier {
    unsigned* bar; unsigned x;
    volatile LAS unsigned* st;
};

__device__ __forceinline__ XcdBarrier xcd_barrier_post(unsigned* bar, volatile LAS unsigned* st) {
    XcdBarrier b; b.bar = bar; b.x = xb_xcc_id(); b.st = st;
    if (threadIdx.x == 0) (void)xb_add(&bar[XB_XCNT(b.x)], 1u);
    return b;
}
__device__ __forceinline__ void xcd_barrier_complete(unsigned* bar, unsigned x, unsigned& nloc, unsigned& nx) {
    const unsigned G = gridDim.x * gridDim.y * gridDim.z;
    unsigned sum, cnt, mine, sp = 0u;
    for (;;) {
        sum = 0u; cnt = 0u; mine = 0u;
#pragma unroll
        for (unsigned j = 0; j < 16; ++j) { const unsigned c = xb_ld(&bar[XB_XCNT(j)]); sum += c; cnt += (c > 0u) ? 1u : 0u; mine = (j == x) ? c : mine; }
        if (sum == G) break;
        __builtin_amdgcn_s_sleep(1);
        if ((++sp & 255u) == 0u) { if (xb_ld(&bar[XB_TMO])) break; if (sp > XB_SPIN_CAP) { atomicAdd(&bar[XB_TMO], 1u); break; } }
    }
    nloc = mine > 0u ? mine : 1u; nx = cnt > 0u ? cnt : 1u;
}

__device__ __forceinline__ void xcd_barrier(const XcdBarrier& b) {
    asm volatile("s_waitcnt vmcnt(0)" ::: "memory");
    __syncthreads();
    if (threadIdx.x == 0) {
        unsigned* bar = b.bar;
        __builtin_amdgcn_s_waitcnt(0);
        unsigned nloc = b.st[0], nx = b.st[1];
        if (nloc == 0u) { xcd_barrier_complete(bar, b.x, nloc, nx); b.st[0] = nloc; b.st[1] = nx; }
        const unsigned old = xb_add(&bar[XB_XSUB(b.x)], 1u);
        const unsigned gen = old / nloc;
        if (old + 1u == (gen + 1u) * nloc) {
            __builtin_amdgcn_fence(__ATOMIC_RELEASE, "agent");
            asm volatile("s_waitcnt vmcnt(0)" ::: "memory");
            const unsigned og = xb_add(&bar[XB_TOP], 1u);
            const unsigned tg = og / nx;
            if (og + 1u == (tg + 1u) * nx) xb_add(&bar[XB_TOPGEN], 1u);
            else XB_SPIN(xb_ld(&bar[XB_TOPGEN]) == tg, bar);
            __builtin_amdgcn_fence(__ATOMIC_ACQUIRE, "agent");
            xb_add(&bar[XB_XGEN(b.x)], 1u);
            asm volatile("s_waitcnt vmcnt(0)" ::: "memory");
        } else {
            XB_SPIN(xb_ld(&bar[XB_XGEN(b.x)]) == gen, bar);
            __builtin_amdgcn_fence(__ATOMIC_ACQUIRE, "agent");
            asm volatile("s_waitcnt vmcnt(0)" ::: "memory");
        }
    }
    __syncthreads();
}
constexpr int LDS_BYTES = 147456;
__global__ void __launch_bounds__(NTHREADS, 2) fwd_kernel(Args args) {
    extern __shared__ __attribute__((aligned(16))) unsigned char lds[];
    Frame F;
    F.lds = (LAS unsigned char*)lds; F.ldsg = (char*)lds;
    F.tid = threadIdx.x; F.lane = F.tid & 63; F.wid = __builtin_amdgcn_readfirstlane(F.tid >> 6);
    F.blk = blockIdx.x; F.G = gridDim.x; F.gw = F.blk * NWAVES + F.wid; F.NGW = F.G * NWAVES;
    F.a = &args;
    F.out = args.out; F.ws = args.ws; F.ctl = g_ctl;
    const int lo = args.ph_lo, hi = args.ph_hi;
#if MK_ONE_LAUNCH
    cg::grid_group grid = cg::this_grid();
    volatile LAS unsigned* bst = (volatile LAS unsigned*)(F.lds + 144 * 1024 - 16);
    if (F.tid < 2) bst[F.tid] = 0u;
    __syncthreads();
    const XcdBarrier bar = xcd_barrier_post(F.ctl + CW_BAR, bst);
#define SEAM(k) do { if (lo <= (k) && (k) + 1 < hi) { xcd_barrier(bar); } asm volatile("" : "+v"(F.tid), "+v"(F.lane)); } while (0)
    if (hi > NPHASE) grid.sync();
#else
#define SEAM(k) do { } while (0)
#endif
#define IN(k) (lo <= (k) && (k) < hi)
    if (IN(0)) { p0_prologue(F); } SEAM(0);
    if (IN(1)) { p1_proj(F); } SEAM(1);
    if (IN(2)) { p2_mixer_a(F); p2_attention(F); } SEAM(2);
    if (IN(3)) { p3_merged(F); } SEAM(3);
    if (IN(4)) { p4_out(F); } SEAM(4);
    if (IN(5)) { p5_router(F); } SEAM(5);
    if (IN(6)) { p7_moe_a(F); } SEAM(6);
    if (IN(7)) { p7_moe_b(F); } SEAM(7);
    if (IN(8)) { p8_moe_c(F); } SEAM(8);
    if (IN(9)) { p9_combine(F); }
#if MK_ONE_LAUNCH
    __syncthreads();
    if (F.tid == 0) { __threadfence(); bst[0] = atomicAdd(F.ctl + CW_DONE, 1u) == (unsigned)F.G - 1u ? 1u : 0u; }
    __syncthreads();
    if (bst[0]) { __threadfence();
        for (int i = F.tid; i < (int)(CTL_ZERO_BYTES / 16); i += NTHREADS) ((u32x4*)F.ctl)[i] = (u32x4){0u, 0u, 0u, 0u}; }
#endif
#undef IN
#undef SEAM
}

extern "C" void kernel_launch(void* const* d_in, const int* in_sizes, int n_in, void* d_out, int out_size, void* d_ws, size_t ws_size, hipStream_t stream) {
    static int grid = 0;
    if (grid == 0) {
        if (n_in != 26 || out_size != M * DM || ws_size < WS_END) { fprintf(stderr, "kernel_launch: unexpected shapes (n_in %d out %d ws %zu)\n", n_in, out_size, ws_size); grid = -1; return; }
        int dev = 0, cus = 0, per_cu = 0;
        (void)hipGetDevice(&dev); (void)hipDeviceGetAttribute(&cus, hipDeviceAttributeMultiprocessorCount, dev);
        if (hipFuncSetAttribute((const void*)fwd_kernel, hipFuncAttributeMaxDynamicSharedMemorySize, LDS_BYTES) != hipSuccess) { fprintf(stderr, "kernel_launch: hipFuncSetAttribute failed\n"); grid = -1; return; }
        if (hipOccupancyMaxActiveBlocksPerMultiprocessor(&per_cu, (const void*)fwd_kernel, NTHREADS, LDS_BYTES) != hipSuccess || per_cu < 1) { fprintf(stderr, "kernel_launch: occupancy query says %d\n", per_cu); per_cu = 1; }
        (void)hipGetLastError();
        grid = cus;
    }
    if (grid < 0) return;
    Args a{};
    for (int i = 0; i < 26; ++i) a.in[i] = (const float*)d_in[i];
    a.out = (float*)d_out; a.ws = (unsigned char*)d_ws;
#if MK_ONE_LAUNCH
    a.ph_lo = 0; a.ph_hi = NPHASE;
    void* kargs[] = {&a};
    hipError_t e = hipLaunchCooperativeKernel((const void*)fwd_kernel, dim3(grid), dim3(NTHREADS), kargs, LDS_BYTES, stream);
    if (e != hipSuccess) fprintf(stderr, "cooperative launch failed: %s (grid %d)\n", hipGetErrorString(e), grid);
#else
    for (int p = 0; p < NPHASE; ++p) { a.ph_lo = p; a.ph_hi = p + 1; hipLaunchKernelGGL(fwd_kernel, dim3(grid), dim3(NTHREADS), LDS_BYTES, stream, a); }
#endif
}
```
